# Optimizing an MI355X kernel written in HIP

```python
import math
import jax, jax.numpy as jnp
from jax import lax
import numpy as np

D_MODEL = 2048
BATCH = 4
SEQ = 2048
DEPTH = 2

CHUNK = 64
Q_BLOCK = 128
NORM_EPS = 1e-6
DN_HEADS = 8
DN_HEAD_DIM = 128
DN_WIDTH = DN_HEADS * DN_HEAD_DIM
DN_CONV = 4
SG_GROUPS = 8
SG_GROUP_DIM = 128
SG_WIDTH = SG_GROUPS * SG_GROUP_DIM
SG_BLOCK = 128
MLA_HEADS = 8
MLA_Q_RANK = 512
MLA_KV_RANK = 512
MLA_NOPE = 128
MLA_ROPE = 64
MLA_V = 128
ROPE_THETA = 10000.0
N_BRANCH = 3
BRANCH_WIDTH = 1024
D_FF = 5632
IN_COLS = (4 * DN_WIDTH + 2 * DN_HEADS) + 2 * SG_WIDTH + (MLA_Q_RANK + MLA_KV_RANK + MLA_ROPE) + N_BRANCH * D_MODEL

kernel_name = "hybrid_deltanet_gmlp_mla_macaron"


def rms_norm(x, g, eps=NORM_EPS):
    xf = x.astype(jnp.float32)
    y = xf * lax.rsqrt(jnp.mean(xf * xf, axis=-1, keepdims=True) + eps)
    return (y * g.astype(jnp.float32)).astype(x.dtype)


def layer_norm(x, g, b, eps=1e-5):
    xf = x.astype(jnp.float32)
    mu = jnp.mean(xf, axis=-1, keepdims=True)
    var = jnp.mean(jnp.square(xf - mu), axis=-1, keepdims=True)
    y = (xf - mu) * lax.rsqrt(var + eps) * g.astype(jnp.float32) + b.astype(jnp.float32)
    return y.astype(x.dtype)


def l2_normalize(x, eps=1e-6):
    return x * lax.rsqrt(jnp.sum(x * x, axis=-1, keepdims=True) + eps)


def swiglu(h, w_gate, w_up, w_down):
    return (jax.nn.silu(h @ w_gate) * (h @ w_up)) @ w_down


def causal_conv(x, w):
    k_len, ch = w.shape
    return lax.conv_general_dilated(x, w[:, None, :], window_strides=(1,), padding=[(k_len - 1, 0)],
                                    dimension_numbers=("NWC", "WIO", "NWC"), feature_group_count=ch)


def apply_rope(x, cos, sin):
    xf = x.astype(jnp.float32)
    x1, x2 = jnp.split(xf, 2, axis=-1)
    return jnp.concatenate([x1 * cos - x2 * sin, x1 * sin + x2 * cos], axis=-1).astype(x.dtype)


def _offsets(sizes):
    out, acc = [], 0
    for s in sizes:
        acc += s
        out.append(acc)
    return out


def chunk_gated_delta(q, k, v, g, beta):
    B, S, H, DK = q.shape
    DV = v.shape[-1]
    N = S // CHUNK

    def to_chunks(t):
        return t.reshape((B, N, CHUNK) + t.shape[2:]).swapaxes(2, 3)

    q, k, v, g, beta = (to_chunks(t) for t in (q, k, v, g, beta))
    g = jnp.cumsum(g, axis=-1)
    idx = jnp.arange(CHUNK)
    incl = idx[:, None] >= idx[None, :]
    strict = idx[:, None] > idx[None, :]
    decay = jnp.exp(jnp.where(incl, g[..., :, None] - g[..., None, :], -jnp.inf))
    k_beta = k * beta[..., None]
    a_mat = jnp.where(strict, jnp.einsum("bnhid,bnhjd->bnhij", k_beta, k) * decay, 0.0)
    rhs = jnp.concatenate([k_beta * jnp.exp(g)[..., None], v * beta[..., None]], axis=-1)
    sol = lax.linalg.triangular_solve(a_mat + jnp.eye(CHUNK, dtype=a_mat.dtype), rhs,
                                      left_side=True, lower=True, unit_diagonal=True)
    w, u = sol[..., :DK], sol[..., DK:]
    qk = jnp.einsum("bnhid,bnhjd->bnhij", q, k) * decay

    def step(state, inp):
        q_c, k_c, u_c, w_c, g_c, qk_c = inp
        v_new = u_c - jnp.einsum("bhcd,bhde->bhce", w_c, state)
        o_c = (jnp.einsum("bhcd,bhde->bhce", q_c * jnp.exp(g_c)[..., None], state)
               + jnp.einsum("bhij,bhje->bhie", qk_c, v_new))
        g_last = g_c[..., -1:]
        state = (state * jnp.exp(g_last)[..., None]
                 + jnp.einsum("bhcd,bhce->bhde", k_c * jnp.exp(g_last - g_c)[..., None], v_new))
        return state, o_c

    state0 = jnp.zeros((B, H, DK, DV), q.dtype)
    xs = tuple(t.swapaxes(0, 1) for t in (q, k, u, w, g, qk))
    _, o = lax.scan(step, state0, xs)
    return o.transpose(1, 0, 3, 2, 4).reshape(B, S, H, DV)


def deltanet_branch(qkv, z, a, b, conv_w, a_log, dt_bias, norm_g):
    B, S, _ = qkv.shape
    f32 = jnp.float32
    qkv = jax.nn.silu(causal_conv(qkv, conv_w))
    q, k, v = [t.reshape(B, S, DN_HEADS, DN_HEAD_DIM).astype(f32) for t in jnp.split(qkv, 3, axis=-1)]
    q = l2_normalize(q) * (DN_HEAD_DIM ** -0.5)
    k = l2_normalize(k)
    beta = jax.nn.sigmoid(b.astype(f32))
    g = -jnp.exp(a_log.astype(f32)) * jax.nn.softplus(a.astype(f32) + dt_bias.astype(f32))
    o = chunk_gated_delta(q, k, v, g, beta)
    o = rms_norm(o, norm_g) * jax.nn.silu(z.reshape(B, S, DN_HEADS, DN_HEAD_DIM).astype(f32))
    return o.reshape(B, S, DN_WIDTH).astype(qkv.dtype)


def spatial_gating_branch(sg_in, ln_g, ln_b, w_s, b_s):
    B, S, _ = sg_in.shape
    zz = jax.nn.gelu(sg_in, approximate=False)
    u, v = jnp.split(zz, 2, axis=-1)
    v = layer_norm(v, ln_g, ln_b)
    v = v.reshape(B, S // SG_BLOCK, SG_BLOCK, SG_GROUPS, SG_GROUP_DIM)
    chunk_id = jnp.arange(SG_BLOCK) // CHUNK
    mask = chunk_id[None, :] <= chunk_id[:, None]
    w = jnp.where(mask[None], w_s, 0.0)
    mixed = jnp.einsum("gij,bnjgc->bnigc", w.astype(v.dtype), v) + b_s.T[:, :, None].astype(v.dtype)
    return u * mixed.reshape(B, S, SG_WIDTH)


def mla_branch(cq, ckv, kr, cos, sin, cq_g, ckv_g, w_uq, w_ukv):
    B, S, _ = cq.shape
    q = (rms_norm(cq, cq_g) @ w_uq).reshape(B, S, MLA_HEADS, MLA_NOPE + MLA_ROPE)
    q_nope = q[..., :MLA_NOPE]
    q_rope = apply_rope(q[..., MLA_NOPE:], cos[:, :, None], sin[:, :, None])
    kv = (rms_norm(ckv, ckv_g) @ w_ukv).reshape(B, S, MLA_HEADS, MLA_NOPE + MLA_V)
    k_nope, v = kv[..., :MLA_NOPE], kv[..., MLA_NOPE:]
    k_rope = apply_rope(kr, cos, sin)
    nb = S // Q_BLOCK
    qn_blocks = q_nope.reshape(B, nb, Q_BLOCK, MLA_HEADS, MLA_NOPE).swapaxes(0, 1)
    qr_blocks = q_rope.reshape(B, nb, Q_BLOCK, MLA_HEADS, MLA_ROPE).swapaxes(0, 1)
    key_chunk = jnp.arange(S) // CHUNK
    scale = (MLA_NOPE + MLA_ROPE) ** -0.5

    def attend(args):
        blk, qn, qr = args
        q_chunk = (blk * Q_BLOCK + jnp.arange(Q_BLOCK)) // CHUNK
        s = (jnp.einsum("bqhd,bkhd->bhqk", qn, k_nope, preferred_element_type=jnp.float32)
             + jnp.einsum("bqhd,bkd->bhqk", qr, k_rope, preferred_element_type=jnp.float32)) * scale
        s = jnp.where(key_chunk[None, :] <= q_chunk[:, None], s, -1e30)
        p = jax.nn.softmax(s, axis=-1)
        return jnp.einsum("bhqk,bkhd->bqhd", p.astype(v.dtype), v)

    o = lax.map(attend, (jnp.arange(nb), qn_blocks, qr_blocks))
    return o.swapaxes(0, 1).reshape(B, S, MLA_HEADS * MLA_V)


def hybrid_mixer(h, cos, sin, w_in, conv_w, a_log, dt_bias, dn_g, ln_g, ln_b, sg_w, sg_b,
                 cq_g, ckv_g, w_uq, w_ukv, w_branch, w_out):
    B, S, D = h.shape
    proj = h @ w_in
    sizes = [3 * DN_WIDTH, DN_WIDTH, DN_HEADS, DN_HEADS, 2 * SG_WIDTH, MLA_Q_RANK, MLA_KV_RANK, MLA_ROPE]
    qkv, z, a, b, sg_in, cq, ckv, kr, gate_logits = jnp.split(proj, _offsets(sizes), axis=-1)
    o_a = deltanet_branch(qkv, z, a, b, conv_w, a_log, dt_bias, dn_g)
    o_b = spatial_gating_branch(sg_in, ln_g, ln_b, sg_w, sg_b)
    o_c = mla_branch(cq, ckv, kr, cos, sin, cq_g, ckv_g, w_uq, w_ukv)
    ys = jnp.stack([o_a, o_b, o_c], axis=2)
    y = jnp.einsum("bsnw,nwd->bsnd", ys, w_branch)
    gates = jax.nn.sigmoid(gate_logits.astype(jnp.float32)).reshape(B, S, N_BRANCH, D)
    merged = jnp.sum(gates.astype(y.dtype) * y, axis=2)
    return merged @ w_out


def setup_inputs(seed: int = 0) -> dict:
    key = jax.random.key(seed)
    ks = jax.random.split(key, 24)
    f32 = jnp.float32

    def nrm(k, shape, fan_in):
        return jax.random.normal(k, shape, f32) * (fan_in ** -0.5)

    def gain(k, shape):
        return 1.0 + 0.05 * jax.random.normal(k, shape, f32)

    x = jax.random.normal(ks[0], (BATCH, SEQ, D_MODEL), f32)
    offset = jax.random.randint(ks[1], (BATCH, 1), 0, 64, dtype=jnp.int32) * CHUNK
    positions = (offset + jnp.arange(SEQ, dtype=jnp.int32)[None, :]).astype(jnp.int32)
    dt = jnp.exp(jax.random.uniform(ks[11], (DEPTH, DN_HEADS), f32, math.log(1e-3), math.log(1e-1)))
    return {
        "x": x,
        "positions": positions,
        "norm_g": gain(ks[2], (DEPTH, 6, D_MODEL)),
        "ffn_w_gate": nrm(ks[3], (DEPTH, 2, D_MODEL, D_FF), D_MODEL),
        "ffn_w_up": nrm(ks[4], (DEPTH, 2, D_MODEL, D_FF), D_MODEL),
        "ffn_w_down": nrm(ks[5], (DEPTH, 2, D_FF, D_MODEL), D_FF),
        "w_in": nrm(ks[6], (DEPTH, D_MODEL, IN_COLS), D_MODEL),
        "dn_conv_w": nrm(ks[7], (DEPTH, DN_CONV, 3 * DN_WIDTH), DN_CONV),
        "dn_a_log": jnp.log(jax.random.uniform(ks[8], (DEPTH, DN_HEADS), f32, 1.0, 16.0)),
        "dn_dt_bias": dt + jnp.log(-jnp.expm1(-dt)),
        "dn_norm_g": gain(ks[9], (DEPTH, DN_HEAD_DIM)),
        "sg_ln_g": gain(ks[10], (DEPTH, SG_WIDTH)),
        "sg_ln_b": 0.02 * jax.random.normal(ks[12], (DEPTH, SG_WIDTH), f32),
        "sg_w": nrm(ks[13], (DEPTH, SG_GROUPS, SG_BLOCK, SG_BLOCK), SG_BLOCK),
        "sg_b": 1.0 + 0.1 * jax.random.normal(ks[14], (DEPTH, SG_GROUPS, SG_BLOCK), f32),
        "mla_cq_norm_g": gain(ks[15], (DEPTH, MLA_Q_RANK)),
        "mla_ckv_norm_g": gain(ks[16], (DEPTH, MLA_KV_RANK)),
        "mla_w_uq": nrm(ks[17], (DEPTH, MLA_Q_RANK, MLA_HEADS * (MLA_NOPE + MLA_ROPE)), MLA_Q_RANK),
        "mla_w_ukv": nrm(ks[18], (DEPTH, MLA_KV_RANK, MLA_HEADS * (MLA_NOPE + MLA_V)), MLA_KV_RANK),
        "w_branch": nrm(ks[19], (DEPTH, N_BRANCH, BRANCH_WIDTH, D_MODEL), BRANCH_WIDTH),
        "w_out": nrm(ks[20], (DEPTH, D_MODEL, D_MODEL), D_MODEL),
    }


def reference(x, positions, norm_g, ffn_w_gate, ffn_w_up, ffn_w_down, w_in, dn_conv_w, dn_a_log,
              dn_dt_bias, dn_norm_g, sg_ln_g, sg_ln_b, sg_w, sg_b, mla_cq_norm_g, mla_ckv_norm_g,
              mla_w_uq, mla_w_ukv, w_branch, w_out):
    inv_freq = jnp.power(ROPE_THETA, -jnp.arange(0, MLA_ROPE, 2, dtype=jnp.float32) / MLA_ROPE)
    ang = positions.astype(jnp.float32)[..., None] * inv_freq
    cos, sin = jnp.cos(ang), jnp.sin(ang)
    for l in range(DEPTH):
        ng = norm_g[l]
        f = swiglu(rms_norm(x, ng[0]), ffn_w_gate[l, 0], ffn_w_up[l, 0], ffn_w_down[l, 0])
        x = x + 0.5 * rms_norm(f, ng[1])
        h = rms_norm(x, ng[2])
        m = hybrid_mixer(h, cos, sin, w_in[l], dn_conv_w[l], dn_a_log[l], dn_dt_bias[l], dn_norm_g[l],
                         sg_ln_g[l], sg_ln_b[l], sg_w[l], sg_b[l], mla_cq_norm_g[l], mla_ckv_norm_g[l],
                         mla_w_uq[l], mla_w_ukv[l], w_branch[l], w_out[l])
        x = x + rms_norm(m, ng[3])
        f = swiglu(rms_norm(x, ng[4]), ffn_w_gate[l, 1], ffn_w_up[l, 1], ffn_w_down[l, 1])
        x = x + 0.5 * rms_norm(f, ng[5])
    return x
```

```cpp
#include <hip/hip_runtime.h>
#include <hip/hip_cooperative_groups.h>
#include <cstdio>
namespace cg = cooperative_groups;

#define LAS __attribute__((address_space(3)))
typedef unsigned short bf16_t;
typedef short bf16x8 __attribute__((ext_vector_type(8)));
typedef short s16x4 __attribute__((ext_vector_type(4)));
typedef float f32x4 __attribute__((ext_vector_type(4)));
typedef float f32x2 __attribute__((ext_vector_type(2)));
typedef unsigned u32x4 __attribute__((ext_vector_type(4)));
typedef unsigned u32x2 __attribute__((ext_vector_type(2)));

constexpr int T_ = 8192, DM = 2048, FF = 5632, NIN = 13392, NINP = 13568, SEQ_ = 2048;
constexpr int LDS_BYTES = 151552;
constexpr float EPS = 1e-6f;

constexpr size_t al256(size_t x) { return (x + 255) & ~(size_t)255; }
constexpr size_t OFF_WGU = 0;
constexpr size_t OFF_WDN = OFF_WGU + (size_t)2 * 11264 * 2048 * 2;
constexpr size_t OFF_WIN = OFF_WDN + (size_t)2 * 2048 * 5632 * 2;
constexpr size_t OFF_WUQ = OFF_WIN + (size_t)NINP * 2048 * 2;
constexpr size_t OFF_WUKV = OFF_WUQ + (size_t)1536 * 512 * 2;
constexpr size_t OFF_WBR = OFF_WUKV + (size_t)2048 * 512 * 2;
constexpr size_t OFF_WOUT = OFF_WBR + (size_t)3 * 2048 * 1024 * 2;
constexpr size_t OFF_SGW = OFF_WOUT + (size_t)2048 * 2048 * 2;
constexpr size_t OFF_H = OFF_SGW + (size_t)8 * 128 * 128 * 2;
constexpr size_t OFF_F = OFF_H + (size_t)T_ * 2048 * 2;
constexpr size_t OFF_GATE = OFF_F + (size_t)T_ * 2048 * 4;
constexpr size_t OFF_QKV = OFF_GATE + (size_t)T_ * 6144 * 2;
constexpr size_t OFF_Z = OFF_QKV + (size_t)T_ * 3072 * 2;
constexpr size_t OFF_SG = OFF_Z + (size_t)T_ * 1024 * 2;
constexpr size_t OFF_CQ = OFF_SG + (size_t)T_ * 2048 * 2;
constexpr size_t OFF_CKV = OFF_CQ + (size_t)T_ * 512 * 2;
constexpr size_t OFF_MISC = OFF_CKV + (size_t)T_ * 512 * 2;
constexpr size_t OFF_DW = OFF_MISC + (size_t)T_ * 128 * 4;
constexpr size_t OFF_DQG = OFF_DW + (size_t)1024 * 8192 * 2;
constexpr size_t OFF_DKGT = OFF_DQG + (size_t)1024 * 8192 * 2;
constexpr size_t OFF_DUT = OFF_DKGT + (size_t)1024 * 8192 * 2;
constexpr size_t OFF_DQK = OFF_DUT + (size_t)1024 * 8192 * 2;
constexpr size_t OFF_DEG = OFF_DQK + (size_t)1024 * 4096 * 2;
constexpr size_t OFF_QB = OFF_DEG + 4096;
constexpr size_t OFF_KN = OFF_QB + (size_t)T_ * 1536 * 2;
constexpr size_t OFF_KR = OFF_KN + (size_t)T_ * 1024 * 2;
constexpr size_t OFF_VT = OFF_KR + (size_t)T_ * 64 * 2;
constexpr size_t OFF_OA = OFF_VT + (size_t)1024 * 8192 * 2;
constexpr size_t OFF_OB = OFF_OA + (size_t)T_ * 1024 * 2;
constexpr size_t OFF_OC = OFF_OB + (size_t)T_ * 1024 * 2;
constexpr size_t OFF_MERGED = OFF_OC + (size_t)T_ * 1024 * 2;
constexpr size_t OFF_STATS = OFF_MERGED + (size_t)T_ * 2048 * 2;
constexpr size_t OFF_RS = OFF_STATS + (size_t)T_ * 2 * 4;
constexpr size_t OFF_CS = OFF_RS + (size_t)T_ * 2 * 4;
constexpr size_t OFF_CTR = OFF_CS + (size_t)T_ * 64 * 4;
constexpr size_t WS_END = OFF_CTR + 256;

struct Params {
    const float* x; const int* pos; const float* norm_g; const float* wg; const float* wu; const float* wd; const float* win;
    const float* convw; const float* alog; const float* dtb; const float* dng; const float* lng; const float* lnb; const float* sgw; const float* sgb;
    const float* cqg; const float* ckvg; const float* wuq; const float* wukv; const float* wbr; const float* wout;
    float* out; unsigned char* ws;
};

__device__ __forceinline__ unsigned pk2(float lo, float hi) { unsigned r; asm volatile("v_cvt_pk_bf16_f32 %0, %1, %2" : "=v"(r) : "v"(lo), "v"(hi)); return r; }
__device__ __forceinline__ float bflo(unsigned u) { return __uint_as_float(u << 16); }
__device__ __forceinline__ float bfhi(unsigned u) { return __uint_as_float(u & 0xffff0000u); }
__device__ __forceinline__ float bf1(bf16_t b) { return __uint_as_float(((unsigned)b) << 16); }
__device__ __forceinline__ bf16_t f2bf(float f) { return (bf16_t)(pk2(f, 0.f) & 0xffffu); }
__device__ __forceinline__ float wave_sum(float v) {
#pragma unroll
    for (int o = 1; o < 64; o <<= 1) v += __shfl_xor(v, o);
    return v;
}
__device__ __forceinline__ float sigmoidf_(float x) { return 1.f / (1.f + __expf(-x)); }
__device__ __forceinline__ float siluf_(float x) { return x / (1.f + __expf(-x)); }
__device__ __forceinline__ f32x2 gelu_pk(f32x2 v) {
    const f32x2 av = __builtin_elementwise_abs(v), d = av * 0.2316418882f + 1.0f;
    f32x2 t; t.x = __builtin_amdgcn_rcpf(d.x); t.y = __builtin_amdgcn_rcpf(d.y);
    f32x2 q = t * 0.5307027145f + (-0.7265760135f); q = q * t + 0.7107068705f; q = q * t + (-0.142248368f); q = q * t + 0.127414796f; q = q * t;
    const f32x2 s = (v * v) * (-0.72134752044f);
    f32x2 e; e.x = __builtin_amdgcn_exp2f(s.x); e.y = __builtin_amdgcn_exp2f(s.y);
    const f32x2 m = v * (q * e), r = v - m;
    f32x2 o; o.x = v.x < 0.f ? m.x : r.x; o.y = v.y < 0.f ? m.y : r.y; return o;
}
__device__ __forceinline__ bf16x8 load2x4(const bf16_t* p) {
    const s16x4 lo = *(const s16x4*)p, hi = *(const s16x4*)(p + 16);
    return __builtin_shufflevector(lo, hi, 0, 1, 2, 3, 4, 5, 6, 7);
}
__device__ __forceinline__ bf16x8 pack8(f32x4 a, f32x4 b) {
    u32x4 w; w.x = pk2(a[0], a[1]); w.y = pk2(a[2], a[3]); w.z = pk2(b[0], b[1]); w.w = pk2(b[2], b[3]);
    return __builtin_bit_cast(bf16x8, w);
}
#define MFMA16(a, b, c) __builtin_amdgcn_mfma_f32_16x16x32_bf16((a), (b), (c), 0, 0, 0)
#define LDS_WAIT() asm volatile("s_waitcnt lgkmcnt(0)" ::: "memory")

namespace pg8 {
constexpr int BM = 256, BK = 64, HALF = 128, HTB = HALF * BK * 2, NXCD = 8, WGM = 8;
__device__ __forceinline__ int lds_byte(int r, int c) { const int st = (r >> 4) * 2 + (c >> 5), rr = r & 15, cc = c & 31, ob = rr * 64 + cc * 2; return st * 1024 + (ob ^ (((ob >> 9) & 1) << 5)); }
__device__ __forceinline__ void stage_rc(int b, int& R, int& C) { const int st = b / 1024, sb = b % 1024, swz = sb ^ (((sb >> 9) & 1) << 5); R = (st >> 1) * 16 + swz / 64; C = (st & 1) * 32 + (swz % 64) / 2; }
__device__ __forceinline__ int perm32(int rho) { const int n = rho >> 4, i = rho & 15; return 8 * (i >> 2) + 4 * n + (i & 3); }
struct Unit { int pm, pn; };
struct Gemm { const bf16_t* A; const bf16_t* Bt; int M, N, K; };
struct StaticOrder {
    int nM, nN, nwg, G, c;
    __device__ __forceinline__ void init(int M, int N, int G_, int c_) { nM = M / BM; nN = N / BM; nwg = nM * nN; G = G_; c = c_; }
    __device__ __forceinline__ bool next(int i, Unit& u) const {
        const long L = (long)i * G + c; if (L >= nwg) return false;
        int wgid = (int)L; { const int q = nwg / NXCD, r = nwg % NXCD, xcd = wgid % NXCD, off = wgid / NXCD; wgid = (xcd < r ? xcd * (q + 1) : r * (q + 1) + (xcd - r) * q) + off; }
        const int nig = WGM * nN, gid = wgid / nig, fm = gid * WGM, gsz = (nM - fm) < WGM ? (nM - fm) : WGM;
        u.pm = fm + ((wgid % nig) % gsz); u.pn = (wgid % nig) / gsz; return true;
    }
};
template <class Epi>
__device__ __forceinline__ void gemm_phase(LAS unsigned char* lds, const Gemm g, const StaticOrder& S, const Epi& E) {
    int tid = threadIdx.x; asm volatile("" : "+v"(tid));
    const int wid = __builtin_amdgcn_readfirstlane(tid >> 6), lane = tid & 63, wr = wid >> 2, wc = wid & 3, fr = lane & 15, fq = lane >> 4;
    const int K = g.K, nt = K / BK;
    unsigned voffA[2], voffB[2];
#pragma unroll
    for (int i = 0; i < 2; ++i) { int R, C; stage_rc(tid * 16 + i * 8192, R, C); const int Rb = Epi::PERM ? ((R & ~31) + perm32(R & 31)) : R;
        voffA[i] = (unsigned)(R * K + C) * 2u; voffB[i] = (unsigned)(Rb * K + C) * 2u; }
    const size_t kstep = (size_t)(BK * 2);
    const size_t hstep = (size_t)HALF * K * 2;
    const size_t tstep = 2 * hstep;
    const unsigned ldsw = (unsigned)wid * 1024u;
    const int aoff = lds_byte(wr * 64 + fr, fq * 8), boff = lds_byte(wc * 32 + fr, fq * 8);
#define PG8_SA(b, h) (((b) * 2 + (h)) * HTB)
#define PG8_SB(b, h) ((4 + (b) * 2 + (h)) * HTB)
#define PG8_STAGE(bufoff, gbase, voff) do { _Pragma("unroll") for (int _i = 0; _i < 2; ++_i) \
        __builtin_amdgcn_global_load_lds((const unsigned*)((const char*)(gbase) + (voff)[_i]), (LAS unsigned*)(lds + (bufoff) + ldsw + _i * 8192), 16, 0, 0); } while (0)
#define PG8_LDA(dst, b, h) do { _Pragma("unroll") for (int m = 0; m < 4; ++m) _Pragma("unroll") for (int k = 0; k < 2; ++k) dst[m][k] = *(const LAS bf16x8*)(lds + PG8_SA(b, h) + aoff + m * 2048 + k * 1024); } while (0)
#define PG8_LDB(dst, b, h) do { _Pragma("unroll") for (int n = 0; n < 2; ++n) _Pragma("unroll") for (int k = 0; k < 2; ++k) dst[n][k] = *(const LAS bf16x8*)(lds + PG8_SB(b, h) + boff + n * 2048 + k * 1024); } while (0)
#define PG8_MMA(ai, bj, At, Bt) do { __builtin_amdgcn_s_setprio(1); _Pragma("unroll") for (int m = 0; m < 4; ++m) _Pragma("unroll") for (int n = 0; n < 2; ++n) _Pragma("unroll") for (int k = 0; k < 2; ++k) \
        acc[ai][bj][m][n] = __builtin_amdgcn_mfma_f32_16x16x32_bf16(Bt[n][k], At[m][k], acc[ai][bj][m][n], 0, 0, 0); __builtin_amdgcn_s_setprio(0); } while (0)
#define PG8_WAIT_V(n) asm volatile("s_waitcnt vmcnt(" #n ")" ::: "memory")
#define PG8_WAIT_L(n) asm volatile("s_waitcnt lgkmcnt(" #n ")" ::: "memory")
#define PG8_BAR __builtin_amdgcn_s_barrier()
#define PG8_SCHED __builtin_amdgcn_sched_barrier(0)
    Unit cur, nxt; int ui = 0;
    if (!S.next(0, cur)) return;
    f32x4 acc[2][2][4][2];
#pragma unroll
    for (int a = 0; a < 2; ++a)
#pragma unroll
        for (int b = 0; b < 2; ++b)
#pragma unroll
            for (int m = 0; m < 4; ++m)
#pragma unroll
                for (int n = 0; n < 2; ++n) acc[a][b][m][n] = (f32x4){0.f, 0.f, 0.f, 0.f};
    bf16x8 At[4][2], B0[2][2], B1[2][2];
    const char* cA = (const char*)g.A + (size_t)cur.pm * tstep; const char* cB = (const char*)g.Bt + (size_t)cur.pn * tstep;
    PG8_STAGE(PG8_SB(0, 0), cB, voffB); PG8_STAGE(PG8_SA(0, 0), cA, voffA); PG8_STAGE(PG8_SB(0, 1), cB + hstep, voffB); PG8_STAGE(PG8_SA(0, 1), cA + hstep, voffA);
    if (wr == 1) PG8_BAR;
    PG8_WAIT_V(4); PG8_BAR;
    PG8_STAGE(PG8_SB(1, 0), cB + kstep, voffB); PG8_STAGE(PG8_SA(1, 0), cA + kstep, voffA); PG8_STAGE(PG8_SB(1, 1), cB + hstep + kstep, voffB);
    PG8_WAIT_V(6); PG8_BAR;
    for (;;) {
        const bool has_next = S.next(ui + 1, nxt);
        const char* nA = has_next ? (const char*)g.A + (size_t)nxt.pm * tstep : cA; const char* nB = has_next ? (const char*)g.Bt + (size_t)nxt.pn * tstep : cB;
        for (int t = 0; t < nt; t += 2) {
            const bool last = (t == nt - 2);
            const char* a1 = cA + (size_t)(t + 1) * kstep;
            const char* a2 = last ? nA : cA + (size_t)(t + 2) * kstep; const char* b2 = last ? nB : cB + (size_t)(t + 2) * kstep;
            const char* a3 = a2 + kstep; const char* b3 = b2 + kstep;
            PG8_LDB(B0, 0, 0); PG8_SCHED; PG8_LDA(At, 0, 0); PG8_STAGE(PG8_SA(1, 1), a1 + hstep, voffA);
            PG8_WAIT_L(8); PG8_BAR; PG8_WAIT_L(0); PG8_MMA(0, 0, At, B0); PG8_BAR; PG8_SCHED;
            PG8_LDB(B1, 0, 1); PG8_STAGE(PG8_SB(0, 0), b2, voffB);
            PG8_BAR; PG8_WAIT_L(0); PG8_MMA(0, 1, At, B1); PG8_BAR;
            PG8_LDA(At, 0, 1); PG8_STAGE(PG8_SA(0, 0), a2, voffA);
            PG8_BAR; PG8_WAIT_L(0); PG8_MMA(1, 0, At, B0); PG8_BAR; PG8_SCHED;
            PG8_STAGE(PG8_SB(0, 1), b2 + hstep, voffB);
            PG8_WAIT_V(6); PG8_BAR; PG8_MMA(1, 1, At, B1); PG8_BAR;
            PG8_LDB(B0, 1, 0); PG8_SCHED; PG8_LDA(At, 1, 0); PG8_STAGE(PG8_SA(0, 1), a2 + hstep, voffA);
            PG8_WAIT_L(8); PG8_BAR; PG8_WAIT_L(0); PG8_MMA(0, 0, At, B0); PG8_BAR; PG8_SCHED;
            PG8_LDB(B1, 1, 1); PG8_STAGE(PG8_SB(1, 0), b3, voffB);
            PG8_BAR; PG8_WAIT_L(0); PG8_MMA(0, 1, At, B1); PG8_BAR;
            PG8_LDA(At, 1, 1); PG8_STAGE(PG8_SA(1, 0), a3, voffA);
            PG8_BAR; PG8_WAIT_L(0); PG8_MMA(1, 0, At, B0); PG8_BAR; PG8_SCHED;
            PG8_STAGE(PG8_SB(1, 1), b3 + hstep, voffB);
            PG8_WAIT_V(6); PG8_BAR; PG8_MMA(1, 1, At, B1); PG8_BAR;
        }
        E(acc, cur, wr, wc, fr, fq);
        if (!has_next) break;
#pragma unroll
        for (int a = 0; a < 2; ++a)
#pragma unroll
            for (int b = 0; b < 2; ++b)
#pragma unroll
                for (int m = 0; m < 4; ++m)
#pragma unroll
                    for (int n = 0; n < 2; ++n) acc[a][b][m][n] = (f32x4){0.f, 0.f, 0.f, 0.f};
        cur = nxt; cA = nA; cB = nB; ++ui;
    }
    PG8_WAIT_V(0);
    if (wr == 0) PG8_BAR;
    PG8_BAR;
#undef PG8_SA
#undef PG8_SB
#undef PG8_STAGE
#undef PG8_LDA
#undef PG8_LDB
#undef PG8_MMA
#undef PG8_WAIT_V
#undef PG8_WAIT_L
#undef PG8_BAR
#undef PG8_SCHED
}
}
using pg8::Unit;
typedef f32x4 Acc[2][2][4][2];

struct EpiF32 {
    static constexpr bool PERM = false;
    float* C; int ldc;
    __device__ __forceinline__ void operator()(const Acc& acc, const Unit& u, int wr, int wc, int fr, int fq) const {
        const int row0 = u.pm * 256 + wr * 64 + fr, col0 = u.pn * 256 + wc * 32 + 4 * fq;
#pragma unroll
        for (int ai = 0; ai < 2; ++ai)
#pragma unroll
            for (int m = 0; m < 4; ++m) { float* rowp = C + (size_t)(row0 + ai * 128 + m * 16) * ldc + col0;
#pragma unroll
                for (int bj = 0; bj < 2; ++bj)
#pragma unroll
                    for (int n = 0; n < 2; ++n) *(f32x4*)(rowp + bj * 128 + n * 16) = acc[ai][bj][m][n]; }
    }
};
struct EpiSwiGLU {
    static constexpr bool PERM = true;
    bf16_t* O;
    __device__ __forceinline__ void operator()(const Acc& acc, const Unit& u, int wr, int wc, int fr, int fq) const {
        const int row0 = u.pm * 256 + wr * 64 + fr, col0 = u.pn * 128 + wc * 32 + 8 * fq;
#pragma unroll
        for (int ai = 0; ai < 2; ++ai)
#pragma unroll
            for (int m = 0; m < 4; ++m) {
                f32x4 v0, v1;
#pragma unroll
                for (int e = 0; e < 4; ++e) { v0[e] = siluf_(acc[ai][0][m][0][e]) * acc[ai][1][m][0][e]; v1[e] = siluf_(acc[ai][0][m][1][e]) * acc[ai][1][m][1][e]; }
                u32x4 w; w.x = pk2(v0[0], v0[1]); w.y = pk2(v0[2], v0[3]); w.z = pk2(v1[0], v1[1]); w.w = pk2(v1[2], v1[3]);
                *(u32x4*)(O + (size_t)(row0 + ai * 128 + m * 16) * FF + col0) = w; }
    }
};
struct EpiWin {
    static constexpr bool PERM = true;
    unsigned char* ws;
    __device__ __forceinline__ void operator()(const Acc& acc, const Unit& u, int wr, int wc, int fr, int fq) const {
        const int pn = u.pn, row0 = u.pm * 256 + wr * 64 + fr;
        if (pn == 52) {
            float* M = (float*)(ws + OFF_MISC);
#pragma unroll
            for (int ai = 0; ai < 2; ++ai)
#pragma unroll
                for (int m = 0; m < 4; ++m)
#pragma unroll
                    for (int n = 0; n < 2; ++n) *(f32x4*)(M + (size_t)(row0 + ai * 128 + m * 16) * 128 + 32 * wc + 8 * fq + 4 * n) = acc[ai][0][m][n];
            return;
        }
        bf16_t* base; int ld, col, mode = 0;
        if (pn < 12) { base = (bf16_t*)(ws + OFF_QKV); ld = 3072; col = pn * 256; }
        else if (pn < 16) { base = (bf16_t*)(ws + OFF_Z); ld = 1024; col = (pn - 12) * 256; }
        else if (pn < 24) { base = (bf16_t*)(ws + OFF_SG); ld = 2048; col = (pn - 16) * 256; mode = 2; }
        else if (pn < 26) { base = (bf16_t*)(ws + OFF_CQ); ld = 512; col = (pn - 24) * 256; }
        else if (pn < 28) { base = (bf16_t*)(ws + OFF_CKV); ld = 512; col = (pn - 26) * 256; }
        else { base = (bf16_t*)(ws + OFF_GATE); ld = 6144; col = (pn - 28) * 256; mode = 1; }
        col += wc * 32 + 8 * fq;
#pragma unroll
        for (int ai = 0; ai < 2; ++ai)
#pragma unroll
            for (int m = 0; m < 4; ++m) { bf16_t* rowp = base + (size_t)(row0 + ai * 128 + m * 16) * ld + col;
#pragma unroll
                for (int bj = 0; bj < 2; ++bj) { f32x4 v0 = acc[ai][bj][m][0], v1 = acc[ai][bj][m][1];
                    if (mode == 1) {
#pragma unroll
                        for (int e = 0; e < 4; ++e) { v0[e] = sigmoidf_(v0[e]); v1[e] = sigmoidf_(v1[e]); } }
                    else if (mode == 2) { f32x2 a = gelu_pk((f32x2){v0[0], v0[1]}), b = gelu_pk((f32x2){v0[2], v0[3]}), c = gelu_pk((f32x2){v1[0], v1[1]}), d = gelu_pk((f32x2){v1[2], v1[3]});
                        v0 = (f32x4){a.x, a.y, b.x, b.y}; v1 = (f32x4){c.x, c.y, d.x, d.y}; }
                    u32x4 w; w.x = pk2(v0[0], v0[1]); w.y = pk2(v0[2], v0[3]); w.z = pk2(v1[0], v1[1]); w.w = pk2(v1[2], v1[3]);
                    *(u32x4*)(rowp + bj * 128) = w; } }
    }
};
struct EpiQ {
    static constexpr bool PERM = true;
    bf16_t* QB; const float* RS; const float* CS; float qscale;
    __device__ __forceinline__ void operator()(const Acc& acc, const Unit& u, int wr, int wc, int fr, int fq) const {
        const int pn = u.pn, row0 = u.pm * 256 + wr * 64 + fr;
#pragma unroll
        for (int ai = 0; ai < 2; ++ai)
#pragma unroll
            for (int m = 0; m < 4; ++m) { const int row = row0 + ai * 128 + m * 16; const float sc = RS[row * 2] * qscale;
                if (pn < 4) {
#pragma unroll
                    for (int bj = 0; bj < 2; ++bj) { const f32x4 v0 = acc[ai][bj][m][0] * sc, v1 = acc[ai][bj][m][1] * sc;
                        u32x4 w; w.x = pk2(v0[0], v0[1]); w.y = pk2(v0[2], v0[3]); w.z = pk2(v1[0], v1[1]); w.w = pk2(v1[2], v1[3]);
                        *(u32x4*)(QB + (size_t)row * 1536 + (pn * 2 + bj) * 192 + wc * 32 + 8 * fq) = w; }
                } else {
                    const int head = (pn - 4) * 4 + wc, i0 = 8 * fq;
                    const f32x4 c0 = *(const f32x4*)(CS + (size_t)row * 64 + i0), c1 = *(const f32x4*)(CS + (size_t)row * 64 + i0 + 4);
                    const f32x4 s0 = *(const f32x4*)(CS + (size_t)row * 64 + 32 + i0), s1 = *(const f32x4*)(CS + (size_t)row * 64 + 32 + i0 + 4);
                    const f32x4 x10 = acc[ai][0][m][0] * sc, x11 = acc[ai][0][m][1] * sc, x20 = acc[ai][1][m][0] * sc, x21 = acc[ai][1][m][1] * sc;
                    const f32x4 a0 = x10 * c0 - x20 * s0, a1 = x11 * c1 - x21 * s1, b0 = x10 * s0 + x20 * c0, b1 = x11 * s1 + x21 * c1;
                    u32x4 w; w.x = pk2(a0[0], a0[1]); w.y = pk2(a0[2], a0[3]); w.z = pk2(a1[0], a1[1]); w.w = pk2(a1[2], a1[3]);
                    *(u32x4*)(QB + (size_t)row * 1536 + head * 192 + 128 + i0) = w;
                    w.x = pk2(b0[0], b0[1]); w.y = pk2(b0[2], b0[3]); w.z = pk2(b1[0], b1[1]); w.w = pk2(b1[2], b1[3]);
                    *(u32x4*)(QB + (size_t)row * 1536 + head * 192 + 160 + i0) = w;
                } }
    }
};
struct EpiKN {
    static constexpr bool PERM = true;
    bf16_t* O; const float* RS;
    __device__ __forceinline__ void operator()(const Acc& acc, const Unit& u, int wr, int wc, int fr, int fq) const {
        const int row0 = u.pm * 256 + wr * 64 + fr, col0 = u.pn * 256 + wc * 32 + 8 * fq;
#pragma unroll
        for (int ai = 0; ai < 2; ++ai)
#pragma unroll
            for (int m = 0; m < 4; ++m) { const int row = row0 + ai * 128 + m * 16; const float sc = RS[row * 2 + 1];
#pragma unroll
                for (int bj = 0; bj < 2; ++bj) { const f32x4 v0 = acc[ai][bj][m][0] * sc, v1 = acc[ai][bj][m][1] * sc;
                    u32x4 w; w.x = pk2(v0[0], v0[1]); w.y = pk2(v0[2], v0[3]); w.z = pk2(v1[0], v1[1]); w.w = pk2(v1[2], v1[3]);
                    *(u32x4*)(O + (size_t)row * 1024 + col0 + bj * 128) = w; } }
    }
};
struct EpiVT {
    static constexpr bool PERM = true;
    bf16_t* O; const float* RS;
    __device__ __forceinline__ void operator()(const Acc& acc, const Unit& u, int wr, int wc, int fr, int fq) const {
        const int row0 = u.pm * 256 + wr * 64 + fr, col0 = u.pn * 256 + wc * 32 + 8 * fq;
        float sc[2][8];
#pragma unroll
        for (int bj = 0; bj < 2; ++bj)
#pragma unroll
            for (int e = 0; e < 8; ++e) sc[bj][e] = RS[(col0 + bj * 128 + e) * 2 + 1];
#pragma unroll
        for (int ai = 0; ai < 2; ++ai)
#pragma unroll
            for (int m = 0; m < 4; ++m) { const int row = row0 + ai * 128 + m * 16;
#pragma unroll
                for (int bj = 0; bj < 2; ++bj) { const f32x4 v0 = acc[ai][bj][m][0], v1 = acc[ai][bj][m][1];
                    u32x4 w; w.x = pk2(v0[0] * sc[bj][0], v0[1] * sc[bj][1]); w.y = pk2(v0[2] * sc[bj][2], v0[3] * sc[bj][3]);
                    w.z = pk2(v1[0] * sc[bj][4], v1[1] * sc[bj][5]); w.w = pk2(v1[2] * sc[bj][6], v1[3] * sc[bj][7]);
                    *(u32x4*)(O + (size_t)row * 8192 + col0 + bj * 128) = w; } }
    }
};
template <int BR> struct EpiBranch {
    static constexpr bool PERM = true;
    float* ACC; const bf16_t* GATE; bf16_t* OUT;
    __device__ __forceinline__ void operator()(const Acc& acc, const Unit& u, int wr, int wc, int fr, int fq) const {
        const int row0 = u.pm * 256 + wr * 64 + fr, col0 = u.pn * 256 + wc * 32 + 8 * fq;
#pragma unroll
        for (int ai = 0; ai < 2; ++ai)
#pragma unroll
            for (int m = 0; m < 4; ++m) { const int row = row0 + ai * 128 + m * 16;
#pragma unroll
                for (int bj = 0; bj < 2; ++bj) { const int col = col0 + bj * 128;
                    const u32x4 gw = *(const u32x4*)(GATE + (size_t)row * 6144 + BR * 2048 + col);
                    f32x4 v0 = acc[ai][bj][m][0], v1 = acc[ai][bj][m][1];
                    v0[0] *= bflo(gw.x); v0[1] *= bfhi(gw.x); v0[2] *= bflo(gw.y); v0[3] *= bfhi(gw.y);
                    v1[0] *= bflo(gw.z); v1[1] *= bfhi(gw.z); v1[2] *= bflo(gw.w); v1[3] *= bfhi(gw.w);
                    float* ap = ACC + (size_t)row * 2048 + col;
                    if (BR > 0) { v0 += *(const f32x4*)ap; v1 += *(const f32x4*)(ap + 4); }
                    if (BR < 2) { *(f32x4*)ap = v0; *(f32x4*)(ap + 4) = v1; }
                    else { u32x4 w; w.x = pk2(v0[0], v0[1]); w.y = pk2(v0[2], v0[3]); w.z = pk2(v1[0], v1[1]); w.w = pk2(v1[2], v1[3]);
                        *(u32x4*)(OUT + (size_t)row * 2048 + col) = w; } } }
    }
};

template <class Epi>
__device__ __forceinline__ void run_gemm(LAS unsigned char* lds, const bf16_t* A, const bf16_t* Bt, int M, int N, int K, const Epi& E) {
    pg8::Gemm g; g.A = A; g.Bt = Bt; g.M = M; g.N = N; g.K = K;
    pg8::StaticOrder S; S.init(M, N, (int)gridDim.x, (int)blockIdx.x);
    pg8::gemm_phase<Epi>(lds, g, S, E);
}

template <class Map>
__device__ __forceinline__ void cvt_item(const float* W, int K, int N, bf16_t* WT, const float* kscale, LAS float* scr, int item, int lane, Map map) {
    const int nblk = (N + 31) / 32, kb = item / nblk, nb = item % nblk, k0 = 64 * kb, n0 = 32 * nb;
    const int ncol = n0 + (lane & 31); const bool ok = ncol < N;
#pragma unroll 8
    for (int i = 0; i < 32; ++i) { const int kk = 2 * i + (lane >> 5); float v = ok ? W[(size_t)(k0 + kk) * N + ncol] : 0.f; if (kscale) v *= kscale[k0 + kk]; scr[kk * 33 + (lane & 31)] = v; }
    LDS_WAIT();
    const int c = lane & 7;
#pragma unroll
    for (int j = 0; j < 4; ++j) { const int n = (lane >> 3) + 8 * j; const LAS float* s = scr + (8 * c) * 33 + n;
        if (n0 + n < N) { const int drow = map(n0 + n);
            u32x4 o; o.x = pk2(s[0 * 33], s[1 * 33]); o.y = pk2(s[2 * 33], s[3 * 33]); o.z = pk2(s[4 * 33], s[5 * 33]); o.w = pk2(s[6 * 33], s[7 * 33]);
            *(u32x4*)(WT + (size_t)drow * K + k0 + 8 * c) = o; } }
    LDS_WAIT();
}
struct MapId { __device__ __forceinline__ int operator()(int n) const { return n; } };
struct MapGU { int off; __device__ __forceinline__ int operator()(int n) const { return (n >> 7) * 256 + off + (n & 127); } };
struct MapWin { __device__ __forceinline__ int operator()(int n) const {
    if (n < 4096) return n;
    if (n < 4112) return 13312 + 64 + (n - 4096);
    if (n < 6160) return 4096 + (n - 4112);
    if (n < 6672) return 6144 + (n - 6160);
    if (n < 7184) return 6656 + (n - 6672);
    if (n < 7248) return 13312 + (n - 7184);
    return 7168 + (n - 7248); } };
struct MapUQ { __device__ __forceinline__ int operator()(int n) const { const int hh = n / 192, d = n - hh * 192;
    if (d < 128) return (hh >> 1) * 256 + (hh & 1) * 128 + d;
    if (d < 160) return 1024 + (hh >> 2) * 256 + (hh & 3) * 32 + (d - 128);
    return 1024 + (hh >> 2) * 256 + 128 + (hh & 3) * 32 + (d - 160); } };
struct MapUKV { __device__ __forceinline__ int operator()(int n) const { const int hh = n >> 8, d = n & 255; return d < 128 ? hh * 128 + d : 1024 + hh * 128 + (d - 128); } };

__device__ __forceinline__ void convert_layer(const Params& p, int l, LAS unsigned char* lds) {
    int tid = threadIdx.x; asm volatile("" : "+v"(tid));
    const int lane = tid & 63, wave = tid >> 6;
    LAS float* scr = (LAS float*)(lds + wave * 8448);
    const int gw = blockIdx.x * 8 + wave, NGW = gridDim.x * 8;
    unsigned char* ws = p.ws;
    constexpr int I_GU = 32 * 176, I_DN = 88 * 64, I_WIN = 32 * 419, I_UQ = 8 * 48, I_UKV = 8 * 64, I_BR = 16 * 64, I_OUT = 32 * 64;
    constexpr int NITEMS = 4 * I_GU + 2 * I_DN + I_WIN + I_UQ + I_UKV + 3 * I_BR + I_OUT;
    for (int it = gw; it < NITEMS; it += NGW) {
        int r = it;
        if (r < 4 * I_GU) { const int which = r / I_GU, i = which >> 1, up = which & 1; r -= which * I_GU;
            const float* W = (up ? p.wu : p.wg) + (size_t)(l * 2 + i) * 2048 * FF;
            MapGU mp; mp.off = up * 128;
            cvt_item(W, 2048, FF, (bf16_t*)(ws + OFF_WGU) + (size_t)i * 11264 * 2048, nullptr, scr, r, lane, mp); continue; }
        r -= 4 * I_GU;
        if (r < 2 * I_DN) { const int i = r / I_DN; r -= i * I_DN;
            cvt_item(p.wd + (size_t)(l * 2 + i) * FF * 2048, FF, 2048, (bf16_t*)(ws + OFF_WDN) + (size_t)i * 2048 * FF, nullptr, scr, r, lane, MapId()); continue; }
        r -= 2 * I_DN;
        if (r < I_WIN) { cvt_item(p.win + (size_t)l * 2048 * NIN, 2048, NIN, (bf16_t*)(ws + OFF_WIN), nullptr, scr, r, lane, MapWin()); continue; }
        r -= I_WIN;
        if (r < I_UQ) { cvt_item(p.wuq + (size_t)l * 512 * 1536, 512, 1536, (bf16_t*)(ws + OFF_WUQ), p.cqg + l * 512, scr, r, lane, MapUQ()); continue; }
        r -= I_UQ;
        if (r < I_UKV) { cvt_item(p.wukv + (size_t)l * 512 * 2048, 512, 2048, (bf16_t*)(ws + OFF_WUKV), p.ckvg + l * 512, scr, r, lane, MapUKV()); continue; }
        r -= I_UKV;
        if (r < 3 * I_BR) { const int j = r / I_BR; r -= j * I_BR;
            cvt_item(p.wbr + (size_t)(l * 3 + j) * 1024 * 2048, 1024, 2048, (bf16_t*)(ws + OFF_WBR) + (size_t)j * 2048 * 1024, nullptr, scr, r, lane, MapId()); continue; }
        r -= 3 * I_BR;
        cvt_item(p.wout + (size_t)l * 2048 * 2048, 2048, 2048, (bf16_t*)(ws + OFF_WOUT), nullptr, scr, r, lane, MapId());
    }
    const size_t gt = (size_t)blockIdx.x * 512 + tid, NGT = (size_t)gridDim.x * 512;
    { bf16_t* SGW = (bf16_t*)(ws + OFF_SGW); const float* src = p.sgw + (size_t)l * 8 * 128 * 128;
      for (size_t e = gt; e < (size_t)8 * 128 * 128; e += NGT) { const int j = (int)(e & 127), i = (int)((e >> 7) & 127); SGW[e] = ((j >> 6) <= (i >> 6)) ? f2bf(src[e]) : (bf16_t)0; } }
    { bf16_t* WIN = (bf16_t*)(ws + OFF_WIN) + (size_t)(13312 + 80) * 2048;
      for (size_t e = gt; e < (size_t)176 * 2048; e += NGT) WIN[e] = 0; }
}

__device__ __forceinline__ void rowpass(const float* xin, const float* f, float alpha, const float* gpost, const float* gpre, float* xout, bf16_t* hout) {
    int tid = threadIdx.x; asm volatile("" : "+v"(tid));
    const int lane = tid & 63, wave = tid >> 6;
    const int gw = blockIdx.x * 8 + wave, NGW = gridDim.x * 8;
    for (int row = gw; row < T_; row += NGW) {
        f32x4 xv[8];
        const f32x4* xr = (const f32x4*)(xin + (size_t)row * DM) + lane;
#pragma unroll
        for (int j = 0; j < 8; ++j) xv[j] = xr[64 * j];
        if (f) {
            f32x4 fv[8]; float ss = 0.f;
            const f32x4* fr = (const f32x4*)(f + (size_t)row * DM) + lane;
#pragma unroll
            for (int j = 0; j < 8; ++j) { fv[j] = fr[64 * j]; ss += fv[j][0] * fv[j][0] + fv[j][1] * fv[j][1] + fv[j][2] * fv[j][2] + fv[j][3] * fv[j][3]; }
            const float rs = rsqrtf(wave_sum(ss) * (1.f / DM) + EPS) * alpha;
#pragma unroll
            for (int j = 0; j < 8; ++j) { const f32x4 gg = *((const f32x4*)gpost + lane + 64 * j); xv[j] += fv[j] * rs * gg; }
        }
        f32x4* xo = (f32x4*)(xout + (size_t)row * DM) + lane;
#pragma unroll
        for (int j = 0; j < 8; ++j) xo[64 * j] = xv[j];
        if (hout) {
            float ss = 0.f;
#pragma unroll
            for (int j = 0; j < 8; ++j) ss += xv[j][0] * xv[j][0] + xv[j][1] * xv[j][1] + xv[j][2] * xv[j][2] + xv[j][3] * xv[j][3];
            const float rs = rsqrtf(wave_sum(ss) * (1.f / DM) + EPS);
            u32x2* ho = (u32x2*)(hout + (size_t)row * DM) + lane;
#pragma unroll
            for (int j = 0; j < 8; ++j) { const f32x4 gg = *((const f32x4*)gpre + lane + 64 * j); const f32x4 y = xv[j] * rs * gg;
                u32x2 w; w.x = pk2(y[0], y[1]); w.y = pk2(y[2], y[3]); ho[64 * j] = w; }
        }
    }
}

__device__ __forceinline__ void dn_prep_item(const Params& p, int l, LAS float* L, int item) {
    unsigned char* ws = p.ws;
    int tid = threadIdx.x; asm volatile("" : "+v"(tid));
    const int lane = tid & 63;
    const int h = item & 7, n = (item >> 3) & 31, b = item >> 8;
    const int t0 = b * SEQ_ + n * 64;
    LAS float* sQ = L; LAS float* sK = L + 64 * 132; LAS float* sX = L + 2 * 64 * 132; LAS float* sA = sX + 64 * 256; LAS float* sG = sA + 64 * 68; LAS float* sB = sG + 64;
    const bf16_t* QKV = (const bf16_t*)(ws + OFF_QKV);
    const float* MISC = (const float*)(ws + OFF_MISC);
    const float* cw = p.convw + (size_t)l * 4 * 3072;
    for (int task = tid; task < 64 * 48; task += 512) {
        const int t = task / 48, cgp = task - t * 48, part = cgp >> 4, d0 = (cgp & 15) * 8, ch = part * 1024 + h * 128 + d0;
        float a[8];
#pragma unroll
        for (int e = 0; e < 8; ++e) a[e] = 0.f;
#pragma unroll
        for (int j = 0; j < 4; ++j) { const int s = n * 64 + t - 3 + j;
            if (s >= 0) { const u32x4 xv = *(const u32x4*)(QKV + (size_t)(b * SEQ_ + s) * 3072 + ch);
                const f32x4 w0 = *(const f32x4*)(cw + j * 3072 + ch), w1 = *(const f32x4*)(cw + j * 3072 + ch + 4);
                a[0] += w0[0] * bflo(xv.x); a[1] += w0[1] * bfhi(xv.x); a[2] += w0[2] * bflo(xv.y); a[3] += w0[3] * bfhi(xv.y);
                a[4] += w1[0] * bflo(xv.z); a[5] += w1[1] * bfhi(xv.z); a[6] += w1[2] * bflo(xv.w); a[7] += w1[3] * bfhi(xv.w); } }
        LAS float* dst = part == 0 ? sQ + t * 132 + d0 : (part == 1 ? sK + t * 132 + d0 : sX + t * 256 + 128 + d0);
#pragma unroll
        for (int e = 0; e < 8; ++e) dst[e] = siluf_(a[e]);
    }
    __syncthreads();
    { const int row = tid >> 2, sub = tid & 3; LAS float* rp = (row < 64 ? sQ + row * 132 : sK + (row - 64) * 132) + sub * 32;
      float ss = 0.f;
#pragma unroll
      for (int e = 0; e < 32; ++e) ss += rp[e] * rp[e];
      ss += __shfl_xor(ss, 1); ss += __shfl_xor(ss, 2);
      const float sc = rsqrtf(ss + 1e-6f) * (row < 64 ? 0.08838834764831845f : 1.f);
#pragma unroll
      for (int e = 0; e < 32; ++e) rp[e] *= sc; }
    if (tid < 64) { const float av = MISC[(size_t)(t0 + tid) * 128 + 64 + h], bv = MISC[(size_t)(t0 + tid) * 128 + 72 + h];
        const float xx = av + p.dtb[l * 8 + h]; const float sp = xx > 20.f ? xx : log1pf(__expf(xx));
        float gv = -__expf(p.alog[l * 8 + h]) * sp;
#pragma unroll
        for (int o = 1; o < 64; o <<= 1) { const float y = __shfl_up(gv, o); if (lane >= o) gv += y; }
        sG[tid] = gv; sB[tid] = sigmoidf_(bv); }
    __syncthreads();
    { const int i = tid >> 3, jl = tid & 7;
      float aa[8], qq[8];
#pragma unroll
      for (int jj = 0; jj < 8; ++jj) { aa[jj] = 0.f; qq[jj] = 0.f; }
      for (int d4 = 0; d4 < 32; ++d4) { const f32x4 ki = *(const LAS f32x4*)(sK + i * 132 + d4 * 4), qi = *(const LAS f32x4*)(sQ + i * 132 + d4 * 4);
#pragma unroll
          for (int jj = 0; jj < 8; ++jj) if (8 * jj <= i) { const f32x4 kj = *(const LAS f32x4*)(sK + (jl + 8 * jj) * 132 + d4 * 4);
              aa[jj] += ki[0] * kj[0] + ki[1] * kj[1] + ki[2] * kj[2] + ki[3] * kj[3]; qq[jj] += qi[0] * kj[0] + qi[1] * kj[1] + qi[2] * kj[2] + qi[3] * kj[3]; } }
      const float gi = sG[i], bi = sB[i];
      bf16_t* QKo = (bf16_t*)(ws + OFF_DQK) + (size_t)item * 4096 + i * 64;
#pragma unroll
      for (int jj = 0; jj < 8; ++jj) { const int j = jl + 8 * jj; const float dec = (j <= i) ? __expf(gi - sG[j]) : 0.f;
          sA[i * 68 + j] = (j < i) ? bi * aa[jj] * dec : 0.f;
          QKo[j] = f2bf((j <= i) ? qq[jj] * dec : 0.f); } }
    for (int task = tid; task < 64 * 32; task += 512) { const int t = task >> 5, d4 = task & 31; const float bt = sB[t], kb = bt * __expf(sG[t]);
        const f32x4 kv = *(const LAS f32x4*)(sK + t * 132 + d4 * 4); *(LAS f32x4*)(sX + t * 256 + d4 * 4) = kv * kb;
        LAS f32x4* vp = (LAS f32x4*)(sX + t * 256 + 128 + d4 * 4); *vp = *vp * bt; }
    __syncthreads();
    if (tid < 256) {
        for (int i = 1; i < 64; ++i) { float s = sX[i * 256 + tid];
            for (int j4 = 0; j4 < i; j4 += 4) { const f32x4 a4 = *(const LAS f32x4*)(sA + i * 68 + j4);
                s -= a4[0] * sX[(j4 + 0) * 256 + tid] + a4[1] * sX[(j4 + 1) * 256 + tid] + a4[2] * sX[(j4 + 2) * 256 + tid] + a4[3] * sX[(j4 + 3) * 256 + tid]; }
            sX[i * 256 + tid] = s; }
    }
    __syncthreads();
    { bf16_t* Wo = (bf16_t*)(ws + OFF_DW) + (size_t)item * 8192; bf16_t* QGo = (bf16_t*)(ws + OFF_DQG) + (size_t)item * 8192;
      bf16_t* KGTo = (bf16_t*)(ws + OFF_DKGT) + (size_t)item * 8192; bf16_t* UTo = (bf16_t*)(ws + OFF_DUT) + (size_t)item * 8192;
      const float glast = sG[63];
      for (int task = tid; task < 1024; task += 512) {
          { const int c = task >> 4, d0 = (task & 15) * 8;
            const f32x4 a = *(const LAS f32x4*)(sX + c * 256 + d0), b2 = *(const LAS f32x4*)(sX + c * 256 + d0 + 4);
            u32x4 w; w.x = pk2(a[0], a[1]); w.y = pk2(a[2], a[3]); w.z = pk2(b2[0], b2[1]); w.w = pk2(b2[2], b2[3]);
            *(u32x4*)(Wo + c * 128 + d0) = w;
            const float eg = __expf(sG[c]);
            const f32x4 q0 = *(const LAS f32x4*)(sQ + c * 132 + d0) * eg, q1 = *(const LAS f32x4*)(sQ + c * 132 + d0 + 4) * eg;
            w.x = pk2(q0[0], q0[1]); w.y = pk2(q0[2], q0[3]); w.z = pk2(q1[0], q1[1]); w.w = pk2(q1[2], q1[3]);
            *(u32x4*)(QGo + c * 128 + d0) = w; }
          { const int d = task & 127, c0 = (task >> 7) * 8;
            float uu[8], kk[8];
#pragma unroll
            for (int e = 0; e < 8; ++e) { uu[e] = sX[(c0 + e) * 256 + 128 + d]; kk[e] = sK[(c0 + e) * 132 + d] * __expf(glast - sG[c0 + e]); }
            u32x4 w; w.x = pk2(uu[0], uu[1]); w.y = pk2(uu[2], uu[3]); w.z = pk2(uu[4], uu[5]); w.w = pk2(uu[6], uu[7]);
            *(u32x4*)(UTo + d * 64 + c0) = w;
            w.x = pk2(kk[0], kk[1]); w.y = pk2(kk[2], kk[3]); w.z = pk2(kk[4], kk[5]); w.w = pk2(kk[6], kk[7]);
            *(u32x4*)(KGTo + d * 64 + c0) = w; }
      }
      if (tid == 0) ((float*)(ws + OFF_DEG))[item] = __expf(glast); }
    __syncthreads();
}

__device__ __forceinline__ void row_items(const Params& p) {
    unsigned char* ws = p.ws;
    int tid = threadIdx.x; asm volatile("" : "+v"(tid));
    const int lane = tid & 63, wave = tid >> 6;
    const int gw = blockIdx.x * 8 + wave, NGW = gridDim.x * 8;
    const bf16_t* SG = (const bf16_t*)(ws + OFF_SG); const bf16_t* CQ = (const bf16_t*)(ws + OFF_CQ); const bf16_t* CKV = (const bf16_t*)(ws + OFF_CKV);
    const float* MISC = (const float*)(ws + OFF_MISC); const float* CS = (const float*)(ws + OFF_CS);
    float* STATS = (float*)(ws + OFF_STATS); float* RS = (float*)(ws + OFF_RS); bf16_t* KR = (bf16_t*)(ws + OFF_KR);
    for (int t = gw; t < T_; t += NGW) {
        { const u32x4 a = *(const u32x4*)(SG + (size_t)t * 2048 + 1024 + lane * 16), b = *(const u32x4*)(SG + (size_t)t * 2048 + 1024 + lane * 16 + 8);
          float v[16]; v[0] = bflo(a.x); v[1] = bfhi(a.x); v[2] = bflo(a.y); v[3] = bfhi(a.y); v[4] = bflo(a.z); v[5] = bfhi(a.z); v[6] = bflo(a.w); v[7] = bfhi(a.w);
          v[8] = bflo(b.x); v[9] = bfhi(b.x); v[10] = bflo(b.y); v[11] = bfhi(b.y); v[12] = bflo(b.z); v[13] = bfhi(b.z); v[14] = bflo(b.w); v[15] = bfhi(b.w);
          float s = 0.f;
#pragma unroll
          for (int e = 0; e < 16; ++e) s += v[e];
          const float mean = wave_sum(s) * (1.f / 1024.f); float s2 = 0.f;
#pragma unroll
          for (int e = 0; e < 16; ++e) { const float d = v[e] - mean; s2 += d * d; }
          const float rstd = rsqrtf(wave_sum(s2) * (1.f / 1024.f) + 1e-5f);
          if (lane == 0) { STATS[t * 2] = mean; STATS[t * 2 + 1] = rstd; } }
        { const u32x4 a = *(const u32x4*)(CQ + (size_t)t * 512 + lane * 8), b = *(const u32x4*)(CKV + (size_t)t * 512 + lane * 8);
          float sa = bflo(a.x) * bflo(a.x) + bfhi(a.x) * bfhi(a.x) + bflo(a.y) * bflo(a.y) + bfhi(a.y) * bfhi(a.y) + bflo(a.z) * bflo(a.z) + bfhi(a.z) * bfhi(a.z) + bflo(a.w) * bflo(a.w) + bfhi(a.w) * bfhi(a.w);
          float sb = bflo(b.x) * bflo(b.x) + bfhi(b.x) * bfhi(b.x) + bflo(b.y) * bflo(b.y) + bfhi(b.y) * bfhi(b.y) + bflo(b.z) * bflo(b.z) + bfhi(b.z) * bfhi(b.z) + bflo(b.w) * bflo(b.w) + bfhi(b.w) * bfhi(b.w);
          sa = wave_sum(sa); sb = wave_sum(sb);
          if (lane == 0) { RS[t * 2] = rsqrtf(sa * (1.f / 512.f) + EPS); RS[t * 2 + 1] = rsqrtf(sb * (1.f / 512.f) + EPS); } }
        if (lane < 32) { const float x1 = MISC[(size_t)t * 128 + lane], x2 = MISC[(size_t)t * 128 + 32 + lane];
            const float c = CS[(size_t)t * 64 + lane], s = CS[(size_t)t * 64 + 32 + lane];
            KR[(size_t)t * 64 + lane] = f2bf(x1 * c - x2 * s); KR[(size_t)t * 64 + 32 + lane] = f2bf(x1 * s + x2 * c); }
    }
}

__device__ __forceinline__ void dn_scan_item(const Params& p, int l, LAS float* L, int bh) {
    unsigned char* ws = p.ws;
    int tid = threadIdx.x; asm volatile("" : "+v"(tid));
    const int lane = tid & 63, wave = tid >> 6, jl = lane & 15, g = lane >> 4;
    const int b = bh >> 3, h = bh & 7, dv0 = wave * 16;
    const bf16_t* Z = (const bf16_t*)(ws + OFF_Z); bf16_t* OA = (bf16_t*)(ws + OFF_OA);
    const float* EGp = (const float*)(ws + OFF_DEG);
    const float ng0 = p.dng[l * 128 + lane], ng1 = p.dng[l * 128 + 64 + lane];
    f32x4 S[8];
#pragma unroll
    for (int i = 0; i < 8; ++i) S[i] = (f32x4){0.f, 0.f, 0.f, 0.f};
    int par = 0;
    for (int n = 0; n < 32; ++n) {
        const int item = (b * 32 + n) * 8 + h;
        const bf16_t* Wp = (const bf16_t*)(ws + OFF_DW) + (size_t)item * 8192; const bf16_t* QGp = (const bf16_t*)(ws + OFF_DQG) + (size_t)item * 8192;
        const bf16_t* KGTp = (const bf16_t*)(ws + OFF_DKGT) + (size_t)item * 8192; const bf16_t* UTp = (const bf16_t*)(ws + OFF_DUT) + (size_t)item * 8192;
        const bf16_t* QKp = (const bf16_t*)(ws + OFF_DQK) + (size_t)item * 4096;
        const float eg = EGp[item];
        bf16x8 sf[4];
#pragma unroll
        for (int ks = 0; ks < 4; ++ks) sf[ks] = pack8(S[2 * ks], S[2 * ks + 1]);
        f32x4 vn[4];
#pragma unroll
        for (int cb = 0; cb < 4; ++cb) { f32x4 acc = (f32x4){0.f, 0.f, 0.f, 0.f};
#pragma unroll
            for (int ks = 0; ks < 4; ++ks) { const bf16x8 a = load2x4(Wp + (cb * 16 + jl) * 128 + ks * 32 + g * 4); acc = MFMA16(a, sf[ks], acc); }
            const u32x2 uw = *(const u32x2*)(UTp + (dv0 + jl) * 64 + cb * 16 + g * 4);
            vn[cb] = (f32x4){bflo(uw.x), bfhi(uw.x), bflo(uw.y), bfhi(uw.y)} - acc; }
        bf16x8 vf[2];
        vf[0] = pack8(vn[0], vn[1]); vf[1] = pack8(vn[2], vn[3]);
        LAS float* sO = L + par * (64 * 132);
#pragma unroll
        for (int cb = 0; cb < 4; ++cb) { f32x4 acc = (f32x4){0.f, 0.f, 0.f, 0.f};
#pragma unroll
            for (int ks = 0; ks < 4; ++ks) { const bf16x8 a = load2x4(QGp + (cb * 16 + jl) * 128 + ks * 32 + g * 4); acc = MFMA16(a, sf[ks], acc); }
#pragma unroll
            for (int k2 = 0; k2 < 2; ++k2) { const bf16x8 a = load2x4(QKp + (cb * 16 + jl) * 64 + k2 * 32 + g * 4); acc = MFMA16(a, vf[k2], acc); }
#pragma unroll
            for (int r = 0; r < 4; ++r) sO[(cb * 16 + g * 4 + r) * 132 + dv0 + jl] = acc[r]; }
#pragma unroll
        for (int db = 0; db < 8; ++db) { f32x4 acc = S[db] * eg;
#pragma unroll
            for (int k2 = 0; k2 < 2; ++k2) { const bf16x8 a = load2x4(KGTp + (db * 16 + jl) * 64 + k2 * 32 + g * 4); acc = MFMA16(a, vf[k2], acc); }
            S[db] = acc; }
        __syncthreads();
#pragma unroll
        for (int cc = 0; cc < 8; ++cc) { const int c = wave * 8 + cc; const float o0 = sO[c * 132 + lane], o1 = sO[c * 132 + 64 + lane];
            const float rs = rsqrtf(wave_sum(o0 * o0 + o1 * o1) * (1.f / 128.f) + EPS);
            const size_t tok = (size_t)b * SEQ_ + n * 64 + c;
            const float z0 = bf1(Z[tok * 1024 + h * 128 + lane]), z1 = bf1(Z[tok * 1024 + h * 128 + 64 + lane]);
            OA[tok * 1024 + h * 128 + lane] = f2bf(o0 * rs * ng0 * siluf_(z0));
            OA[tok * 1024 + h * 128 + 64 + lane] = f2bf(o1 * rs * ng1 * siluf_(z1)); }
        par ^= 1;
    }
    __syncthreads();
}

__device__ __forceinline__ void attn_item(const Params& p, int idx) {
    unsigned char* ws = p.ws;
    int tid = threadIdx.x; asm volatile("" : "+v"(tid));
    const int lane = tid & 63, wave = tid >> 6, jl = lane & 15, g = lane >> 4;
    const int qb = 15 - (idx >> 5), bh = idx & 31, b = bh >> 3, h = bh & 7;
    const int s0 = qb * 128 + wave * 16; const size_t tq = (size_t)b * SEQ_ + s0 + jl;
    const bf16_t* QB = (const bf16_t*)(ws + OFF_QB);
    bf16x8 qf[6];
#pragma unroll
    for (int ks = 0; ks < 6; ++ks) qf[ks] = *(const bf16x8*)(QB + tq * 1536 + h * 192 + ks * 32 + g * 8);
    const int nkb = (((s0 >> 6) + 1) * 64) >> 5;
    const bf16_t* KNb = (const bf16_t*)(ws + OFF_KN) + (size_t)(b * SEQ_) * 1024 + h * 128;
    const bf16_t* KRb = (const bf16_t*)(ws + OFF_KR) + (size_t)(b * SEQ_) * 64;
    const bf16_t* VTb = (const bf16_t*)(ws + OFF_VT) + (size_t)(h * 128) * 8192 + (size_t)b * SEQ_;
    f32x4 o[8];
#pragma unroll
    for (int i = 0; i < 8; ++i) o[i] = (f32x4){0.f, 0.f, 0.f, 0.f};
    float mrun = -1e30f, lsum = 0.f;
    for (int kb = 0; kb < nkb; ++kb) {
        f32x4 s[2];
#pragma unroll
        for (int sb = 0; sb < 2; ++sb) { const int key = kb * 32 + sb * 16 + jl; f32x4 acc = (f32x4){0.f, 0.f, 0.f, 0.f};
#pragma unroll
            for (int ks = 0; ks < 4; ++ks) { const bf16x8 kf = *(const bf16x8*)(KNb + (size_t)key * 1024 + ks * 32 + g * 8); acc = MFMA16(kf, qf[ks], acc); }
#pragma unroll
            for (int ks = 0; ks < 2; ++ks) { const bf16x8 kf = *(const bf16x8*)(KRb + (size_t)key * 64 + ks * 32 + g * 8); acc = MFMA16(kf, qf[4 + ks], acc); }
            s[sb] = acc; }
        float mx = fmaxf(fmaxf(fmaxf(s[0][0], s[0][1]), fmaxf(s[0][2], s[0][3])), fmaxf(fmaxf(s[1][0], s[1][1]), fmaxf(s[1][2], s[1][3])));
        mx = fmaxf(mx, __shfl_xor(mx, 16)); mx = fmaxf(mx, __shfl_xor(mx, 32));
        const float mnew = fmaxf(mrun, mx), alpha = __builtin_amdgcn_exp2f(mrun - mnew); mrun = mnew;
        float ps = 0.f;
#pragma unroll
        for (int sb = 0; sb < 2; ++sb)
#pragma unroll
            for (int r = 0; r < 4; ++r) { const float pv = __builtin_amdgcn_exp2f(s[sb][r] - mnew); s[sb][r] = pv; ps += pv; }
        lsum = lsum * alpha + ps;
        const bf16x8 pf = pack8(s[0], s[1]);
#pragma unroll
        for (int db = 0; db < 8; ++db) { const bf16x8 a = load2x4(VTb + (size_t)(db * 16 + jl) * 8192 + kb * 32 + g * 4); o[db] = MFMA16(a, pf, o[db] * alpha); }
    }
    lsum += __shfl_xor(lsum, 16); lsum += __shfl_xor(lsum, 32);
    const float inv = 1.f / lsum;
    bf16_t* OC = (bf16_t*)(ws + OFF_OC);
#pragma unroll
    for (int db = 0; db < 8; ++db) { const f32x4 v = o[db] * inv; u32x2 w; w.x = pk2(v[0], v[1]); w.y = pk2(v[2], v[3]);
        *(u32x2*)(OC + tq * 1024 + h * 128 + db * 16 + g * 4) = w; }
}

__device__ __forceinline__ void sg_item(const Params& p, int l, int idx) {
    unsigned char* ws = p.ws;
    int tid = threadIdx.x; asm volatile("" : "+v"(tid));
    const int lane = tid & 63, wave = tid >> 6, jl = lane & 15, g = lane >> 4;
    const int gi = idx & 7, nb = (idx >> 3) & 15, b = idx >> 7;
    const size_t t0 = (size_t)b * SEQ_ + nb * 128; const int cc = gi * 128 + wave * 16 + jl;
    const bf16_t* SG = (const bf16_t*)(ws + OFF_SG); const float* STATS = (const float*)(ws + OFF_STATS); const bf16_t* SGW = (const bf16_t*)(ws + OFF_SGW);
    bf16_t* OB = (bf16_t*)(ws + OFF_OB);
    const float lg = p.lng[l * 1024 + cc], lb = p.lnb[l * 1024 + cc];
    bf16x8 bfr[4];
#pragma unroll
    for (int kb = 0; kb < 4; ++kb) { float v[8];
#pragma unroll
        for (int e = 0; e < 8; ++e) { const size_t tok = t0 + kb * 32 + g * 8 + e; const f32x2 st = *(const f32x2*)(STATS + tok * 2);
            v[e] = (bf1(SG[tok * 2048 + 1024 + cc]) - st.x) * st.y * lg + lb; }
        u32x4 w; w.x = pk2(v[0], v[1]); w.y = pk2(v[2], v[3]); w.z = pk2(v[4], v[5]); w.w = pk2(v[6], v[7]); bfr[kb] = __builtin_bit_cast(bf16x8, w); }
#pragma unroll
    for (int ib = 0; ib < 8; ++ib) { f32x4 acc = (f32x4){0.f, 0.f, 0.f, 0.f};
#pragma unroll
        for (int kb = 0; kb < 4; ++kb) { const bf16x8 a = *(const bf16x8*)(SGW + (size_t)(gi * 128 + ib * 16 + jl) * 128 + kb * 32 + g * 8); acc = MFMA16(a, bfr[kb], acc); }
#pragma unroll
        for (int r = 0; r < 4; ++r) { const int i = ib * 16 + g * 4 + r; const size_t tok = t0 + i;
            const float mixed = acc[r] + p.sgb[l * 1024 + gi * 128 + i];
            OB[tok * 1024 + cc] = f2bf(bf1(SG[tok * 2048 + cc]) * mixed); } }
}

typedef const Params __attribute__((address_space(4)))* KP;
__device__ __forceinline__ Params ldp(KP q) {
#if defined(__HIP_DEVICE_COMPILE__)
    asm volatile("" : "+s"(q)); return *q;
#else
    return Params{};
#endif
}
#define PQ const Params p = ldp(kp); unsigned char* ws = p.ws; (void)ws;
__global__ __launch_bounds__(512, 2) void fwd_megakernel(Params p_unused) {
    extern __shared__ __attribute__((aligned(16))) unsigned char shm[];
    LAS unsigned char* lds = (LAS unsigned char*)shm;
    LAS float* L = (LAS float*)shm;
    LAS int* s_item = (LAS int*)(shm + 151296);
    cg::grid_group grid = cg::this_grid();
    KP kp = (KP)__builtin_amdgcn_kernarg_segment_ptr();

#ifndef NO_CVT
    { PQ convert_layer(p, 0, lds); }
#endif
    { PQ int tid = threadIdx.x; asm volatile("" : "+v"(tid));
      const size_t gt = (size_t)blockIdx.x * 512 + tid, NGT = (size_t)gridDim.x * 512; float* CS = (float*)(ws + OFF_CS);
      for (size_t e = gt; e < (size_t)T_ * 32; e += NGT) { const int t = (int)(e >> 5), i = (int)(e & 31);
          const float inv_freq = exp2f(-(float)(2 * i) * (1.f / 64.f) * 13.287712379549449f);
          const float ang = (float)p.pos[t] * inv_freq; float sn, cs; sn = sinf(ang); cs = cosf(ang);
          CS[(size_t)t * 64 + i] = cs; CS[(size_t)t * 64 + 32 + i] = sn; }
      if (gt < 64) ((unsigned*)(ws + OFF_CTR))[gt] = 0u; }
    { PQ rowpass(p.x, nullptr, 0.f, nullptr, p.norm_g, p.out, (bf16_t*)(ws + OFF_H)); }
    grid.sync();

    for (int l = 0; l < 2; ++l) {
        { PQ EpiSwiGLU e; e.O = (bf16_t*)(ws + OFF_GATE); run_gemm(lds, (const bf16_t*)(ws + OFF_H), (const bf16_t*)(ws + OFF_WGU), T_, 11264, 2048, e); }
        grid.sync();
        { PQ EpiF32 e; e.C = (float*)(ws + OFF_F); e.ldc = DM; run_gemm(lds, (const bf16_t*)(ws + OFF_GATE), (const bf16_t*)(ws + OFF_WDN), T_, 2048, FF, e); }
        grid.sync();
        { PQ const float* ng = p.norm_g + (size_t)l * 6 * DM; rowpass(p.out, (const float*)(ws + OFF_F), 0.5f, ng + DM, ng + 2 * DM, p.out, (bf16_t*)(ws + OFF_H)); }
        grid.sync();
        { PQ EpiWin e; e.ws = ws; run_gemm(lds, (const bf16_t*)(ws + OFF_H), (const bf16_t*)(ws + OFF_WIN), T_, NINP, 2048, e); }
        grid.sync();
#ifndef NO_PREP
        { PQ for (int item = blockIdx.x; item < 1024; item += gridDim.x) dn_prep_item(p, l, L, item); }
#endif
#ifndef NO_ROWI
        { PQ row_items(p); }
#endif
        grid.sync();
        { PQ EpiQ e; e.QB = (bf16_t*)(ws + OFF_QB); e.RS = (const float*)(ws + OFF_RS); e.CS = (const float*)(ws + OFF_CS); e.qscale = 0.07216878364870322f * 1.4426950408889634f;
          run_gemm(lds, (const bf16_t*)(ws + OFF_CQ), (const bf16_t*)(ws + OFF_WUQ), T_, 1536, 512, e); }
        { PQ EpiKN e; e.O = (bf16_t*)(ws + OFF_KN); e.RS = (const float*)(ws + OFF_RS);
          run_gemm(lds, (const bf16_t*)(ws + OFF_CKV), (const bf16_t*)(ws + OFF_WUKV), T_, 1024, 512, e); }
        { PQ EpiVT e; e.O = (bf16_t*)(ws + OFF_VT); e.RS = (const float*)(ws + OFF_RS);
          run_gemm(lds, (const bf16_t*)(ws + OFF_WUKV) + (size_t)1024 * 512, (const bf16_t*)(ws + OFF_CKV), 1024, T_, 512, e); }
        grid.sync();
        for (;;) {
            PQ
            __syncthreads();
            if (threadIdx.x == 0) *s_item = (int)atomicAdd((unsigned*)(ws + OFF_CTR) + l, 1u);
            __syncthreads();
            const int it = *s_item;
            if (it >= 32 + 512 + 512) break;
#ifndef NO_SCAN
            if (it < 32) dn_scan_item(p, l, L, it);
#endif
#ifndef NO_ATTN
            if (it >= 32 && it < 32 + 512) attn_item(p, it - 32);
#endif
#ifndef NO_SG
            if (it >= 32 + 512) sg_item(p, l, it - 32 - 512);
#endif
        }
        grid.sync();
        { PQ EpiBranch<0> e; e.ACC = (float*)(ws + OFF_F); e.GATE = (const bf16_t*)(ws + OFF_GATE); e.OUT = (bf16_t*)(ws + OFF_MERGED); run_gemm(lds, (const bf16_t*)(ws + OFF_OA), (const bf16_t*)(ws + OFF_WBR), T_, 2048, 1024, e); }
        { PQ EpiBranch<1> e; e.ACC = (float*)(ws + OFF_F); e.GATE = (const bf16_t*)(ws + OFF_GATE); e.OUT = (bf16_t*)(ws + OFF_MERGED); run_gemm(lds, (const bf16_t*)(ws + OFF_OB), (const bf16_t*)(ws + OFF_WBR) + (size_t)2048 * 1024, T_, 2048, 1024, e); }
        { PQ EpiBranch<2> e; e.ACC = (float*)(ws + OFF_F); e.GATE = (const bf16_t*)(ws + OFF_GATE); e.OUT = (bf16_t*)(ws + OFF_MERGED); run_gemm(lds, (const bf16_t*)(ws + OFF_OC), (const bf16_t*)(ws + OFF_WBR) + (size_t)2 * 2048 * 1024, T_, 2048, 1024, e); }
        grid.sync();
        { PQ EpiF32 e; e.C = (float*)(ws + OFF_F); e.ldc = DM; run_gemm(lds, (const bf16_t*)(ws + OFF_MERGED), (const bf16_t*)(ws + OFF_WOUT), T_, 2048, 2048, e); }
        grid.sync();
        { PQ const float* ng = p.norm_g + (size_t)l * 6 * DM; rowpass(p.out, (const float*)(ws + OFF_F), 1.0f, ng + 3 * DM, ng + 4 * DM, p.out, (bf16_t*)(ws + OFF_H)); }
        grid.sync();
        { PQ EpiSwiGLU e; e.O = (bf16_t*)(ws + OFF_GATE); run_gemm(lds, (const bf16_t*)(ws + OFF_H), (const bf16_t*)(ws + OFF_WGU) + (size_t)11264 * 2048, T_, 11264, 2048, e); }
        grid.sync();
        { PQ EpiF32 e; e.C = (float*)(ws + OFF_F); e.ldc = DM; run_gemm(lds, (const bf16_t*)(ws + OFF_GATE), (const bf16_t*)(ws + OFF_WDN) + (size_t)2048 * FF, T_, 2048, FF, e); }
        grid.sync();
        if (l == 0) {
            { PQ const float* ng = p.norm_g; rowpass(p.out, (const float*)(ws + OFF_F), 0.5f, ng + 5 * DM, ng + 6 * DM, p.out, (bf16_t*)(ws + OFF_H)); }
#ifndef NO_CVT
            { PQ convert_layer(p, 1, lds); }
#endif
            grid.sync();
        } else {
            { PQ const float* ng = p.norm_g + (size_t)6 * DM; rowpass(p.out, (const float*)(ws + OFF_F), 0.5f, ng + 5 * DM, nullptr, p.out, nullptr); }
        }
    }
}

extern "C" void kernel_launch(void* const* d_in, const int* in_sizes, int n_in, void* d_out, int out_size, void* d_ws, size_t ws_size, hipStream_t stream) {
    static int grid_blocks = 0;
    if (!grid_blocks) {
        if (ws_size < WS_END) { fprintf(stderr, "kernel_launch: workspace too small: %zu < %zu\n", ws_size, (size_t)WS_END); grid_blocks = -1; return; }
        int dev = 0, cus = 0, per_cu = 0;
        (void)hipGetDevice(&dev);
        (void)hipDeviceGetAttribute(&cus, hipDeviceAttributeMultiprocessorCount, dev);
        if (hipFuncSetAttribute((const void*)fwd_megakernel, hipFuncAttributeMaxDynamicSharedMemorySize, LDS_BYTES) != hipSuccess) fprintf(stderr, "kernel_launch: hipFuncSetAttribute failed\n");
        if (hipOccupancyMaxActiveBlocksPerMultiprocessor(&per_cu, (const void*)fwd_megakernel, 512, LDS_BYTES) != hipSuccess || per_cu < 1) per_cu = 1;
        (void)hipGetLastError();
        grid_blocks = cus * per_cu;
    }
    if (grid_blocks < 0) return;
    Params p{};
    p.x = (const float*)d_in[0]; p.pos = (const int*)d_in[1]; p.norm_g = (const float*)d_in[2]; p.wg = (const float*)d_in[3]; p.wu = (const float*)d_in[4];
    p.wd = (const float*)d_in[5]; p.win = (const float*)d_in[6]; p.convw = (const float*)d_in[7]; p.alog = (const float*)d_in[8]; p.dtb = (const float*)d_in[9];
    p.dng = (const float*)d_in[10]; p.lng = (const float*)d_in[11]; p.lnb = (const float*)d_in[12]; p.sgw = (const float*)d_in[13]; p.sgb = (const float*)d_in[14];
    p.cqg = (const float*)d_in[15]; p.ckvg = (const float*)d_in[16]; p.wuq = (const float*)d_in[17]; p.wukv = (const float*)d_in[18]; p.wbr = (const float*)d_in[19];
    p.wout = (const float*)d_in[20]; p.out = (float*)d_out; p.ws = (unsigned char*)d_ws;
    void* args[] = {&p};
    hipError_t e = hipLaunchCooperativeKernel((const void*)fwd_megakernel, dim3(grid_blocks), dim3(512), args, LDS_BYTES, stream);
    if (e != hipSuccess) fprintf(stderr, "cooperative launch failed: %s (grid %d)\n", hipGetErrorString(e), grid_blocks);
}
```

```cpp
#include <hip/hip_runtime.h>
#include <hip/hip_cooperative_groups.h>
#include <cstdio>
namespace cg = cooperative_groups;

#define LAS __attribute__((address_space(3)))
typedef unsigned short bf16_t;
typedef short bf16x8 __attribute__((ext_vector_type(8)));
typedef short s16x4 __attribute__((ext_vector_type(4)));
typedef float f32x4 __attribute__((ext_vector_type(4)));
typedef float f32x2 __attribute__((ext_vector_type(2)));
typedef unsigned u32x4 __attribute__((ext_vector_type(4)));
typedef unsigned u32x2 __attribute__((ext_vector_type(2)));

constexpr int T_ = 8192, DM = 2048, FF = 5632, NIN = 13392, NINP = 13568, SEQ_ = 2048;
constexpr int LDS_BYTES = 151552;
constexpr float EPS = 1e-6f;

constexpr size_t al256(size_t x) { return (x + 255) & ~(size_t)255; }
constexpr size_t OFF_WGU = 0;
constexpr size_t OFF_WDN = OFF_WGU + (size_t)2 * 11264 * 2048 * 2;
constexpr size_t OFF_WIN = OFF_WDN + (size_t)2 * 2048 * 5632 * 2;
constexpr size_t OFF_WUQ = OFF_WIN + (size_t)NINP * 2048 * 2;
constexpr size_t OFF_WUKV = OFF_WUQ + (size_t)1536 * 512 * 2;
constexpr size_t OFF_WBR = OFF_WUKV + (size_t)2048 * 512 * 2;
constexpr size_t OFF_WOUT = OFF_WBR + (size_t)3 * 2048 * 1024 * 2;
constexpr size_t OFF_SGW = OFF_WOUT + (size_t)2048 * 2048 * 2;
constexpr size_t OFF_H = OFF_SGW + (size_t)8 * 128 * 128 * 2;
constexpr size_t OFF_F = OFF_H + (size_t)T_ * 2048 * 2;
constexpr size_t OFF_GATE = OFF_F + (size_t)T_ * 2048 * 4;
constexpr size_t OFF_QKV = OFF_GATE + (size_t)T_ * 6144 * 2;
constexpr size_t OFF_Z = OFF_QKV + (size_t)T_ * 3072 * 2;
constexpr size_t OFF_SG = OFF_Z + (size_t)T_ * 1024 * 2;
constexpr size_t OFF_CQ = OFF_SG + (size_t)T_ * 2048 * 2;
constexpr size_t OFF_CKV = OFF_CQ + (size_t)T_ * 512 * 2;
constexpr size_t OFF_MISC = OFF_CKV + (size_t)T_ * 512 * 2;
constexpr size_t OFF_DW = OFF_MISC + (size_t)T_ * 128 * 4;
constexpr size_t OFF_DQG = OFF_DW + (size_t)1024 * 8192 * 2;
constexpr size_t OFF_DKGT = OFF_DQG + (size_t)1024 * 8192 * 2;
constexpr size_t OFF_DUT = OFF_DKGT + (size_t)1024 * 8192 * 2;
constexpr size_t OFF_DQK = OFF_DUT + (size_t)1024 * 8192 * 2;
constexpr size_t OFF_DEG = OFF_DQK + (size_t)1024 * 4096 * 2;
constexpr size_t OFF_QB = OFF_DEG + 4096;
constexpr size_t OFF_KN = OFF_QB + (size_t)T_ * 1536 * 2;
constexpr size_t OFF_KR = OFF_KN + (size_t)T_ * 1024 * 2;
constexpr size_t OFF_VT = OFF_KR + (size_t)T_ * 64 * 2;
constexpr size_t OFF_OA = OFF_VT + (size_t)1024 * 8192 * 2;
constexpr size_t OFF_OB = OFF_OA + (size_t)T_ * 1024 * 2;
constexpr size_t OFF_OC = OFF_OB + (size_t)T_ * 1024 * 2;
constexpr size_t OFF_MERGED = OFF_OC + (size_t)T_ * 1024 * 2;
constexpr size_t OFF_STATS = OFF_MERGED + (size_t)T_ * 2048 * 2;
constexpr size_t OFF_RS = OFF_STATS + (size_t)T_ * 2 * 4;
constexpr size_t OFF_CS = OFF_RS + (size_t)T_ * 2 * 4;
constexpr size_t OFF_CTR = OFF_CS + (size_t)T_ * 64 * 4;
constexpr size_t OFF_BAR = OFF_CTR + 256;
constexpr size_t WS_END = OFF_BAR + 16384;

struct Params {
    const float* x; const int* pos; const float* norm_g; const float* wg; const float* wu; const float* wd; const float* win;
    const float* convw; const float* alog; const float* dtb; const float* dng; const float* lng; const float* lnb; const float* sgw; const float* sgb;
    const float* cqg; const float* ckvg; const float* wuq; const float* wukv; const float* wbr; const float* wout;
    float* out; unsigned char* ws;
};

__device__ __forceinline__ unsigned pk2(float lo, float hi) { unsigned r; asm volatile("v_cvt_pk_bf16_f32 %0, %1, %2" : "=v"(r) : "v"(lo), "v"(hi)); return r; }
__device__ __forceinline__ float bflo(unsigned u) { return __uint_as_float(u << 16); }
__device__ __forceinline__ float bfhi(unsigned u) { return __uint_as_float(u & 0xffff0000u); }
__device__ __forceinline__ float bf1(bf16_t b) { return __uint_as_float(((unsigned)b) << 16); }
__device__ __forceinline__ bf16_t f2bf(float f) { return (bf16_t)(pk2(f, 0.f) & 0xffffu); }
__device__ __forceinline__ float wave_sum(float v) {
#pragma unroll
    for (int o = 1; o < 64; o <<= 1) v += __shfl_xor(v, o);
    return v;
}
__device__ __forceinline__ float sigmoidf_(float x) { return 1.f / (1.f + __expf(-x)); }
__device__ __forceinline__ float siluf_(float x) { return x / (1.f + __expf(-x)); }
__device__ __forceinline__ f32x2 gelu_pk(f32x2 v) {
    const f32x2 av = __builtin_elementwise_abs(v), d = av * 0.2316418882f + 1.0f;
    f32x2 t; t.x = __builtin_amdgcn_rcpf(d.x); t.y = __builtin_amdgcn_rcpf(d.y);
    f32x2 q = t * 0.5307027145f + (-0.7265760135f); q = q * t + 0.7107068705f; q = q * t + (-0.142248368f); q = q * t + 0.127414796f; q = q * t;
    const f32x2 s = (v * v) * (-0.72134752044f);
    f32x2 e; e.x = __builtin_amdgcn_exp2f(s.x); e.y = __builtin_amdgcn_exp2f(s.y);
    const f32x2 m = v * (q * e), r = v - m;
    f32x2 o; o.x = v.x < 0.f ? m.x : r.x; o.y = v.y < 0.f ? m.y : r.y; return o;
}
__device__ __forceinline__ bf16x8 load2x4(const bf16_t* p) {
    const s16x4 lo = *(const s16x4*)p, hi = *(const s16x4*)(p + 16);
    return __builtin_shufflevector(lo, hi, 0, 1, 2, 3, 4, 5, 6, 7);
}
__device__ __forceinline__ bf16x8 pack8(f32x4 a, f32x4 b) {
    u32x4 w; w.x = pk2(a[0], a[1]); w.y = pk2(a[2], a[3]); w.z = pk2(b[0], b[1]); w.w = pk2(b[2], b[3]);
    return __builtin_bit_cast(bf16x8, w);
}
#define MFMA16(a, b, c) __builtin_amdgcn_mfma_f32_16x16x32_bf16((a), (b), (c), 0, 0, 0)
#define LDS_WAIT() asm volatile("s_waitcnt lgkmcnt(0)" ::: "memory")

namespace pg8 {
constexpr int BM = 256, BK = 64, HALF = 128, HTB = HALF * BK * 2, NXCD = 8, WGM = 8;
__device__ __forceinline__ int lds_byte(int r, int c) { const int st = (r >> 4) * 2 + (c >> 5), rr = r & 15, cc = c & 31, ob = rr * 64 + cc * 2; return st * 1024 + (ob ^ (((ob >> 9) & 1) << 5)); }
__device__ __forceinline__ void stage_rc(int b, int& R, int& C) { const int st = b / 1024, sb = b % 1024, swz = sb ^ (((sb >> 9) & 1) << 5); R = (st >> 1) * 16 + swz / 64; C = (st & 1) * 32 + (swz % 64) / 2; }
__device__ __forceinline__ int perm32(int rho) { const int n = rho >> 4, i = rho & 15; return 8 * (i >> 2) + 4 * n + (i & 3); }
struct Unit { int pm, pn; };
struct Gemm { const bf16_t* A; const bf16_t* Bt; int M, N, K; };
struct StaticOrder {
    int nM, nN, nwg, G, c;
    __device__ __forceinline__ void init(int M, int N, int G_, int c_) { nM = M / BM; nN = N / BM; nwg = nM * nN; G = G_; c = c_; }
    __device__ __forceinline__ bool next(int i, Unit& u) const {
        const long L = (long)i * G + c; if (L >= nwg) return false;
        int wgid = (int)L; { const int q = nwg / NXCD, r = nwg % NXCD, xcd = wgid % NXCD, off = wgid / NXCD; wgid = (xcd < r ? xcd * (q + 1) : r * (q + 1) + (xcd - r) * q) + off; }
        const int nig = WGM * nN, gid = wgid / nig, fm = gid * WGM, gsz = (nM - fm) < WGM ? (nM - fm) : WGM;
        u.pm = fm + ((wgid % nig) % gsz); u.pn = (wgid % nig) / gsz; return true;
    }
};
template <class Epi>
__device__ __forceinline__ void gemm_phase(LAS unsigned char* lds, const Gemm g, const StaticOrder& S, const Epi& E) {
    int tid = threadIdx.x; asm volatile("" : "+v"(tid));
    const int wid = __builtin_amdgcn_readfirstlane(tid >> 6), lane = tid & 63, wr = wid >> 2, wc = wid & 3, fr = lane & 15, fq = lane >> 4;
    const int K = g.K, nt = K / BK;
    unsigned voffA[2], voffB[2];
#pragma unroll
    for (int i = 0; i < 2; ++i) { int R, C; stage_rc(tid * 16 + i * 8192, R, C); const int Rb = Epi::PERM ? ((R & ~31) + perm32(R & 31)) : R;
        voffA[i] = (unsigned)(R * K + C) * 2u; voffB[i] = (unsigned)(Rb * K + C) * 2u; }
    const size_t kstep = (size_t)(BK * 2);
    const size_t hstep = (size_t)HALF * K * 2;
    const size_t tstep = 2 * hstep;
    const unsigned ldsw = (unsigned)wid * 1024u;
    const int aoff = lds_byte(wr * 64 + fr, fq * 8), boff = lds_byte(wc * 32 + fr, fq * 8);
#define PG8_SA(b, h) (((b) * 2 + (h)) * HTB)
#define PG8_SB(b, h) ((4 + (b) * 2 + (h)) * HTB)
#define PG8_STAGE(bufoff, gbase, voff) do { _Pragma("unroll") for (int _i = 0; _i < 2; ++_i) \
        __builtin_amdgcn_global_load_lds((const unsigned*)((const char*)(gbase) + (voff)[_i]), (LAS unsigned*)(lds + (bufoff) + ldsw + _i * 8192), 16, 0, 0); } while (0)
#define PG8_LDA(dst, b, h) do { _Pragma("unroll") for (int m = 0; m < 4; ++m) _Pragma("unroll") for (int k = 0; k < 2; ++k) dst[m][k] = *(const LAS bf16x8*)(lds + PG8_SA(b, h) + aoff + m * 2048 + k * 1024); } while (0)
#define PG8_LDB(dst, b, h) do { _Pragma("unroll") for (int n = 0; n < 2; ++n) _Pragma("unroll") for (int k = 0; k < 2; ++k) dst[n][k] = *(const LAS bf16x8*)(lds + PG8_SB(b, h) + boff + n * 2048 + k * 1024); } while (0)
#define PG8_MMA(ai, bj, At, Bt) do { __builtin_amdgcn_s_setprio(1); _Pragma("unroll") for (int m = 0; m < 4; ++m) _Pragma("unroll") for (int n = 0; n < 2; ++n) _Pragma("unroll") for (int k = 0; k < 2; ++k) \
        acc[ai][bj][m][n] = __builtin_amdgcn_mfma_f32_16x16x32_bf16(Bt[n][k], At[m][k], acc[ai][bj][m][n], 0, 0, 0); __builtin_amdgcn_s_setprio(0); } while (0)
#define PG8_WAIT_V(n) asm volatile("s_waitcnt vmcnt(" #n ")" ::: "memory")
#define PG8_WAIT_L(n) asm volatile("s_waitcnt lgkmcnt(" #n ")" ::: "memory")
#define PG8_BAR __builtin_amdgcn_s_barrier()
#define PG8_SCHED __builtin_amdgcn_sched_barrier(0)
    Unit cur, nxt; int ui = 0;
    if (!S.next(0, cur)) return;
    f32x4 acc[2][2][4][2];
#pragma unroll
    for (int a = 0; a < 2; ++a)
#pragma unroll
        for (int b = 0; b < 2; ++b)
#pragma unroll
            for (int m = 0; m < 4; ++m)
#pragma unroll
                for (int n = 0; n < 2; ++n) acc[a][b][m][n] = (f32x4){0.f, 0.f, 0.f, 0.f};
    bf16x8 At[4][2], B0[2][2], B1[2][2];
    const char* cA = (const char*)g.A + (size_t)cur.pm * tstep; const char* cB = (const char*)g.Bt + (size_t)cur.pn * tstep;
    PG8_STAGE(PG8_SB(0, 0), cB, voffB); PG8_STAGE(PG8_SA(0, 0), cA, voffA); PG8_STAGE(PG8_SB(0, 1), cB + hstep, voffB); PG8_STAGE(PG8_SA(0, 1), cA + hstep, voffA);
    if (wr == 1) PG8_BAR;
    PG8_WAIT_V(4); PG8_BAR;
    PG8_STAGE(PG8_SB(1, 0), cB + kstep, voffB); PG8_STAGE(PG8_SA(1, 0), cA + kstep, voffA); PG8_STAGE(PG8_SB(1, 1), cB + hstep + kstep, voffB);
    PG8_WAIT_V(6); PG8_BAR;
    for (;;) {
        const bool has_next = S.next(ui + 1, nxt);
        const char* nA = has_next ? (const char*)g.A + (size_t)nxt.pm * tstep : cA; const char* nB = has_next ? (const char*)g.Bt + (size_t)nxt.pn * tstep : cB;
        for (int t = 0; t < nt; t += 2) {
            const bool last = (t == nt - 2);
            const char* a1 = cA + (size_t)(t + 1) * kstep;
            const char* a2 = last ? nA : cA + (size_t)(t + 2) * kstep; const char* b2 = last ? nB : cB + (size_t)(t + 2) * kstep;
            const char* a3 = a2 + kstep; const char* b3 = b2 + kstep;
            PG8_LDB(B0, 0, 0); PG8_SCHED; PG8_LDA(At, 0, 0); PG8_STAGE(PG8_SA(1, 1), a1 + hstep, voffA);
            PG8_WAIT_L(8); PG8_BAR; PG8_WAIT_L(0); PG8_MMA(0, 0, At, B0); PG8_BAR; PG8_SCHED;
            PG8_LDB(B1, 0, 1); PG8_STAGE(PG8_SB(0, 0), b2, voffB);
            PG8_BAR; PG8_WAIT_L(0); PG8_MMA(0, 1, At, B1); PG8_BAR;
            PG8_LDA(At, 0, 1); PG8_STAGE(PG8_SA(0, 0), a2, voffA);
            PG8_BAR; PG8_WAIT_L(0); PG8_MMA(1, 0, At, B0); PG8_BAR; PG8_SCHED;
            PG8_STAGE(PG8_SB(0, 1), b2 + hstep, voffB);
            PG8_WAIT_V(6); PG8_BAR; PG8_MMA(1, 1, At, B1); PG8_BAR;
            PG8_LDB(B0, 1, 0); PG8_SCHED; PG8_LDA(At, 1, 0); PG8_STAGE(PG8_SA(0, 1), a2 + hstep, voffA);
            PG8_WAIT_L(8); PG8_BAR; PG8_WAIT_L(0); PG8_MMA(0, 0, At, B0); PG8_BAR; PG8_SCHED;
            PG8_LDB(B1, 1, 1); PG8_STAGE(PG8_SB(1, 0), b3, voffB);
            PG8_BAR; PG8_WAIT_L(0); PG8_MMA(0, 1, At, B1); PG8_BAR;
            PG8_LDA(At, 1, 1); PG8_STAGE(PG8_SA(1, 0), a3, voffA);
            PG8_BAR; PG8_WAIT_L(0); PG8_MMA(1, 0, At, B0); PG8_BAR; PG8_SCHED;
            PG8_STAGE(PG8_SB(1, 1), b3 + hstep, voffB);
            PG8_WAIT_V(6); PG8_BAR; PG8_MMA(1, 1, At, B1); PG8_BAR;
        }
        E(acc, cur, wr, wc, fr, fq);
        if (!has_next) break;
#pragma unroll
        for (int a = 0; a < 2; ++a)
#pragma unroll
            for (int b = 0; b < 2; ++b)
#pragma unroll
                for (int m = 0; m < 4; ++m)
#pragma unroll
                    for (int n = 0; n < 2; ++n) acc[a][b][m][n] = (f32x4){0.f, 0.f, 0.f, 0.f};
        cur = nxt; cA = nA; cB = nB; ++ui;
    }
    PG8_WAIT_V(0);
    if (wr == 0) PG8_BAR;
    PG8_BAR;
#undef PG8_SA
#undef PG8_SB
#undef PG8_STAGE
#undef PG8_LDA
#undef PG8_LDB
#undef PG8_MMA
#undef PG8_WAIT_V
#undef PG8_WAIT_L
#undef PG8_BAR
#undef PG8_SCHED
}
}
using pg8::Unit;
typedef f32x4 Acc[2][2][4][2];

struct EpiF32 {
    static constexpr bool PERM = false;
    float* C; int ldc;
    __device__ __forceinline__ void operator()(const Acc& acc, const Unit& u, int wr, int wc, int fr, int fq) const {
        const int row0 = u.pm * 256 + wr * 64 + fr, col0 = u.pn * 256 + wc * 32 + 4 * fq;
#pragma unroll
        for (int ai = 0; ai < 2; ++ai)
#pragma unroll
            for (int m = 0; m < 4; ++m) { float* rowp = C + (size_t)(row0 + ai * 128 + m * 16) * ldc + col0;
#pragma unroll
                for (int bj = 0; bj < 2; ++bj)
#pragma unroll
                    for (int n = 0; n < 2; ++n) *(f32x4*)(rowp + bj * 128 + n * 16) = acc[ai][bj][m][n]; }
    }
};
struct EpiSwiGLU {
    static constexpr bool PERM = true;
    bf16_t* O;
    __device__ __forceinline__ void operator()(const Acc& acc, const Unit& u, int wr, int wc, int fr, int fq) const {
        const int row0 = u.pm * 256 + wr * 64 + fr, col0 = u.pn * 128 + wc * 32 + 8 * fq;
#pragma unroll
        for (int ai = 0; ai < 2; ++ai)
#pragma unroll
            for (int m = 0; m < 4; ++m) {
                f32x4 v0, v1;
#pragma unroll
                for (int e = 0; e < 4; ++e) { v0[e] = siluf_(acc[ai][0][m][0][e]) * acc[ai][1][m][0][e]; v1[e] = siluf_(acc[ai][0][m][1][e]) * acc[ai][1][m][1][e]; }
                u32x4 w; w.x = pk2(v0[0], v0[1]); w.y = pk2(v0[2], v0[3]); w.z = pk2(v1[0], v1[1]); w.w = pk2(v1[2], v1[3]);
                *(u32x4*)(O + (size_t)(row0 + ai * 128 + m * 16) * FF + col0) = w; }
    }
};
struct EpiWin {
    static constexpr bool PERM = true;
    unsigned char* ws;
    __device__ __forceinline__ void operator()(const Acc& acc, const Unit& u, int wr, int wc, int fr, int fq) const {
        const int pn = u.pn, row0 = u.pm * 256 + wr * 64 + fr;
        if (pn == 52) {
            float* M = (float*)(ws + OFF_MISC);
#pragma unroll
            for (int ai = 0; ai < 2; ++ai)
#pragma unroll
                for (int m = 0; m < 4; ++m)
#pragma unroll
                    for (int n = 0; n < 2; ++n) *(f32x4*)(M + (size_t)(row0 + ai * 128 + m * 16) * 128 + 32 * wc + 8 * fq + 4 * n) = acc[ai][0][m][n];
            return;
        }
        bf16_t* base; int ld, col, mode = 0;
        if (pn < 12) { base = (bf16_t*)(ws + OFF_QKV); ld = 3072; col = pn * 256; }
        else if (pn < 16) { base = (bf16_t*)(ws + OFF_Z); ld = 1024; col = (pn - 12) * 256; }
        else if (pn < 24) { base = (bf16_t*)(ws + OFF_SG); ld = 2048; col = (pn - 16) * 256; mode = 2; }
        else if (pn < 26) { base = (bf16_t*)(ws + OFF_CQ); ld = 512; col = (pn - 24) * 256; }
        else if (pn < 28) { base = (bf16_t*)(ws + OFF_CKV); ld = 512; col = (pn - 26) * 256; }
        else { base = (bf16_t*)(ws + OFF_GATE); ld = 6144; col = (pn - 28) * 256; mode = 1; }
        col += wc * 32 + 8 * fq;
#pragma unroll
        for (int ai = 0; ai < 2; ++ai)
#pragma unroll
            for (int m = 0; m < 4; ++m) { bf16_t* rowp = base + (size_t)(row0 + ai * 128 + m * 16) * ld + col;
#pragma unroll
                for (int bj = 0; bj < 2; ++bj) { f32x4 v0 = acc[ai][bj][m][0], v1 = acc[ai][bj][m][1];
                    if (mode == 1) {
#pragma unroll
                        for (int e = 0; e < 4; ++e) { v0[e] = sigmoidf_(v0[e]); v1[e] = sigmoidf_(v1[e]); } }
                    else if (mode == 2) { f32x2 a = gelu_pk((f32x2){v0[0], v0[1]}), b = gelu_pk((f32x2){v0[2], v0[3]}), c = gelu_pk((f32x2){v1[0], v1[1]}), d = gelu_pk((f32x2){v1[2], v1[3]});
                        v0 = (f32x4){a.x, a.y, b.x, b.y}; v1 = (f32x4){c.x, c.y, d.x, d.y}; }
                    u32x4 w; w.x = pk2(v0[0], v0[1]); w.y = pk2(v0[2], v0[3]); w.z = pk2(v1[0], v1[1]); w.w = pk2(v1[2], v1[3]);
                    *(u32x4*)(rowp + bj * 128) = w; } }
    }
};
struct EpiQ {
    static constexpr bool PERM = true;
    bf16_t* QB; const float* RS; const float* CS; float qscale;
    __device__ __forceinline__ void operator()(const Acc& acc, const Unit& u, int wr, int wc, int fr, int fq) const {
        const int pn = u.pn, row0 = u.pm * 256 + wr * 64 + fr;
#pragma unroll
        for (int ai = 0; ai < 2; ++ai)
#pragma unroll
            for (int m = 0; m < 4; ++m) { const int row = row0 + ai * 128 + m * 16; const float sc = RS[row * 2] * qscale;
                if (pn < 4) {
#pragma unroll
                    for (int bj = 0; bj < 2; ++bj) { const f32x4 v0 = acc[ai][bj][m][0] * sc, v1 = acc[ai][bj][m][1] * sc;
                        u32x4 w; w.x = pk2(v0[0], v0[1]); w.y = pk2(v0[2], v0[3]); w.z = pk2(v1[0], v1[1]); w.w = pk2(v1[2], v1[3]);
                        *(u32x4*)(QB + (size_t)row * 1536 + (pn * 2 + bj) * 192 + wc * 32 + 8 * fq) = w; }
                } else {
                    const int head = (pn - 4) * 4 + wc, i0 = 8 * fq;
                    const f32x4 c0 = *(const f32x4*)(CS + (size_t)row * 64 + i0), c1 = *(const f32x4*)(CS + (size_t)row * 64 + i0 + 4);
                    const f32x4 s0 = *(const f32x4*)(CS + (size_t)row * 64 + 32 + i0), s1 = *(const f32x4*)(CS + (size_t)row * 64 + 32 + i0 + 4);
                    const f32x4 x10 = acc[ai][0][m][0] * sc, x11 = acc[ai][0][m][1] * sc, x20 = acc[ai][1][m][0] * sc, x21 = acc[ai][1][m][1] * sc;
                    const f32x4 a0 = x10 * c0 - x20 * s0, a1 = x11 * c1 - x21 * s1, b0 = x10 * s0 + x20 * c0, b1 = x11 * s1 + x21 * c1;
                    u32x4 w; w.x = pk2(a0[0], a0[1]); w.y = pk2(a0[2], a0[3]); w.z = pk2(a1[0], a1[1]); w.w = pk2(a1[2], a1[3]);
                    *(u32x4*)(QB + (size_t)row * 1536 + head * 192 + 128 + i0) = w;
                    w.x = pk2(b0[0], b0[1]); w.y = pk2(b0[2], b0[3]); w.z = pk2(b1[0], b1[1]); w.w = pk2(b1[2], b1[3]);
                    *(u32x4*)(QB + (size_t)row * 1536 + head * 192 + 160 + i0) = w;
                } }
    }
};
struct EpiKN {
    static constexpr bool PERM = true;
    bf16_t* O; const float* RS;
    __device__ __forceinline__ void operator()(const Acc& acc, const Unit& u, int wr, int wc, int fr, int fq) const {
        const int row0 = u.pm * 256 + wr * 64 + fr, col0 = u.pn * 256 + wc * 32 + 8 * fq;
#pragma unroll
        for (int ai = 0; ai < 2; ++ai)
#pragma unroll
            for (int m = 0; m < 4; ++m) { const int row = row0 + ai * 128 + m * 16; const float sc = RS[row * 2 + 1];
#pragma unroll
                for (int bj = 0; bj < 2; ++bj) { const f32x4 v0 = acc[ai][bj][m][0] * sc, v1 = acc[ai][bj][m][1] * sc;
                    u32x4 w; w.x = pk2(v0[0], v0[1]); w.y = pk2(v0[2], v0[3]); w.z = pk2(v1[0], v1[1]); w.w = pk2(v1[2], v1[3]);
                    *(u32x4*)(O + (size_t)row * 1024 + col0 + bj * 128) = w; } }
    }
};
struct EpiVT {
    static constexpr bool PERM = true;
    bf16_t* O; const float* RS;
    __device__ __forceinline__ void operator()(const Acc& acc, const Unit& u, int wr, int wc, int fr, int fq) const {
        const int row0 = u.pm * 256 + wr * 64 + fr, col0 = u.pn * 256 + wc * 32 + 8 * fq;
        float sc[2][8];
#pragma unroll
        for (int bj = 0; bj < 2; ++bj)
#pragma unroll
            for (int e = 0; e < 8; ++e) sc[bj][e] = RS[(col0 + bj * 128 + e) * 2 + 1];
#pragma unroll
        for (int ai = 0; ai < 2; ++ai)
#pragma unroll
            for (int m = 0; m < 4; ++m) { const int row = row0 + ai * 128 + m * 16;
#pragma unroll
                for (int bj = 0; bj < 2; ++bj) { const f32x4 v0 = acc[ai][bj][m][0], v1 = acc[ai][bj][m][1];
                    u32x4 w; w.x = pk2(v0[0] * sc[bj][0], v0[1] * sc[bj][1]); w.y = pk2(v0[2] * sc[bj][2], v0[3] * sc[bj][3]);
                    w.z = pk2(v1[0] * sc[bj][4], v1[1] * sc[bj][5]); w.w = pk2(v1[2] * sc[bj][6], v1[3] * sc[bj][7]);
                    *(u32x4*)(O + (size_t)row * 8192 + col0 + bj * 128) = w; } }
    }
};
template <int BR> struct EpiBranch {
    static constexpr bool PERM = true;
    float* ACC; const bf16_t* GATE; bf16_t* OUT;
    __device__ __forceinline__ void operator()(const Acc& acc, const Unit& u, int wr, int wc, int fr, int fq) const {
        const int row0 = u.pm * 256 + wr * 64 + fr, col0 = u.pn * 256 + wc * 32 + 8 * fq;
#pragma unroll
        for (int ai = 0; ai < 2; ++ai)
#pragma unroll
            for (int m = 0; m < 4; ++m) { const int row = row0 + ai * 128 + m * 16;
#pragma unroll
                for (int bj = 0; bj < 2; ++bj) { const int col = col0 + bj * 128;
                    const u32x4 gw = *(const u32x4*)(GATE + (size_t)row * 6144 + BR * 2048 + col);
                    f32x4 v0 = acc[ai][bj][m][0], v1 = acc[ai][bj][m][1];
                    v0[0] *= bflo(gw.x); v0[1] *= bfhi(gw.x); v0[2] *= bflo(gw.y); v0[3] *= bfhi(gw.y);
                    v1[0] *= bflo(gw.z); v1[1] *= bfhi(gw.z); v1[2] *= bflo(gw.w); v1[3] *= bfhi(gw.w);
                    float* ap = ACC + (size_t)row * 2048 + col;
                    if (BR > 0) { v0 += *(const f32x4*)ap; v1 += *(const f32x4*)(ap + 4); }
                    if (BR < 2) { *(f32x4*)ap = v0; *(f32x4*)(ap + 4) = v1; }
                    else { u32x4 w; w.x = pk2(v0[0], v0[1]); w.y = pk2(v0[2], v0[3]); w.z = pk2(v1[0], v1[1]); w.w = pk2(v1[2], v1[3]);
                        *(u32x4*)(OUT + (size_t)row * 2048 + col) = w; } } }
    }
};

template <class Epi>
__device__ __forceinline__ void run_gemm(LAS unsigned char* lds, const bf16_t* A, const bf16_t* Bt, int M, int N, int K, const Epi& E) {
    pg8::Gemm g; g.A = A; g.Bt = Bt; g.M = M; g.N = N; g.K = K;
    pg8::StaticOrder S; S.init(M, N, (int)gridDim.x, (int)blockIdx.x);
    pg8::gemm_phase<Epi>(lds, g, S, E);
}

template <class Map>
__device__ __forceinline__ void cvt_item(const float* W, int K, int N, bf16_t* WT, const float* kscale, LAS float* scr, int item, int lane, Map map) {
    const int nblk = (N + 31) / 32, kb = item / nblk, nb = item % nblk, k0 = 64 * kb, n0 = 32 * nb;
    {
        const int nc4 = n0 + 4 * (lane & 7); const bool ok4 = nc4 < N;
        f32x4 v[8];
#pragma unroll
        for (int i = 0; i < 8; ++i) { const int kk = 8 * i + (lane >> 3); v[i] = ok4 ? *(const f32x4*)(W + (size_t)(k0 + kk) * N + nc4) : (f32x4){0.f, 0.f, 0.f, 0.f}; }
#pragma unroll
        for (int i = 0; i < 8; ++i) { const int kk = 8 * i + (lane >> 3); f32x4 x = v[i]; if (kscale) x = x * kscale[k0 + kk];
            LAS float* d = scr + kk * 33 + 4 * (lane & 7); d[0] = x[0]; d[1] = x[1]; d[2] = x[2]; d[3] = x[3]; }
    }
    LDS_WAIT();
    const int c = lane & 7;
#pragma unroll
    for (int j = 0; j < 4; ++j) { const int n = (lane >> 3) + 8 * j; const LAS float* s = scr + (8 * c) * 33 + n;
        if (n0 + n < N) { const int drow = map(n0 + n);
            u32x4 o; o.x = pk2(s[0 * 33], s[1 * 33]); o.y = pk2(s[2 * 33], s[3 * 33]); o.z = pk2(s[4 * 33], s[5 * 33]); o.w = pk2(s[6 * 33], s[7 * 33]);
            *(u32x4*)(WT + (size_t)drow * K + k0 + 8 * c) = o; } }
    LDS_WAIT();
}
struct MapId { __device__ __forceinline__ int operator()(int n) const { return n; } };
struct MapGU { int off; __device__ __forceinline__ int operator()(int n) const { return (n >> 7) * 256 + off + (n & 127); } };
struct MapWin { __device__ __forceinline__ int operator()(int n) const {
    if (n < 4096) return n;
    if (n < 4112) return 13312 + 64 + (n - 4096);
    if (n < 6160) return 4096 + (n - 4112);
    if (n < 6672) return 6144 + (n - 6160);
    if (n < 7184) return 6656 + (n - 6672);
    if (n < 7248) return 13312 + (n - 7184);
    return 7168 + (n - 7248); } };
struct MapUQ { __device__ __forceinline__ int operator()(int n) const { const int hh = n / 192, d = n - hh * 192;
    if (d < 128) return (hh >> 1) * 256 + (hh & 1) * 128 + d;
    if (d < 160) return 1024 + (hh >> 2) * 256 + (hh & 3) * 32 + (d - 128);
    return 1024 + (hh >> 2) * 256 + 128 + (hh & 3) * 32 + (d - 160); } };
struct MapUKV { __device__ __forceinline__ int operator()(int n) const { const int hh = n >> 8, d = n & 255; return d < 128 ? hh * 128 + d : 1024 + hh * 128 + (d - 128); } };

__device__ __forceinline__ void convert_layer(const Params& p, int l, LAS unsigned char* lds) {
    int tid = threadIdx.x; asm volatile("" : "+v"(tid));
    const int lane = tid & 63, wave = tid >> 6;
    LAS float* scr = (LAS float*)(lds + wave * 8448);
    const int gw = blockIdx.x * 8 + wave, NGW = gridDim.x * 8;
    unsigned char* ws = p.ws;
    constexpr int I_GU = 32 * 176, I_DN = 88 * 64, I_WIN = 32 * 419, I_UQ = 8 * 48, I_UKV = 8 * 64, I_BR = 16 * 64, I_OUT = 32 * 64;
    constexpr int NITEMS = 4 * I_GU + 2 * I_DN + I_WIN + I_UQ + I_UKV + 3 * I_BR + I_OUT;
    for (int it = gw; it < NITEMS; it += NGW) {
        int r = it;
        if (r < 4 * I_GU) { const int which = r / I_GU, i = which >> 1, up = which & 1; r -= which * I_GU;
            const float* W = (up ? p.wu : p.wg) + (size_t)(l * 2 + i) * 2048 * FF;
            MapGU mp; mp.off = up * 128;
            cvt_item(W, 2048, FF, (bf16_t*)(ws + OFF_WGU) + (size_t)i * 11264 * 2048, nullptr, scr, r, lane, mp); continue; }
        r -= 4 * I_GU;
        if (r < 2 * I_DN) { const int i = r / I_DN; r -= i * I_DN;
            cvt_item(p.wd + (size_t)(l * 2 + i) * FF * 2048, FF, 2048, (bf16_t*)(ws + OFF_WDN) + (size_t)i * 2048 * FF, nullptr, scr, r, lane, MapId()); continue; }
        r -= 2 * I_DN;
        if (r < I_WIN) { cvt_item(p.win + (size_t)l * 2048 * NIN, 2048, NIN, (bf16_t*)(ws + OFF_WIN), nullptr, scr, r, lane, MapWin()); continue; }
        r -= I_WIN;
        if (r < I_UQ) { cvt_item(p.wuq + (size_t)l * 512 * 1536, 512, 1536, (bf16_t*)(ws + OFF_WUQ), p.cqg + l * 512, scr, r, lane, MapUQ()); continue; }
        r -= I_UQ;
        if (r < I_UKV) { cvt_item(p.wukv + (size_t)l * 512 * 2048, 512, 2048, (bf16_t*)(ws + OFF_WUKV), p.ckvg + l * 512, scr, r, lane, MapUKV()); continue; }
        r -= I_UKV;
        if (r < 3 * I_BR) { const int j = r / I_BR; r -= j * I_BR;
            cvt_item(p.wbr + (size_t)(l * 3 + j) * 1024 * 2048, 1024, 2048, (bf16_t*)(ws + OFF_WBR) + (size_t)j * 2048 * 1024, nullptr, scr, r, lane, MapId()); continue; }
        r -= 3 * I_BR;
        cvt_item(p.wout + (size_t)l * 2048 * 2048, 2048, 2048, (bf16_t*)(ws + OFF_WOUT), nullptr, scr, r, lane, MapId());
    }
    const size_t gt = (size_t)blockIdx.x * 512 + tid, NGT = (size_t)gridDim.x * 512;
    { bf16_t* SGW = (bf16_t*)(ws + OFF_SGW); const float* src = p.sgw + (size_t)l * 8 * 128 * 128;
      for (size_t e = gt; e < (size_t)8 * 128 * 128; e += NGT) { const int j = (int)(e & 127), i = (int)((e >> 7) & 127); SGW[e] = ((j >> 6) <= (i >> 6)) ? f2bf(src[e]) : (bf16_t)0; } }
    { bf16_t* WIN = (bf16_t*)(ws + OFF_WIN) + (size_t)(13312 + 80) * 2048;
      for (size_t e = gt; e < (size_t)176 * 2048; e += NGT) WIN[e] = 0; }
}

__device__ __forceinline__ void rowpass(const float* xin, const float* f, float alpha, const float* gpost, const float* gpre, float* xout, bf16_t* hout) {
    int tid = threadIdx.x; asm volatile("" : "+v"(tid));
    const int lane = tid & 63, wave = tid >> 6;
    const int gw = blockIdx.x * 8 + wave, NGW = gridDim.x * 8;
    for (int row = gw; row < T_; row += NGW) {
        f32x4 xv[8];
        const f32x4* xr = (const f32x4*)(xin + (size_t)row * DM) + lane;
#pragma unroll
        for (int j = 0; j < 8; ++j) xv[j] = xr[64 * j];
        if (f) {
            f32x4 fv[8]; float ss = 0.f;
            const f32x4* fr = (const f32x4*)(f + (size_t)row * DM) + lane;
#pragma unroll
            for (int j = 0; j < 8; ++j) { fv[j] = fr[64 * j]; ss += fv[j][0] * fv[j][0] + fv[j][1] * fv[j][1] + fv[j][2] * fv[j][2] + fv[j][3] * fv[j][3]; }
            const float rs = rsqrtf(wave_sum(ss) * (1.f / DM) + EPS) * alpha;
#pragma unroll
            for (int j = 0; j < 8; ++j) { const f32x4 gg = *((const f32x4*)gpost + lane + 64 * j); xv[j] += fv[j] * rs * gg; }
        }
        f32x4* xo = (f32x4*)(xout + (size_t)row * DM) + lane;
#pragma unroll
        for (int j = 0; j < 8; ++j) xo[64 * j] = xv[j];
        if (hout) {
            float ss = 0.f;
#pragma unroll
            for (int j = 0; j < 8; ++j) ss += xv[j][0] * xv[j][0] + xv[j][1] * xv[j][1] + xv[j][2] * xv[j][2] + xv[j][3] * xv[j][3];
            const float rs = rsqrtf(wave_sum(ss) * (1.f / DM) + EPS);
            u32x2* ho = (u32x2*)(hout + (size_t)row * DM) + lane;
#pragma unroll
            for (int j = 0; j < 8; ++j) { const f32x4 gg = *((const f32x4*)gpre + lane + 64 * j); const f32x4 y = xv[j] * rs * gg;
                u32x2 w; w.x = pk2(y[0], y[1]); w.y = pk2(y[2], y[3]); ho[64 * j] = w; }
        }
    }
}

__device__ __forceinline__ void dn_prep_item(const Params& p, int l, LAS float* L, int item) {
    unsigned char* ws = p.ws;
    int tid = threadIdx.x; asm volatile("" : "+v"(tid));
    const int lane = tid & 63;
    const int h = item & 7, n = (item >> 3) & 31, b = item >> 8;
    const int t0 = b * SEQ_ + n * 64;
    LAS float* sQ = L; LAS float* sK = L + 64 * 132; LAS float* sX = L + 2 * 64 * 132; LAS float* sA = sX + 64 * 256; LAS float* sG = sA + 64 * 68; LAS float* sB = sG + 64;
    const bf16_t* QKV = (const bf16_t*)(ws + OFF_QKV);
    const float* MISC = (const float*)(ws + OFF_MISC);
    const float* cw = p.convw + (size_t)l * 4 * 3072;
    for (int task = tid; task < 64 * 48; task += 512) {
        const int t = task / 48, cgp = task - t * 48, part = cgp >> 4, d0 = (cgp & 15) * 8, ch = part * 1024 + h * 128 + d0;
        float a[8];
#pragma unroll
        for (int e = 0; e < 8; ++e) a[e] = 0.f;
#pragma unroll
        for (int j = 0; j < 4; ++j) { const int s = n * 64 + t - 3 + j;
            if (s >= 0) { const u32x4 xv = *(const u32x4*)(QKV + (size_t)(b * SEQ_ + s) * 3072 + ch);
                const f32x4 w0 = *(const f32x4*)(cw + j * 3072 + ch), w1 = *(const f32x4*)(cw + j * 3072 + ch + 4);
                a[0] += w0[0] * bflo(xv.x); a[1] += w0[1] * bfhi(xv.x); a[2] += w0[2] * bflo(xv.y); a[3] += w0[3] * bfhi(xv.y);
                a[4] += w1[0] * bflo(xv.z); a[5] += w1[1] * bfhi(xv.z); a[6] += w1[2] * bflo(xv.w); a[7] += w1[3] * bfhi(xv.w); } }
        LAS float* dst = part == 0 ? sQ + t * 132 + d0 : (part == 1 ? sK + t * 132 + d0 : sX + t * 256 + 128 + d0);
#pragma unroll
        for (int e = 0; e < 8; ++e) dst[e] = siluf_(a[e]);
    }
    __syncthreads();
    { const int row = tid >> 2, sub = tid & 3; LAS float* rp = (row < 64 ? sQ + row * 132 : sK + (row - 64) * 132) + sub * 32;
      float ss = 0.f;
#pragma unroll
      for (int e = 0; e < 32; ++e) ss += rp[e] * rp[e];
      ss += __shfl_xor(ss, 1); ss += __shfl_xor(ss, 2);
      const float sc = rsqrtf(ss + 1e-6f) * (row < 64 ? 0.08838834764831845f : 1.f);
#pragma unroll
      for (int e = 0; e < 32; ++e) rp[e] *= sc; }
    if (tid < 64) { const float av = MISC[(size_t)(t0 + tid) * 128 + 64 + h], bv = MISC[(size_t)(t0 + tid) * 128 + 72 + h];
        const float xx = av + p.dtb[l * 8 + h]; const float sp = xx > 20.f ? xx : log1pf(__expf(xx));
        float gv = -__expf(p.alog[l * 8 + h]) * sp;
#pragma unroll
        for (int o = 1; o < 64; o <<= 1) { const float y = __shfl_up(gv, o); if (lane >= o) gv += y; }
        sG[tid] = gv; sB[tid] = sigmoidf_(bv); }
    __syncthreads();
    { const int i = tid >> 3, jl = tid & 7;
      float aa[8], qq[8];
#pragma unroll
      for (int jj = 0; jj < 8; ++jj) { aa[jj] = 0.f; qq[jj] = 0.f; }
      for (int d4 = 0; d4 < 32; ++d4) { const f32x4 ki = *(const LAS f32x4*)(sK + i * 132 + d4 * 4), qi = *(const LAS f32x4*)(sQ + i * 132 + d4 * 4);
#pragma unroll
          for (int jj = 0; jj < 8; ++jj) if (8 * jj <= i) { const f32x4 kj = *(const LAS f32x4*)(sK + (jl + 8 * jj) * 132 + d4 * 4);
              aa[jj] += ki[0] * kj[0] + ki[1] * kj[1] + ki[2] * kj[2] + ki[3] * kj[3]; qq[jj] += qi[0] * kj[0] + qi[1] * kj[1] + qi[2] * kj[2] + qi[3] * kj[3]; } }
      const float gi = sG[i], bi = sB[i];
      bf16_t* QKo = (bf16_t*)(ws + OFF_DQK) + (size_t)item * 4096 + i * 64;
#pragma unroll
      for (int jj = 0; jj < 8; ++jj) { const int j = jl + 8 * jj; const float dec = (j <= i) ? __expf(gi - sG[j]) : 0.f;
          sA[i * 68 + j] = (j < i) ? bi * aa[jj] * dec : 0.f;
          QKo[j] = f2bf((j <= i) ? qq[jj] * dec : 0.f); } }
    for (int task = tid; task < 64 * 32; task += 512) { const int t = task >> 5, d4 = task & 31; const float bt = sB[t], kb = bt * __expf(sG[t]);
        const f32x4 kv = *(const LAS f32x4*)(sK + t * 132 + d4 * 4); *(LAS f32x4*)(sX + t * 256 + d4 * 4) = kv * kb;
        LAS f32x4* vp = (LAS f32x4*)(sX + t * 256 + 128 + d4 * 4); *vp = *vp * bt; }
    __syncthreads();
    if (tid < 256) {
        for (int i = 1; i < 64; ++i) { float s = sX[i * 256 + tid];
            for (int j4 = 0; j4 < i; j4 += 4) { const f32x4 a4 = *(const LAS f32x4*)(sA + i * 68 + j4);
                s -= a4[0] * sX[(j4 + 0) * 256 + tid] + a4[1] * sX[(j4 + 1) * 256 + tid] + a4[2] * sX[(j4 + 2) * 256 + tid] + a4[3] * sX[(j4 + 3) * 256 + tid]; }
            sX[i * 256 + tid] = s; }
    }
    __syncthreads();
    { bf16_t* Wo = (bf16_t*)(ws + OFF_DW) + (size_t)item * 8192; bf16_t* QGo = (bf16_t*)(ws + OFF_DQG) + (size_t)item * 8192;
      bf16_t* KGTo = (bf16_t*)(ws + OFF_DKGT) + (size_t)item * 8192; bf16_t* UTo = (bf16_t*)(ws + OFF_DUT) + (size_t)item * 8192;
      const float glast = sG[63];
      for (int task = tid; task < 1024; task += 512) {
          { const int c = task >> 4, d0 = (task & 15) * 8;
            const f32x4 a = *(const LAS f32x4*)(sX + c * 256 + d0), b2 = *(const LAS f32x4*)(sX + c * 256 + d0 + 4);
            u32x4 w; w.x = pk2(a[0], a[1]); w.y = pk2(a[2], a[3]); w.z = pk2(b2[0], b2[1]); w.w = pk2(b2[2], b2[3]);
            *(u32x4*)(Wo + c * 128 + d0) = w;
            const float eg = __expf(sG[c]);
            const f32x4 q0 = *(const LAS f32x4*)(sQ + c * 132 + d0) * eg, q1 = *(const LAS f32x4*)(sQ + c * 132 + d0 + 4) * eg;
            w.x = pk2(q0[0], q0[1]); w.y = pk2(q0[2], q0[3]); w.z = pk2(q1[0], q1[1]); w.w = pk2(q1[2], q1[3]);
            *(u32x4*)(QGo + c * 128 + d0) = w; }
          { const int d = task & 127, c0 = (task >> 7) * 8;
            float uu[8], kk[8];
#pragma unroll
            for (int e = 0; e < 8; ++e) { uu[e] = sX[(c0 + e) * 256 + 128 + d]; kk[e] = sK[(c0 + e) * 132 + d] * __expf(glast - sG[c0 + e]); }
            u32x4 w; w.x = pk2(uu[0], uu[1]); w.y = pk2(uu[2], uu[3]); w.z = pk2(uu[4], uu[5]); w.w = pk2(uu[6], uu[7]);
            *(u32x4*)(UTo + d * 64 + c0) = w;
            w.x = pk2(kk[0], kk[1]); w.y = pk2(kk[2], kk[3]); w.z = pk2(kk[4], kk[5]); w.w = pk2(kk[6], kk[7]);
            *(u32x4*)(KGTo + d * 64 + c0) = w; }
      }
      if (tid == 0) ((float*)(ws + OFF_DEG))[item] = __expf(glast); }
    __syncthreads();
}

__device__ __forceinline__ void row_items(const Params& p) {
    unsigned char* ws = p.ws;
    int tid = threadIdx.x; asm volatile("" : "+v"(tid));
    const int lane = tid & 63, wave = tid >> 6;
    const int gw = blockIdx.x * 8 + wave, NGW = gridDim.x * 8;
    const bf16_t* SG = (const bf16_t*)(ws + OFF_SG); const bf16_t* CQ = (const bf16_t*)(ws + OFF_CQ); const bf16_t* CKV = (const bf16_t*)(ws + OFF_CKV);
    const float* MISC = (const float*)(ws + OFF_MISC); const float* CS = (const float*)(ws + OFF_CS);
    float* STATS = (float*)(ws + OFF_STATS); float* RS = (float*)(ws + OFF_RS); bf16_t* KR = (bf16_t*)(ws + OFF_KR);
    for (int t = gw; t < T_; t += NGW) {
        { const u32x4 a = *(const u32x4*)(SG + (size_t)t * 2048 + 1024 + lane * 16), b = *(const u32x4*)(SG + (size_t)t * 2048 + 1024 + lane * 16 + 8);
          float v[16]; v[0] = bflo(a.x); v[1] = bfhi(a.x); v[2] = bflo(a.y); v[3] = bfhi(a.y); v[4] = bflo(a.z); v[5] = bfhi(a.z); v[6] = bflo(a.w); v[7] = bfhi(a.w);
          v[8] = bflo(b.x); v[9] = bfhi(b.x); v[10] = bflo(b.y); v[11] = bfhi(b.y); v[12] = bflo(b.z); v[13] = bfhi(b.z); v[14] = bflo(b.w); v[15] = bfhi(b.w);
          float s = 0.f;
#pragma unroll
          for (int e = 0; e < 16; ++e) s += v[e];
          const float mean = wave_sum(s) * (1.f / 1024.f); float s2 = 0.f;
#pragma unroll
          for (int e = 0; e < 16; ++e) { const float d = v[e] - mean; s2 += d * d; }
          const float rstd = rsqrtf(wave_sum(s2) * (1.f / 1024.f) + 1e-5f);
          if (lane == 0) { STATS[t * 2] = mean; STATS[t * 2 + 1] = rstd; } }
        { const u32x4 a = *(const u32x4*)(CQ + (size_t)t * 512 + lane * 8), b = *(const u32x4*)(CKV + (size_t)t * 512 + lane * 8);
          float sa = bflo(a.x) * bflo(a.x) + bfhi(a.x) * bfhi(a.x) + bflo(a.y) * bflo(a.y) + bfhi(a.y) * bfhi(a.y) + bflo(a.z) * bflo(a.z) + bfhi(a.z) * bfhi(a.z) + bflo(a.w) * bflo(a.w) + bfhi(a.w) * bfhi(a.w);
          float sb = bflo(b.x) * bflo(b.x) + bfhi(b.x) * bfhi(b.x) + bflo(b.y) * bflo(b.y) + bfhi(b.y) * bfhi(b.y) + bflo(b.z) * bflo(b.z) + bfhi(b.z) * bfhi(b.z) + bflo(b.w) * bflo(b.w) + bfhi(b.w) * bfhi(b.w);
          sa = wave_sum(sa); sb = wave_sum(sb);
          if (lane == 0) { RS[t * 2] = rsqrtf(sa * (1.f / 512.f) + EPS); RS[t * 2 + 1] = rsqrtf(sb * (1.f / 512.f) + EPS); } }
        if (lane < 32) { const float x1 = MISC[(size_t)t * 128 + lane], x2 = MISC[(size_t)t * 128 + 32 + lane];
            const float c = CS[(size_t)t * 64 + lane], s = CS[(size_t)t * 64 + 32 + lane];
            KR[(size_t)t * 64 + lane] = f2bf(x1 * c - x2 * s); KR[(size_t)t * 64 + 32 + lane] = f2bf(x1 * s + x2 * c); }
    }
}

__device__ __forceinline__ void dn_scan_item(const Params& p, int l, LAS float* L, int bh) {
    unsigned char* ws = p.ws;
    int tid = threadIdx.x; asm volatile("" : "+v"(tid));
    const int lane = tid & 63, wave = tid >> 6, jl = lane & 15, g = lane >> 4;
    const int b = bh >> 3, h = bh & 7, dv0 = wave * 16;
    const bf16_t* Z = (const bf16_t*)(ws + OFF_Z); bf16_t* OA = (bf16_t*)(ws + OFF_OA);
    const float* EGp = (const float*)(ws + OFF_DEG);
    const float ng0 = p.dng[l * 128 + lane], ng1 = p.dng[l * 128 + 64 + lane];
    f32x4 S[8];
#pragma unroll
    for (int i = 0; i < 8; ++i) S[i] = (f32x4){0.f, 0.f, 0.f, 0.f};
    int par = 0;
    for (int n = 0; n < 32; ++n) {
        const int item = (b * 32 + n) * 8 + h;
        const bf16_t* Wp = (const bf16_t*)(ws + OFF_DW) + (size_t)item * 8192; const bf16_t* QGp = (const bf16_t*)(ws + OFF_DQG) + (size_t)item * 8192;
        const bf16_t* KGTp = (const bf16_t*)(ws + OFF_DKGT) + (size_t)item * 8192; const bf16_t* UTp = (const bf16_t*)(ws + OFF_DUT) + (size_t)item * 8192;
        const bf16_t* QKp = (const bf16_t*)(ws + OFF_DQK) + (size_t)item * 4096;
        const float eg = EGp[item];
        bf16x8 sf[4];
#pragma unroll
        for (int ks = 0; ks < 4; ++ks) sf[ks] = pack8(S[2 * ks], S[2 * ks + 1]);
        f32x4 vn[4];
#pragma unroll
        for (int cb = 0; cb < 4; ++cb) { f32x4 acc = (f32x4){0.f, 0.f, 0.f, 0.f};
#pragma unroll
            for (int ks = 0; ks < 4; ++ks) { const bf16x8 a = load2x4(Wp + (cb * 16 + jl) * 128 + ks * 32 + g * 4); acc = MFMA16(a, sf[ks], acc); }
            const u32x2 uw = *(const u32x2*)(UTp + (dv0 + jl) * 64 + cb * 16 + g * 4);
            vn[cb] = (f32x4){bflo(uw.x), bfhi(uw.x), bflo(uw.y), bfhi(uw.y)} - acc; }
        bf16x8 vf[2];
        vf[0] = pack8(vn[0], vn[1]); vf[1] = pack8(vn[2], vn[3]);
        LAS float* sO = L + par * (64 * 132);
#pragma unroll
        for (int cb = 0; cb < 4; ++cb) { f32x4 acc = (f32x4){0.f, 0.f, 0.f, 0.f};
#pragma unroll
            for (int ks = 0; ks < 4; ++ks) { const bf16x8 a = load2x4(QGp + (cb * 16 + jl) * 128 + ks * 32 + g * 4); acc = MFMA16(a, sf[ks], acc); }
#pragma unroll
            for (int k2 = 0; k2 < 2; ++k2) { const bf16x8 a = load2x4(QKp + (cb * 16 + jl) * 64 + k2 * 32 + g * 4); acc = MFMA16(a, vf[k2], acc); }
#pragma unroll
            for (int r = 0; r < 4; ++r) sO[(cb * 16 + g * 4 + r) * 132 + dv0 + jl] = acc[r]; }
#pragma unroll
        for (int db = 0; db < 8; ++db) { f32x4 acc = S[db] * eg;
#pragma unroll
            for (int k2 = 0; k2 < 2; ++k2) { const bf16x8 a = load2x4(KGTp + (db * 16 + jl) * 64 + k2 * 32 + g * 4); acc = MFMA16(a, vf[k2], acc); }
            S[db] = acc; }
        __syncthreads();
#pragma unroll
        for (int cc = 0; cc < 8; ++cc) { const int c = wave * 8 + cc; const float o0 = sO[c * 132 + lane], o1 = sO[c * 132 + 64 + lane];
            const float rs = rsqrtf(wave_sum(o0 * o0 + o1 * o1) * (1.f / 128.f) + EPS);
            const size_t tok = (size_t)b * SEQ_ + n * 64 + c;
            const float z0 = bf1(Z[tok * 1024 + h * 128 + lane]), z1 = bf1(Z[tok * 1024 + h * 128 + 64 + lane]);
            OA[tok * 1024 + h * 128 + lane] = f2bf(o0 * rs * ng0 * siluf_(z0));
            OA[tok * 1024 + h * 128 + 64 + lane] = f2bf(o1 * rs * ng1 * siluf_(z1)); }
        par ^= 1;
    }
    __syncthreads();
}

__device__ __forceinline__ void attn_wave_item(const Params& p, int wi) {
    unsigned char* ws = p.ws;
    int tid = threadIdx.x; asm volatile("" : "+v"(tid));
    const int lane = tid & 63, jl = lane & 15, g = lane >> 4;
    const int qg = 63 - (wi >> 5), bh = wi & 31, b = bh >> 3, h = bh & 7;
    const int s0 = qg * 32; const size_t tq = (size_t)b * SEQ_ + s0 + jl;
    const bf16_t* QB = (const bf16_t*)(ws + OFF_QB);
    bf16x8 qf[2][6];
#pragma unroll
    for (int u = 0; u < 2; ++u)
#pragma unroll
        for (int ks = 0; ks < 6; ++ks) qf[u][ks] = *(const bf16x8*)(QB + (tq + u * 16) * 1536 + h * 192 + ks * 32 + g * 8);
    const int nkb = (((s0 >> 6) + 1) * 64) >> 5;
    const bf16_t* KNb = (const bf16_t*)(ws + OFF_KN) + (size_t)(b * SEQ_) * 1024 + h * 128;
    const bf16_t* KRb = (const bf16_t*)(ws + OFF_KR) + (size_t)(b * SEQ_) * 64;
    const bf16_t* VTb = (const bf16_t*)(ws + OFF_VT) + (size_t)(h * 128) * 8192 + (size_t)b * SEQ_;
    f32x4 o[2][8];
#pragma unroll
    for (int u = 0; u < 2; ++u)
#pragma unroll
        for (int i = 0; i < 8; ++i) o[u][i] = (f32x4){0.f, 0.f, 0.f, 0.f};
    float mrun[2] = {-1e30f, -1e30f}, lsum[2] = {0.f, 0.f};
    for (int kb = 0; kb < nkb; ++kb) {
        f32x4 s[2][2];
#pragma unroll
        for (int sb = 0; sb < 2; ++sb) { const int key = kb * 32 + sb * 16 + jl; f32x4 a0 = (f32x4){0.f, 0.f, 0.f, 0.f}, a1 = a0;
#pragma unroll
            for (int ks = 0; ks < 4; ++ks) { const bf16x8 kf = *(const bf16x8*)(KNb + (size_t)key * 1024 + ks * 32 + g * 8); a0 = MFMA16(kf, qf[0][ks], a0); a1 = MFMA16(kf, qf[1][ks], a1); }
#pragma unroll
            for (int ks = 0; ks < 2; ++ks) { const bf16x8 kf = *(const bf16x8*)(KRb + (size_t)key * 64 + ks * 32 + g * 8); a0 = MFMA16(kf, qf[0][4 + ks], a0); a1 = MFMA16(kf, qf[1][4 + ks], a1); }
            s[0][sb] = a0; s[1][sb] = a1; }
        bf16x8 pf[2]; float alpha[2];
#pragma unroll
        for (int u = 0; u < 2; ++u) {
            float mx = fmaxf(fmaxf(fmaxf(s[u][0][0], s[u][0][1]), fmaxf(s[u][0][2], s[u][0][3])), fmaxf(fmaxf(s[u][1][0], s[u][1][1]), fmaxf(s[u][1][2], s[u][1][3])));
            mx = fmaxf(mx, __shfl_xor(mx, 16)); mx = fmaxf(mx, __shfl_xor(mx, 32));
            const float mnew = fmaxf(mrun[u], mx); alpha[u] = __builtin_amdgcn_exp2f(mrun[u] - mnew); mrun[u] = mnew;
            float ps = 0.f;
#pragma unroll
            for (int sb = 0; sb < 2; ++sb)
#pragma unroll
                for (int r = 0; r < 4; ++r) { const float pv = __builtin_amdgcn_exp2f(s[u][sb][r] - mnew); s[u][sb][r] = pv; ps += pv; }
            lsum[u] = lsum[u] * alpha[u] + ps;
            pf[u] = pack8(s[u][0], s[u][1]); }
#pragma unroll
        for (int db = 0; db < 8; ++db) { const bf16x8 a = load2x4(VTb + (size_t)(db * 16 + jl) * 8192 + kb * 32 + g * 4);
            o[0][db] = MFMA16(a, pf[0], o[0][db] * alpha[0]); o[1][db] = MFMA16(a, pf[1], o[1][db] * alpha[1]); }
    }
    bf16_t* OC = (bf16_t*)(ws + OFF_OC);
#pragma unroll
    for (int u = 0; u < 2; ++u) { float l = lsum[u]; l += __shfl_xor(l, 16); l += __shfl_xor(l, 32); const float inv = 1.f / l;
#pragma unroll
        for (int db = 0; db < 8; ++db) { const f32x4 v = o[u][db] * inv; u32x2 w; w.x = pk2(v[0], v[1]); w.y = pk2(v[2], v[3]);
            *(u32x2*)(OC + (tq + u * 16) * 1024 + h * 128 + db * 16 + g * 4) = w; } }
}

__device__ __forceinline__ void sg_wave_item(const Params& p, int l, int widx) {
    unsigned char* ws = p.ws;
    int tid = threadIdx.x; asm volatile("" : "+v"(tid));
    const int lane = tid & 63, wave = widx & 7, idx = widx >> 3, jl = lane & 15, g = lane >> 4;
    const int gi = idx & 7, nb = (idx >> 3) & 15, b = idx >> 7;
    const size_t t0 = (size_t)b * SEQ_ + nb * 128; const int cc = gi * 128 + wave * 16 + jl;
    const bf16_t* SG = (const bf16_t*)(ws + OFF_SG); const float* STATS = (const float*)(ws + OFF_STATS); const bf16_t* SGW = (const bf16_t*)(ws + OFF_SGW);
    bf16_t* OB = (bf16_t*)(ws + OFF_OB);
    const float lg = p.lng[l * 1024 + cc], lb = p.lnb[l * 1024 + cc];
    bf16x8 bfr[4];
#pragma unroll
    for (int kb = 0; kb < 4; ++kb) { float v[8];
#pragma unroll
        for (int e = 0; e < 8; ++e) { const size_t tok = t0 + kb * 32 + g * 8 + e; const f32x2 st = *(const f32x2*)(STATS + tok * 2);
            v[e] = (bf1(SG[tok * 2048 + 1024 + cc]) - st.x) * st.y * lg + lb; }
        u32x4 w; w.x = pk2(v[0], v[1]); w.y = pk2(v[2], v[3]); w.z = pk2(v[4], v[5]); w.w = pk2(v[6], v[7]); bfr[kb] = __builtin_bit_cast(bf16x8, w); }
#pragma unroll
    for (int ib = 0; ib < 8; ++ib) { f32x4 acc = (f32x4){0.f, 0.f, 0.f, 0.f};
#pragma unroll
        for (int kb = 0; kb < 4; ++kb) { const bf16x8 a = *(const bf16x8*)(SGW + (size_t)(gi * 128 + ib * 16 + jl) * 128 + kb * 32 + g * 8); acc = MFMA16(a, bfr[kb], acc); }
#pragma unroll
        for (int r = 0; r < 4; ++r) { const int i = ib * 16 + g * 4 + r; const size_t tok = t0 + i;
            const float mixed = acc[r] + p.sgb[l * 1024 + gi * 128 + i];
            OB[tok * 1024 + cc] = f2bf(bf1(SG[tok * 2048 + cc]) * mixed); } }
}

#define XB_TMO      128
#define XB_XCNT(j)  (256  + 64 * (j))
#define XB_XSUB(j)  (1280 + 64 * (j))
#define XB_XGEN(j)  (2304 + 64 * (j))
#define XB_TOP      3328
#define XB_TOPGEN   3392
#define XCD_BAR_WORDS 3456
#define XB_SPIN_CAP (1u << 18)
__device__ __forceinline__ unsigned xb_ld(unsigned* p)              { return __hip_atomic_load(p, __ATOMIC_RELAXED, __HIP_MEMORY_SCOPE_AGENT); }
__device__ __forceinline__ unsigned xb_add(unsigned* p, unsigned v) { return __hip_atomic_fetch_add(p, v, __ATOMIC_RELAXED, __HIP_MEMORY_SCOPE_AGENT); }
__device__ __forceinline__ unsigned xb_xcc_id() { return (unsigned)__builtin_amdgcn_s_getreg((3 << 11) | 20) & 0xFu; }
#define XB_SPIN(cond, bar) do { unsigned _sp = 0; while (cond) { __builtin_amdgcn_s_sleep(1); \
    if ((++_sp & 255u) == 0u) { if (xb_ld(&(bar)[XB_TMO])) break; if (_sp > XB_SPIN_CAP) { atomicAdd(&(bar)[XB_TMO], 1u); break; } } } } while (0)
__device__ __forceinline__ void xcd_barrier_complete(unsigned* bar, unsigned x, unsigned& nloc, unsigned& nx) {
    const unsigned G = gridDim.x * gridDim.y * gridDim.z;
    unsigned sum, cnt, mine, sp = 0u;
    for (;;) {
        sum = 0u; cnt = 0u; mine = 0u;
#pragma unroll
        for (unsigned j = 0; j < 16; ++j) { const unsigned c = xb_ld(&bar[XB_XCNT(j)]); sum += c; cnt += (c > 0u) ? 1u : 0u; mine = (j == x) ? c : mine; }
        if (sum == G) break;
        __builtin_amdgcn_s_sleep(1);
        if ((++sp & 255u) == 0u) { if (xb_ld(&bar[XB_TMO])) break; if (sp > XB_SPIN_CAP) { atomicAdd(&bar[XB_TMO], 1u); break; } }
    }
    nloc = mine > 0u ? mine : 1u; nx = cnt > 0u ? cnt : 1u;
}
__device__ __forceinline__ void xcd_barrier(unsigned* bar, volatile LAS unsigned* st) {
    asm volatile("s_waitcnt vmcnt(0)" ::: "memory");
    __syncthreads();
    if (threadIdx.x == 0) {
        const unsigned x = xb_xcc_id();
        __builtin_amdgcn_s_waitcnt(0);
        unsigned nloc = st[0], nx = st[1];
        if (nloc == 0u) { xcd_barrier_complete(bar, x, nloc, nx); st[0] = nloc; st[1] = nx; }
        const unsigned old = xb_add(&bar[XB_XSUB(x)], 1u);
        const unsigned gen = old / nloc;
        if (old + 1u == (gen + 1u) * nloc) {
            __builtin_amdgcn_fence(__ATOMIC_RELEASE, "agent");
            asm volatile("s_waitcnt vmcnt(0)" ::: "memory");
            const unsigned og = xb_add(&bar[XB_TOP], 1u);
            const unsigned tg = og / nx;
            if (og + 1u == (tg + 1u) * nx) xb_add(&bar[XB_TOPGEN], 1u);
            else XB_SPIN(xb_ld(&bar[XB_TOPGEN]) == tg, bar);
            __builtin_amdgcn_fence(__ATOMIC_ACQUIRE, "agent");
            xb_add(&bar[XB_XGEN(x)], 1u);
            asm volatile("s_waitcnt vmcnt(0)" ::: "memory");
        } else {
            XB_SPIN(xb_ld(&bar[XB_XGEN(x)]) == gen, bar);
            __builtin_amdgcn_fence(__ATOMIC_ACQUIRE, "agent");
            asm volatile("s_waitcnt vmcnt(0)" ::: "memory");
        }
    }
    __syncthreads();
}

#ifndef NREP_GEMM
#define NREP_GEMM 1
#endif
#ifndef NREP_MIX
#define NREP_MIX 1
#endif
#ifndef NREP_PREP
#define NREP_PREP NREP_MIX
#endif
#ifndef NREP_P7
#define NREP_P7 NREP_MIX
#endif
#ifndef NREP_ROW
#define NREP_ROW 0
#endif
#ifndef NREP_CVT
#define NREP_CVT 1
#endif
#ifndef NREP_SYNC
#define NREP_SYNC 1
#endif
#define GSYNC() do { for (int r_ = 0; r_ < NREP_SYNC; ++r_) { PQ xcd_barrier((unsigned*)(ws + OFF_BAR), (volatile LAS unsigned*)(shm + 151312)); } } while (0)
#define RG for (int rg_ = 0; rg_ < NREP_GEMM; ++rg_)
typedef const Params __attribute__((address_space(4)))* KP;
__device__ __forceinline__ Params ldp(KP q) {
#if defined(__HIP_DEVICE_COMPILE__)
    asm volatile("" : "+s"(q)); return *q;
#else
    return Params{};
#endif
}
#define PQ const Params p = ldp(kp); unsigned char* ws = p.ws; (void)ws;
__global__ __launch_bounds__(512, 2) void fwd_megakernel(Params p_unused) {
    extern __shared__ __attribute__((aligned(16))) unsigned char shm[];
    LAS unsigned char* lds = (LAS unsigned char*)shm;
    LAS float* L = (LAS float*)shm;
    LAS int* s_item = (LAS int*)(shm + 151296);
    cg::grid_group grid = cg::this_grid();
    KP kp = (KP)__builtin_amdgcn_kernarg_segment_ptr();
    if (threadIdx.x == 0) { LAS unsigned* st = (LAS unsigned*)(shm + 151312); st[0] = 0u; st[1] = 0u; PQ (void)xb_add((unsigned*)(ws + OFF_BAR) + XB_XCNT(xb_xcc_id()), 1u); }
    __syncthreads();

#ifndef NO_CVT
    for (int rc_ = 0; rc_ < NREP_CVT; ++rc_) { PQ convert_layer(p, 0, lds); }
#endif
    { PQ int tid = threadIdx.x; asm volatile("" : "+v"(tid));
      const size_t gt = (size_t)blockIdx.x * 512 + tid, NGT = (size_t)gridDim.x * 512; float* CS = (float*)(ws + OFF_CS);
      for (size_t e = gt; e < (size_t)T_ * 32; e += NGT) { const int t = (int)(e >> 5), i = (int)(e & 31);
          const float inv_freq = exp2f(-(float)(2 * i) * (1.f / 64.f) * 13.287712379549449f);
          const float ang = (float)p.pos[t] * inv_freq; float sn, cs; sn = sinf(ang); cs = cosf(ang);
          CS[(size_t)t * 64 + i] = cs; CS[(size_t)t * 64 + 32 + i] = sn; }
      if (gt < 64) ((unsigned*)(ws + OFF_CTR))[gt] = 0u; }
    { PQ rowpass(p.x, nullptr, 0.f, nullptr, p.norm_g, p.out, (bf16_t*)(ws + OFF_H)); }
    grid.sync();

    for (int l = 0; l < 2; ++l) {
        RG { PQ EpiSwiGLU e; e.O = (bf16_t*)(ws + OFF_GATE); run_gemm(lds, (const bf16_t*)(ws + OFF_H), (const bf16_t*)(ws + OFF_WGU), T_, 11264, 2048, e); }
        GSYNC();
        RG { PQ EpiF32 e; e.C = (float*)(ws + OFF_F); e.ldc = DM; run_gemm(lds, (const bf16_t*)(ws + OFF_GATE), (const bf16_t*)(ws + OFF_WDN), T_, 2048, FF, e); }
        GSYNC();
        for (int rr_ = 0; rr_ < NREP_ROW; ++rr_) { PQ const float* ng = p.norm_g + (size_t)l * 6 * DM; rowpass(p.out, (const float*)(ws + OFF_F), 0.0f, ng + DM, ng + 2 * DM, p.out, (bf16_t*)(ws + OFF_H)); }
        { PQ const float* ng = p.norm_g + (size_t)l * 6 * DM; rowpass(p.out, (const float*)(ws + OFF_F), 0.5f, ng + DM, ng + 2 * DM, p.out, (bf16_t*)(ws + OFF_H)); }
        GSYNC();
        RG { PQ EpiWin e; e.ws = ws; run_gemm(lds, (const bf16_t*)(ws + OFF_H), (const bf16_t*)(ws + OFF_WIN), T_, NINP, 2048, e); }
        GSYNC();
        for (int rm_ = 0; rm_ < NREP_PREP; ++rm_) {
#ifndef NO_PREP
        { PQ for (int item = blockIdx.x; item < 1024; item += gridDim.x) dn_prep_item(p, l, L, item); }
#endif
#ifndef NO_ROWI
        { PQ row_items(p); }
#endif
        }
        GSYNC();
        RG { PQ EpiQ e; e.QB = (bf16_t*)(ws + OFF_QB); e.RS = (const float*)(ws + OFF_RS); e.CS = (const float*)(ws + OFF_CS); e.qscale = 0.07216878364870322f * 1.4426950408889634f;
          run_gemm(lds, (const bf16_t*)(ws + OFF_CQ), (const bf16_t*)(ws + OFF_WUQ), T_, 1536, 512, e); }
        RG { PQ EpiKN e; e.O = (bf16_t*)(ws + OFF_KN); e.RS = (const float*)(ws + OFF_RS);
          run_gemm(lds, (const bf16_t*)(ws + OFF_CKV), (const bf16_t*)(ws + OFF_WUKV), T_, 1024, 512, e); }
        RG { PQ EpiVT e; e.O = (bf16_t*)(ws + OFF_VT); e.RS = (const float*)(ws + OFF_RS);
          run_gemm(lds, (const bf16_t*)(ws + OFF_WUKV) + (size_t)1024 * 512, (const bf16_t*)(ws + OFF_CKV), 1024, T_, 512, e); }
        GSYNC();
        for (int rm_ = 0; rm_ < NREP_P7; ++rm_) {
        for (;;) {
            PQ
            __syncthreads();
            if (threadIdx.x == 0) *s_item = (int)atomicAdd((unsigned*)(ws + OFF_CTR) + l + 8 * rm_, 1u);
            __syncthreads();
            const int it = *s_item;
            if (it >= 32) break;
#ifndef NO_SCAN
            dn_scan_item(p, l, L, it);
#endif
        }
        for (;;) {
            PQ
            int it = 0;
            if ((threadIdx.x & 63) == 0) it = (int)atomicAdd((unsigned*)(ws + OFF_CTR) + 4 + l + 8 * rm_, 1u);
            it = __builtin_amdgcn_readfirstlane(it);
            if (it >= 2048 + 4096) break;
#ifndef NO_ATTN
            if (it < 2048) attn_wave_item(p, it);
#endif
#ifndef NO_SG
            if (it >= 2048) sg_wave_item(p, l, it - 2048);
#endif
        }
        }
        GSYNC();
        { PQ EpiBranch<0> e; e.ACC = (float*)(ws + OFF_F); e.GATE = (const bf16_t*)(ws + OFF_GATE); e.OUT = (bf16_t*)(ws + OFF_MERGED); run_gemm(lds, (const bf16_t*)(ws + OFF_OA), (const bf16_t*)(ws + OFF_WBR), T_, 2048, 1024, e); }
        { PQ EpiBranch<1> e; e.ACC = (float*)(ws + OFF_F); e.GATE = (const bf16_t*)(ws + OFF_GATE); e.OUT = (bf16_t*)(ws + OFF_MERGED); run_gemm(lds, (const bf16_t*)(ws + OFF_OB), (const bf16_t*)(ws + OFF_WBR) + (size_t)2048 * 1024, T_, 2048, 1024, e); }
        { PQ EpiBranch<2> e; e.ACC = (float*)(ws + OFF_F); e.GATE = (const bf16_t*)(ws + OFF_GATE); e.OUT = (bf16_t*)(ws + OFF_MERGED); run_gemm(lds, (const bf16_t*)(ws + OFF_OC), (const bf16_t*)(ws + OFF_WBR) + (size_t)2 * 2048 * 1024, T_, 2048, 1024, e); }
        GSYNC();
        RG { PQ EpiF32 e; e.C = (float*)(ws + OFF_F); e.ldc = DM; run_gemm(lds, (const bf16_t*)(ws + OFF_MERGED), (const bf16_t*)(ws + OFF_WOUT), T_, 2048, 2048, e); }
        GSYNC();
        for (int rr_ = 0; rr_ < NREP_ROW; ++rr_) { PQ const float* ng = p.norm_g + (size_t)l * 6 * DM; rowpass(p.out, (const float*)(ws + OFF_F), 0.0f, ng + 3 * DM, ng + 4 * DM, p.out, (bf16_t*)(ws + OFF_H)); }
        { PQ const float* ng = p.norm_g + (size_t)l * 6 * DM; rowpass(p.out, (const float*)(ws + OFF_F), 1.0f, ng + 3 * DM, ng + 4 * DM, p.out, (bf16_t*)(ws + OFF_H)); }
        GSYNC();
        RG { PQ EpiSwiGLU e; e.O = (bf16_t*)(ws + OFF_GATE); run_gemm(lds, (const bf16_t*)(ws + OFF_H), (const bf16_t*)(ws + OFF_WGU) + (size_t)11264 * 2048, T_, 11264, 2048, e); }
        GSYNC();
        RG { PQ EpiF32 e; e.C = (float*)(ws + OFF_F); e.ldc = DM; run_gemm(lds, (const bf16_t*)(ws + OFF_GATE), (const bf16_t*)(ws + OFF_WDN) + (size_t)2048 * FF, T_, 2048, FF, e); }
        GSYNC();
        if (l == 0) {
            for (int rr_ = 0; rr_ < NREP_ROW; ++rr_) { PQ const float* ng = p.norm_g; rowpass(p.out, (const float*)(ws + OFF_F), 0.0f, ng + 5 * DM, ng + 6 * DM, p.out, (bf16_t*)(ws + OFF_H)); }
            { PQ const float* ng = p.norm_g; rowpass(p.out, (const float*)(ws + OFF_F), 0.5f, ng + 5 * DM, ng + 6 * DM, p.out, (bf16_t*)(ws + OFF_H)); }
#ifndef NO_CVT
            for (int rc_ = 0; rc_ < NREP_CVT; ++rc_) { PQ convert_layer(p, 1, lds); }
#endif
            GSYNC();
        } else {
            for (int rr_ = 0; rr_ < NREP_ROW; ++rr_) { PQ const float* ng = p.norm_g + (size_t)6 * DM; rowpass(p.out, (const float*)(ws + OFF_F), 0.0f, ng + 5 * DM, nullptr, p.out, nullptr); }
            { PQ const float* ng = p.norm_g + (size_t)6 * DM; rowpass(p.out, (const float*)(ws + OFF_F), 0.5f, ng + 5 * DM, nullptr, p.out, nullptr); }
        }
    }
}

extern "C" void kernel_launch(void* const* d_in, const int* in_sizes, int n_in, void* d_out, int out_size, void* d_ws, size_t ws_size, hipStream_t stream) {
    static int grid_blocks = 0;
    if (!grid_blocks) {
        if (ws_size < WS_END) { fprintf(stderr, "kernel_launch: workspace too small: %zu < %zu\n", ws_size, (size_t)WS_END); grid_blocks = -1; return; }
        int dev = 0, cus = 0, per_cu = 0;
        (void)hipGetDevice(&dev);
        (void)hipDeviceGetAttribute(&cus, hipDeviceAttributeMultiprocessorCount, dev);
        if (hipFuncSetAttribute((const void*)fwd_megakernel, hipFuncAttributeMaxDynamicSharedMemorySize, LDS_BYTES) != hipSuccess) fprintf(stderr, "kernel_launch: hipFuncSetAttribute failed\n");
        if (hipOccupancyMaxActiveBlocksPerMultiprocessor(&per_cu, (const void*)fwd_megakernel, 512, LDS_BYTES) != hipSuccess || per_cu < 1) per_cu = 1;
        (void)hipGetLastError();
        grid_blocks = cus * per_cu;
    }
    if (grid_blocks < 0) return;
    Params p{};
    p.x = (const float*)d_in[0]; p.pos = (const int*)d_in[1]; p.norm_g = (const float*)d_in[2]; p.wg = (const float*)d_in[3]; p.wu = (const float*)d_in[4];
    p.wd = (const float*)d_in[5]; p.win = (const float*)d_in[6]; p.convw = (const float*)d_in[7]; p.alog = (const float*)d_in[8]; p.dtb = (const float*)d_in[9];
    p.dng = (const float*)d_in[10]; p.lng = (const float*)d_in[11]; p.lnb = (const float*)d_in[12]; p.sgw = (const float*)d_in[13]; p.sgb = (const float*)d_in[14];
    p.cqg = (const float*)d_in[15]; p.ckvg = (const float*)d_in[16]; p.wuq = (const float*)d_in[17]; p.wukv = (const float*)d_in[18]; p.wbr = (const float*)d_in[19];
    p.wout = (const float*)d_in[20]; p.out = (float*)d_out; p.ws = (unsigned char*)d_ws;
    (void)hipMemsetAsync((unsigned char*)d_ws + OFF_BAR, 0, XCD_BAR_WORDS * 4, stream);
    void* args[] = {&p};
    hipError_t e = hipLaunchCooperativeKernel((const void*)fwd_megakernel, dim3(grid_blocks), dim3(512), args, LDS_BYTES, stream);
    if (e != hipSuccess) fprintf(stderr, "cooperative launch failed: %s (grid %d)\n", hipGetErrorString(e), grid_blocks);
}
```

```cpp
#include <hip/hip_runtime.h>
#include <hip/hip_cooperative_groups.h>
#include <cstdio>
namespace cg = cooperative_groups;

#define LAS __attribute__((address_space(3)))
typedef unsigned short bf16_t;
typedef short bf16x8 __attribute__((ext_vector_type(8)));
typedef short s16x4 __attribute__((ext_vector_type(4)));
typedef float f32x4 __attribute__((ext_vector_type(4)));
typedef float f32x2 __attribute__((ext_vector_type(2)));
typedef unsigned u32x4 __attribute__((ext_vector_type(4)));
typedef unsigned u32x2 __attribute__((ext_vector_type(2)));

constexpr int T_ = 8192, DM = 2048, FF = 5632, NIN = 13392, NINP = 13568, SEQ_ = 2048;
constexpr int LDS_BYTES = 152576;
constexpr int LDS_ITEM = 152320, LDS_ST = 152336;
constexpr float EPS = 1e-6f;

constexpr size_t al256(size_t x) { return (x + 255) & ~(size_t)255; }
constexpr size_t OFF_WGU = 0;
constexpr size_t OFF_WDN = OFF_WGU + (size_t)2 * 11264 * 2048 * 2;
constexpr size_t OFF_WIN = OFF_WDN + (size_t)2 * 2048 * 5632 * 2;
constexpr size_t OFF_WUQ = OFF_WIN + (size_t)NINP * 2048 * 2;
constexpr size_t OFF_WUKV = OFF_WUQ + (size_t)1536 * 512 * 2;
constexpr size_t OFF_WBR = OFF_WUKV + (size_t)2048 * 512 * 2;
constexpr size_t OFF_WOUT = OFF_WBR + (size_t)3 * 2048 * 1024 * 2;
constexpr size_t OFF_SGW = OFF_WOUT + (size_t)2048 * 2048 * 2;
constexpr size_t OFF_H = OFF_SGW + (size_t)8 * 128 * 128 * 2;
constexpr size_t OFF_F = OFF_H + (size_t)T_ * 2048 * 2;
constexpr size_t OFF_GATE = OFF_F + (size_t)T_ * 2048 * 4;
constexpr size_t OFF_QKV = OFF_GATE + (size_t)T_ * 6144 * 2;
constexpr size_t OFF_Z = OFF_QKV + (size_t)T_ * 3072 * 2;
constexpr size_t OFF_SG = OFF_Z + (size_t)T_ * 1024 * 2;
constexpr size_t OFF_CQ = OFF_SG + (size_t)T_ * 2048 * 2;
constexpr size_t OFF_CKV = OFF_CQ + (size_t)T_ * 512 * 2;
constexpr size_t OFF_MISC = OFF_CKV + (size_t)T_ * 512 * 2;
constexpr size_t OFF_DW = OFF_MISC + (size_t)T_ * 128 * 4;
constexpr size_t OFF_DQG = OFF_DW + (size_t)1024 * 8192 * 2;
constexpr size_t OFF_DKGT = OFF_DQG + (size_t)1024 * 8192 * 2;
constexpr size_t OFF_DUT = OFF_DKGT + (size_t)1024 * 8192 * 2;
constexpr size_t OFF_DQK = OFF_DUT + (size_t)1024 * 8192 * 2;
constexpr size_t OFF_DEG = OFF_DQK + (size_t)1024 * 4096 * 2;
constexpr size_t OFF_QB = OFF_DEG + 4096;
constexpr size_t OFF_KN = OFF_QB + (size_t)T_ * 1536 * 2;
constexpr size_t OFF_KR = OFF_KN + (size_t)T_ * 1024 * 2;
constexpr size_t OFF_VT = OFF_KR + (size_t)T_ * 64 * 2;
constexpr size_t OFF_OA = OFF_VT + (size_t)1024 * 8192 * 2;
constexpr size_t OFF_OB = OFF_OA + (size_t)T_ * 1024 * 2;
constexpr size_t OFF_OC = OFF_OB + (size_t)T_ * 1024 * 2;
constexpr size_t OFF_MERGED = OFF_OC + (size_t)T_ * 1024 * 2;
constexpr size_t OFF_STATS = OFF_MERGED + (size_t)T_ * 2048 * 2;
constexpr size_t OFF_RS = OFF_STATS + (size_t)T_ * 2 * 4;
constexpr size_t OFF_CS = OFF_RS + (size_t)T_ * 2 * 4;
constexpr size_t OFF_CTR = OFF_CS + (size_t)T_ * 64 * 4;
constexpr size_t OFF_BAR = OFF_CTR + 256;
constexpr size_t WS_END = OFF_BAR + 16384;

struct Params {
    const float* x; const int* pos; const float* norm_g; const float* wg; const float* wu; const float* wd; const float* win;
    const float* convw; const float* alog; const float* dtb; const float* dng; const float* lng; const float* lnb; const float* sgw; const float* sgb;
    const float* cqg; const float* ckvg; const float* wuq; const float* wukv; const float* wbr; const float* wout;
    float* out; unsigned char* ws;
};

__device__ __forceinline__ unsigned pk2(float lo, float hi) { unsigned r; asm volatile("v_cvt_pk_bf16_f32 %0, %1, %2" : "=v"(r) : "v"(lo), "v"(hi)); return r; }
__device__ __forceinline__ float bflo(unsigned u) { return __uint_as_float(u << 16); }
__device__ __forceinline__ float bfhi(unsigned u) { return __uint_as_float(u & 0xffff0000u); }
__device__ __forceinline__ float bf1(bf16_t b) { return __uint_as_float(((unsigned)b) << 16); }
__device__ __forceinline__ bf16_t f2bf(float f) { return (bf16_t)(pk2(f, 0.f) & 0xffffu); }
__device__ __forceinline__ float wave_sum(float v) {
#pragma unroll
    for (int o = 1; o < 64; o <<= 1) v += __shfl_xor(v, o);
    return v;
}
__device__ __forceinline__ float sigmoidf_(float x) { return 1.f / (1.f + __expf(-x)); }
__device__ __forceinline__ float siluf_(float x) { return x / (1.f + __expf(-x)); }
__device__ __forceinline__ f32x2 gelu_pk(f32x2 v) {
    const f32x2 av = __builtin_elementwise_abs(v), d = av * 0.2316418882f + 1.0f;
    f32x2 t; t.x = __builtin_amdgcn_rcpf(d.x); t.y = __builtin_amdgcn_rcpf(d.y);
    f32x2 q = t * 0.5307027145f + (-0.7265760135f); q = q * t + 0.7107068705f; q = q * t + (-0.142248368f); q = q * t + 0.127414796f; q = q * t;
    const f32x2 s = (v * v) * (-0.72134752044f);
    f32x2 e; e.x = __builtin_amdgcn_exp2f(s.x); e.y = __builtin_amdgcn_exp2f(s.y);
    const f32x2 m = v * (q * e), r = v - m;
    f32x2 o; o.x = v.x < 0.f ? m.x : r.x; o.y = v.y < 0.f ? m.y : r.y; return o;
}
__device__ __forceinline__ bf16x8 load2x4(const bf16_t* p) {
    const s16x4 lo = *(const s16x4*)p, hi = *(const s16x4*)(p + 16);
    return __builtin_shufflevector(lo, hi, 0, 1, 2, 3, 4, 5, 6, 7);
}
__device__ __forceinline__ bf16x8 pack8(f32x4 a, f32x4 b) {
    u32x4 w; w.x = pk2(a[0], a[1]); w.y = pk2(a[2], a[3]); w.z = pk2(b[0], b[1]); w.w = pk2(b[2], b[3]);
    return __builtin_bit_cast(bf16x8, w);
}
#define MFMA16(a, b, c) __builtin_amdgcn_mfma_f32_16x16x32_bf16((a), (b), (c), 0, 0, 0)
#define LDS_WAIT() asm volatile("s_waitcnt lgkmcnt(0)" ::: "memory")

namespace pg8 {
constexpr int BM = 256, BK = 64, HALF = 128, HTB = HALF * BK * 2, NXCD = 8, WGM = 8;
__device__ __forceinline__ int lds_byte(int r, int c) { const int st = (r >> 4) * 2 + (c >> 5), rr = r & 15, cc = c & 31, ob = rr * 64 + cc * 2; return st * 1024 + (ob ^ (((ob >> 9) & 1) << 5)); }
__device__ __forceinline__ void stage_rc(int b, int& R, int& C) { const int st = b / 1024, sb = b % 1024, swz = sb ^ (((sb >> 9) & 1) << 5); R = (st >> 1) * 16 + swz / 64; C = (st & 1) * 32 + (swz % 64) / 2; }
__device__ __forceinline__ int perm32(int rho) { const int n = rho >> 4, i = rho & 15; return 8 * (i >> 2) + 4 * n + (i & 3); }
struct Unit { int pm, pn; };
struct Gemm { const bf16_t* A; const bf16_t* Bt; int M, N, K; };
struct StaticOrder {
    int nM, nN, nwg, G, c;
    __device__ __forceinline__ void init(int M, int N, int G_, int c_) { nM = M / BM; nN = N / BM; nwg = nM * nN; G = G_; c = c_; }
    __device__ __forceinline__ bool next(int i, Unit& u) const {
        const long L = (long)i * G + c; if (L >= nwg) return false;
        int wgid = (int)L; { const int q = nwg / NXCD, r = nwg % NXCD, xcd = wgid % NXCD, off = wgid / NXCD; wgid = (xcd < r ? xcd * (q + 1) : r * (q + 1) + (xcd - r) * q) + off; }
        const int nig = WGM * nN, gid = wgid / nig, fm = gid * WGM, gsz = (nM - fm) < WGM ? (nM - fm) : WGM;
        u.pm = fm + ((wgid % nig) % gsz); u.pn = (wgid % nig) / gsz; return true;
    }
};
template <class Epi>
__device__ __forceinline__ void gemm_phase(LAS unsigned char* lds, const Gemm g, const StaticOrder& S, const Epi& E) {
    int tid = threadIdx.x; asm volatile("" : "+v"(tid));
    const int wid = __builtin_amdgcn_readfirstlane(tid >> 6), lane = tid & 63, wr = wid >> 2, wc = wid & 3, fr = lane & 15, fq = lane >> 4;
    const int K = g.K, nt = K / BK;
    unsigned voffA[2], voffB[2];
#pragma unroll
    for (int i = 0; i < 2; ++i) { int R, C; stage_rc(tid * 16 + i * 8192, R, C); const int Rb = Epi::PERM ? ((R & ~31) + perm32(R & 31)) : R;
        voffA[i] = (unsigned)(R * K + C) * 2u; voffB[i] = (unsigned)(Rb * K + C) * 2u; }
    const size_t kstep = (size_t)(BK * 2);
    const size_t hstep = (size_t)HALF * K * 2;
    const size_t tstep = 2 * hstep;
    const unsigned ldsw = (unsigned)wid * 1024u;
    const int aoff = lds_byte(wr * 64 + fr, fq * 8), boff = lds_byte(wc * 32 + fr, fq * 8);
#define PG8_SA(b, h) (((b) * 2 + (h)) * HTB)
#define PG8_SB(b, h) ((4 + (b) * 2 + (h)) * HTB)
#define PG8_STAGE(bufoff, gbase, voff) do { _Pragma("unroll") for (int _i = 0; _i < 2; ++_i) \
        __builtin_amdgcn_global_load_lds((const unsigned*)((const char*)(gbase) + (voff)[_i]), (LAS unsigned*)(lds + (bufoff) + ldsw + _i * 8192), 16, 0, 0); } while (0)
#define PG8_LDA(dst, b, h) do { _Pragma("unroll") for (int m = 0; m < 4; ++m) _Pragma("unroll") for (int k = 0; k < 2; ++k) dst[m][k] = *(const LAS bf16x8*)(lds + PG8_SA(b, h) + aoff + m * 2048 + k * 1024); } while (0)
#define PG8_LDB(dst, b, h) do { _Pragma("unroll") for (int n = 0; n < 2; ++n) _Pragma("unroll") for (int k = 0; k < 2; ++k) dst[n][k] = *(const LAS bf16x8*)(lds + PG8_SB(b, h) + boff + n * 2048 + k * 1024); } while (0)
#define PG8_MMA(ai, bj, At, Bt) do { __builtin_amdgcn_s_setprio(1); _Pragma("unroll") for (int m = 0; m < 4; ++m) _Pragma("unroll") for (int n = 0; n < 2; ++n) _Pragma("unroll") for (int k = 0; k < 2; ++k) \
        acc[ai][bj][m][n] = __builtin_amdgcn_mfma_f32_16x16x32_bf16(Bt[n][k], At[m][k], acc[ai][bj][m][n], 0, 0, 0); __builtin_amdgcn_s_setprio(0); } while (0)
#define PG8_WAIT_V(n) asm volatile("s_waitcnt vmcnt(" #n ")" ::: "memory")
#define PG8_WAIT_L(n) asm volatile("s_waitcnt lgkmcnt(" #n ")" ::: "memory")
#define PG8_BAR __builtin_amdgcn_s_barrier()
#define PG8_SCHED __builtin_amdgcn_sched_barrier(0)
    Unit cur, nxt; int ui = 0;
    if (!S.next(0, cur)) return;
    f32x4 acc[2][2][4][2];
#pragma unroll
    for (int a = 0; a < 2; ++a)
#pragma unroll
        for (int b = 0; b < 2; ++b)
#pragma unroll
            for (int m = 0; m < 4; ++m)
#pragma unroll
                for (int n = 0; n < 2; ++n) acc[a][b][m][n] = (f32x4){0.f, 0.f, 0.f, 0.f};
    bf16x8 At[4][2], B0[2][2], B1[2][2];
    const char* cA = (const char*)g.A + (size_t)cur.pm * tstep; const char* cB = (const char*)g.Bt + (size_t)cur.pn * tstep;
    PG8_STAGE(PG8_SB(0, 0), cB, voffB); PG8_STAGE(PG8_SA(0, 0), cA, voffA); PG8_STAGE(PG8_SB(0, 1), cB + hstep, voffB); PG8_STAGE(PG8_SA(0, 1), cA + hstep, voffA);
    if (wr == 1) PG8_BAR;
    PG8_WAIT_V(4); PG8_BAR;
    PG8_STAGE(PG8_SB(1, 0), cB + kstep, voffB); PG8_STAGE(PG8_SA(1, 0), cA + kstep, voffA); PG8_STAGE(PG8_SB(1, 1), cB + hstep + kstep, voffB);
    PG8_WAIT_V(6); PG8_BAR;
    for (;;) {
        const bool has_next = S.next(ui + 1, nxt);
        const char* nA = has_next ? (const char*)g.A + (size_t)nxt.pm * tstep : cA; const char* nB = has_next ? (const char*)g.Bt + (size_t)nxt.pn * tstep : cB;
        for (int t = 0; t < nt; t += 2) {
            const bool last = (t == nt - 2);
            const char* a1 = cA + (size_t)(t + 1) * kstep;
            const char* a2 = last ? nA : cA + (size_t)(t + 2) * kstep; const char* b2 = last ? nB : cB + (size_t)(t + 2) * kstep;
            const char* a3 = a2 + kstep; const char* b3 = b2 + kstep;
            PG8_LDB(B0, 0, 0); PG8_SCHED; PG8_LDA(At, 0, 0); PG8_STAGE(PG8_SA(1, 1), a1 + hstep, voffA);
            PG8_WAIT_L(8); PG8_BAR; PG8_WAIT_L(0); PG8_MMA(0, 0, At, B0); PG8_BAR; PG8_SCHED;
            PG8_LDB(B1, 0, 1); PG8_STAGE(PG8_SB(0, 0), b2, voffB);
            PG8_BAR; PG8_WAIT_L(0); PG8_MMA(0, 1, At, B1); PG8_BAR;
            PG8_LDA(At, 0, 1); PG8_STAGE(PG8_SA(0, 0), a2, voffA);
            PG8_BAR; PG8_WAIT_L(0); PG8_MMA(1, 0, At, B0); PG8_BAR; PG8_SCHED;
            PG8_STAGE(PG8_SB(0, 1), b2 + hstep, voffB);
            PG8_WAIT_V(6); PG8_BAR; PG8_MMA(1, 1, At, B1); PG8_BAR;
            PG8_LDB(B0, 1, 0); PG8_SCHED; PG8_LDA(At, 1, 0); PG8_STAGE(PG8_SA(0, 1), a2 + hstep, voffA);
            PG8_WAIT_L(8); PG8_BAR; PG8_WAIT_L(0); PG8_MMA(0, 0, At, B0); PG8_BAR; PG8_SCHED;
            PG8_LDB(B1, 1, 1); PG8_STAGE(PG8_SB(1, 0), b3, voffB);
            PG8_BAR; PG8_WAIT_L(0); PG8_MMA(0, 1, At, B1); PG8_BAR;
            PG8_LDA(At, 1, 1); PG8_STAGE(PG8_SA(1, 0), a3, voffA);
            PG8_BAR; PG8_WAIT_L(0); PG8_MMA(1, 0, At, B0); PG8_BAR; PG8_SCHED;
            PG8_STAGE(PG8_SB(1, 1), b3 + hstep, voffB);
            PG8_WAIT_V(6); PG8_BAR; PG8_MMA(1, 1, At, B1); PG8_BAR;
        }
        E(acc, cur, wr, wc, fr, fq);
        if (!has_next) break;
#pragma unroll
        for (int a = 0; a < 2; ++a)
#pragma unroll
            for (int b = 0; b < 2; ++b)
#pragma unroll
                for (int m = 0; m < 4; ++m)
#pragma unroll
                    for (int n = 0; n < 2; ++n) acc[a][b][m][n] = (f32x4){0.f, 0.f, 0.f, 0.f};
        cur = nxt; cA = nA; cB = nB; ++ui;
    }
    PG8_WAIT_V(0);
    if (wr == 0) PG8_BAR;
    PG8_BAR;
#undef PG8_SA
#undef PG8_SB
#undef PG8_STAGE
#undef PG8_LDA
#undef PG8_LDB
#undef PG8_MMA
#undef PG8_WAIT_V
#undef PG8_WAIT_L
#undef PG8_BAR
#undef PG8_SCHED
}
}
using pg8::Unit;
typedef f32x4 Acc[2][2][4][2];

struct EpiF32 {
    static constexpr bool PERM = false;
    float* C; int ldc;
    __device__ __forceinline__ void operator()(const Acc& acc, const Unit& u, int wr, int wc, int fr, int fq) const {
        const int row0 = u.pm * 256 + wr * 64 + fr, col0 = u.pn * 256 + wc * 32 + 4 * fq;
#pragma unroll
        for (int ai = 0; ai < 2; ++ai)
#pragma unroll
            for (int m = 0; m < 4; ++m) { float* rowp = C + (size_t)(row0 + ai * 128 + m * 16) * ldc + col0;
#pragma unroll
                for (int bj = 0; bj < 2; ++bj)
#pragma unroll
                    for (int n = 0; n < 2; ++n) *(f32x4*)(rowp + bj * 128 + n * 16) = acc[ai][bj][m][n]; }
    }
};
struct EpiSwiGLU {
    static constexpr bool PERM = true;
    bf16_t* O;
    __device__ __forceinline__ void operator()(const Acc& acc, const Unit& u, int wr, int wc, int fr, int fq) const {
        const int row0 = u.pm * 256 + wr * 64 + fr, col0 = u.pn * 128 + wc * 32 + 8 * fq;
#pragma unroll
        for (int ai = 0; ai < 2; ++ai)
#pragma unroll
            for (int m = 0; m < 4; ++m) {
                f32x4 v0, v1;
#pragma unroll
                for (int e = 0; e < 4; ++e) { v0[e] = siluf_(acc[ai][0][m][0][e]) * acc[ai][1][m][0][e]; v1[e] = siluf_(acc[ai][0][m][1][e]) * acc[ai][1][m][1][e]; }
                u32x4 w; w.x = pk2(v0[0], v0[1]); w.y = pk2(v0[2], v0[3]); w.z = pk2(v1[0], v1[1]); w.w = pk2(v1[2], v1[3]);
                *(u32x4*)(O + (size_t)(row0 + ai * 128 + m * 16) * FF + col0) = w; }
    }
};
struct EpiWin {
    static constexpr bool PERM = true;
    unsigned char* ws;
    __device__ __forceinline__ void operator()(const Acc& acc, const Unit& u, int wr, int wc, int fr, int fq) const {
        const int pn = u.pn, row0 = u.pm * 256 + wr * 64 + fr;
        if (pn == 52) {
            float* M = (float*)(ws + OFF_MISC);
#pragma unroll
            for (int ai = 0; ai < 2; ++ai)
#pragma unroll
                for (int m = 0; m < 4; ++m)
#pragma unroll
                    for (int n = 0; n < 2; ++n) *(f32x4*)(M + (size_t)(row0 + ai * 128 + m * 16) * 128 + 32 * wc + 8 * fq + 4 * n) = acc[ai][0][m][n];
            return;
        }
        bf16_t* base; int ld, col, mode = 0;
        if (pn < 12) { base = (bf16_t*)(ws + OFF_QKV); ld = 3072; col = pn * 256; }
        else if (pn < 16) { base = (bf16_t*)(ws + OFF_Z); ld = 1024; col = (pn - 12) * 256; }
        else if (pn < 24) { base = (bf16_t*)(ws + OFF_SG); ld = 2048; col = (pn - 16) * 256; mode = 2; }
        else if (pn < 26) { base = (bf16_t*)(ws + OFF_CQ); ld = 512; col = (pn - 24) * 256; }
        else if (pn < 28) { base = (bf16_t*)(ws + OFF_CKV); ld = 512; col = (pn - 26) * 256; }
        else { base = (bf16_t*)(ws + OFF_GATE); ld = 6144; col = (pn - 28) * 256; mode = 1; }
        col += wc * 32 + 8 * fq;
#pragma unroll
        for (int ai = 0; ai < 2; ++ai)
#pragma unroll
            for (int m = 0; m < 4; ++m) { bf16_t* rowp = base + (size_t)(row0 + ai * 128 + m * 16) * ld + col;
#pragma unroll
                for (int bj = 0; bj < 2; ++bj) { f32x4 v0 = acc[ai][bj][m][0], v1 = acc[ai][bj][m][1];
                    if (mode == 1) {
#pragma unroll
                        for (int e = 0; e < 4; ++e) { v0[e] = sigmoidf_(v0[e]); v1[e] = sigmoidf_(v1[e]); } }
                    else if (mode == 2) { f32x2 a = gelu_pk((f32x2){v0[0], v0[1]}), b = gelu_pk((f32x2){v0[2], v0[3]}), c = gelu_pk((f32x2){v1[0], v1[1]}), d = gelu_pk((f32x2){v1[2], v1[3]});
                        v0 = (f32x4){a.x, a.y, b.x, b.y}; v1 = (f32x4){c.x, c.y, d.x, d.y}; }
                    u32x4 w; w.x = pk2(v0[0], v0[1]); w.y = pk2(v0[2], v0[3]); w.z = pk2(v1[0], v1[1]); w.w = pk2(v1[2], v1[3]);
                    *(u32x4*)(rowp + bj * 128) = w; } }
    }
};
struct EpiQ {
    static constexpr bool PERM = true;
    bf16_t* QB; const float* RS; const float* CS; float qscale;
    __device__ __forceinline__ void operator()(const Acc& acc, const Unit& u, int wr, int wc, int fr, int fq) const {
        const int pn = u.pn, row0 = u.pm * 256 + wr * 64 + fr;
#pragma unroll
        for (int ai = 0; ai < 2; ++ai)
#pragma unroll
            for (int m = 0; m < 4; ++m) { const int row = row0 + ai * 128 + m * 16; const float sc = RS[row * 2] * qscale;
                if (pn < 4) {
#pragma unroll
                    for (int bj = 0; bj < 2; ++bj) { const f32x4 v0 = acc[ai][bj][m][0] * sc, v1 = acc[ai][bj][m][1] * sc;
                        u32x4 w; w.x = pk2(v0[0], v0[1]); w.y = pk2(v0[2], v0[3]); w.z = pk2(v1[0], v1[1]); w.w = pk2(v1[2], v1[3]);
                        *(u32x4*)(QB + (size_t)row * 1536 + (pn * 2 + bj) * 192 + wc * 32 + 8 * fq) = w; }
                } else {
                    const int head = (pn - 4) * 4 + wc, i0 = 8 * fq;
                    const f32x4 c0 = *(const f32x4*)(CS + (size_t)row * 64 + i0), c1 = *(const f32x4*)(CS + (size_t)row * 64 + i0 + 4);
                    const f32x4 s0 = *(const f32x4*)(CS + (size_t)row * 64 + 32 + i0), s1 = *(const f32x4*)(CS + (size_t)row * 64 + 32 + i0 + 4);
                    const f32x4 x10 = acc[ai][0][m][0] * sc, x11 = acc[ai][0][m][1] * sc, x20 = acc[ai][1][m][0] * sc, x21 = acc[ai][1][m][1] * sc;
                    const f32x4 a0 = x10 * c0 - x20 * s0, a1 = x11 * c1 - x21 * s1, b0 = x10 * s0 + x20 * c0, b1 = x11 * s1 + x21 * c1;
                    u32x4 w; w.x = pk2(a0[0], a0[1]); w.y = pk2(a0[2], a0[3]); w.z = pk2(a1[0], a1[1]); w.w = pk2(a1[2], a1[3]);
                    *(u32x4*)(QB + (size_t)row * 1536 + head * 192 + 128 + i0) = w;
                    w.x = pk2(b0[0], b0[1]); w.y = pk2(b0[2], b0[3]); w.z = pk2(b1[0], b1[1]); w.w = pk2(b1[2], b1[3]);
                    *(u32x4*)(QB + (size_t)row * 1536 + head * 192 + 160 + i0) = w;
                } }
    }
};
struct EpiKN {
    static constexpr bool PERM = true;
    bf16_t* O; const float* RS;
    __device__ __forceinline__ void operator()(const Acc& acc, const Unit& u, int wr, int wc, int fr, int fq) const {
        const int row0 = u.pm * 256 + wr * 64 + fr, col0 = u.pn * 256 + wc * 32 + 8 * fq;
#pragma unroll
        for (int ai = 0; ai < 2; ++ai)
#pragma unroll
            for (int m = 0; m < 4; ++m) { const int row = row0 + ai * 128 + m * 16; const float sc = RS[row * 2 + 1];
#pragma unroll
                for (int bj = 0; bj < 2; ++bj) { const f32x4 v0 = acc[ai][bj][m][0] * sc, v1 = acc[ai][bj][m][1] * sc;
                    u32x4 w; w.x = pk2(v0[0], v0[1]); w.y = pk2(v0[2], v0[3]); w.z = pk2(v1[0], v1[1]); w.w = pk2(v1[2], v1[3]);
                    *(u32x4*)(O + (size_t)row * 1024 + col0 + bj * 128) = w; } }
    }
};
struct EpiVT {
    static constexpr bool PERM = true;
    bf16_t* O; const float* RS;
    __device__ __forceinline__ void operator()(const Acc& acc, const Unit& u, int wr, int wc, int fr, int fq) const {
        const int row0 = u.pm * 256 + wr * 64 + fr, col0 = u.pn * 256 + wc * 32 + 8 * fq;
        float sc[2][8];
#pragma unroll
        for (int bj = 0; bj < 2; ++bj)
#pragma unroll
            for (int e = 0; e < 8; ++e) sc[bj][e] = RS[(col0 + bj * 128 + e) * 2 + 1];
#pragma unroll
        for (int ai = 0; ai < 2; ++ai)
#pragma unroll
            for (int m = 0; m < 4; ++m) { const int row = row0 + ai * 128 + m * 16;
#pragma unroll
                for (int bj = 0; bj < 2; ++bj) { const f32x4 v0 = acc[ai][bj][m][0], v1 = acc[ai][bj][m][1];
                    u32x4 w; w.x = pk2(v0[0] * sc[bj][0], v0[1] * sc[bj][1]); w.y = pk2(v0[2] * sc[bj][2], v0[3] * sc[bj][3]);
                    w.z = pk2(v1[0] * sc[bj][4], v1[1] * sc[bj][5]); w.w = pk2(v1[2] * sc[bj][6], v1[3] * sc[bj][7]);
                    *(u32x4*)(O + (size_t)row * 8192 + col0 + bj * 128) = w; } }
    }
};
template <int BR> struct EpiBranch {
    static constexpr bool PERM = true;
    float* ACC; const bf16_t* GATE; bf16_t* OUT;
    __device__ __forceinline__ void operator()(const Acc& acc, const Unit& u, int wr, int wc, int fr, int fq) const {
        const int row0 = u.pm * 256 + wr * 64 + fr, col0 = u.pn * 256 + wc * 32 + 8 * fq;
#pragma unroll
        for (int ai = 0; ai < 2; ++ai)
#pragma unroll
            for (int m = 0; m < 4; ++m) { const int row = row0 + ai * 128 + m * 16;
#pragma unroll
                for (int bj = 0; bj < 2; ++bj) { const int col = col0 + bj * 128;
                    const u32x4 gw = *(const u32x4*)(GATE + (size_t)row * 6144 + BR * 2048 + col);
                    f32x4 v0 = acc[ai][bj][m][0], v1 = acc[ai][bj][m][1];
                    v0[0] *= bflo(gw.x); v0[1] *= bfhi(gw.x); v0[2] *= bflo(gw.y); v0[3] *= bfhi(gw.y);
                    v1[0] *= bflo(gw.z); v1[1] *= bfhi(gw.z); v1[2] *= bflo(gw.w); v1[3] *= bfhi(gw.w);
                    float* ap = ACC + (size_t)row * 2048 + col;
                    if (BR > 0) { v0 += *(const f32x4*)ap; v1 += *(const f32x4*)(ap + 4); }
                    if (BR < 2) { *(f32x4*)ap = v0; *(f32x4*)(ap + 4) = v1; }
                    else { u32x4 w; w.x = pk2(v0[0], v0[1]); w.y = pk2(v0[2], v0[3]); w.z = pk2(v1[0], v1[1]); w.w = pk2(v1[2], v1[3]);
                        *(u32x4*)(OUT + (size_t)row * 2048 + col) = w; } } }
    }
};

template <class Epi>
__device__ __forceinline__ void run_gemm(LAS unsigned char* lds, const bf16_t* A, const bf16_t* Bt, int M, int N, int K, const Epi& E) {
    pg8::Gemm g; g.A = A; g.Bt = Bt; g.M = M; g.N = N; g.K = K;
    pg8::StaticOrder S; S.init(M, N, (int)gridDim.x, (int)blockIdx.x);
    pg8::gemm_phase<Epi>(lds, g, S, E);
}

template <class Map>
__device__ __forceinline__ void cvt_item(const float* W, int K, int N, bf16_t* WT, const float* kscale, LAS float* scr, int item, int lane, Map map) {
    const int nblk = (N + 31) / 32, kb = item / nblk, nb = item % nblk, k0 = 64 * kb, n0 = 32 * nb;
    {
        const int nc4 = n0 + 4 * (lane & 7); const bool ok4 = nc4 < N;
        f32x4 v[8];
#pragma unroll
        for (int i = 0; i < 8; ++i) { const int kk = 8 * i + (lane >> 3); v[i] = ok4 ? *(const f32x4*)(W + (size_t)(k0 + kk) * N + nc4) : (f32x4){0.f, 0.f, 0.f, 0.f}; }
#pragma unroll
        for (int i = 0; i < 8; ++i) { const int kk = 8 * i + (lane >> 3); f32x4 x = v[i]; if (kscale) x = x * kscale[k0 + kk];
            LAS float* d = scr + kk * 33 + 4 * (lane & 7); d[0] = x[0]; d[1] = x[1]; d[2] = x[2]; d[3] = x[3]; }
    }
    LDS_WAIT();
    const int c = lane & 7;
#pragma unroll
    for (int j = 0; j < 4; ++j) { const int n = (lane >> 3) + 8 * j; const LAS float* s = scr + (8 * c) * 33 + n;
        if (n0 + n < N) { const int drow = map(n0 + n);
            u32x4 o; o.x = pk2(s[0 * 33], s[1 * 33]); o.y = pk2(s[2 * 33], s[3 * 33]); o.z = pk2(s[4 * 33], s[5 * 33]); o.w = pk2(s[6 * 33], s[7 * 33]);
            *(u32x4*)(WT + (size_t)drow * K + k0 + 8 * c) = o; } }
    LDS_WAIT();
}
struct MapId { __device__ __forceinline__ int operator()(int n) const { return n; } };
struct MapGU { int off; __device__ __forceinline__ int operator()(int n) const { return (n >> 7) * 256 + off + (n & 127); } };
struct MapWin { __device__ __forceinline__ int operator()(int n) const {
    if (n < 4096) return n;
    if (n < 4112) return 13312 + 64 + (n - 4096);
    if (n < 6160) return 4096 + (n - 4112);
    if (n < 6672) return 6144 + (n - 6160);
    if (n < 7184) return 6656 + (n - 6672);
    if (n < 7248) return 13312 + (n - 7184);
    return 7168 + (n - 7248); } };
struct MapUQ { __device__ __forceinline__ int operator()(int n) const { const int hh = n / 192, d = n - hh * 192;
    if (d < 128) return (hh >> 1) * 256 + (hh & 1) * 128 + d;
    if (d < 160) return 1024 + (hh >> 2) * 256 + (hh & 3) * 32 + (d - 128);
    return 1024 + (hh >> 2) * 256 + 128 + (hh & 3) * 32 + (d - 160); } };
struct MapUKV { __device__ __forceinline__ int operator()(int n) const { const int hh = n >> 8, d = n & 255; return d < 128 ? hh * 128 + d : 1024 + hh * 128 + (d - 128); } };

__device__ __forceinline__ void convert_layer(const Params& p, int l, LAS unsigned char* lds) {
    int tid = threadIdx.x; asm volatile("" : "+v"(tid));
    const int lane = tid & 63, wave = tid >> 6;
    LAS float* scr = (LAS float*)(lds + wave * 8448);
    const int gw = blockIdx.x * 8 + wave, NGW = gridDim.x * 8;
    unsigned char* ws = p.ws;
    constexpr int I_GU = 32 * 176, I_DN = 88 * 64, I_WIN = 32 * 419, I_UQ = 8 * 48, I_UKV = 8 * 64, I_BR = 16 * 64, I_OUT = 32 * 64;
    constexpr int NITEMS = 4 * I_GU + 2 * I_DN + I_WIN + I_UQ + I_UKV + 3 * I_BR + I_OUT;
    for (int it = gw; it < NITEMS; it += NGW) {
        int r = it;
        if (r < 4 * I_GU) { const int which = r / I_GU, i = which >> 1, up = which & 1; r -= which * I_GU;
            const float* W = (up ? p.wu : p.wg) + (size_t)(l * 2 + i) * 2048 * FF;
            MapGU mp; mp.off = up * 128;
            cvt_item(W, 2048, FF, (bf16_t*)(ws + OFF_WGU) + (size_t)i * 11264 * 2048, nullptr, scr, r, lane, mp); continue; }
        r -= 4 * I_GU;
        if (r < 2 * I_DN) { const int i = r / I_DN; r -= i * I_DN;
            cvt_item(p.wd + (size_t)(l * 2 + i) * FF * 2048, FF, 2048, (bf16_t*)(ws + OFF_WDN) + (size_t)i * 2048 * FF, nullptr, scr, r, lane, MapId()); continue; }
        r -= 2 * I_DN;
        if (r < I_WIN) { cvt_item(p.win + (size_t)l * 2048 * NIN, 2048, NIN, (bf16_t*)(ws + OFF_WIN), nullptr, scr, r, lane, MapWin()); continue; }
        r -= I_WIN;
        if (r < I_UQ) { cvt_item(p.wuq + (size_t)l * 512 * 1536, 512, 1536, (bf16_t*)(ws + OFF_WUQ), p.cqg + l * 512, scr, r, lane, MapUQ()); continue; }
        r -= I_UQ;
        if (r < I_UKV) { cvt_item(p.wukv + (size_t)l * 512 * 2048, 512, 2048, (bf16_t*)(ws + OFF_WUKV), p.ckvg + l * 512, scr, r, lane, MapUKV()); continue; }
        r -= I_UKV;
        if (r < 3 * I_BR) { const int j = r / I_BR; r -= j * I_BR;
            cvt_item(p.wbr + (size_t)(l * 3 + j) * 1024 * 2048, 1024, 2048, (bf16_t*)(ws + OFF_WBR) + (size_t)j * 2048 * 1024, nullptr, scr, r, lane, MapId()); continue; }
        r -= 3 * I_BR;
        cvt_item(p.wout + (size_t)l * 2048 * 2048, 2048, 2048, (bf16_t*)(ws + OFF_WOUT), nullptr, scr, r, lane, MapId());
    }
    const size_t gt = (size_t)blockIdx.x * 512 + tid, NGT = (size_t)gridDim.x * 512;
    { bf16_t* SGW = (bf16_t*)(ws + OFF_SGW); const float* src = p.sgw + (size_t)l * 8 * 128 * 128;
      for (size_t e = gt; e < (size_t)8 * 128 * 128; e += NGT) { const int j = (int)(e & 127), i = (int)((e >> 7) & 127); SGW[e] = ((j >> 6) <= (i >> 6)) ? f2bf(src[e]) : (bf16_t)0; } }
    { bf16_t* WIN = (bf16_t*)(ws + OFF_WIN) + (size_t)(13312 + 80) * 2048;
      for (size_t e = gt; e < (size_t)176 * 2048; e += NGT) WIN[e] = 0; }
}

__device__ __forceinline__ void rowpass(const float* xin, const float* f, float alpha, const float* gpost, const float* gpre, float* xout, bf16_t* hout) {
    int tid = threadIdx.x; asm volatile("" : "+v"(tid));
    const int lane = tid & 63, wave = tid >> 6;
    const int gw = blockIdx.x * 8 + wave, NGW = gridDim.x * 8;
    for (int row = gw; row < T_; row += NGW) {
        f32x4 xv[8];
        const f32x4* xr = (const f32x4*)(xin + (size_t)row * DM) + lane;
#pragma unroll
        for (int j = 0; j < 8; ++j) xv[j] = xr[64 * j];
        if (f) {
            f32x4 fv[8]; float ss = 0.f;
            const f32x4* fr = (const f32x4*)(f + (size_t)row * DM) + lane;
#pragma unroll
            for (int j = 0; j < 8; ++j) { fv[j] = fr[64 * j]; ss += fv[j][0] * fv[j][0] + fv[j][1] * fv[j][1] + fv[j][2] * fv[j][2] + fv[j][3] * fv[j][3]; }
            const float rs = rsqrtf(wave_sum(ss) * (1.f / DM) + EPS) * alpha;
#pragma unroll
            for (int j = 0; j < 8; ++j) { const f32x4 gg = *((const f32x4*)gpost + lane + 64 * j); xv[j] += fv[j] * rs * gg; }
        }
        f32x4* xo = (f32x4*)(xout + (size_t)row * DM) + lane;
#pragma unroll
        for (int j = 0; j < 8; ++j) xo[64 * j] = xv[j];
        if (hout) {
            float ss = 0.f;
#pragma unroll
            for (int j = 0; j < 8; ++j) ss += xv[j][0] * xv[j][0] + xv[j][1] * xv[j][1] + xv[j][2] * xv[j][2] + xv[j][3] * xv[j][3];
            const float rs = rsqrtf(wave_sum(ss) * (1.f / DM) + EPS);
            u32x2* ho = (u32x2*)(hout + (size_t)row * DM) + lane;
#pragma unroll
            for (int j = 0; j < 8; ++j) { const f32x4 gg = *((const f32x4*)gpre + lane + 64 * j); const f32x4 y = xv[j] * rs * gg;
                u32x2 w; w.x = pk2(y[0], y[1]); w.y = pk2(y[2], y[3]); ho[64 * j] = w; }
        }
    }
}

constexpr int XS = 260;
__device__ __forceinline__ void dn_prep_item(const Params& p, int l, LAS float* L, int item) {
    unsigned char* ws = p.ws;
    int tid = threadIdx.x; asm volatile("" : "+v"(tid));
    const int lane = tid & 63, wave = tid >> 6;
    const int h = item & 7, n = (item >> 3) & 31, b = item >> 8;
    const int t0 = b * SEQ_ + n * 64;
    LAS float* sQ = L; LAS float* sK = L + 64 * 132; LAS float* sX = L + 2 * 64 * 132; LAS float* sA = sX + 64 * XS; LAS float* sG = sA + 64 * 68; LAS float* sB = sG + 64;
    const bf16_t* QKV = (const bf16_t*)(ws + OFF_QKV);
    const float* MISC = (const float*)(ws + OFF_MISC);
    const float* cw = p.convw + (size_t)l * 4 * 3072;
    if (tid < 384) {
        const int cgp = tid % 48, tq = tid / 48, part = cgp >> 4, d0 = (cgp & 15) * 8, ch = part * 1024 + h * 128 + d0;
        f32x4 w0[4], w1[4];
#pragma unroll
        for (int j = 0; j < 4; ++j) { w0[j] = *(const f32x4*)(cw + j * 3072 + ch); w1[j] = *(const f32x4*)(cw + j * 3072 + ch + 4); }
        u32x4 xr[11];
#pragma unroll
        for (int r = 0; r < 11; ++r) { const int sq = n * 64 + tq * 8 - 3 + r; const int sc = sq < 0 ? 0 : sq;
            u32x4 v = *(const u32x4*)(QKV + (size_t)(b * SEQ_ + sc) * 3072 + ch);
            if (sq < 0) v = (u32x4){0u, 0u, 0u, 0u};
            xr[r] = v; }
#pragma unroll
        for (int tt = 0; tt < 8; ++tt) { const int t = tq * 8 + tt;
            f32x4 a0 = (f32x4){0.f, 0.f, 0.f, 0.f}, a1 = a0;
#pragma unroll
            for (int j = 0; j < 4; ++j) { const u32x4 xv = xr[tt + j];
                a0 += w0[j] * (f32x4){bflo(xv.x), bfhi(xv.x), bflo(xv.y), bfhi(xv.y)}; a1 += w1[j] * (f32x4){bflo(xv.z), bfhi(xv.z), bflo(xv.w), bfhi(xv.w)}; }
            LAS float* dst = part == 0 ? sQ + t * 132 + d0 : (part == 1 ? sK + t * 132 + d0 : sX + t * XS + 128 + d0);
#pragma unroll
            for (int e = 0; e < 4; ++e) { dst[e] = siluf_(a0[e]); dst[4 + e] = siluf_(a1[e]); } }
    }
    __syncthreads();
    { const int row = tid >> 2, sub = tid & 3; LAS float* rp = (row < 64 ? sQ + row * 132 : sK + (row - 64) * 132) + sub * 32;
      float ss = 0.f;
#pragma unroll
      for (int e = 0; e < 32; ++e) ss += rp[e] * rp[e];
      ss += __shfl_xor(ss, 1); ss += __shfl_xor(ss, 2);
      const float sc = rsqrtf(ss + 1e-6f) * (row < 64 ? 0.08838834764831845f : 1.f);
#pragma unroll
      for (int e = 0; e < 32; ++e) rp[e] *= sc; }
    if (tid < 64) { const float av = MISC[(size_t)(t0 + tid) * 128 + 64 + h], bv = MISC[(size_t)(t0 + tid) * 128 + 72 + h];
        const float xx = av + p.dtb[l * 8 + h]; const float sp = xx > 20.f ? xx : log1pf(__expf(xx));
        float gv = -__expf(p.alog[l * 8 + h]) * sp;
#pragma unroll
        for (int o = 1; o < 64; o <<= 1) { const float y = __shfl_up(gv, o); if (lane >= o) gv += y; }
        sG[tid] = gv; sB[tid] = sigmoidf_(bv); }
    __syncthreads();
    { const int jl = lane & 15, g = lane >> 4, ib = wave >> 1;
      bf16_t* QKo = (bf16_t*)(ws + OFF_DQK) + (size_t)item * 4096;
#pragma unroll
      for (int jj = 0; jj < 2; ++jj) { const int jb = (wave & 1) * 2 + jj;
          f32x4 aA = (f32x4){0.f, 0.f, 0.f, 0.f}, aQ = aA;
          if (jb <= ib) {
#pragma unroll
              for (int ks = 0; ks < 4; ++ks) {
                  const LAS float* kip = sK + (ib * 16 + jl) * 132 + ks * 32 + g * 8; const LAS float* qip = sQ + (ib * 16 + jl) * 132 + ks * 32 + g * 8;
                  const LAS float* kjp = sK + (jb * 16 + jl) * 132 + ks * 32 + g * 8;
                  const bf16x8 ki = pack8(*(const LAS f32x4*)kip, *(const LAS f32x4*)(kip + 4)), qi = pack8(*(const LAS f32x4*)qip, *(const LAS f32x4*)(qip + 4));
                  const bf16x8 kj = pack8(*(const LAS f32x4*)kjp, *(const LAS f32x4*)(kjp + 4));
                  aA = MFMA16(ki, kj, aA); aQ = MFMA16(qi, kj, aQ); } }
          const int j = jb * 16 + jl; const float gj = sG[j];
          const int pj = (j & 32) + ((j & 15) >> 2) * 8 + ((j >> 4) & 1) * 4 + (j & 3);
#pragma unroll
          for (int r = 0; r < 4; ++r) { const int i = ib * 16 + g * 4 + r; const float dec = (j <= i) ? __expf(sG[i] - gj) : 0.f;
              sA[i * 68 + j] = (j < i) ? sB[i] * aA[r] * dec : 0.f;
              QKo[i * 64 + pj] = f2bf((j <= i) ? aQ[r] * dec : 0.f); } } }
    for (int task = tid; task < 64 * 32; task += 512) { const int t = task >> 5, d4 = task & 31; const float bt = sB[t], kb = bt * __expf(sG[t]);
        const f32x4 kv = *(const LAS f32x4*)(sK + t * 132 + d4 * 4); *(LAS f32x4*)(sX + t * XS + d4 * 4) = kv * kb;
        LAS f32x4* vp = (LAS f32x4*)(sX + t * XS + 128 + d4 * 4); *vp = *vp * bt; }
    __syncthreads();
    { const int col = tid >> 1, half = tid & 1;
      for (int i = 1; i < 64; ++i) { float part = 0.f;
          for (int j4 = half * 4; j4 < i; j4 += 8) { const f32x4 a4 = *(const LAS f32x4*)(sA + i * 68 + j4);
              part += a4[0] * sX[(j4 + 0) * XS + col] + a4[1] * sX[(j4 + 1) * XS + col] + a4[2] * sX[(j4 + 2) * XS + col] + a4[3] * sX[(j4 + 3) * XS + col]; }
          part += __shfl_xor(part, 1);
          const float sv = sX[i * XS + col] - part;
          sX[i * XS + col] = sv;
          asm volatile("" ::: "memory"); } }
    __syncthreads();
    { bf16_t* Wo = (bf16_t*)(ws + OFF_DW) + (size_t)item * 8192; bf16_t* QGo = (bf16_t*)(ws + OFF_DQG) + (size_t)item * 8192;
      bf16_t* KGTo = (bf16_t*)(ws + OFF_DKGT) + (size_t)item * 8192; bf16_t* UTo = (bf16_t*)(ws + OFF_DUT) + (size_t)item * 8192;
      const float glast = sG[63];
      for (int task = tid; task < 1024; task += 512) {
          { const int c = task >> 4, pc = task & 15, dA = (pc >> 2) * 32 + (pc & 3) * 4, dB = dA + 16;
            const f32x4 a = *(const LAS f32x4*)(sX + c * XS + dA), b2 = *(const LAS f32x4*)(sX + c * XS + dB);
            u32x4 w; w.x = pk2(a[0], a[1]); w.y = pk2(a[2], a[3]); w.z = pk2(b2[0], b2[1]); w.w = pk2(b2[2], b2[3]);
            *(u32x4*)(Wo + c * 128 + pc * 8) = w;
            const float eg = __expf(sG[c]);
            const f32x4 q0 = *(const LAS f32x4*)(sQ + c * 132 + dA) * eg, q1 = *(const LAS f32x4*)(sQ + c * 132 + dB) * eg;
            w.x = pk2(q0[0], q0[1]); w.y = pk2(q0[2], q0[3]); w.z = pk2(q1[0], q1[1]); w.w = pk2(q1[2], q1[3]);
            *(u32x4*)(QGo + c * 128 + pc * 8) = w; }
          { const int d = task & 127, pc = task >> 7, cA = (pc >> 2) * 32 + (pc & 3) * 4, c0 = pc * 8;
            float uu[8], kk[8];
#pragma unroll
            for (int e = 0; e < 8; ++e) { uu[e] = sX[(c0 + e) * XS + 128 + d]; const int cc = cA + (e & 3) + (e >> 2) * 16; kk[e] = sK[cc * 132 + d] * __expf(glast - sG[cc]); }
            u32x4 w; w.x = pk2(uu[0], uu[1]); w.y = pk2(uu[2], uu[3]); w.z = pk2(uu[4], uu[5]); w.w = pk2(uu[6], uu[7]);
            *(u32x4*)(UTo + d * 64 + c0) = w;
            w.x = pk2(kk[0], kk[1]); w.y = pk2(kk[2], kk[3]); w.z = pk2(kk[4], kk[5]); w.w = pk2(kk[6], kk[7]);
            *(u32x4*)(KGTo + d * 64 + pc * 8) = w; }
      }
      if (tid == 0) ((float*)(ws + OFF_DEG))[item] = __expf(glast); }
    __syncthreads();
}

__device__ __forceinline__ void row_items(const Params& p) {
    unsigned char* ws = p.ws;
    int tid = threadIdx.x; asm volatile("" : "+v"(tid));
    const int lane = tid & 63, wave = tid >> 6;
    const int gw = blockIdx.x * 8 + wave, NGW = gridDim.x * 8;
    const bf16_t* SG = (const bf16_t*)(ws + OFF_SG); const bf16_t* CQ = (const bf16_t*)(ws + OFF_CQ); const bf16_t* CKV = (const bf16_t*)(ws + OFF_CKV);
    const float* MISC = (const float*)(ws + OFF_MISC); const float* CS = (const float*)(ws + OFF_CS);
    float* STATS = (float*)(ws + OFF_STATS); float* RS = (float*)(ws + OFF_RS); bf16_t* KR = (bf16_t*)(ws + OFF_KR);
    for (int t = gw; t < T_; t += NGW) {
        { const u32x4 a = *(const u32x4*)(SG + (size_t)t * 2048 + 1024 + lane * 16), b = *(const u32x4*)(SG + (size_t)t * 2048 + 1024 + lane * 16 + 8);
          float v[16]; v[0] = bflo(a.x); v[1] = bfhi(a.x); v[2] = bflo(a.y); v[3] = bfhi(a.y); v[4] = bflo(a.z); v[5] = bfhi(a.z); v[6] = bflo(a.w); v[7] = bfhi(a.w);
          v[8] = bflo(b.x); v[9] = bfhi(b.x); v[10] = bflo(b.y); v[11] = bfhi(b.y); v[12] = bflo(b.z); v[13] = bfhi(b.z); v[14] = bflo(b.w); v[15] = bfhi(b.w);
          float s = 0.f;
#pragma unroll
          for (int e = 0; e < 16; ++e) s += v[e];
          const float mean = wave_sum(s) * (1.f / 1024.f); float s2 = 0.f;
#pragma unroll
          for (int e = 0; e < 16; ++e) { const float d = v[e] - mean; s2 += d * d; }
          const float rstd = rsqrtf(wave_sum(s2) * (1.f / 1024.f) + 1e-5f);
          if (lane == 0) { STATS[t * 2] = mean; STATS[t * 2 + 1] = rstd; } }
        { const u32x4 a = *(const u32x4*)(CQ + (size_t)t * 512 + lane * 8), b = *(const u32x4*)(CKV + (size_t)t * 512 + lane * 8);
          float sa = bflo(a.x) * bflo(a.x) + bfhi(a.x) * bfhi(a.x) + bflo(a.y) * bflo(a.y) + bfhi(a.y) * bfhi(a.y) + bflo(a.z) * bflo(a.z) + bfhi(a.z) * bfhi(a.z) + bflo(a.w) * bflo(a.w) + bfhi(a.w) * bfhi(a.w);
          float sb = bflo(b.x) * bflo(b.x) + bfhi(b.x) * bfhi(b.x) + bflo(b.y) * bflo(b.y) + bfhi(b.y) * bfhi(b.y) + bflo(b.z) * bflo(b.z) + bfhi(b.z) * bfhi(b.z) + bflo(b.w) * bflo(b.w) + bfhi(b.w) * bfhi(b.w);
          sa = wave_sum(sa); sb = wave_sum(sb);
          if (lane == 0) { RS[t * 2] = rsqrtf(sa * (1.f / 512.f) + EPS); RS[t * 2 + 1] = rsqrtf(sb * (1.f / 512.f) + EPS); } }
        if (lane < 32) { const float x1 = MISC[(size_t)t * 128 + lane], x2 = MISC[(size_t)t * 128 + 32 + lane];
            const float c = CS[(size_t)t * 64 + lane], s = CS[(size_t)t * 64 + 32 + lane];
            KR[(size_t)t * 64 + lane] = f2bf(x1 * c - x2 * s); KR[(size_t)t * 64 + 32 + lane] = f2bf(x1 * s + x2 * c); }
    }
}

__device__ __forceinline__ void dn_scan_item(const Params& p, int l, LAS unsigned char* lds, int bh) {
    unsigned char* ws = p.ws;
    int tid = threadIdx.x; asm volatile("" : "+v"(tid));
    const int lane = tid & 63, wave = tid >> 6, jl = lane & 15, g = lane >> 4;
    const int b = bh >> 3, h = bh & 7, dv0 = wave * 16;
    LAS bf16_t* sW = (LAS bf16_t*)lds; LAS bf16_t* sQG = sW + 64 * 136; LAS bf16_t* sKGT = sQG + 64 * 136; LAS bf16_t* sUT = sKGT + 128 * 72; LAS bf16_t* sQK = sUT + 128 * 72;
    LAS float* sO = (LAS float*)(sQK + 64 * 72);
    const bf16_t* Z = (const bf16_t*)(ws + OFF_Z); bf16_t* OA = (bf16_t*)(ws + OFF_OA);
    const float* EGp = (const float*)(ws + OFF_DEG);
    const float ng0 = p.dng[l * 128 + lane], ng1 = p.dng[l * 128 + 64 + lane];
    const int gA = (tid >> 4) * 128 + (tid & 15) * 8, lA = (tid >> 4) * 136 + (tid & 15) * 8;
    const int gB = (tid >> 3) * 64 + (tid & 7) * 8, lB = (tid >> 3) * 72 + (tid & 7) * 8;
    u32x4 r[9];
#define SCAN_LOAD(nn) do { const size_t it_ = (size_t)((b * 32 + (nn)) * 8 + h); \
        const bf16_t* Wg = (const bf16_t*)(ws + OFF_DW) + it_ * 8192; const bf16_t* QGg = (const bf16_t*)(ws + OFF_DQG) + it_ * 8192; \
        const bf16_t* KGg = (const bf16_t*)(ws + OFF_DKGT) + it_ * 8192; const bf16_t* UTg = (const bf16_t*)(ws + OFF_DUT) + it_ * 8192; const bf16_t* QKg = (const bf16_t*)(ws + OFF_DQK) + it_ * 4096; \
        r[0] = *(const u32x4*)(Wg + gA); r[1] = *(const u32x4*)(Wg + gA + 32 * 128); r[2] = *(const u32x4*)(QGg + gA); r[3] = *(const u32x4*)(QGg + gA + 32 * 128); \
        r[4] = *(const u32x4*)(KGg + gB); r[5] = *(const u32x4*)(KGg + gB + 64 * 64); r[6] = *(const u32x4*)(UTg + gB); r[7] = *(const u32x4*)(UTg + gB + 64 * 64); r[8] = *(const u32x4*)(QKg + gB); } while (0)
#define SCAN_STORE() do { *(LAS u32x4*)(sW + lA) = r[0]; *(LAS u32x4*)(sW + lA + 32 * 136) = r[1]; *(LAS u32x4*)(sQG + lA) = r[2]; *(LAS u32x4*)(sQG + lA + 32 * 136) = r[3]; \
        *(LAS u32x4*)(sKGT + lB) = r[4]; *(LAS u32x4*)(sKGT + lB + 64 * 72) = r[5]; *(LAS u32x4*)(sUT + lB) = r[6]; *(LAS u32x4*)(sUT + lB + 64 * 72) = r[7]; *(LAS u32x4*)(sQK + lB) = r[8]; } while (0)
    f32x4 S[8];
#pragma unroll
    for (int i = 0; i < 8; ++i) S[i] = (f32x4){0.f, 0.f, 0.f, 0.f};
    __syncthreads();
    SCAN_LOAD(0); SCAN_STORE();
    __syncthreads();
    for (int n = 0; n < 32; ++n) {
        const int item = (b * 32 + n) * 8 + h;
        if (n + 1 < 32) SCAN_LOAD(n + 1);
        const float eg = EGp[item];
        const size_t tokb = (size_t)b * SEQ_ + n * 64 + wave * 8;
        bf16_t zz0[8], zz1[8];
#pragma unroll
        for (int cc = 0; cc < 8; ++cc) { zz0[cc] = Z[(tokb + cc) * 1024 + h * 128 + lane]; zz1[cc] = Z[(tokb + cc) * 1024 + h * 128 + 64 + lane]; }
        bf16x8 sf[4];
#pragma unroll
        for (int ks = 0; ks < 4; ++ks) sf[ks] = pack8(S[2 * ks], S[2 * ks + 1]);
        f32x4 vn[4];
#pragma unroll
        for (int cb = 0; cb < 4; ++cb) { f32x4 acc = (f32x4){0.f, 0.f, 0.f, 0.f};
#pragma unroll
            for (int ks = 0; ks < 4; ++ks) { const bf16x8 a = *(const LAS bf16x8*)(sW + (cb * 16 + jl) * 136 + ks * 32 + g * 8); acc = MFMA16(a, sf[ks], acc); }
            const u32x2 uw = *(const LAS u32x2*)(sUT + (dv0 + jl) * 72 + cb * 16 + g * 4);
            vn[cb] = (f32x4){bflo(uw.x), bfhi(uw.x), bflo(uw.y), bfhi(uw.y)} - acc; }
        bf16x8 vf[2];
        vf[0] = pack8(vn[0], vn[1]); vf[1] = pack8(vn[2], vn[3]);
#pragma unroll
        for (int cb = 0; cb < 4; ++cb) { f32x4 acc = (f32x4){0.f, 0.f, 0.f, 0.f};
#pragma unroll
            for (int ks = 0; ks < 4; ++ks) { const bf16x8 a = *(const LAS bf16x8*)(sQG + (cb * 16 + jl) * 136 + ks * 32 + g * 8); acc = MFMA16(a, sf[ks], acc); }
#pragma unroll
            for (int k2 = 0; k2 < 2; ++k2) { const bf16x8 a = *(const LAS bf16x8*)(sQK + (cb * 16 + jl) * 72 + k2 * 32 + g * 8); acc = MFMA16(a, vf[k2], acc); }
#pragma unroll
            for (int rr = 0; rr < 4; ++rr) sO[(cb * 16 + g * 4 + rr) * 132 + dv0 + jl] = acc[rr]; }
#pragma unroll
        for (int db = 0; db < 8; ++db) { f32x4 acc = S[db] * eg;
#pragma unroll
            for (int k2 = 0; k2 < 2; ++k2) { const bf16x8 a = *(const LAS bf16x8*)(sKGT + (db * 16 + jl) * 72 + k2 * 32 + g * 8); acc = MFMA16(a, vf[k2], acc); }
            S[db] = acc; }
        __syncthreads();
        if (n + 1 < 32) SCAN_STORE();
#pragma unroll
        for (int cc = 0; cc < 8; ++cc) { const int c = wave * 8 + cc; const float o0 = sO[c * 132 + lane], o1 = sO[c * 132 + 64 + lane];
            const float rs = rsqrtf(wave_sum(o0 * o0 + o1 * o1) * (1.f / 128.f) + EPS);
            OA[(tokb + cc) * 1024 + h * 128 + lane] = f2bf(o0 * rs * ng0 * siluf_(bf1(zz0[cc])));
            OA[(tokb + cc) * 1024 + h * 128 + 64 + lane] = f2bf(o1 * rs * ng1 * siluf_(bf1(zz1[cc]))); }
        __syncthreads();
    }
#undef SCAN_LOAD
#undef SCAN_STORE
}

__device__ __forceinline__ void attn_wave_item(const Params& p, int wi) {
    unsigned char* ws = p.ws;
    int tid = threadIdx.x; asm volatile("" : "+v"(tid));
    const int lane = tid & 63, jl = lane & 15, g = lane >> 4;
    const int qg = 63 - (wi >> 5), bh = wi & 31, b = bh >> 3, h = bh & 7;
    const int s0 = qg * 32; const size_t tq = (size_t)b * SEQ_ + s0 + jl;
    const bf16_t* QB = (const bf16_t*)(ws + OFF_QB);
    bf16x8 qf[2][6];
#pragma unroll
    for (int u = 0; u < 2; ++u)
#pragma unroll
        for (int ks = 0; ks < 6; ++ks) qf[u][ks] = *(const bf16x8*)(QB + (tq + u * 16) * 1536 + h * 192 + ks * 32 + g * 8);
    const int nkb = (((s0 >> 6) + 1) * 64) >> 5;
    const bf16_t* KNb = (const bf16_t*)(ws + OFF_KN) + (size_t)(b * SEQ_) * 1024 + h * 128;
    const bf16_t* KRb = (const bf16_t*)(ws + OFF_KR) + (size_t)(b * SEQ_) * 64;
    const bf16_t* VTb = (const bf16_t*)(ws + OFF_VT) + (size_t)(h * 128) * 8192 + (size_t)b * SEQ_;
    f32x4 o[2][8];
#pragma unroll
    for (int u = 0; u < 2; ++u)
#pragma unroll
        for (int i = 0; i < 8; ++i) o[u][i] = (f32x4){0.f, 0.f, 0.f, 0.f};
    float mrun[2] = {-1e30f, -1e30f}, lsum[2] = {0.f, 0.f};
    for (int kb = 0; kb < nkb; ++kb) {
        f32x4 s[2][2];
#pragma unroll
        for (int sb = 0; sb < 2; ++sb) { const int key = kb * 32 + sb * 16 + jl; f32x4 a0 = (f32x4){0.f, 0.f, 0.f, 0.f}, a1 = a0;
#pragma unroll
            for (int ks = 0; ks < 4; ++ks) { const bf16x8 kf = *(const bf16x8*)(KNb + (size_t)key * 1024 + ks * 32 + g * 8); a0 = MFMA16(kf, qf[0][ks], a0); a1 = MFMA16(kf, qf[1][ks], a1); }
#pragma unroll
            for (int ks = 0; ks < 2; ++ks) { const bf16x8 kf = *(const bf16x8*)(KRb + (size_t)key * 64 + ks * 32 + g * 8); a0 = MFMA16(kf, qf[0][4 + ks], a0); a1 = MFMA16(kf, qf[1][4 + ks], a1); }
            s[0][sb] = a0; s[1][sb] = a1; }
        bf16x8 pf[2]; float alpha[2];
#pragma unroll
        for (int u = 0; u < 2; ++u) {
            float mx = fmaxf(fmaxf(fmaxf(s[u][0][0], s[u][0][1]), fmaxf(s[u][0][2], s[u][0][3])), fmaxf(fmaxf(s[u][1][0], s[u][1][1]), fmaxf(s[u][1][2], s[u][1][3])));
            mx = fmaxf(mx, __shfl_xor(mx, 16)); mx = fmaxf(mx, __shfl_xor(mx, 32));
            const float mnew = fmaxf(mrun[u], mx); alpha[u] = __builtin_amdgcn_exp2f(mrun[u] - mnew); mrun[u] = mnew;
            float ps = 0.f;
#pragma unroll
            for (int sb = 0; sb < 2; ++sb)
#pragma unroll
                for (int r = 0; r < 4; ++r) { const float pv = __builtin_amdgcn_exp2f(s[u][sb][r] - mnew); s[u][sb][r] = pv; ps += pv; }
            lsum[u] = lsum[u] * alpha[u] + ps;
            pf[u] = pack8(s[u][0], s[u][1]); }
#pragma unroll
        for (int db = 0; db < 8; ++db) { const bf16x8 a = load2x4(VTb + (size_t)(db * 16 + jl) * 8192 + kb * 32 + g * 4);
            o[0][db] = MFMA16(a, pf[0], o[0][db] * alpha[0]); o[1][db] = MFMA16(a, pf[1], o[1][db] * alpha[1]); }
    }
    bf16_t* OC = (bf16_t*)(ws + OFF_OC);
#pragma unroll
    for (int u = 0; u < 2; ++u) { float l = lsum[u]; l += __shfl_xor(l, 16); l += __shfl_xor(l, 32); const float inv = 1.f / l;
#pragma unroll
        for (int db = 0; db < 8; ++db) { const f32x4 v = o[u][db] * inv; u32x2 w; w.x = pk2(v[0], v[1]); w.y = pk2(v[2], v[3]);
            *(u32x2*)(OC + (tq + u * 16) * 1024 + h * 128 + db * 16 + g * 4) = w; } }
}

__device__ __forceinline__ void sg_wave_item(const Params& p, int l, int widx) {
    unsigned char* ws = p.ws;
    int tid = threadIdx.x; asm volatile("" : "+v"(tid));
    const int lane = tid & 63, wave = widx & 7, idx = widx >> 3, jl = lane & 15, g = lane >> 4;
    const int gi = idx & 7, nb = (idx >> 3) & 15, b = idx >> 7;
    const size_t t0 = (size_t)b * SEQ_ + nb * 128; const int cc = gi * 128 + wave * 16 + jl;
    const bf16_t* SG = (const bf16_t*)(ws + OFF_SG); const float* STATS = (const float*)(ws + OFF_STATS); const bf16_t* SGW = (const bf16_t*)(ws + OFF_SGW);
    bf16_t* OB = (bf16_t*)(ws + OFF_OB);
    const float lg = p.lng[l * 1024 + cc], lb = p.lnb[l * 1024 + cc];
    bf16x8 bfr[4];
#pragma unroll
    for (int kb = 0; kb < 4; ++kb) { float v[8];
#pragma unroll
        for (int e = 0; e < 8; ++e) { const size_t tok = t0 + kb * 32 + g * 8 + e; const f32x2 st = *(const f32x2*)(STATS + tok * 2);
            v[e] = (bf1(SG[tok * 2048 + 1024 + cc]) - st.x) * st.y * lg + lb; }
        u32x4 w; w.x = pk2(v[0], v[1]); w.y = pk2(v[2], v[3]); w.z = pk2(v[4], v[5]); w.w = pk2(v[6], v[7]); bfr[kb] = __builtin_bit_cast(bf16x8, w); }
#pragma unroll
    for (int ib = 0; ib < 8; ++ib) { f32x4 acc = (f32x4){0.f, 0.f, 0.f, 0.f};
#pragma unroll
        for (int kb = 0; kb < 4; ++kb) { const bf16x8 a = *(const bf16x8*)(SGW + (size_t)(gi * 128 + ib * 16 + jl) * 128 + kb * 32 + g * 8); acc = MFMA16(a, bfr[kb], acc); }
#pragma unroll
        for (int r = 0; r < 4; ++r) { const int i = ib * 16 + g * 4 + r; const size_t tok = t0 + i;
            const float mixed = acc[r] + p.sgb[l * 1024 + gi * 128 + i];
            OB[tok * 1024 + cc] = f2bf(bf1(SG[tok * 2048 + cc]) * mixed); } }
}

#define XB_TMO      128
#define XB_XCNT(j)  (256  + 64 * (j))
#define XB_XSUB(j)  (1280 + 64 * (j))
#define XB_XGEN(j)  (2304 + 64 * (j))
#define XB_TOP      3328
#define XB_TOPGEN   3392
#define XCD_BAR_WORDS 3456
#define XB_SPIN_CAP (1u << 18)
__device__ __forceinline__ unsigned xb_ld(unsigned* p)              { return __hip_atomic_load(p, __ATOMIC_RELAXED, __HIP_MEMORY_SCOPE_AGENT); }
__device__ __forceinline__ unsigned xb_add(unsigned* p, unsigned v) { return __hip_atomic_fetch_add(p, v, __ATOMIC_RELAXED, __HIP_MEMORY_SCOPE_AGENT); }
__device__ __forceinline__ unsigned xb_xcc_id() { return (unsigned)__builtin_amdgcn_s_getreg((3 << 11) | 20) & 0xFu; }
#define XB_SPIN(cond, bar) do { unsigned _sp = 0; while (cond) { __builtin_amdgcn_s_sleep(1); \
    if ((++_sp & 255u) == 0u) { if (xb_ld(&(bar)[XB_TMO])) break; if (_sp > XB_SPIN_CAP) { atomicAdd(&(bar)[XB_TMO], 1u); break; } } } } while (0)
__device__ __forceinline__ void xcd_barrier_complete(unsigned* bar, unsigned x, unsigned& nloc, unsigned& nx) {
    const unsigned G = gridDim.x * gridDim.y * gridDim.z;
    unsigned sum, cnt, mine, sp = 0u;
    for (;;) {
        sum = 0u; cnt = 0u; mine = 0u;
#pragma unroll
        for (unsigned j = 0; j < 16; ++j) { const unsigned c = xb_ld(&bar[XB_XCNT(j)]); sum += c; cnt += (c > 0u) ? 1u : 0u; mine = (j == x) ? c : mine; }
        if (sum == G) break;
        __builtin_amdgcn_s_sleep(1);
        if ((++sp & 255u) == 0u) { if (xb_ld(&bar[XB_TMO])) break; if (sp > XB_SPIN_CAP) { atomicAdd(&bar[XB_TMO], 1u); break; } }
    }
    nloc = mine > 0u ? mine : 1u; nx = cnt > 0u ? cnt : 1u;
}
__device__ __forceinline__ void xcd_barrier(unsigned* bar, volatile LAS unsigned* st) {
    asm volatile("s_waitcnt vmcnt(0)" ::: "memory");
    __syncthreads();
    if (threadIdx.x == 0) {
        const unsigned x = xb_xcc_id();
        __builtin_amdgcn_s_waitcnt(0);
        unsigned nloc = st[0], nx = st[1];
        if (nloc == 0u) { xcd_barrier_complete(bar, x, nloc, nx); st[0] = nloc; st[1] = nx; }
        const unsigned old = xb_add(&bar[XB_XSUB(x)], 1u);
        const unsigned gen = old / nloc;
        if (old + 1u == (gen + 1u) * nloc) {
            __builtin_amdgcn_fence(__ATOMIC_RELEASE, "agent");
            asm volatile("s_waitcnt vmcnt(0)" ::: "memory");
            const unsigned og = xb_add(&bar[XB_TOP], 1u);
            const unsigned tg = og / nx;
            if (og + 1u == (tg + 1u) * nx) xb_add(&bar[XB_TOPGEN], 1u);
            else XB_SPIN(xb_ld(&bar[XB_TOPGEN]) == tg, bar);
            __builtin_amdgcn_fence(__ATOMIC_ACQUIRE, "agent");
            xb_add(&bar[XB_XGEN(x)], 1u);
            asm volatile("s_waitcnt vmcnt(0)" ::: "memory");
        } else {
            XB_SPIN(xb_ld(&bar[XB_XGEN(x)]) == gen, bar);
            __builtin_amdgcn_fence(__ATOMIC_ACQUIRE, "agent");
            asm volatile("s_waitcnt vmcnt(0)" ::: "memory");
        }
    }
    __syncthreads();
}

#ifndef NREP_GEMM
#define NREP_GEMM 1
#endif
#ifndef NREP_MIX
#define NREP_MIX 1
#endif
#ifndef NREP_PREP
#define NREP_PREP NREP_MIX
#endif
#ifndef NREP_P7
#define NREP_P7 NREP_MIX
#endif
#ifndef NREP_ROW
#define NREP_ROW 0
#endif
#ifndef NREP_CVT
#define NREP_CVT 1
#endif
#ifndef NREP_SYNC
#define NREP_SYNC 1
#endif
#define GSYNC() do { for (int r_ = 0; r_ < NREP_SYNC; ++r_) { PQ xcd_barrier((unsigned*)(ws + OFF_BAR), (volatile LAS unsigned*)(shm + LDS_ST)); } } while (0)
#define RG for (int rg_ = 0; rg_ < NREP_GEMM; ++rg_)
typedef const Params __attribute__((address_space(4)))* KP;
__device__ __forceinline__ Params ldp(KP q) {
#if defined(__HIP_DEVICE_COMPILE__)
    asm volatile("" : "+s"(q)); return *q;
#else
    return Params{};
#endif
}
#define PQ const Params p = ldp(kp); unsigned char* ws = p.ws; (void)ws;
__global__ __launch_bounds__(512, 2) void fwd_megakernel(Params p_unused) {
    extern __shared__ __attribute__((aligned(16))) unsigned char shm[];
    LAS unsigned char* lds = (LAS unsigned char*)shm;
    LAS float* L = (LAS float*)shm;
    LAS int* s_item = (LAS int*)(shm + LDS_ITEM);
    cg::grid_group grid = cg::this_grid();
    KP kp = (KP)__builtin_amdgcn_kernarg_segment_ptr();
    if (threadIdx.x == 0) { LAS unsigned* st = (LAS unsigned*)(shm + LDS_ST); st[0] = 0u; st[1] = 0u; PQ (void)xb_add((unsigned*)(ws + OFF_BAR) + XB_XCNT(xb_xcc_id()), 1u); }
    __syncthreads();

#ifndef NO_CVT
    for (int rc_ = 0; rc_ < NREP_CVT; ++rc_) { PQ convert_layer(p, 0, lds); }
#endif
    { PQ int tid = threadIdx.x; asm volatile("" : "+v"(tid));
      const size_t gt = (size_t)blockIdx.x * 512 + tid, NGT = (size_t)gridDim.x * 512; float* CS = (float*)(ws + OFF_CS);
      for (size_t e = gt; e < (size_t)T_ * 32; e += NGT) { const int t = (int)(e >> 5), i = (int)(e & 31);
          const float inv_freq = exp2f(-(float)(2 * i) * (1.f / 64.f) * 13.287712379549449f);
          const float ang = (float)p.pos[t] * inv_freq; float sn, cs; sn = sinf(ang); cs = cosf(ang);
          CS[(size_t)t * 64 + i] = cs; CS[(size_t)t * 64 + 32 + i] = sn; }
      if (gt < 64) ((unsigned*)(ws + OFF_CTR))[gt] = 0u; }
    { PQ rowpass(p.x, nullptr, 0.f, nullptr, p.norm_g, p.out, (bf16_t*)(ws + OFF_H)); }
    grid.sync();

    for (int l = 0; l < 2; ++l) {
        RG { PQ EpiSwiGLU e; e.O = (bf16_t*)(ws + OFF_GATE); run_gemm(lds, (const bf16_t*)(ws + OFF_H), (const bf16_t*)(ws + OFF_WGU), T_, 11264, 2048, e); }
        GSYNC();
        RG { PQ EpiF32 e; e.C = (float*)(ws + OFF_F); e.ldc = DM; run_gemm(lds, (const bf16_t*)(ws + OFF_GATE), (const bf16_t*)(ws + OFF_WDN), T_, 2048, FF, e); }
        GSYNC();
        for (int rr_ = 0; rr_ < NREP_ROW; ++rr_) { PQ const float* ng = p.norm_g + (size_t)l * 6 * DM; rowpass(p.out, (const float*)(ws + OFF_F), 0.0f, ng + DM, ng + 2 * DM, p.out, (bf16_t*)(ws + OFF_H)); }
        { PQ const float* ng = p.norm_g + (size_t)l * 6 * DM; rowpass(p.out, (const float*)(ws + OFF_F), 0.5f, ng + DM, ng + 2 * DM, p.out, (bf16_t*)(ws + OFF_H)); }
        GSYNC();
        RG { PQ EpiWin e; e.ws = ws; run_gemm(lds, (const bf16_t*)(ws + OFF_H), (const bf16_t*)(ws + OFF_WIN), T_, NINP, 2048, e); }
        GSYNC();
        for (int rm_ = 0; rm_ < NREP_PREP; ++rm_) {
#ifndef NO_PREP
        { PQ for (int item = blockIdx.x; item < 1024; item += gridDim.x) dn_prep_item(p, l, L, item); }
#endif
#ifndef NO_ROWI
        { PQ row_items(p); }
#endif
        }
        GSYNC();
        RG { PQ EpiQ e; e.QB = (bf16_t*)(ws + OFF_QB); e.RS = (const float*)(ws + OFF_RS); e.CS = (const float*)(ws + OFF_CS); e.qscale = 0.07216878364870322f * 1.4426950408889634f;
          run_gemm(lds, (const bf16_t*)(ws + OFF_CQ), (const bf16_t*)(ws + OFF_WUQ), T_, 1536, 512, e); }
        RG { PQ EpiKN e; e.O = (bf16_t*)(ws + OFF_KN); e.RS = (const float*)(ws + OFF_RS);
          run_gemm(lds, (const bf16_t*)(ws + OFF_CKV), (const bf16_t*)(ws + OFF_WUKV), T_, 1024, 512, e); }
        RG { PQ EpiVT e; e.O = (bf16_t*)(ws + OFF_VT); e.RS = (const float*)(ws + OFF_RS);
          run_gemm(lds, (const bf16_t*)(ws + OFF_WUKV) + (size_t)1024 * 512, (const bf16_t*)(ws + OFF_CKV), 1024, T_, 512, e); }
        GSYNC();
        for (int rm_ = 0; rm_ < NREP_P7; ++rm_) {
        for (;;) {
            PQ
            __syncthreads();
            if (threadIdx.x == 0) *s_item = (int)atomicAdd((unsigned*)(ws + OFF_CTR) + l + 8 * rm_, 1u);
            __syncthreads();
            const int it = *s_item;
            if (it >= 32) break;
#ifndef NO_SCAN
            dn_scan_item(p, l, lds, it);
#endif
        }
        for (;;) {
            PQ
            int it = 0;
            if ((threadIdx.x & 63) == 0) it = (int)atomicAdd((unsigned*)(ws + OFF_CTR) + 4 + l + 8 * rm_, 1u);
            it = __builtin_amdgcn_readfirstlane(it);
            if (it >= 2048 + 4096) break;
#ifndef NO_ATTN
            if (it < 2048) attn_wave_item(p, it);
#endif
#ifndef NO_SG
            if (it >= 2048) sg_wave_item(p, l, it - 2048);
#endif
        }
        }
        GSYNC();
        { PQ EpiBranch<0> e; e.ACC = (float*)(ws + OFF_F); e.GATE = (const bf16_t*)(ws + OFF_GATE); e.OUT = (bf16_t*)(ws + OFF_MERGED); run_gemm(lds, (const bf16_t*)(ws + OFF_OA), (const bf16_t*)(ws + OFF_WBR), T_, 2048, 1024, e); }
        { PQ EpiBranch<1> e; e.ACC = (float*)(ws + OFF_F); e.GATE = (const bf16_t*)(ws + OFF_GATE); e.OUT = (bf16_t*)(ws + OFF_MERGED); run_gemm(lds, (const bf16_t*)(ws + OFF_OB), (const bf16_t*)(ws + OFF_WBR) + (size_t)2048 * 1024, T_, 2048, 1024, e); }
        { PQ EpiBranch<2> e; e.ACC = (float*)(ws + OFF_F); e.GATE = (const bf16_t*)(ws + OFF_GATE); e.OUT = (bf16_t*)(ws + OFF_MERGED); run_gemm(lds, (const bf16_t*)(ws + OFF_OC), (const bf16_t*)(ws + OFF_WBR) + (size_t)2 * 2048 * 1024, T_, 2048, 1024, e); }
        GSYNC();
        RG { PQ EpiF32 e; e.C = (float*)(ws + OFF_F); e.ldc = DM; run_gemm(lds, (const bf16_t*)(ws + OFF_MERGED), (const bf16_t*)(ws + OFF_WOUT), T_, 2048, 2048, e); }
        GSYNC();
        for (int rr_ = 0; rr_ < NREP_ROW; ++rr_) { PQ const float* ng = p.norm_g + (size_t)l * 6 * DM; rowpass(p.out, (const float*)(ws + OFF_F), 0.0f, ng + 3 * DM, ng + 4 * DM, p.out, (bf16_t*)(ws + OFF_H)); }
        { PQ const float* ng = p.norm_g + (size_t)l * 6 * DM; rowpass(p.out, (const float*)(ws + OFF_F), 1.0f, ng + 3 * DM, ng + 4 * DM, p.out, (bf16_t*)(ws + OFF_H)); }
        GSYNC();
        RG { PQ EpiSwiGLU e; e.O = (bf16_t*)(ws + OFF_GATE); run_gemm(lds, (const bf16_t*)(ws + OFF_H), (const bf16_t*)(ws + OFF_WGU) + (size_t)11264 * 2048, T_, 11264, 2048, e); }
        GSYNC();
        RG { PQ EpiF32 e; e.C = (float*)(ws + OFF_F); e.ldc = DM; run_gemm(lds, (const bf16_t*)(ws + OFF_GATE), (const bf16_t*)(ws + OFF_WDN) + (size_t)2048 * FF, T_, 2048, FF, e); }
        GSYNC();
        if (l == 0) {
            for (int rr_ = 0; rr_ < NREP_ROW; ++rr_) { PQ const float* ng = p.norm_g; rowpass(p.out, (const float*)(ws + OFF_F), 0.0f, ng + 5 * DM, ng + 6 * DM, p.out, (bf16_t*)(ws + OFF_H)); }
            { PQ const float* ng = p.norm_g; rowpass(p.out, (const float*)(ws + OFF_F), 0.5f, ng + 5 * DM, ng + 6 * DM, p.out, (bf16_t*)(ws + OFF_H)); }
#ifndef NO_CVT
            for (int rc_ = 0; rc_ < NREP_CVT; ++rc_) { PQ convert_layer(p, 1, lds); }
#endif
            GSYNC();
        } else {
            for (int rr_ = 0; rr_ < NREP_ROW; ++rr_) { PQ const float* ng = p.norm_g + (size_t)6 * DM; rowpass(p.out, (const float*)(ws + OFF_F), 0.0f, ng + 5 * DM, nullptr, p.out, nullptr); }
            { PQ const float* ng = p.norm_g + (size_t)6 * DM; rowpass(p.out, (const float*)(ws + OFF_F), 0.5f, ng + 5 * DM, nullptr, p.out, nullptr); }
        }
    }
}

extern "C" void kernel_launch(void* const* d_in, const int* in_sizes, int n_in, void* d_out, int out_size, void* d_ws, size_t ws_size, hipStream_t stream) {
    static int grid_blocks = 0;
    if (!grid_blocks) {
        if (ws_size < WS_END) { fprintf(stderr, "kernel_launch: workspace too small: %zu < %zu\n", ws_size, (size_t)WS_END); grid_blocks = -1; return; }
        int dev = 0, cus = 0, per_cu = 0;
        (void)hipGetDevice(&dev);
        (void)hipDeviceGetAttribute(&cus, hipDeviceAttributeMultiprocessorCount, dev);
        if (hipFuncSetAttribute((const void*)fwd_megakernel, hipFuncAttributeMaxDynamicSharedMemorySize, LDS_BYTES) != hipSuccess) fprintf(stderr, "kernel_launch: hipFuncSetAttribute failed\n");
        if (hipOccupancyMaxActiveBlocksPerMultiprocessor(&per_cu, (const void*)fwd_megakernel, 512, LDS_BYTES) != hipSuccess || per_cu < 1) per_cu = 1;
        (void)hipGetLastError();
        grid_blocks = cus * per_cu;
    }
    if (grid_blocks < 0) return;
    Params p{};
    p.x = (const float*)d_in[0]; p.pos = (const int*)d_in[1]; p.norm_g = (const float*)d_in[2]; p.wg = (const float*)d_in[3]; p.wu = (const float*)d_in[4];
    p.wd = (const float*)d_in[5]; p.win = (const float*)d_in[6]; p.convw = (const float*)d_in[7]; p.alog = (const float*)d_in[8]; p.dtb = (const float*)d_in[9];
    p.dng = (const float*)d_in[10]; p.lng = (const float*)d_in[11]; p.lnb = (const float*)d_in[12]; p.sgw = (const float*)d_in[13]; p.sgb = (const float*)d_in[14];
    p.cqg = (const float*)d_in[15]; p.ckvg = (const float*)d_in[16]; p.wuq = (const float*)d_in[17]; p.wukv = (const float*)d_in[18]; p.wbr = (const float*)d_in[19];
    p.wout = (const float*)d_in[20]; p.out = (float*)d_out; p.ws = (unsigned char*)d_ws;
    (void)hipMemsetAsync((unsigned char*)d_ws + OFF_BAR, 0, XCD_BAR_WORDS * 4, stream);
    void* args[] = {&p};
    hipError_t e = hipLaunchCooperativeKernel((const void*)fwd_megakernel, dim3(grid_blocks), dim3(512), args, LDS_BYTES, stream);
    if (e != hipSuccess) fprintf(stderr, "cooperative launch failed: %s (grid %d)\n", hipGetErrorString(e), grid_blocks);
}
```

```cpp
#include <hip/hip_runtime.h>
#include <hip/hip_cooperative_groups.h>
#include <cstdio>
namespace cg = cooperative_groups;

#define LAS __attribute__((address_space(3)))
typedef unsigned short bf16_t;
typedef short bf16x8 __attribute__((ext_vector_type(8)));
typedef short s16x4 __attribute__((ext_vector_type(4)));
typedef float f32x4 __attribute__((ext_vector_type(4)));
typedef float f32x2 __attribute__((ext_vector_type(2)));
typedef unsigned u32x4 __attribute__((ext_vector_type(4)));
typedef unsigned u32x2 __attribute__((ext_vector_type(2)));

constexpr int T_ = 8192, DM = 2048, FF = 5632, NIN = 13392, NINP = 13568, SEQ_ = 2048;
constexpr int LDS_BYTES = 152576;
constexpr int LDS_ITEM = 152320, LDS_ST = 152336;
constexpr float EPS = 1e-6f;

constexpr size_t al256(size_t x) { return (x + 255) & ~(size_t)255; }
constexpr size_t OFF_WGU = 0;
constexpr size_t OFF_WDN = OFF_WGU + (size_t)2 * 11264 * 2048 * 2;
constexpr size_t OFF_WIN = OFF_WDN + (size_t)2 * 2048 * 5632 * 2;
constexpr size_t OFF_WUQ = OFF_WIN + (size_t)NINP * 2048 * 2;
constexpr size_t OFF_WUKV = OFF_WUQ + (size_t)1536 * 512 * 2;
constexpr size_t OFF_WBR = OFF_WUKV + (size_t)2048 * 512 * 2;
constexpr size_t OFF_WOUT = OFF_WBR + (size_t)3 * 2048 * 1024 * 2;
constexpr size_t OFF_SGW = OFF_WOUT + (size_t)2048 * 2048 * 2;
constexpr size_t OFF_H = OFF_SGW + (size_t)8 * 128 * 128 * 2;
constexpr size_t OFF_F = OFF_H + (size_t)T_ * 2048 * 2;
constexpr size_t OFF_GATE = OFF_F + (size_t)T_ * 2048 * 4;
constexpr size_t OFF_QKV = OFF_GATE + (size_t)T_ * 6144 * 2;
constexpr size_t OFF_Z = OFF_QKV + (size_t)T_ * 3072 * 2;
constexpr size_t OFF_SG = OFF_Z + (size_t)T_ * 1024 * 2;
constexpr size_t OFF_CQ = OFF_SG + (size_t)T_ * 2048 * 2;
constexpr size_t OFF_CKV = OFF_CQ + (size_t)T_ * 512 * 2;
constexpr size_t OFF_MISC = OFF_CKV + (size_t)T_ * 512 * 2;
constexpr size_t OFF_DW = OFF_MISC + (size_t)T_ * 128 * 4;
constexpr size_t OFF_DQG = OFF_DW + (size_t)1024 * 8192 * 2;
constexpr size_t OFF_DKGT = OFF_DQG + (size_t)1024 * 8192 * 2;
constexpr size_t OFF_DUT = OFF_DKGT + (size_t)1024 * 8192 * 2;
constexpr size_t OFF_DQK = OFF_DUT + (size_t)1024 * 8192 * 2;
constexpr size_t OFF_DEG = OFF_DQK + (size_t)1024 * 4096 * 2;
constexpr size_t OFF_QB = OFF_DEG + 4096;
constexpr size_t OFF_KN = OFF_QB + (size_t)T_ * 1536 * 2;
constexpr size_t OFF_KR = OFF_KN + (size_t)T_ * 1024 * 2;
constexpr size_t OFF_VT = OFF_KR + (size_t)T_ * 64 * 2;
constexpr size_t OFF_OA = OFF_VT + (size_t)1024 * 8192 * 2;
constexpr size_t OFF_OB = OFF_OA + (size_t)T_ * 1024 * 2;
constexpr size_t OFF_OC = OFF_OB + (size_t)T_ * 1024 * 2;
constexpr size_t OFF_MERGED = OFF_OC + (size_t)T_ * 1024 * 2;
constexpr size_t OFF_STATS = OFF_MERGED + (size_t)T_ * 2048 * 2;
constexpr size_t OFF_RS = OFF_STATS + (size_t)T_ * 2 * 4;
constexpr size_t OFF_CS = OFF_RS + (size_t)T_ * 2 * 4;
constexpr size_t OFF_CTR = OFF_CS + (size_t)T_ * 64 * 4;
constexpr size_t OFF_BAR = OFF_CTR + 256;
constexpr size_t WS_END = OFF_BAR + 16384;

struct Params {
    const float* x; const int* pos; const float* norm_g; const float* wg; const float* wu; const float* wd; const float* win;
    const float* convw; const float* alog; const float* dtb; const float* dng; const float* lng; const float* lnb; const float* sgw; const float* sgb;
    const float* cqg; const float* ckvg; const float* wuq; const float* wukv; const float* wbr; const float* wout;
    float* out; unsigned char* ws;
};

__device__ __forceinline__ unsigned pk2(float lo, float hi) { unsigned r; asm volatile("v_cvt_pk_bf16_f32 %0, %1, %2" : "=v"(r) : "v"(lo), "v"(hi)); return r; }
__device__ __forceinline__ float bflo(unsigned u) { return __uint_as_float(u << 16); }
__device__ __forceinline__ float bfhi(unsigned u) { return __uint_as_float(u & 0xffff0000u); }
__device__ __forceinline__ float bf1(bf16_t b) { return __uint_as_float(((unsigned)b) << 16); }
__device__ __forceinline__ bf16_t f2bf(float f) { return (bf16_t)(pk2(f, 0.f) & 0xffffu); }
__device__ __forceinline__ float wave_sum(float v) {
#pragma unroll
    for (int o = 1; o < 64; o <<= 1) v += __shfl_xor(v, o);
    return v;
}
__device__ __forceinline__ float sigmoidf_(float x) { return 1.f / (1.f + __expf(-x)); }
__device__ __forceinline__ float siluf_(float x) { return x / (1.f + __expf(-x)); }
__device__ __forceinline__ f32x2 gelu_pk(f32x2 v) {
    const f32x2 av = __builtin_elementwise_abs(v), d = av * 0.2316418882f + 1.0f;
    f32x2 t; t.x = __builtin_amdgcn_rcpf(d.x); t.y = __builtin_amdgcn_rcpf(d.y);
    f32x2 q = t * 0.5307027145f + (-0.7265760135f); q = q * t + 0.7107068705f; q = q * t + (-0.142248368f); q = q * t + 0.127414796f; q = q * t;
    const f32x2 s = (v * v) * (-0.72134752044f);
    f32x2 e; e.x = __builtin_amdgcn_exp2f(s.x); e.y = __builtin_amdgcn_exp2f(s.y);
    const f32x2 m = v * (q * e), r = v - m;
    f32x2 o; o.x = v.x < 0.f ? m.x : r.x; o.y = v.y < 0.f ? m.y : r.y; return o;
}
__device__ __forceinline__ bf16x8 load2x4(const bf16_t* p) {
    const s16x4 lo = *(const s16x4*)p, hi = *(const s16x4*)(p + 16);
    return __builtin_shufflevector(lo, hi, 0, 1, 2, 3, 4, 5, 6, 7);
}
__device__ __forceinline__ bf16x8 pack8(f32x4 a, f32x4 b) {
    u32x4 w; w.x = pk2(a[0], a[1]); w.y = pk2(a[2], a[3]); w.z = pk2(b[0], b[1]); w.w = pk2(b[2], b[3]);
    return __builtin_bit_cast(bf16x8, w);
}
#define MFMA16(a, b, c) __builtin_amdgcn_mfma_f32_16x16x32_bf16((a), (b), (c), 0, 0, 0)
#define LDS_WAIT() asm volatile("s_waitcnt lgkmcnt(0)" ::: "memory")

namespace pg8 {
constexpr int BM = 256, BK = 64, HALF = 128, HTB = HALF * BK * 2, NXCD = 8, WGM = 8;
__device__ __forceinline__ int lds_byte(int r, int c) { const int st = (r >> 4) * 2 + (c >> 5), rr = r & 15, cc = c & 31, ob = rr * 64 + cc * 2; return st * 1024 + (ob ^ (((ob >> 9) & 1) << 5)); }
__device__ __forceinline__ void stage_rc(int b, int& R, int& C) { const int st = b / 1024, sb = b % 1024, swz = sb ^ (((sb >> 9) & 1) << 5); R = (st >> 1) * 16 + swz / 64; C = (st & 1) * 32 + (swz % 64) / 2; }
__device__ __forceinline__ int perm32(int rho) { const int n = rho >> 4, i = rho & 15; return 8 * (i >> 2) + 4 * n + (i & 3); }
struct Unit { int pm, pn; };
struct Gemm { const bf16_t* A; const bf16_t* Bt; int M, N, K; };
struct StaticOrder {
    int nM, nN, nwg, G, c;
    __device__ __forceinline__ void init(int M, int N, int G_, int c_) { nM = M / BM; nN = N / BM; nwg = nM * nN; G = G_; c = c_; }
    __device__ __forceinline__ bool next(int i, Unit& u) const {
        const long L = (long)i * G + c; if (L >= nwg) return false;
        int wgid = (int)L; { const int q = nwg / NXCD, r = nwg % NXCD, xcd = wgid % NXCD, off = wgid / NXCD; wgid = (xcd < r ? xcd * (q + 1) : r * (q + 1) + (xcd - r) * q) + off; }
        const int nig = WGM * nN, gid = wgid / nig, fm = gid * WGM, gsz = (nM - fm) < WGM ? (nM - fm) : WGM;
        u.pm = fm + ((wgid % nig) % gsz); u.pn = (wgid % nig) / gsz; return true;
    }
};
template <class Epi>
__device__ __forceinline__ void gemm_phase(LAS unsigned char* lds, const Gemm g, const StaticOrder& S, const Epi& E) {
    int tid = threadIdx.x; asm volatile("" : "+v"(tid));
    const int wid = __builtin_amdgcn_readfirstlane(tid >> 6), lane = tid & 63, wr = wid >> 2, wc = wid & 3, fr = lane & 15, fq = lane >> 4;
    const int K = g.K, nt = K / BK;
    unsigned voffA[2], voffB[2];
#pragma unroll
    for (int i = 0; i < 2; ++i) { int R, C; stage_rc(tid * 16 + i * 8192, R, C); const int Rb = Epi::PERM ? ((R & ~31) + perm32(R & 31)) : R;
        voffA[i] = (unsigned)(R * K + C) * 2u; voffB[i] = (unsigned)(Rb * K + C) * 2u; }
    const size_t kstep = (size_t)(BK * 2);
    const size_t hstep = (size_t)HALF * K * 2;
    const size_t tstep = 2 * hstep;
    const unsigned ldsw = (unsigned)wid * 1024u;
    const int aoff = lds_byte(wr * 64 + fr, fq * 8), boff = lds_byte(wc * 32 + fr, fq * 8);
#define PG8_SA(b, h) (((b) * 2 + (h)) * HTB)
#define PG8_SB(b, h) ((4 + (b) * 2 + (h)) * HTB)
#define PG8_STAGE(bufoff, gbase, voff) do { _Pragma("unroll") for (int _i = 0; _i < 2; ++_i) \
        __builtin_amdgcn_global_load_lds((const unsigned*)((const char*)(gbase) + (voff)[_i]), (LAS unsigned*)(lds + (bufoff) + ldsw + _i * 8192), 16, 0, 0); } while (0)
#define PG8_LDA(dst, b, h) do { _Pragma("unroll") for (int m = 0; m < 4; ++m) _Pragma("unroll") for (int k = 0; k < 2; ++k) dst[m][k] = *(const LAS bf16x8*)(lds + PG8_SA(b, h) + aoff + m * 2048 + k * 1024); } while (0)
#define PG8_LDB(dst, b, h) do { _Pragma("unroll") for (int n = 0; n < 2; ++n) _Pragma("unroll") for (int k = 0; k < 2; ++k) dst[n][k] = *(const LAS bf16x8*)(lds + PG8_SB(b, h) + boff + n * 2048 + k * 1024); } while (0)
#define PG8_MMA(ai, bj, At, Bt) do { __builtin_amdgcn_s_setprio(1); _Pragma("unroll") for (int m = 0; m < 4; ++m) _Pragma("unroll") for (int n = 0; n < 2; ++n) _Pragma("unroll") for (int k = 0; k < 2; ++k) \
        acc[ai][bj][m][n] = __builtin_amdgcn_mfma_f32_16x16x32_bf16(Bt[n][k], At[m][k], acc[ai][bj][m][n], 0, 0, 0); __builtin_amdgcn_s_setprio(0); } while (0)
#define PG8_WAIT_V(n) asm volatile("s_waitcnt vmcnt(" #n ")" ::: "memory")
#define PG8_WAIT_L(n) asm volatile("s_waitcnt lgkmcnt(" #n ")" ::: "memory")
#define PG8_BAR __builtin_amdgcn_s_barrier()
#define PG8_SCHED __builtin_amdgcn_sched_barrier(0)
    Unit cur, nxt; int ui = 0;
    if (!S.next(0, cur)) return;
    f32x4 acc[2][2][4][2];
#pragma unroll
    for (int a = 0; a < 2; ++a)
#pragma unroll
        for (int b = 0; b < 2; ++b)
#pragma unroll
            for (int m = 0; m < 4; ++m)
#pragma unroll
                for (int n = 0; n < 2; ++n) acc[a][b][m][n] = (f32x4){0.f, 0.f, 0.f, 0.f};
    bf16x8 At[4][2], B0[2][2], B1[2][2];
    const char* cA = (const char*)g.A + (size_t)cur.pm * tstep; const char* cB = (const char*)g.Bt + (size_t)cur.pn * tstep;
    PG8_STAGE(PG8_SB(0, 0), cB, voffB); PG8_STAGE(PG8_SA(0, 0), cA, voffA); PG8_STAGE(PG8_SB(0, 1), cB + hstep, voffB); PG8_STAGE(PG8_SA(0, 1), cA + hstep, voffA);
    if (wr == 1) PG8_BAR;
    PG8_WAIT_V(4); PG8_BAR;
    PG8_STAGE(PG8_SB(1, 0), cB + kstep, voffB); PG8_STAGE(PG8_SA(1, 0), cA + kstep, voffA); PG8_STAGE(PG8_SB(1, 1), cB + hstep + kstep, voffB);
    PG8_WAIT_V(6); PG8_BAR;
    for (;;) {
        const bool has_next = S.next(ui + 1, nxt);
        const char* nA = has_next ? (const char*)g.A + (size_t)nxt.pm * tstep : cA; const char* nB = has_next ? (const char*)g.Bt + (size_t)nxt.pn * tstep : cB;
        for (int t = 0; t < nt; t += 2) {
            const bool last = (t == nt - 2);
            const char* a1 = cA + (size_t)(t + 1) * kstep;
            const char* a2 = last ? nA : cA + (size_t)(t + 2) * kstep; const char* b2 = last ? nB : cB + (size_t)(t + 2) * kstep;
            const char* a3 = a2 + kstep; const char* b3 = b2 + kstep;
            PG8_LDB(B0, 0, 0); PG8_SCHED; PG8_LDA(At, 0, 0); PG8_STAGE(PG8_SA(1, 1), a1 + hstep, voffA);
            PG8_WAIT_L(8); PG8_BAR; PG8_WAIT_L(0); PG8_MMA(0, 0, At, B0); PG8_BAR; PG8_SCHED;
            PG8_LDB(B1, 0, 1); PG8_STAGE(PG8_SB(0, 0), b2, voffB);
            PG8_BAR; PG8_WAIT_L(0); PG8_MMA(0, 1, At, B1); PG8_BAR;
            PG8_LDA(At, 0, 1); PG8_STAGE(PG8_SA(0, 0), a2, voffA);
            PG8_BAR; PG8_WAIT_L(0); PG8_MMA(1, 0, At, B0); PG8_BAR; PG8_SCHED;
            PG8_STAGE(PG8_SB(0, 1), b2 + hstep, voffB);
            PG8_WAIT_V(6); PG8_BAR; PG8_MMA(1, 1, At, B1); PG8_BAR;
            PG8_LDB(B0, 1, 0); PG8_SCHED; PG8_LDA(At, 1, 0); PG8_STAGE(PG8_SA(0, 1), a2 + hstep, voffA);
            PG8_WAIT_L(8); PG8_BAR; PG8_WAIT_L(0); PG8_MMA(0, 0, At, B0); PG8_BAR; PG8_SCHED;
            PG8_LDB(B1, 1, 1); PG8_STAGE(PG8_SB(1, 0), b3, voffB);
            PG8_BAR; PG8_WAIT_L(0); PG8_MMA(0, 1, At, B1); PG8_BAR;
            PG8_LDA(At, 1, 1); PG8_STAGE(PG8_SA(1, 0), a3, voffA);
            PG8_BAR; PG8_WAIT_L(0); PG8_MMA(1, 0, At, B0); PG8_BAR; PG8_SCHED;
            PG8_STAGE(PG8_SB(1, 1), b3 + hstep, voffB);
            PG8_WAIT_V(6); PG8_BAR; PG8_MMA(1, 1, At, B1); PG8_BAR;
        }
        E(acc, cur, wr, wc, fr, fq);
        if (!has_next) break;
#pragma unroll
        for (int a = 0; a < 2; ++a)
#pragma unroll
            for (int b = 0; b < 2; ++b)
#pragma unroll
                for (int m = 0; m < 4; ++m)
#pragma unroll
                    for (int n = 0; n < 2; ++n) acc[a][b][m][n] = (f32x4){0.f, 0.f, 0.f, 0.f};
        cur = nxt; cA = nA; cB = nB; ++ui;
    }
    PG8_WAIT_V(0);
    if (wr == 0) PG8_BAR;
    PG8_BAR;
#undef PG8_SA
#undef PG8_SB
#undef PG8_STAGE
#undef PG8_LDA
#undef PG8_LDB
#undef PG8_MMA
#undef PG8_WAIT_V
#undef PG8_WAIT_L
#undef PG8_BAR
#undef PG8_SCHED
}
}
using pg8::Unit;
typedef f32x4 Acc[2][2][4][2];

struct EpiF32 {
    static constexpr bool PERM = false;
    float* C; int ldc;
    __device__ __forceinline__ void operator()(const Acc& acc, const Unit& u, int wr, int wc, int fr, int fq) const {
        const int row0 = u.pm * 256 + wr * 64 + fr, col0 = u.pn * 256 + wc * 32 + 4 * fq;
#pragma unroll
        for (int ai = 0; ai < 2; ++ai)
#pragma unroll
            for (int m = 0; m < 4; ++m) { float* rowp = C + (size_t)(row0 + ai * 128 + m * 16) * ldc + col0;
#pragma unroll
                for (int bj = 0; bj < 2; ++bj)
#pragma unroll
                    for (int n = 0; n < 2; ++n) *(f32x4*)(rowp + bj * 128 + n * 16) = acc[ai][bj][m][n]; }
    }
};
struct EpiSwiGLU {
    static constexpr bool PERM = true;
    bf16_t* O;
    __device__ __forceinline__ void operator()(const Acc& acc, const Unit& u, int wr, int wc, int fr, int fq) const {
        const int row0 = u.pm * 256 + wr * 64 + fr, col0 = u.pn * 128 + wc * 32 + 8 * fq;
#pragma unroll
        for (int ai = 0; ai < 2; ++ai)
#pragma unroll
            for (int m = 0; m < 4; ++m) {
                f32x4 v0, v1;
#pragma unroll
                for (int e = 0; e < 4; ++e) { v0[e] = siluf_(acc[ai][0][m][0][e]) * acc[ai][1][m][0][e]; v1[e] = siluf_(acc[ai][0][m][1][e]) * acc[ai][1][m][1][e]; }
                u32x4 w; w.x = pk2(v0[0], v0[1]); w.y = pk2(v0[2], v0[3]); w.z = pk2(v1[0], v1[1]); w.w = pk2(v1[2], v1[3]);
                *(u32x4*)(O + (size_t)(row0 + ai * 128 + m * 16) * FF + col0) = w; }
    }
};
struct EpiWin {
    static constexpr bool PERM = true;
    unsigned char* ws;
    __device__ __forceinline__ void operator()(const Acc& acc, const Unit& u, int wr, int wc, int fr, int fq) const {
        const int pn = u.pn, row0 = u.pm * 256 + wr * 64 + fr;
        if (pn == 52) {
            float* M = (float*)(ws + OFF_MISC);
#pragma unroll
            for (int ai = 0; ai < 2; ++ai)
#pragma unroll
                for (int m = 0; m < 4; ++m)
#pragma unroll
                    for (int n = 0; n < 2; ++n) *(f32x4*)(M + (size_t)(row0 + ai * 128 + m * 16) * 128 + 32 * wc + 8 * fq + 4 * n) = acc[ai][0][m][n];
            return;
        }
        bf16_t* base; int ld, col, mode = 0;
        if (pn < 12) { base = (bf16_t*)(ws + OFF_QKV); ld = 3072; col = pn * 256; }
        else if (pn < 16) { base = (bf16_t*)(ws + OFF_Z); ld = 1024; col = (pn - 12) * 256; }
        else if (pn < 24) { base = (bf16_t*)(ws + OFF_SG); ld = 2048; col = (pn - 16) * 256; mode = 2; }
        else if (pn < 26) { base = (bf16_t*)(ws + OFF_CQ); ld = 512; col = (pn - 24) * 256; }
        else if (pn < 28) { base = (bf16_t*)(ws + OFF_CKV); ld = 512; col = (pn - 26) * 256; }
        else { base = (bf16_t*)(ws + OFF_GATE); ld = 6144; col = (pn - 28) * 256; mode = 1; }
        col += wc * 32 + 8 * fq;
#pragma unroll
        for (int ai = 0; ai < 2; ++ai)
#pragma unroll
            for (int m = 0; m < 4; ++m) { bf16_t* rowp = base + (size_t)(row0 + ai * 128 + m * 16) * ld + col;
#pragma unroll
                for (int bj = 0; bj < 2; ++bj) { f32x4 v0 = acc[ai][bj][m][0], v1 = acc[ai][bj][m][1];
                    if (mode == 1) {
#pragma unroll
                        for (int e = 0; e < 4; ++e) { v0[e] = sigmoidf_(v0[e]); v1[e] = sigmoidf_(v1[e]); } }
                    else if (mode == 2) { f32x2 a = gelu_pk((f32x2){v0[0], v0[1]}), b = gelu_pk((f32x2){v0[2], v0[3]}), c = gelu_pk((f32x2){v1[0], v1[1]}), d = gelu_pk((f32x2){v1[2], v1[3]});
                        v0 = (f32x4){a.x, a.y, b.x, b.y}; v1 = (f32x4){c.x, c.y, d.x, d.y}; }
                    u32x4 w; w.x = pk2(v0[0], v0[1]); w.y = pk2(v0[2], v0[3]); w.z = pk2(v1[0], v1[1]); w.w = pk2(v1[2], v1[3]);
                    *(u32x4*)(rowp + bj * 128) = w; } }
    }
};
struct EpiQ {
    static constexpr bool PERM = true;
    bf16_t* QB; const float* RS; const float* CS; float qscale;
    __device__ __forceinline__ void operator()(const Acc& acc, const Unit& u, int wr, int wc, int fr, int fq) const {
        const int pn = u.pn, row0 = u.pm * 256 + wr * 64 + fr;
#pragma unroll
        for (int ai = 0; ai < 2; ++ai)
#pragma unroll
            for (int m = 0; m < 4; ++m) { const int row = row0 + ai * 128 + m * 16; const float sc = RS[row * 2] * qscale;
                if (pn < 4) {
#pragma unroll
                    for (int bj = 0; bj < 2; ++bj) { const f32x4 v0 = acc[ai][bj][m][0] * sc, v1 = acc[ai][bj][m][1] * sc;
                        u32x4 w; w.x = pk2(v0[0], v0[1]); w.y = pk2(v0[2], v0[3]); w.z = pk2(v1[0], v1[1]); w.w = pk2(v1[2], v1[3]);
                        *(u32x4*)(QB + (size_t)row * 1536 + (pn * 2 + bj) * 192 + wc * 32 + 8 * fq) = w; }
                } else {
                    const int head = (pn - 4) * 4 + wc, i0 = 8 * fq;
                    const f32x4 c0 = *(const f32x4*)(CS + (size_t)row * 64 + i0), c1 = *(const f32x4*)(CS + (size_t)row * 64 + i0 + 4);
                    const f32x4 s0 = *(const f32x4*)(CS + (size_t)row * 64 + 32 + i0), s1 = *(const f32x4*)(CS + (size_t)row * 64 + 32 + i0 + 4);
                    const f32x4 x10 = acc[ai][0][m][0] * sc, x11 = acc[ai][0][m][1] * sc, x20 = acc[ai][1][m][0] * sc, x21 = acc[ai][1][m][1] * sc;
                    const f32x4 a0 = x10 * c0 - x20 * s0, a1 = x11 * c1 - x21 * s1, b0 = x10 * s0 + x20 * c0, b1 = x11 * s1 + x21 * c1;
                    u32x4 w; w.x = pk2(a0[0], a0[1]); w.y = pk2(a0[2], a0[3]); w.z = pk2(a1[0], a1[1]); w.w = pk2(a1[2], a1[3]);
                    *(u32x4*)(QB + (size_t)row * 1536 + head * 192 + 128 + i0) = w;
                    w.x = pk2(b0[0], b0[1]); w.y = pk2(b0[2], b0[3]); w.z = pk2(b1[0], b1[1]); w.w = pk2(b1[2], b1[3]);
                    *(u32x4*)(QB + (size_t)row * 1536 + head * 192 + 160 + i0) = w;
                } }
    }
};
struct EpiKN {
    static constexpr bool PERM = true;
    bf16_t* O; const float* RS;
    __device__ __forceinline__ void operator()(const Acc& acc, const Unit& u, int wr, int wc, int fr, int fq) const {
        const int row0 = u.pm * 256 + wr * 64 + fr, col0 = u.pn * 256 + wc * 32 + 8 * fq;
#pragma unroll
        for (int ai = 0; ai < 2; ++ai)
#pragma unroll
            for (int m = 0; m < 4; ++m) { const int row = row0 + ai * 128 + m * 16; const float sc = RS[row * 2 + 1];
#pragma unroll
                for (int bj = 0; bj < 2; ++bj) { const f32x4 v0 = acc[ai][bj][m][0] * sc, v1 = acc[ai][bj][m][1] * sc;
                    u32x4 w; w.x = pk2(v0[0], v0[1]); w.y = pk2(v0[2], v0[3]); w.z = pk2(v1[0], v1[1]); w.w = pk2(v1[2], v1[3]);
                    *(u32x4*)(O + (size_t)row * 1024 + col0 + bj * 128) = w; } }
    }
};
struct EpiVT {
    static constexpr bool PERM = true;
    bf16_t* O; const float* RS;
    __device__ __forceinline__ void operator()(const Acc& acc, const Unit& u, int wr, int wc, int fr, int fq) const {
        const int row0 = u.pm * 256 + wr * 64 + fr, col0 = u.pn * 256 + wc * 32 + 8 * fq;
        float sc[2][8];
#pragma unroll
        for (int bj = 0; bj < 2; ++bj)
#pragma unroll
            for (int e = 0; e < 8; ++e) sc[bj][e] = RS[(col0 + bj * 128 + e) * 2 + 1];
#pragma unroll
        for (int ai = 0; ai < 2; ++ai)
#pragma unroll
            for (int m = 0; m < 4; ++m) { const int row = row0 + ai * 128 + m * 16;
#pragma unroll
                for (int bj = 0; bj < 2; ++bj) { const f32x4 v0 = acc[ai][bj][m][0], v1 = acc[ai][bj][m][1];
                    u32x4 w; w.x = pk2(v0[0] * sc[bj][0], v0[1] * sc[bj][1]); w.y = pk2(v0[2] * sc[bj][2], v0[3] * sc[bj][3]);
                    w.z = pk2(v1[0] * sc[bj][4], v1[1] * sc[bj][5]); w.w = pk2(v1[2] * sc[bj][6], v1[3] * sc[bj][7]);
                    *(u32x4*)(O + (size_t)row * 8192 + col0 + bj * 128) = w; } }
    }
};
template <int BR> struct EpiBranch {
    static constexpr bool PERM = true;
    float* ACC; const bf16_t* GATE; bf16_t* OUT;
    __device__ __forceinline__ void operator()(const Acc& acc, const Unit& u, int wr, int wc, int fr, int fq) const {
        const int row0 = u.pm * 256 + wr * 64 + fr, col0 = u.pn * 256 + wc * 32 + 8 * fq;
#pragma unroll
        for (int ai = 0; ai < 2; ++ai)
#pragma unroll
            for (int m = 0; m < 4; ++m) { const int row = row0 + ai * 128 + m * 16;
#pragma unroll
                for (int bj = 0; bj < 2; ++bj) { const int col = col0 + bj * 128;
                    const u32x4 gw = *(const u32x4*)(GATE + (size_t)row * 6144 + BR * 2048 + col);
                    f32x4 v0 = acc[ai][bj][m][0], v1 = acc[ai][bj][m][1];
                    v0[0] *= bflo(gw.x); v0[1] *= bfhi(gw.x); v0[2] *= bflo(gw.y); v0[3] *= bfhi(gw.y);
                    v1[0] *= bflo(gw.z); v1[1] *= bfhi(gw.z); v1[2] *= bflo(gw.w); v1[3] *= bfhi(gw.w);
                    float* ap = ACC + (size_t)row * 2048 + col;
                    if (BR > 0) { v0 += *(const f32x4*)ap; v1 += *(const f32x4*)(ap + 4); }
                    if (BR < 2) { *(f32x4*)ap = v0; *(f32x4*)(ap + 4) = v1; }
                    else { u32x4 w; w.x = pk2(v0[0], v0[1]); w.y = pk2(v0[2], v0[3]); w.z = pk2(v1[0], v1[1]); w.w = pk2(v1[2], v1[3]);
                        *(u32x4*)(OUT + (size_t)row * 2048 + col) = w; } } }
    }
};

template <class Epi>
__device__ __forceinline__ void run_gemm(LAS unsigned char* lds, const bf16_t* A, const bf16_t* Bt, int M, int N, int K, const Epi& E) {
    pg8::Gemm g; g.A = A; g.Bt = Bt; g.M = M; g.N = N; g.K = K;
    pg8::StaticOrder S; S.init(M, N, (int)gridDim.x, (int)blockIdx.x);
    pg8::gemm_phase<Epi>(lds, g, S, E);
}

template <class Map>
__device__ __forceinline__ void cvt_item(const float* W, int K, int N, bf16_t* WT, const float* kscale, LAS float* scr, int item, int lane, Map map) {
    const int nblk = (N + 31) / 32, kb = item / nblk, nb = item % nblk, k0 = 64 * kb, n0 = 32 * nb;
    {
        const int nc4 = n0 + 4 * (lane & 7); const bool ok4 = nc4 < N;
        f32x4 v[8];
#pragma unroll
        for (int i = 0; i < 8; ++i) { const int kk = 8 * i + (lane >> 3); v[i] = ok4 ? *(const f32x4*)(W + (size_t)(k0 + kk) * N + nc4) : (f32x4){0.f, 0.f, 0.f, 0.f}; }
#pragma unroll
        for (int i = 0; i < 8; ++i) { const int kk = 8 * i + (lane >> 3); f32x4 x = v[i]; if (kscale) x = x * kscale[k0 + kk];
            LAS float* d = scr + kk * 33 + 4 * (lane & 7); d[0] = x[0]; d[1] = x[1]; d[2] = x[2]; d[3] = x[3]; }
    }
    LDS_WAIT();
    const int c = lane & 7;
#pragma unroll
    for (int j = 0; j < 4; ++j) { const int n = (lane >> 3) + 8 * j; const LAS float* s = scr + (8 * c) * 33 + n;
        if (n0 + n < N) { const int drow = map(n0 + n);
            u32x4 o; o.x = pk2(s[0 * 33], s[1 * 33]); o.y = pk2(s[2 * 33], s[3 * 33]); o.z = pk2(s[4 * 33], s[5 * 33]); o.w = pk2(s[6 * 33], s[7 * 33]);
            *(u32x4*)(WT + (size_t)drow * K + k0 + 8 * c) = o; } }
    LDS_WAIT();
}
struct MapId { __device__ __forceinline__ int operator()(int n) const { return n; } };
struct MapGU { int off; __device__ __forceinline__ int operator()(int n) const { return (n >> 7) * 256 + off + (n & 127); } };
struct MapWin { __device__ __forceinline__ int operator()(int n) const {
    if (n < 4096) return n;
    if (n < 4112) return 13312 + 64 + (n - 4096);
    if (n < 6160) return 4096 + (n - 4112);
    if (n < 6672) return 6144 + (n - 6160);
    if (n < 7184) return 6656 + (n - 6672);
    if (n < 7248) return 13312 + (n - 7184);
    return 7168 + (n - 7248); } };
struct MapUQ { __device__ __forceinline__ int operator()(int n) const { const int hh = n / 192, d = n - hh * 192;
    if (d < 128) return (hh >> 1) * 256 + (hh & 1) * 128 + d;
    if (d < 160) return 1024 + (hh >> 2) * 256 + (hh & 3) * 32 + (d - 128);
    return 1024 + (hh >> 2) * 256 + 128 + (hh & 3) * 32 + (d - 160); } };
struct MapUKV { __device__ __forceinline__ int operator()(int n) const { const int hh = n >> 8, d = n & 255; return d < 128 ? hh * 128 + d : 1024 + hh * 128 + (d - 128); } };

__device__ __forceinline__ void convert_layer(const Params& p, int l, LAS unsigned char* lds) {
    int tid = threadIdx.x; asm volatile("" : "+v"(tid));
    const int lane = tid & 63, wave = tid >> 6;
    LAS float* scr = (LAS float*)(lds + wave * 8448);
    const int gw = blockIdx.x * 8 + wave, NGW = gridDim.x * 8;
    unsigned char* ws = p.ws;
    constexpr int I_GU = 32 * 176, I_DN = 88 * 64, I_WIN = 32 * 419, I_UQ = 8 * 48, I_UKV = 8 * 64, I_BR = 16 * 64, I_OUT = 32 * 64;
    constexpr int NITEMS = 4 * I_GU + 2 * I_DN + I_WIN + I_UQ + I_UKV + 3 * I_BR + I_OUT;
    for (int it = gw; it < NITEMS; it += NGW) {
        int r = it;
        if (r < 4 * I_GU) { const int which = r / I_GU, i = which >> 1, up = which & 1; r -= which * I_GU;
            const float* W = (up ? p.wu : p.wg) + (size_t)(l * 2 + i) * 2048 * FF;
            MapGU mp; mp.off = up * 128;
            cvt_item(W, 2048, FF, (bf16_t*)(ws + OFF_WGU) + (size_t)i * 11264 * 2048, nullptr, scr, r, lane, mp); continue; }
        r -= 4 * I_GU;
        if (r < 2 * I_DN) { const int i = r / I_DN; r -= i * I_DN;
            cvt_item(p.wd + (size_t)(l * 2 + i) * FF * 2048, FF, 2048, (bf16_t*)(ws + OFF_WDN) + (size_t)i * 2048 * FF, nullptr, scr, r, lane, MapId()); continue; }
        r -= 2 * I_DN;
        if (r < I_WIN) { cvt_item(p.win + (size_t)l * 2048 * NIN, 2048, NIN, (bf16_t*)(ws + OFF_WIN), nullptr, scr, r, lane, MapWin()); continue; }
        r -= I_WIN;
        if (r < I_UQ) { cvt_item(p.wuq + (size_t)l * 512 * 1536, 512, 1536, (bf16_t*)(ws + OFF_WUQ), p.cqg + l * 512, scr, r, lane, MapUQ()); continue; }
        r -= I_UQ;
        if (r < I_UKV) { cvt_item(p.wukv + (size_t)l * 512 * 2048, 512, 2048, (bf16_t*)(ws + OFF_WUKV), p.ckvg + l * 512, scr, r, lane, MapUKV()); continue; }
        r -= I_UKV;
        if (r < 3 * I_BR) { const int j = r / I_BR; r -= j * I_BR;
            cvt_item(p.wbr + (size_t)(l * 3 + j) * 1024 * 2048, 1024, 2048, (bf16_t*)(ws + OFF_WBR) + (size_t)j * 2048 * 1024, nullptr, scr, r, lane, MapId()); continue; }
        r -= 3 * I_BR;
        cvt_item(p.wout + (size_t)l * 2048 * 2048, 2048, 2048, (bf16_t*)(ws + OFF_WOUT), nullptr, scr, r, lane, MapId());
    }
    const size_t gt = (size_t)blockIdx.x * 512 + tid, NGT = (size_t)gridDim.x * 512;
    { bf16_t* SGW = (bf16_t*)(ws + OFF_SGW); const float* src = p.sgw + (size_t)l * 8 * 128 * 128;
      for (size_t e = gt; e < (size_t)8 * 128 * 128; e += NGT) { const int j = (int)(e & 127), i = (int)((e >> 7) & 127); SGW[e] = ((j >> 6) <= (i >> 6)) ? f2bf(src[e]) : (bf16_t)0; } }
    { bf16_t* WIN = (bf16_t*)(ws + OFF_WIN) + (size_t)(13312 + 80) * 2048;
      for (size_t e = gt; e < (size_t)176 * 2048; e += NGT) WIN[e] = 0; }
}

__device__ __forceinline__ void rowpass(const float* xin, const float* f, float alpha, const float* gpost, const float* gpre, float* xout, bf16_t* hout) {
    int tid = threadIdx.x; asm volatile("" : "+v"(tid));
    const int lane = tid & 63, wave = tid >> 6;
    const int gw = blockIdx.x * 8 + wave, NGW = gridDim.x * 8;
    for (int row = gw; row < T_; row += NGW) {
        f32x4 xv[8];
        const f32x4* xr = (const f32x4*)(xin + (size_t)row * DM) + lane;
#pragma unroll
        for (int j = 0; j < 8; ++j) xv[j] = xr[64 * j];
        if (f) {
            f32x4 fv[8]; float ss = 0.f;
            const f32x4* fr = (const f32x4*)(f + (size_t)row * DM) + lane;
#pragma unroll
            for (int j = 0; j < 8; ++j) { fv[j] = fr[64 * j]; ss += fv[j][0] * fv[j][0] + fv[j][1] * fv[j][1] + fv[j][2] * fv[j][2] + fv[j][3] * fv[j][3]; }
            const float rs = rsqrtf(wave_sum(ss) * (1.f / DM) + EPS) * alpha;
#pragma unroll
            for (int j = 0; j < 8; ++j) { const f32x4 gg = *((const f32x4*)gpost + lane + 64 * j); xv[j] += fv[j] * rs * gg; }
        }
        f32x4* xo = (f32x4*)(xout + (size_t)row * DM) + lane;
#pragma unroll
        for (int j = 0; j < 8; ++j) xo[64 * j] = xv[j];
        if (hout) {
            float ss = 0.f;
#pragma unroll
            for (int j = 0; j < 8; ++j) ss += xv[j][0] * xv[j][0] + xv[j][1] * xv[j][1] + xv[j][2] * xv[j][2] + xv[j][3] * xv[j][3];
            const float rs = rsqrtf(wave_sum(ss) * (1.f / DM) + EPS);
            u32x2* ho = (u32x2*)(hout + (size_t)row * DM) + lane;
#pragma unroll
            for (int j = 0; j < 8; ++j) { const f32x4 gg = *((const f32x4*)gpre + lane + 64 * j); const f32x4 y = xv[j] * rs * gg;
                u32x2 w; w.x = pk2(y[0], y[1]); w.y = pk2(y[2], y[3]); ho[64 * j] = w; }
        }
    }
}

constexpr int XS = 260;
__device__ __forceinline__ void dn_prep_item(const Params& p, int l, LAS float* L, int item) {
    unsigned char* ws = p.ws;
    int tid = threadIdx.x; asm volatile("" : "+v"(tid));
    const int lane = tid & 63, wave = tid >> 6;
    const int h = item & 7, n = (item >> 3) & 31, b = item >> 8;
    const int t0 = b * SEQ_ + n * 64;
    LAS float* sQ = L; LAS float* sK = L + 64 * 132; LAS float* sX = L + 2 * 64 * 132; LAS float* sA = sX + 64 * XS; LAS float* sG = sA + 64 * 68; LAS float* sB = sG + 64;
    const bf16_t* QKV = (const bf16_t*)(ws + OFF_QKV);
    const float* MISC = (const float*)(ws + OFF_MISC);
    const float* cw = p.convw + (size_t)l * 4 * 3072;
    if (tid < 384) {
        const int cgp = tid % 48, tq = tid / 48, part = cgp >> 4, d0 = (cgp & 15) * 8, ch = part * 1024 + h * 128 + d0;
        f32x4 w0[4], w1[4];
#pragma unroll
        for (int j = 0; j < 4; ++j) { w0[j] = *(const f32x4*)(cw + j * 3072 + ch); w1[j] = *(const f32x4*)(cw + j * 3072 + ch + 4); }
        u32x4 xr[11];
#pragma unroll
        for (int r = 0; r < 11; ++r) { const int sq = n * 64 + tq * 8 - 3 + r; const int sc = sq < 0 ? 0 : sq;
            u32x4 v = *(const u32x4*)(QKV + (size_t)(b * SEQ_ + sc) * 3072 + ch);
            if (sq < 0) v = (u32x4){0u, 0u, 0u, 0u};
            xr[r] = v; }
#pragma unroll
        for (int tt = 0; tt < 8; ++tt) { const int t = tq * 8 + tt;
            f32x4 a0 = (f32x4){0.f, 0.f, 0.f, 0.f}, a1 = a0;
#pragma unroll
            for (int j = 0; j < 4; ++j) { const u32x4 xv = xr[tt + j];
                a0 += w0[j] * (f32x4){bflo(xv.x), bfhi(xv.x), bflo(xv.y), bfhi(xv.y)}; a1 += w1[j] * (f32x4){bflo(xv.z), bfhi(xv.z), bflo(xv.w), bfhi(xv.w)}; }
            LAS float* dst = part == 0 ? sQ + t * 132 + d0 : (part == 1 ? sK + t * 132 + d0 : sX + t * XS + 128 + d0);
#pragma unroll
            for (int e = 0; e < 4; ++e) { dst[e] = siluf_(a0[e]); dst[4 + e] = siluf_(a1[e]); } }
    }
    __syncthreads();
    { const int row = tid >> 2, sub = tid & 3; LAS float* rp = (row < 64 ? sQ + row * 132 : sK + (row - 64) * 132) + sub * 32;
      float ss = 0.f;
#pragma unroll
      for (int e = 0; e < 32; ++e) ss += rp[e] * rp[e];
      ss += __shfl_xor(ss, 1); ss += __shfl_xor(ss, 2);
      const float sc = rsqrtf(ss + 1e-6f) * (row < 64 ? 0.08838834764831845f : 1.f);
#pragma unroll
      for (int e = 0; e < 32; ++e) rp[e] *= sc; }
    if (tid < 64) { const float av = MISC[(size_t)(t0 + tid) * 128 + 64 + h], bv = MISC[(size_t)(t0 + tid) * 128 + 72 + h];
        const float xx = av + p.dtb[l * 8 + h]; const float sp = xx > 20.f ? xx : log1pf(__expf(xx));
        float gv = -__expf(p.alog[l * 8 + h]) * sp;
#pragma unroll
        for (int o = 1; o < 64; o <<= 1) { const float y = __shfl_up(gv, o); if (lane >= o) gv += y; }
        sG[tid] = gv; sB[tid] = sigmoidf_(bv); }
    __syncthreads();
    { const int jl = lane & 15, g = lane >> 4, ib = wave >> 1;
      bf16_t* QKo = (bf16_t*)(ws + OFF_DQK) + (size_t)item * 4096;
#pragma unroll
      for (int jj = 0; jj < 2; ++jj) { const int jb = (wave & 1) * 2 + jj;
          f32x4 aA = (f32x4){0.f, 0.f, 0.f, 0.f}, aQ = aA;
          if (jb <= ib) {
#pragma unroll
              for (int ks = 0; ks < 4; ++ks) {
                  const LAS float* kip = sK + (ib * 16 + jl) * 132 + ks * 32 + g * 8; const LAS float* qip = sQ + (ib * 16 + jl) * 132 + ks * 32 + g * 8;
                  const LAS float* kjp = sK + (jb * 16 + jl) * 132 + ks * 32 + g * 8;
                  const bf16x8 ki = pack8(*(const LAS f32x4*)kip, *(const LAS f32x4*)(kip + 4)), qi = pack8(*(const LAS f32x4*)qip, *(const LAS f32x4*)(qip + 4));
                  const bf16x8 kj = pack8(*(const LAS f32x4*)kjp, *(const LAS f32x4*)(kjp + 4));
                  aA = MFMA16(ki, kj, aA); aQ = MFMA16(qi, kj, aQ); } }
          const int j = jb * 16 + jl; const float gj = sG[j];
          const int pj = (j & 32) + ((j & 15) >> 2) * 8 + ((j >> 4) & 1) * 4 + (j & 3);
#pragma unroll
          for (int r = 0; r < 4; ++r) { const int i = ib * 16 + g * 4 + r; const float dec = (j <= i) ? __expf(sG[i] - gj) : 0.f;
              sA[i * 68 + j] = (j < i) ? sB[i] * aA[r] * dec : 0.f;
              QKo[i * 64 + pj] = f2bf((j <= i) ? aQ[r] * dec : 0.f); } } }
    for (int task = tid; task < 64 * 32; task += 512) { const int t = task >> 5, d4 = task & 31; const float bt = sB[t], kb = bt * __expf(sG[t]);
        const f32x4 kv = *(const LAS f32x4*)(sK + t * 132 + d4 * 4); *(LAS f32x4*)(sX + t * XS + d4 * 4) = kv * kb;
        LAS f32x4* vp = (LAS f32x4*)(sX + t * XS + 128 + d4 * 4); *vp = *vp * bt; }
    __syncthreads();
    { const int col = tid >> 1, half = tid & 1;
      for (int i = 1; i < 64; ++i) { float part = 0.f;
          for (int j4 = half * 4; j4 < i; j4 += 8) { const f32x4 a4 = *(const LAS f32x4*)(sA + i * 68 + j4);
              part += a4[0] * sX[(j4 + 0) * XS + col] + a4[1] * sX[(j4 + 1) * XS + col] + a4[2] * sX[(j4 + 2) * XS + col] + a4[3] * sX[(j4 + 3) * XS + col]; }
          part += __shfl_xor(part, 1);
          const float sv = sX[i * XS + col] - part;
          sX[i * XS + col] = sv;
          asm volatile("" ::: "memory"); } }
    __syncthreads();
    { bf16_t* Wo = (bf16_t*)(ws + OFF_DW) + (size_t)item * 8192; bf16_t* QGo = (bf16_t*)(ws + OFF_DQG) + (size_t)item * 8192;
      bf16_t* KGTo = (bf16_t*)(ws + OFF_DKGT) + (size_t)item * 8192; bf16_t* UTo = (bf16_t*)(ws + OFF_DUT) + (size_t)item * 8192;
      const float glast = sG[63];
      for (int task = tid; task < 1024; task += 512) {
          { const int c = task >> 4, pc = task & 15, dA = (pc >> 2) * 32 + (pc & 3) * 4, dB = dA + 16;
            const f32x4 a = *(const LAS f32x4*)(sX + c * XS + dA), b2 = *(const LAS f32x4*)(sX + c * XS + dB);
            u32x4 w; w.x = pk2(a[0], a[1]); w.y = pk2(a[2], a[3]); w.z = pk2(b2[0], b2[1]); w.w = pk2(b2[2], b2[3]);
            *(u32x4*)(Wo + c * 128 + pc * 8) = w;
            const float eg = __expf(sG[c]);
            const f32x4 q0 = *(const LAS f32x4*)(sQ + c * 132 + dA) * eg, q1 = *(const LAS f32x4*)(sQ + c * 132 + dB) * eg;
            w.x = pk2(q0[0], q0[1]); w.y = pk2(q0[2], q0[3]); w.z = pk2(q1[0], q1[1]); w.w = pk2(q1[2], q1[3]);
            *(u32x4*)(QGo + c * 128 + pc * 8) = w; }
          { const int d = task & 127, pc = task >> 7, cA = (pc >> 2) * 32 + (pc & 3) * 4, c0 = pc * 8;
            float uu[8], kk[8];
#pragma unroll
            for (int e = 0; e < 8; ++e) { uu[e] = sX[(c0 + e) * XS + 128 + d]; const int cc = cA + (e & 3) + (e >> 2) * 16; kk[e] = sK[cc * 132 + d] * __expf(glast - sG[cc]); }
            u32x4 w; w.x = pk2(uu[0], uu[1]); w.y = pk2(uu[2], uu[3]); w.z = pk2(uu[4], uu[5]); w.w = pk2(uu[6], uu[7]);
            *(u32x4*)(UTo + d * 64 + c0) = w;
            w.x = pk2(kk[0], kk[1]); w.y = pk2(kk[2], kk[3]); w.z = pk2(kk[4], kk[5]); w.w = pk2(kk[6], kk[7]);
            *(u32x4*)(KGTo + d * 64 + pc * 8) = w; }
      }
      if (tid == 0) ((float*)(ws + OFF_DEG))[item] = __expf(glast); }
    __syncthreads();
}

__device__ __forceinline__ void row_items(const Params& p) {
    unsigned char* ws = p.ws;
    int tid = threadIdx.x; asm volatile("" : "+v"(tid));
    const int lane = tid & 63, wave = tid >> 6;
    const int gw = blockIdx.x * 8 + wave, NGW = gridDim.x * 8;
    const bf16_t* SG = (const bf16_t*)(ws + OFF_SG); const bf16_t* CQ = (const bf16_t*)(ws + OFF_CQ); const bf16_t* CKV = (const bf16_t*)(ws + OFF_CKV);
    const float* MISC = (const float*)(ws + OFF_MISC); const float* CS = (const float*)(ws + OFF_CS);
    float* STATS = (float*)(ws + OFF_STATS); float* RS = (float*)(ws + OFF_RS); bf16_t* KR = (bf16_t*)(ws + OFF_KR);
    for (int t = gw; t < T_; t += NGW) {
        { const u32x4 a = *(const u32x4*)(SG + (size_t)t * 2048 + 1024 + lane * 16), b = *(const u32x4*)(SG + (size_t)t * 2048 + 1024 + lane * 16 + 8);
          float v[16]; v[0] = bflo(a.x); v[1] = bfhi(a.x); v[2] = bflo(a.y); v[3] = bfhi(a.y); v[4] = bflo(a.z); v[5] = bfhi(a.z); v[6] = bflo(a.w); v[7] = bfhi(a.w);
          v[8] = bflo(b.x); v[9] = bfhi(b.x); v[10] = bflo(b.y); v[11] = bfhi(b.y); v[12] = bflo(b.z); v[13] = bfhi(b.z); v[14] = bflo(b.w); v[15] = bfhi(b.w);
          float s = 0.f;
#pragma unroll
          for (int e = 0; e < 16; ++e) s += v[e];
          const float mean = wave_sum(s) * (1.f / 1024.f); float s2 = 0.f;
#pragma unroll
          for (int e = 0; e < 16; ++e) { const float d = v[e] - mean; s2 += d * d; }
          const float rstd = rsqrtf(wave_sum(s2) * (1.f / 1024.f) + 1e-5f);
          if (lane == 0) { STATS[t * 2] = mean; STATS[t * 2 + 1] = rstd; } }
        { const u32x4 a = *(const u32x4*)(CQ + (size_t)t * 512 + lane * 8), b = *(const u32x4*)(CKV + (size_t)t * 512 + lane * 8);
          float sa = bflo(a.x) * bflo(a.x) + bfhi(a.x) * bfhi(a.x) + bflo(a.y) * bflo(a.y) + bfhi(a.y) * bfhi(a.y) + bflo(a.z) * bflo(a.z) + bfhi(a.z) * bfhi(a.z) + bflo(a.w) * bflo(a.w) + bfhi(a.w) * bfhi(a.w);
          float sb = bflo(b.x) * bflo(b.x) + bfhi(b.x) * bfhi(b.x) + bflo(b.y) * bflo(b.y) + bfhi(b.y) * bfhi(b.y) + bflo(b.z) * bflo(b.z) + bfhi(b.z) * bfhi(b.z) + bflo(b.w) * bflo(b.w) + bfhi(b.w) * bfhi(b.w);
          sa = wave_sum(sa); sb = wave_sum(sb);
          if (lane == 0) { RS[t * 2] = rsqrtf(sa * (1.f / 512.f) + EPS); RS[t * 2 + 1] = rsqrtf(sb * (1.f / 512.f) + EPS); } }
        if (lane < 32) { const float x1 = MISC[(size_t)t * 128 + lane], x2 = MISC[(size_t)t * 128 + 32 + lane];
            const float c = CS[(size_t)t * 64 + lane], s = CS[(size_t)t * 64 + 32 + lane];
            KR[(size_t)t * 64 + lane] = f2bf(x1 * c - x2 * s); KR[(size_t)t * 64 + 32 + lane] = f2bf(x1 * s + x2 * c); }
    }
}

__device__ __forceinline__ void dn_scan_item(const Params& p, int l, LAS unsigned char* lds, int bh) {
    unsigned char* ws = p.ws;
    int tid = threadIdx.x; asm volatile("" : "+v"(tid));
    const int lane = tid & 63, wave = tid >> 6, jl = lane & 15, g = lane >> 4;
    const int b = bh >> 3, h = bh & 7, dv0 = wave * 16;
    LAS bf16_t* sW = (LAS bf16_t*)lds; LAS bf16_t* sQG = sW + 64 * 136; LAS bf16_t* sKGT = sQG + 64 * 136; LAS bf16_t* sUT = sKGT + 128 * 72; LAS bf16_t* sQK = sUT + 128 * 72;
    LAS float* sO = (LAS float*)(sQK + 64 * 72);
    const bf16_t* Z = (const bf16_t*)(ws + OFF_Z); bf16_t* OA = (bf16_t*)(ws + OFF_OA);
    const float* EGp = (const float*)(ws + OFF_DEG);
    const float ng0 = p.dng[l * 128 + lane], ng1 = p.dng[l * 128 + 64 + lane];
    const int gA = (tid >> 4) * 128 + (tid & 15) * 8, lA = (tid >> 4) * 136 + (tid & 15) * 8;
    const int gB = (tid >> 3) * 64 + (tid & 7) * 8, lB = (tid >> 3) * 72 + (tid & 7) * 8;
    u32x4 r[9];
#define SCAN_LOAD(nn) do { const size_t it_ = (size_t)((b * 32 + (nn)) * 8 + h); \
        const bf16_t* Wg = (const bf16_t*)(ws + OFF_DW) + it_ * 8192; const bf16_t* QGg = (const bf16_t*)(ws + OFF_DQG) + it_ * 8192; \
        const bf16_t* KGg = (const bf16_t*)(ws + OFF_DKGT) + it_ * 8192; const bf16_t* UTg = (const bf16_t*)(ws + OFF_DUT) + it_ * 8192; const bf16_t* QKg = (const bf16_t*)(ws + OFF_DQK) + it_ * 4096; \
        r[0] = *(const u32x4*)(Wg + gA); r[1] = *(const u32x4*)(Wg + gA + 32 * 128); r[2] = *(const u32x4*)(QGg + gA); r[3] = *(const u32x4*)(QGg + gA + 32 * 128); \
        r[4] = *(const u32x4*)(KGg + gB); r[5] = *(const u32x4*)(KGg + gB + 64 * 64); r[6] = *(const u32x4*)(UTg + gB); r[7] = *(const u32x4*)(UTg + gB + 64 * 64); r[8] = *(const u32x4*)(QKg + gB); } while (0)
#define SCAN_STORE() do { *(LAS u32x4*)(sW + lA) = r[0]; *(LAS u32x4*)(sW + lA + 32 * 136) = r[1]; *(LAS u32x4*)(sQG + lA) = r[2]; *(LAS u32x4*)(sQG + lA + 32 * 136) = r[3]; \
        *(LAS u32x4*)(sKGT + lB) = r[4]; *(LAS u32x4*)(sKGT + lB + 64 * 72) = r[5]; *(LAS u32x4*)(sUT + lB) = r[6]; *(LAS u32x4*)(sUT + lB + 64 * 72) = r[7]; *(LAS u32x4*)(sQK + lB) = r[8]; } while (0)
    f32x4 S[8];
#pragma unroll
    for (int i = 0; i < 8; ++i) S[i] = (f32x4){0.f, 0.f, 0.f, 0.f};
    __syncthreads();
    SCAN_LOAD(0); SCAN_STORE();
    __syncthreads();
    for (int n = 0; n < 32; ++n) {
        const int item = (b * 32 + n) * 8 + h;
        if (n + 1 < 32) SCAN_LOAD(n + 1);
        const float eg = EGp[item];
        const size_t tokb = (size_t)b * SEQ_ + n * 64 + wave * 8;
        bf16_t zz0[8], zz1[8];
#pragma unroll
        for (int cc = 0; cc < 8; ++cc) { zz0[cc] = Z[(tokb + cc) * 1024 + h * 128 + lane]; zz1[cc] = Z[(tokb + cc) * 1024 + h * 128 + 64 + lane]; }
        bf16x8 sf[4];
#pragma unroll
        for (int ks = 0; ks < 4; ++ks) sf[ks] = pack8(S[2 * ks], S[2 * ks + 1]);
        f32x4 vn[4];
#pragma unroll
        for (int cb = 0; cb < 4; ++cb) { f32x4 acc = (f32x4){0.f, 0.f, 0.f, 0.f};
#pragma unroll
            for (int ks = 0; ks < 4; ++ks) { const bf16x8 a = *(const LAS bf16x8*)(sW + (cb * 16 + jl) * 136 + ks * 32 + g * 8); acc = MFMA16(a, sf[ks], acc); }
            const u32x2 uw = *(const LAS u32x2*)(sUT + (dv0 + jl) * 72 + cb * 16 + g * 4);
            vn[cb] = (f32x4){bflo(uw.x), bfhi(uw.x), bflo(uw.y), bfhi(uw.y)} - acc; }
        bf16x8 vf[2];
        vf[0] = pack8(vn[0], vn[1]); vf[1] = pack8(vn[2], vn[3]);
#pragma unroll
        for (int cb = 0; cb < 4; ++cb) { f32x4 acc = (f32x4){0.f, 0.f, 0.f, 0.f};
#pragma unroll
            for (int ks = 0; ks < 4; ++ks) { const bf16x8 a = *(const LAS bf16x8*)(sQG + (cb * 16 + jl) * 136 + ks * 32 + g * 8); acc = MFMA16(a, sf[ks], acc); }
#pragma unroll
            for (int k2 = 0; k2 < 2; ++k2) { const bf16x8 a = *(const LAS bf16x8*)(sQK + (cb * 16 + jl) * 72 + k2 * 32 + g * 8); acc = MFMA16(a, vf[k2], acc); }
#pragma unroll
            for (int rr = 0; rr < 4; ++rr) sO[(cb * 16 + g * 4 + rr) * 132 + dv0 + jl] = acc[rr]; }
#pragma unroll
        for (int db = 0; db < 8; ++db) { f32x4 acc = S[db] * eg;
#pragma unroll
            for (int k2 = 0; k2 < 2; ++k2) { const bf16x8 a = *(const LAS bf16x8*)(sKGT + (db * 16 + jl) * 72 + k2 * 32 + g * 8); acc = MFMA16(a, vf[k2], acc); }
            S[db] = acc; }
        __syncthreads();
        if (n + 1 < 32) SCAN_STORE();
#pragma unroll
        for (int cc = 0; cc < 8; ++cc) { const int c = wave * 8 + cc; const float o0 = sO[c * 132 + lane], o1 = sO[c * 132 + 64 + lane];
            const float rs = rsqrtf(wave_sum(o0 * o0 + o1 * o1) * (1.f / 128.f) + EPS);
            OA[(tokb + cc) * 1024 + h * 128 + lane] = f2bf(o0 * rs * ng0 * siluf_(bf1(zz0[cc])));
            OA[(tokb + cc) * 1024 + h * 128 + 64 + lane] = f2bf(o1 * rs * ng1 * siluf_(bf1(zz1[cc]))); }
        __syncthreads();
    }
#undef SCAN_LOAD
#undef SCAN_STORE
}

__device__ __forceinline__ void attn_block_item(const Params& p, LAS unsigned char* lds, int idx) {
    unsigned char* ws = p.ws;
    int tid = threadIdx.x; asm volatile("" : "+v"(tid));
    const int lane = tid & 63, wave = tid >> 6, jl = lane & 15, g = lane >> 4;
    const int qblk = 7 - (idx >> 5), bh = idx & 31, b = bh >> 3, h = bh & 7;
    const int s0 = qblk * 256 + wave * 32; const size_t tq = (size_t)b * SEQ_ + s0 + jl;
    const int mychunk = s0 >> 6, ntiles = 4 * qblk + 4;
    const bf16_t* QB = (const bf16_t*)(ws + OFF_QB);
    bf16x8 qf[2][6];
#pragma unroll
    for (int u = 0; u < 2; ++u)
#pragma unroll
        for (int ks = 0; ks < 6; ++ks) qf[u][ks] = *(const bf16x8*)(QB + (tq + u * 16) * 1536 + h * 192 + ks * 32 + g * 8);
    const bf16_t* kp[3]; int kst[3], kl[3];
#pragma unroll
    for (int k = 0; k < 3; ++k) { const int q = tid + 512 * k, row = q / 24, pc = q - row * 24;
        if (pc < 16) { kp[k] = (const bf16_t*)(ws + OFF_KN) + ((size_t)b * SEQ_ + row) * 1024 + h * 128 + pc * 8; kst[k] = 64 * 1024; }
        else { kp[k] = (const bf16_t*)(ws + OFF_KR) + ((size_t)b * SEQ_ + row) * 64 + (pc - 16) * 8; kst[k] = 64 * 64; }
        kl[k] = row * 200 + pc * 8; }
    const bf16_t* vp[2]; int vl[2];
#pragma unroll
    for (int k = 0; k < 2; ++k) { const int q = tid + 512 * k, row = q >> 3, pc = q & 7;
        vp[k] = (const bf16_t*)(ws + OFF_VT) + (size_t)(h * 128 + row) * 8192 + (size_t)b * SEQ_ + pc * 8;
        vl[k] = row * 72 + (pc >> 2) * 32 + (pc & 1) * 16 + ((pc >> 1) & 1) * 4; }
    u32x4 rk[3], rv[2];
#define AT_LOAD(tile) do { _Pragma("unroll") for (int k = 0; k < 3; ++k) rk[k] = *(const u32x4*)(kp[k] + (size_t)(tile) * kst[k]); \
        _Pragma("unroll") for (int k = 0; k < 2; ++k) rv[k] = *(const u32x4*)(vp[k] + (tile) * 64); } while (0)
#define AT_STORE(bi) do { LAS bf16_t* sKb = (LAS bf16_t*)(lds + (bi) * 44032); LAS bf16_t* sVb = sKb + 64 * 200; \
        _Pragma("unroll") for (int k = 0; k < 3; ++k) *(LAS u32x4*)(sKb + kl[k]) = rk[k]; \
        _Pragma("unroll") for (int k = 0; k < 2; ++k) { *(LAS u32x2*)(sVb + vl[k]) = (u32x2){rv[k].x, rv[k].y}; *(LAS u32x2*)(sVb + vl[k] + 8) = (u32x2){rv[k].z, rv[k].w}; } } while (0)
    f32x4 o[2][8];
#pragma unroll
    for (int u = 0; u < 2; ++u)
#pragma unroll
        for (int i = 0; i < 8; ++i) o[u][i] = (f32x4){0.f, 0.f, 0.f, 0.f};
    float mrun[2] = {-1e30f, -1e30f}, lsum[2] = {0.f, 0.f};
    __syncthreads();
    AT_LOAD(0); AT_STORE(0);
    if (ntiles > 1) AT_LOAD(1);
    __syncthreads();
    for (int t = 0; t < ntiles; ++t) {
        if (t + 1 < ntiles) { AT_STORE((t + 1) & 1); if (t + 2 < ntiles) AT_LOAD(t + 2); }
        if (t <= mychunk) {
            const LAS bf16_t* sKb = (const LAS bf16_t*)(lds + (t & 1) * 44032); const LAS bf16_t* sVb = sKb + 64 * 200;
            f32x4 s[2][4];
#pragma unroll
            for (int sb = 0; sb < 4; ++sb) { f32x4 a0 = (f32x4){0.f, 0.f, 0.f, 0.f}, a1 = a0;
#pragma unroll
                for (int ks = 0; ks < 6; ++ks) { const bf16x8 kf = *(const LAS bf16x8*)(sKb + (sb * 16 + jl) * 200 + ks * 32 + g * 8); a0 = MFMA16(kf, qf[0][ks], a0); a1 = MFMA16(kf, qf[1][ks], a1); }
                s[0][sb] = a0; s[1][sb] = a1; }
            bf16x8 pf[2][2]; float alpha[2];
#pragma unroll
            for (int u = 0; u < 2; ++u) {
                float mx = -1e30f;
#pragma unroll
                for (int sb = 0; sb < 4; ++sb) mx = fmaxf(mx, fmaxf(fmaxf(s[u][sb][0], s[u][sb][1]), fmaxf(s[u][sb][2], s[u][sb][3])));
                mx = fmaxf(mx, __shfl_xor(mx, 16)); mx = fmaxf(mx, __shfl_xor(mx, 32));
                const float mnew = fmaxf(mrun[u], mx); alpha[u] = __builtin_amdgcn_exp2f(mrun[u] - mnew); mrun[u] = mnew;
                float ps = 0.f;
#pragma unroll
                for (int sb = 0; sb < 4; ++sb)
#pragma unroll
                    for (int r = 0; r < 4; ++r) { const float pv = __builtin_amdgcn_exp2f(s[u][sb][r] - mnew); s[u][sb][r] = pv; ps += pv; }
                lsum[u] = lsum[u] * alpha[u] + ps;
                pf[u][0] = pack8(s[u][0], s[u][1]); pf[u][1] = pack8(s[u][2], s[u][3]); }
#pragma unroll
            for (int db = 0; db < 8; ++db) { f32x4 c0 = o[0][db] * alpha[0], c1 = o[1][db] * alpha[1];
#pragma unroll
                for (int k2 = 0; k2 < 2; ++k2) { const bf16x8 a = *(const LAS bf16x8*)(sVb + (db * 16 + jl) * 72 + k2 * 32 + g * 8); c0 = MFMA16(a, pf[0][k2], c0); c1 = MFMA16(a, pf[1][k2], c1); }
                o[0][db] = c0; o[1][db] = c1; }
        }
        __syncthreads();
    }
#undef AT_LOAD
#undef AT_STORE
    bf16_t* OC = (bf16_t*)(ws + OFF_OC);
#pragma unroll
    for (int u = 0; u < 2; ++u) { float lt = lsum[u]; lt += __shfl_xor(lt, 16); lt += __shfl_xor(lt, 32); const float inv = 1.f / lt;
#pragma unroll
        for (int db = 0; db < 8; ++db) { const f32x4 v = o[u][db] * inv; u32x2 w; w.x = pk2(v[0], v[1]); w.y = pk2(v[2], v[3]);
            *(u32x2*)(OC + (tq + u * 16) * 1024 + h * 128 + db * 16 + g * 4) = w; } }
}

__device__ __forceinline__ void sg_wave_item(const Params& p, int l, int widx) {
    unsigned char* ws = p.ws;
    int tid = threadIdx.x; asm volatile("" : "+v"(tid));
    const int lane = tid & 63, wave = widx & 7, idx = widx >> 3, jl = lane & 15, g = lane >> 4;
    const int gi = idx & 7, nb = (idx >> 3) & 15, b = idx >> 7;
    const size_t t0 = (size_t)b * SEQ_ + nb * 128; const int cc = gi * 128 + wave * 16 + jl;
    const bf16_t* SG = (const bf16_t*)(ws + OFF_SG); const float* STATS = (const float*)(ws + OFF_STATS); const bf16_t* SGW = (const bf16_t*)(ws + OFF_SGW);
    bf16_t* OB = (bf16_t*)(ws + OFF_OB);
    const float lg = p.lng[l * 1024 + cc], lb = p.lnb[l * 1024 + cc];
    bf16x8 bfr[4];
#pragma unroll
    for (int kb = 0; kb < 4; ++kb) { float v[8];
#pragma unroll
        for (int e = 0; e < 8; ++e) { const size_t tok = t0 + kb * 32 + g * 8 + e; const f32x2 st = *(const f32x2*)(STATS + tok * 2);
            v[e] = (bf1(SG[tok * 2048 + 1024 + cc]) - st.x) * st.y * lg + lb; }
        u32x4 w; w.x = pk2(v[0], v[1]); w.y = pk2(v[2], v[3]); w.z = pk2(v[4], v[5]); w.w = pk2(v[6], v[7]); bfr[kb] = __builtin_bit_cast(bf16x8, w); }
#pragma unroll
    for (int ib = 0; ib < 8; ++ib) { f32x4 acc = (f32x4){0.f, 0.f, 0.f, 0.f};
#pragma unroll
        for (int kb = 0; kb < 4; ++kb) { const bf16x8 a = *(const bf16x8*)(SGW + (size_t)(gi * 128 + ib * 16 + jl) * 128 + kb * 32 + g * 8); acc = MFMA16(a, bfr[kb], acc); }
#pragma unroll
        for (int r = 0; r < 4; ++r) { const int i = ib * 16 + g * 4 + r; const size_t tok = t0 + i;
            const float mixed = acc[r] + p.sgb[l * 1024 + gi * 128 + i];
            OB[tok * 1024 + cc] = f2bf(bf1(SG[tok * 2048 + cc]) * mixed); } }
}

#define XB_TMO      128
#define XB_XCNT(j)  (256  + 64 * (j))
#define XB_XSUB(j)  (1280 + 64 * (j))
#define XB_XGEN(j)  (2304 + 64 * (j))
#define XB_TOP      3328
#define XB_TOPGEN   3392
#define XCD_BAR_WORDS 3456
#define XB_SPIN_CAP (1u << 18)
__device__ __forceinline__ unsigned xb_ld(unsigned* p)              { return __hip_atomic_load(p, __ATOMIC_RELAXED, __HIP_MEMORY_SCOPE_AGENT); }
__device__ __forceinline__ unsigned xb_add(unsigned* p, unsigned v) { return __hip_atomic_fetch_add(p, v, __ATOMIC_RELAXED, __HIP_MEMORY_SCOPE_AGENT); }
__device__ __forceinline__ unsigned xb_xcc_id() { return (unsigned)__builtin_amdgcn_s_getreg((3 << 11) | 20) & 0xFu; }
#define XB_SPIN(cond, bar) do { unsigned _sp = 0; while (cond) { __builtin_amdgcn_s_sleep(1); \
    if ((++_sp & 255u) == 0u) { if (xb_ld(&(bar)[XB_TMO])) break; if (_sp > XB_SPIN_CAP) { atomicAdd(&(bar)[XB_TMO], 1u); break; } } } } while (0)
__device__ __forceinline__ void xcd_barrier_complete(unsigned* bar, unsigned x, unsigned& nloc, unsigned& nx) {
    const unsigned G = gridDim.x * gridDim.y * gridDim.z;
    unsigned sum, cnt, mine, sp = 0u;
    for (;;) {
        sum = 0u; cnt = 0u; mine = 0u;
#pragma unroll
        for (unsigned j = 0; j < 16; ++j) { const unsigned c = xb_ld(&bar[XB_XCNT(j)]); sum += c; cnt += (c > 0u) ? 1u : 0u; mine = (j == x) ? c : mine; }
        if (sum == G) break;
        __builtin_amdgcn_s_sleep(1);
        if ((++sp & 255u) == 0u) { if (xb_ld(&bar[XB_TMO])) break; if (sp > XB_SPIN_CAP) { atomicAdd(&bar[XB_TMO], 1u); break; } }
    }
    nloc = mine > 0u ? mine : 1u; nx = cnt > 0u ? cnt : 1u;
}
__device__ __forceinline__ void xcd_barrier(unsigned* bar, volatile LAS unsigned* st) {
    asm volatile("s_waitcnt vmcnt(0)" ::: "memory");
    __syncthreads();
    if (threadIdx.x == 0) {
        const unsigned x = xb_xcc_id();
        __builtin_amdgcn_s_waitcnt(0);
        unsigned nloc = st[0], nx = st[1];
        if (nloc == 0u) { xcd_barrier_complete(bar, x, nloc, nx); st[0] = nloc; st[1] = nx; }
        const unsigned old = xb_add(&bar[XB_XSUB(x)], 1u);
        const unsigned gen = old / nloc;
        if (old + 1u == (gen + 1u) * nloc) {
            __builtin_amdgcn_fence(__ATOMIC_RELEASE, "agent");
            asm volatile("s_waitcnt vmcnt(0)" ::: "memory");
            const unsigned og = xb_add(&bar[XB_TOP], 1u);
            const unsigned tg = og / nx;
            if (og + 1u == (tg + 1u) * nx) xb_add(&bar[XB_TOPGEN], 1u);
            else XB_SPIN(xb_ld(&bar[XB_TOPGEN]) == tg, bar);
            __builtin_amdgcn_fence(__ATOMIC_ACQUIRE, "agent");
            xb_add(&bar[XB_XGEN(x)], 1u);
            asm volatile("s_waitcnt vmcnt(0)" ::: "memory");
        } else {
            XB_SPIN(xb_ld(&bar[XB_XGEN(x)]) == gen, bar);
            __builtin_amdgcn_fence(__ATOMIC_ACQUIRE, "agent");
            asm volatile("s_waitcnt vmcnt(0)" ::: "memory");
        }
    }
    __syncthreads();
}

#ifndef NREP_GEMM
#define NREP_GEMM 1
#endif
#ifndef NREP_MIX
#define NREP_MIX 1
#endif
#ifndef NREP_PREP
#define NREP_PREP NREP_MIX
#endif
#ifndef NREP_P7
#define NREP_P7 NREP_MIX
#endif
#ifndef NREP_ROW
#define NREP_ROW 0
#endif
#ifndef NREP_CVT
#define NREP_CVT 1
#endif
#ifndef NREP_SYNC
#define NREP_SYNC 1
#endif
#define GSYNC() do { for (int r_ = 0; r_ < NREP_SYNC; ++r_) { PQ xcd_barrier((unsigned*)(ws + OFF_BAR), (volatile LAS unsigned*)(shm + LDS_ST)); } } while (0)
#define RG for (int rg_ = 0; rg_ < NREP_GEMM; ++rg_)
typedef const Params __attribute__((address_space(4)))* KP;
__device__ __forceinline__ Params ldp(KP q) {
#if defined(__HIP_DEVICE_COMPILE__)
    asm volatile("" : "+s"(q)); return *q;
#else
    return Params{};
#endif
}
#define PQ const Params p = ldp(kp); unsigned char* ws = p.ws; (void)ws;
__global__ __launch_bounds__(512, 2) void fwd_megakernel(Params p_unused) {
    extern __shared__ __attribute__((aligned(16))) unsigned char shm[];
    LAS unsigned char* lds = (LAS unsigned char*)shm;
    LAS float* L = (LAS float*)shm;
    LAS int* s_item = (LAS int*)(shm + LDS_ITEM);
    cg::grid_group grid = cg::this_grid();
    KP kp = (KP)__builtin_amdgcn_kernarg_segment_ptr();
    if (threadIdx.x == 0) { LAS unsigned* st = (LAS unsigned*)(shm + LDS_ST); st[0] = 0u; st[1] = 0u; PQ (void)xb_add((unsigned*)(ws + OFF_BAR) + XB_XCNT(xb_xcc_id()), 1u); }
    __syncthreads();

#ifndef NO_CVT
    for (int rc_ = 0; rc_ < NREP_CVT; ++rc_) { PQ convert_layer(p, 0, lds); }
#endif
    { PQ int tid = threadIdx.x; asm volatile("" : "+v"(tid));
      const size_t gt = (size_t)blockIdx.x * 512 + tid, NGT = (size_t)gridDim.x * 512; float* CS = (float*)(ws + OFF_CS);
      for (size_t e = gt; e < (size_t)T_ * 32; e += NGT) { const int t = (int)(e >> 5), i = (int)(e & 31);
          const float inv_freq = exp2f(-(float)(2 * i) * (1.f / 64.f) * 13.287712379549449f);
          const float ang = (float)p.pos[t] * inv_freq; float sn, cs; sn = sinf(ang); cs = cosf(ang);
          CS[(size_t)t * 64 + i] = cs; CS[(size_t)t * 64 + 32 + i] = sn; }
      if (gt < 64) ((unsigned*)(ws + OFF_CTR))[gt] = 0u; }
    { PQ rowpass(p.x, nullptr, 0.f, nullptr, p.norm_g, p.out, (bf16_t*)(ws + OFF_H)); }
    grid.sync();

    for (int l = 0; l < 2; ++l) {
        RG { PQ EpiSwiGLU e; e.O = (bf16_t*)(ws + OFF_GATE); run_gemm(lds, (const bf16_t*)(ws + OFF_H), (const bf16_t*)(ws + OFF_WGU), T_, 11264, 2048, e); }
        GSYNC();
        RG { PQ EpiF32 e; e.C = (float*)(ws + OFF_F); e.ldc = DM; run_gemm(lds, (const bf16_t*)(ws + OFF_GATE), (const bf16_t*)(ws + OFF_WDN), T_, 2048, FF, e); }
        GSYNC();
        for (int rr_ = 0; rr_ < NREP_ROW; ++rr_) { PQ const float* ng = p.norm_g + (size_t)l * 6 * DM; rowpass(p.out, (const float*)(ws + OFF_F), 0.0f, ng + DM, ng + 2 * DM, p.out, (bf16_t*)(ws + OFF_H)); }
        { PQ const float* ng = p.norm_g + (size_t)l * 6 * DM; rowpass(p.out, (const float*)(ws + OFF_F), 0.5f, ng + DM, ng + 2 * DM, p.out, (bf16_t*)(ws + OFF_H)); }
        GSYNC();
        RG { PQ EpiWin e; e.ws = ws; run_gemm(lds, (const bf16_t*)(ws + OFF_H), (const bf16_t*)(ws + OFF_WIN), T_, NINP, 2048, e); }
        GSYNC();
        for (int rm_ = 0; rm_ < NREP_PREP; ++rm_) {
#ifndef NO_PREP
        { PQ for (int item = blockIdx.x; item < 1024; item += gridDim.x) dn_prep_item(p, l, L, item); }
#endif
#ifndef NO_ROWI
        { PQ row_items(p); }
#endif
        }
        GSYNC();
        RG { PQ EpiQ e; e.QB = (bf16_t*)(ws + OFF_QB); e.RS = (const float*)(ws + OFF_RS); e.CS = (const float*)(ws + OFF_CS); e.qscale = 0.07216878364870322f * 1.4426950408889634f;
          run_gemm(lds, (const bf16_t*)(ws + OFF_CQ), (const bf16_t*)(ws + OFF_WUQ), T_, 1536, 512, e); }
        RG { PQ EpiKN e; e.O = (bf16_t*)(ws + OFF_KN); e.RS = (const float*)(ws + OFF_RS);
          run_gemm(lds, (const bf16_t*)(ws + OFF_CKV), (const bf16_t*)(ws + OFF_WUKV), T_, 1024, 512, e); }
        RG { PQ EpiVT e; e.O = (bf16_t*)(ws + OFF_VT); e.RS = (const float*)(ws + OFF_RS);
          run_gemm(lds, (const bf16_t*)(ws + OFF_WUKV) + (size_t)1024 * 512, (const bf16_t*)(ws + OFF_CKV), 1024, T_, 512, e); }
        GSYNC();
        for (int rm_ = 0; rm_ < NREP_P7; ++rm_) {
        for (;;) {
            PQ
            __syncthreads();
            if (threadIdx.x == 0) *s_item = (int)atomicAdd((unsigned*)(ws + OFF_CTR) + l + 8 * rm_, 1u);
            __syncthreads();
            const int it = *s_item;
            if (it >= 32 + 256) break;
            if (it < 32) dn_scan_item(p, l, lds, it);
            else attn_block_item(p, lds, it - 32);
        }
        for (;;) {
            PQ
            int it = 0;
            if ((threadIdx.x & 63) == 0) it = (int)atomicAdd((unsigned*)(ws + OFF_CTR) + 4 + l + 8 * rm_, 1u);
            it = __builtin_amdgcn_readfirstlane(it);
            if (it >= 4096) break;
            sg_wave_item(p, l, it);
        }
        }
        GSYNC();
        { PQ EpiBranch<0> e; e.ACC = (float*)(ws + OFF_F); e.GATE = (const bf16_t*)(ws + OFF_GATE); e.OUT = (bf16_t*)(ws + OFF_MERGED); run_gemm(lds, (const bf16_t*)(ws + OFF_OA), (const bf16_t*)(ws + OFF_WBR), T_, 2048, 1024, e); }
        { PQ EpiBranch<1> e; e.ACC = (float*)(ws + OFF_F); e.GATE = (const bf16_t*)(ws + OFF_GATE); e.OUT = (bf16_t*)(ws + OFF_MERGED); run_gemm(lds, (const bf16_t*)(ws + OFF_OB), (const bf16_t*)(ws + OFF_WBR) + (size_t)2048 * 1024, T_, 2048, 1024, e); }
        { PQ EpiBranch<2> e; e.ACC = (float*)(ws + OFF_F); e.GATE = (const bf16_t*)(ws + OFF_GATE); e.OUT = (bf16_t*)(ws + OFF_MERGED); run_gemm(lds, (const bf16_t*)(ws + OFF_OC), (const bf16_t*)(ws + OFF_WBR) + (size_t)2 * 2048 * 1024, T_, 2048, 1024, e); }
        GSYNC();
        RG { PQ EpiF32 e; e.C = (float*)(ws + OFF_F); e.ldc = DM; run_gemm(lds, (const bf16_t*)(ws + OFF_MERGED), (const bf16_t*)(ws + OFF_WOUT), T_, 2048, 2048, e); }
        GSYNC();
        for (int rr_ = 0; rr_ < NREP_ROW; ++rr_) { PQ const float* ng = p.norm_g + (size_t)l * 6 * DM; rowpass(p.out, (const float*)(ws + OFF_F), 0.0f, ng + 3 * DM, ng + 4 * DM, p.out, (bf16_t*)(ws + OFF_H)); }
        { PQ const float* ng = p.norm_g + (size_t)l * 6 * DM; rowpass(p.out, (const float*)(ws + OFF_F), 1.0f, ng + 3 * DM, ng + 4 * DM, p.out, (bf16_t*)(ws + OFF_H)); }
        GSYNC();
        RG { PQ EpiSwiGLU e; e.O = (bf16_t*)(ws + OFF_GATE); run_gemm(lds, (const bf16_t*)(ws + OFF_H), (const bf16_t*)(ws + OFF_WGU) + (size_t)11264 * 2048, T_, 11264, 2048, e); }
        GSYNC();
        RG { PQ EpiF32 e; e.C = (float*)(ws + OFF_F); e.ldc = DM; run_gemm(lds, (const bf16_t*)(ws + OFF_GATE), (const bf16_t*)(ws + OFF_WDN) + (size_t)2048 * FF, T_, 2048, FF, e); }
        GSYNC();
        if (l == 0) {
            for (int rr_ = 0; rr_ < NREP_ROW; ++rr_) { PQ const float* ng = p.norm_g; rowpass(p.out, (const float*)(ws + OFF_F), 0.0f, ng + 5 * DM, ng + 6 * DM, p.out, (bf16_t*)(ws + OFF_H)); }
            { PQ const float* ng = p.norm_g; rowpass(p.out, (const float*)(ws + OFF_F), 0.5f, ng + 5 * DM, ng + 6 * DM, p.out, (bf16_t*)(ws + OFF_H)); }
#ifndef NO_CVT
            for (int rc_ = 0; rc_ < NREP_CVT; ++rc_) { PQ convert_layer(p, 1, lds); }
#endif
            GSYNC();
        } else {
            for (int rr_ = 0; rr_ < NREP_ROW; ++rr_) { PQ const float* ng = p.norm_g + (size_t)6 * DM; rowpass(p.out, (const float*)(ws + OFF_F), 0.0f, ng + 5 * DM, nullptr, p.out, nullptr); }
            { PQ const float* ng = p.norm_g + (size_t)6 * DM; rowpass(p.out, (const float*)(ws + OFF_F), 0.5f, ng + 5 * DM, nullptr, p.out, nullptr); }
        }
    }
}

extern "C" void kernel_launch(void* const* d_in, const int* in_sizes, int n_in, void* d_out, int out_size, void* d_ws, size_t ws_size, hipStream_t stream) {
    static int grid_blocks = 0;
    if (!grid_blocks) {
        if (ws_size < WS_END) { fprintf(stderr, "kernel_launch: workspace too small: %zu < %zu\n", ws_size, (size_t)WS_END); grid_blocks = -1; return; }
        int dev = 0, cus = 0, per_cu = 0;
        (void)hipGetDevice(&dev);
        (void)hipDeviceGetAttribute(&cus, hipDeviceAttributeMultiprocessorCount, dev);
        if (hipFuncSetAttribute((const void*)fwd_megakernel, hipFuncAttributeMaxDynamicSharedMemorySize, LDS_BYTES) != hipSuccess) fprintf(stderr, "kernel_launch: hipFuncSetAttribute failed\n");
        if (hipOccupancyMaxActiveBlocksPerMultiprocessor(&per_cu, (const void*)fwd_megakernel, 512, LDS_BYTES) != hipSuccess || per_cu < 1) per_cu = 1;
        (void)hipGetLastError();
        grid_blocks = cus * per_cu;
    }
    if (grid_blocks < 0) return;
    Params p{};
    p.x = (const float*)d_in[0]; p.pos = (const int*)d_in[1]; p.norm_g = (const float*)d_in[2]; p.wg = (const float*)d_in[3]; p.wu = (const float*)d_in[4];
    p.wd = (const float*)d_in[5]; p.win = (const float*)d_in[6]; p.convw = (const float*)d_in[7]; p.alog = (const float*)d_in[8]; p.dtb = (const float*)d_in[9];
    p.dng = (const float*)d_in[10]; p.lng = (const float*)d_in[11]; p.lnb = (const float*)d_in[12]; p.sgw = (const float*)d_in[13]; p.sgb = (const float*)d_in[14];
    p.cqg = (const float*)d_in[15]; p.ckvg = (const float*)d_in[16]; p.wuq = (const float*)d_in[17]; p.wukv = (const float*)d_in[18]; p.wbr = (const float*)d_in[19];
    p.wout = (const float*)d_in[20]; p.out = (float*)d_out; p.ws = (unsigned char*)d_ws;
    (void)hipMemsetAsync((unsigned char*)d_ws + OFF_BAR, 0, XCD_BAR_WORDS * 4, stream);
    void* args[] = {&p};
    hipError_t e = hipLaunchCooperativeKernel((const void*)fwd_megakernel, dim3(grid_blocks), dim3(512), args, LDS_BYTES, stream);
    if (e != hipSuccess) fprintf(stderr, "cooperative launch failed: %s (grid %d)\n", hipGetErrorString(e), grid_blocks);
}
```

```cpp
#include <hip/hip_runtime.h>
#include <hip/hip_cooperative_groups.h>
#include <cstdio>
namespace cg = cooperative_groups;

#define LAS __attribute__((address_space(3)))
typedef unsigned short bf16_t;
typedef short bf16x8 __attribute__((ext_vector_type(8)));
typedef short s16x4 __attribute__((ext_vector_type(4)));
typedef float f32x4 __attribute__((ext_vector_type(4)));
typedef float f32x2 __attribute__((ext_vector_type(2)));
typedef unsigned u32x4 __attribute__((ext_vector_type(4)));
typedef unsigned u32x2 __attribute__((ext_vector_type(2)));

constexpr int T_ = 8192, DM = 2048, FF = 5632, NIN = 13392, NINP = 13568, SEQ_ = 2048;
constexpr int LDS_BYTES = 152576;
constexpr int LDS_ITEM = 152320, LDS_ST = 152336;
constexpr float EPS = 1e-6f;

constexpr size_t al256(size_t x) { return (x + 255) & ~(size_t)255; }
constexpr size_t OFF_WGU = 0;
constexpr size_t OFF_WDN = OFF_WGU + (size_t)2 * 11264 * 2048 * 2;
constexpr size_t OFF_WIN = OFF_WDN + (size_t)2 * 2048 * 5632 * 2;
constexpr size_t OFF_WUQ = OFF_WIN + (size_t)NINP * 2048 * 2;
constexpr size_t OFF_WUKV = OFF_WUQ + (size_t)1536 * 512 * 2;
constexpr size_t OFF_WBR = OFF_WUKV + (size_t)2048 * 512 * 2;
constexpr size_t OFF_WOUT = OFF_WBR + (size_t)3 * 2048 * 1024 * 2;
constexpr size_t OFF_SGW = OFF_WOUT + (size_t)2048 * 2048 * 2;
constexpr size_t OFF_H = OFF_SGW + (size_t)8 * 128 * 128 * 2;
constexpr size_t OFF_F = OFF_H + (size_t)T_ * 2048 * 2;
constexpr size_t OFF_GATE = OFF_F + (size_t)T_ * 2048 * 4;
constexpr size_t OFF_QKV = OFF_GATE + (size_t)T_ * 6144 * 2;
constexpr size_t OFF_Z = OFF_QKV + (size_t)T_ * 3072 * 2;
constexpr size_t OFF_SG = OFF_Z + (size_t)T_ * 1024 * 2;
constexpr size_t OFF_CQ = OFF_SG + (size_t)T_ * 2048 * 2;
constexpr size_t OFF_CKV = OFF_CQ + (size_t)T_ * 512 * 2;
constexpr size_t OFF_MISC = OFF_CKV + (size_t)T_ * 512 * 2;
constexpr size_t OFF_DW = OFF_MISC + (size_t)T_ * 128 * 4;
constexpr size_t OFF_DQG = OFF_DW + (size_t)1024 * 8192 * 2;
constexpr size_t OFF_DKGT = OFF_DQG + (size_t)1024 * 8192 * 2;
constexpr size_t OFF_DUT = OFF_DKGT + (size_t)1024 * 8192 * 2;
constexpr size_t OFF_DQK = OFF_DUT + (size_t)1024 * 8192 * 2;
constexpr size_t OFF_DEG = OFF_DQK + (size_t)1024 * 4096 * 2;
constexpr size_t OFF_QB = OFF_DEG + 4096;
constexpr size_t OFF_KN = OFF_QB + (size_t)T_ * 1536 * 2;
constexpr size_t OFF_KR = OFF_KN + (size_t)T_ * 1024 * 2;
constexpr size_t OFF_VT = OFF_KR + (size_t)T_ * 64 * 2;
constexpr size_t OFF_OA = OFF_VT + (size_t)1024 * 8192 * 2;
constexpr size_t OFF_OB = OFF_OA + (size_t)T_ * 1024 * 2;
constexpr size_t OFF_OC = OFF_OB + (size_t)T_ * 1024 * 2;
constexpr size_t OFF_MERGED = OFF_OC + (size_t)T_ * 1024 * 2;
constexpr size_t OFF_STATS = OFF_MERGED + (size_t)T_ * 2048 * 2;
constexpr size_t OFF_RS = OFF_STATS + (size_t)T_ * 2 * 4;
constexpr size_t OFF_CS = OFF_RS + (size_t)T_ * 2 * 4;
constexpr size_t OFF_CTR = OFF_CS + (size_t)T_ * 64 * 4;
constexpr size_t OFF_BAR = OFF_CTR + 256;
constexpr size_t WS_END = OFF_BAR + 16384;

struct Params {
    const float* x; const int* pos; const float* norm_g; const float* wg; const float* wu; const float* wd; const float* win;
    const float* convw; const float* alog; const float* dtb; const float* dng; const float* lng; const float* lnb; const float* sgw; const float* sgb;
    const float* cqg; const float* ckvg; const float* wuq; const float* wukv; const float* wbr; const float* wout;
    float* out; unsigned char* ws;
};

__device__ __forceinline__ unsigned pk2(float lo, float hi) { unsigned r; asm("v_cvt_pk_bf16_f32 %0, %1, %2" : "=v"(r) : "v"(lo), "v"(hi)); return r; }
__device__ __forceinline__ float bflo(unsigned u) { return __uint_as_float(u << 16); }
__device__ __forceinline__ float bfhi(unsigned u) { return __uint_as_float(u & 0xffff0000u); }
__device__ __forceinline__ float bf1(bf16_t b) { return __uint_as_float(((unsigned)b) << 16); }
__device__ __forceinline__ bf16_t f2bf(float f) { return (bf16_t)(pk2(f, 0.f) & 0xffffu); }
__device__ __forceinline__ float wave_sum(float v) {
#pragma unroll
    for (int o = 1; o < 64; o <<= 1) v += __shfl_xor(v, o);
    return v;
}
__device__ __forceinline__ float sigmoidf_(float x) { return __builtin_amdgcn_rcpf(1.f + __builtin_amdgcn_exp2f(-1.4426950408889634f * x)); }
__device__ __forceinline__ float siluf_(float x) { return x * __builtin_amdgcn_rcpf(1.f + __builtin_amdgcn_exp2f(-1.4426950408889634f * x)); }
__device__ __forceinline__ f32x2 gelu_pk(f32x2 v) {
    const f32x2 av = __builtin_elementwise_abs(v), d = av * 0.2316418882f + 1.0f;
    f32x2 t; t.x = __builtin_amdgcn_rcpf(d.x); t.y = __builtin_amdgcn_rcpf(d.y);
    f32x2 q = t * 0.5307027145f + (-0.7265760135f); q = q * t + 0.7107068705f; q = q * t + (-0.142248368f); q = q * t + 0.127414796f; q = q * t;
    const f32x2 s = (v * v) * (-0.72134752044f);
    f32x2 e; e.x = __builtin_amdgcn_exp2f(s.x); e.y = __builtin_amdgcn_exp2f(s.y);
    const f32x2 m = v * (q * e), r = v - m;
    f32x2 o; o.x = v.x < 0.f ? m.x : r.x; o.y = v.y < 0.f ? m.y : r.y; return o;
}
__device__ __forceinline__ bf16x8 load2x4(const bf16_t* p) {
    const s16x4 lo = *(const s16x4*)p, hi = *(const s16x4*)(p + 16);
    return __builtin_shufflevector(lo, hi, 0, 1, 2, 3, 4, 5, 6, 7);
}
__device__ __forceinline__ bf16x8 pack8(f32x4 a, f32x4 b) {
    u32x4 w; w.x = pk2(a[0], a[1]); w.y = pk2(a[2], a[3]); w.z = pk2(b[0], b[1]); w.w = pk2(b[2], b[3]);
    return __builtin_bit_cast(bf16x8, w);
}
#define MFMA16(a, b, c) __builtin_amdgcn_mfma_f32_16x16x32_bf16((a), (b), (c), 0, 0, 0)
#define LDS_WAIT() asm volatile("s_waitcnt lgkmcnt(0)" ::: "memory")

#ifdef TCAT
#define TB(c) do { if (TCAT == (c)) t0_ = __builtin_amdgcn_s_memrealtime(); } while (0)
#define TE(c) do { if (TCAT == (c)) tacc_ += __builtin_amdgcn_s_memrealtime() - t0_; } while (0)
#else
#define TB(c) do {} while (0)
#define TE(c) do {} while (0)
#endif
namespace pg8 {
constexpr int BM = 256, BK = 64, HALF = 128, HTB = HALF * BK * 2, NXCD = 8, WGM = 8;
__device__ __forceinline__ int lds_byte(int r, int c) { const int st = (r >> 4) * 2 + (c >> 5), rr = r & 15, cc = c & 31, ob = rr * 64 + cc * 2; return st * 1024 + (ob ^ (((ob >> 9) & 1) << 5)); }
__device__ __forceinline__ void stage_rc(int b, int& R, int& C) { const int st = b / 1024, sb = b % 1024, swz = sb ^ (((sb >> 9) & 1) << 5); R = (st >> 1) * 16 + swz / 64; C = (st & 1) * 32 + (swz % 64) / 2; }
__device__ __forceinline__ int perm32(int rho) { const int n = rho >> 4, i = rho & 15; return 8 * (i >> 2) + 4 * n + (i & 3); }
struct Unit { int pm, pn, seg; };
struct Gemm { const bf16_t* A; const bf16_t* Bt; int M, N, K; size_t segA, segB; };
struct StaticOrder {
    int nM, nN, nwg, G, c, nseg;
    __device__ __forceinline__ void init(int M, int N, int G_, int c_) { nM = M / BM; nN = N / BM; nwg = nM * nN; G = G_; c = c_; nseg = 1; }
    __device__ __forceinline__ bool next(int i, Unit& u) const {
        const int ti = i / nseg; u.seg = i - ti * nseg;
        const long L = (long)ti * G + c; if (L >= nwg) return false;
        int wgid = (int)L; { const int q = nwg / NXCD, r = nwg % NXCD, xcd = wgid % NXCD, off = wgid / NXCD; wgid = (xcd < r ? xcd * (q + 1) : r * (q + 1) + (xcd - r) * q) + off; }
        const int nig = WGM * nN, gid = wgid / nig, fm = gid * WGM, gsz = (nM - fm) < WGM ? (nM - fm) : WGM;
        u.pm = fm + ((wgid % nig) % gsz); u.pn = (wgid % nig) / gsz; return true;
    }
};
template <class Epi>
__device__ __forceinline__ void gemm_phase(LAS unsigned char* lds, const Gemm g, const StaticOrder& S, const Epi& E) {
    int tid = threadIdx.x; asm volatile("" : "+v"(tid));
    const int wid = __builtin_amdgcn_readfirstlane(tid >> 6), lane = tid & 63, wr = wid >> 2, wc = wid & 3, fr = lane & 15, fq = lane >> 4;
    const int K = g.K, nt = K / BK;
    unsigned voffA[2], voffB[2];
#pragma unroll
    for (int i = 0; i < 2; ++i) { int R, C; stage_rc(tid * 16 + i * 8192, R, C); const int Rb = Epi::PERM ? ((R & ~31) + perm32(R & 31)) : R;
        voffA[i] = (unsigned)(R * K + C) * 2u; voffB[i] = (unsigned)(Rb * K + C) * 2u; }
    const size_t kstep = (size_t)(BK * 2);
    const size_t hstep = (size_t)HALF * K * 2;
    const size_t tstep = 2 * hstep;
    const unsigned ldsw = (unsigned)wid * 1024u;
    const int aoff = lds_byte(wr * 64 + fr, fq * 8), boff = lds_byte(wc * 32 + fr, fq * 8);
#define PG8_SA(b, h) (((b) * 2 + (h)) * HTB)
#define PG8_SB(b, h) ((4 + (b) * 2 + (h)) * HTB)
#define PG8_STAGE(bufoff, gbase, voff) do { _Pragma("unroll") for (int _i = 0; _i < 2; ++_i) \
        __builtin_amdgcn_global_load_lds((const unsigned*)((const char*)(gbase) + (voff)[_i]), (LAS unsigned*)(lds + (bufoff) + ldsw + _i * 8192), 16, 0, 0); } while (0)
#define PG8_LDA(dst, b, h) do { _Pragma("unroll") for (int m = 0; m < 4; ++m) _Pragma("unroll") for (int k = 0; k < 2; ++k) dst[m][k] = *(const LAS bf16x8*)(lds + PG8_SA(b, h) + aoff + m * 2048 + k * 1024); } while (0)
#define PG8_LDB(dst, b, h) do { _Pragma("unroll") for (int n = 0; n < 2; ++n) _Pragma("unroll") for (int k = 0; k < 2; ++k) dst[n][k] = *(const LAS bf16x8*)(lds + PG8_SB(b, h) + boff + n * 2048 + k * 1024); } while (0)
#define PG8_MMA(ai, bj, At, Bt) do { __builtin_amdgcn_s_setprio(1); _Pragma("unroll") for (int m = 0; m < 4; ++m) _Pragma("unroll") for (int n = 0; n < 2; ++n) _Pragma("unroll") for (int k = 0; k < 2; ++k) \
        acc[ai][bj][m][n] = __builtin_amdgcn_mfma_f32_16x16x32_bf16(Bt[n][k], At[m][k], acc[ai][bj][m][n], 0, 0, 0); __builtin_amdgcn_s_setprio(0); } while (0)
#define PG8_WAIT_V(n) asm volatile("s_waitcnt vmcnt(" #n ")" ::: "memory")
#define PG8_WAIT_L(n) asm volatile("s_waitcnt lgkmcnt(" #n ")" ::: "memory")
#define PG8_BAR __builtin_amdgcn_s_barrier()
#define PG8_SCHED __builtin_amdgcn_sched_barrier(0)
    Unit cur, nxt; int ui = 0;
    if (!S.next(0, cur)) return;
    f32x4 acc[2][2][4][2];
#pragma unroll
    for (int a = 0; a < 2; ++a)
#pragma unroll
        for (int b = 0; b < 2; ++b)
#pragma unroll
            for (int m = 0; m < 4; ++m)
#pragma unroll
                for (int n = 0; n < 2; ++n) acc[a][b][m][n] = (f32x4){0.f, 0.f, 0.f, 0.f};
    bf16x8 At[4][2], B0[2][2], B1[2][2];
    const char* cA = (const char*)g.A + cur.seg * g.segA + (size_t)cur.pm * tstep; const char* cB = (const char*)g.Bt + cur.seg * g.segB + (size_t)cur.pn * tstep;
    PG8_STAGE(PG8_SB(0, 0), cB, voffB); PG8_STAGE(PG8_SA(0, 0), cA, voffA); PG8_STAGE(PG8_SB(0, 1), cB + hstep, voffB); PG8_STAGE(PG8_SA(0, 1), cA + hstep, voffA);
    if (wr == 1) PG8_BAR;
    PG8_WAIT_V(4); PG8_BAR;
    PG8_STAGE(PG8_SB(1, 0), cB + kstep, voffB); PG8_STAGE(PG8_SA(1, 0), cA + kstep, voffA); PG8_STAGE(PG8_SB(1, 1), cB + hstep + kstep, voffB);
    PG8_WAIT_V(6); PG8_BAR;
    for (;;) {
        const bool has_next = S.next(ui + 1, nxt);
        const char* nA = has_next ? (const char*)g.A + nxt.seg * g.segA + (size_t)nxt.pm * tstep : cA; const char* nB = has_next ? (const char*)g.Bt + nxt.seg * g.segB + (size_t)nxt.pn * tstep : cB;
        for (int t = 0; t < nt; t += 2) {
            const bool last = (t == nt - 2);
            const char* a1 = cA + (size_t)(t + 1) * kstep;
            const char* a2 = last ? nA : cA + (size_t)(t + 2) * kstep; const char* b2 = last ? nB : cB + (size_t)(t + 2) * kstep;
            const char* a3 = a2 + kstep; const char* b3 = b2 + kstep;
            PG8_LDB(B0, 0, 0); PG8_SCHED; PG8_LDA(At, 0, 0); PG8_STAGE(PG8_SA(1, 1), a1 + hstep, voffA);
            PG8_WAIT_L(8); PG8_BAR; PG8_WAIT_L(0); PG8_MMA(0, 0, At, B0); PG8_BAR; PG8_SCHED;
            PG8_LDB(B1, 0, 1); PG8_STAGE(PG8_SB(0, 0), b2, voffB);
            PG8_BAR; PG8_WAIT_L(0); PG8_MMA(0, 1, At, B1); PG8_BAR;
            PG8_LDA(At, 0, 1); PG8_STAGE(PG8_SA(0, 0), a2, voffA);
            PG8_BAR; PG8_WAIT_L(0); PG8_MMA(1, 0, At, B0); PG8_BAR; PG8_SCHED;
            PG8_STAGE(PG8_SB(0, 1), b2 + hstep, voffB);
            PG8_WAIT_V(6); PG8_BAR; PG8_MMA(1, 1, At, B1); PG8_BAR;
            PG8_LDB(B0, 1, 0); PG8_SCHED; PG8_LDA(At, 1, 0); PG8_STAGE(PG8_SA(0, 1), a2 + hstep, voffA);
            PG8_WAIT_L(8); PG8_BAR; PG8_WAIT_L(0); PG8_MMA(0, 0, At, B0); PG8_BAR; PG8_SCHED;
            PG8_LDB(B1, 1, 1); PG8_STAGE(PG8_SB(1, 0), b3, voffB);
            PG8_BAR; PG8_WAIT_L(0); PG8_MMA(0, 1, At, B1); PG8_BAR;
            PG8_LDA(At, 1, 1); PG8_STAGE(PG8_SA(1, 0), a3, voffA);
            PG8_BAR; PG8_WAIT_L(0); PG8_MMA(1, 0, At, B0); PG8_BAR; PG8_SCHED;
            PG8_STAGE(PG8_SB(1, 1), b3 + hstep, voffB);
            PG8_WAIT_V(6); PG8_BAR; PG8_MMA(1, 1, At, B1); PG8_BAR;
        }
        E(acc, cur, wr, wc, fr, fq);
        if (!has_next) break;
        if (nxt.seg == 0) {
#pragma unroll
        for (int a = 0; a < 2; ++a)
#pragma unroll
            for (int b = 0; b < 2; ++b)
#pragma unroll
                for (int m = 0; m < 4; ++m)
#pragma unroll
                    for (int n = 0; n < 2; ++n) acc[a][b][m][n] = (f32x4){0.f, 0.f, 0.f, 0.f};
        }
        cur = nxt; cA = nA; cB = nB; ++ui;
    }
    PG8_WAIT_V(0);
    if (wr == 0) PG8_BAR;
    PG8_BAR;
#undef PG8_SA
#undef PG8_SB
#undef PG8_STAGE
#undef PG8_LDA
#undef PG8_LDB
#undef PG8_MMA
#undef PG8_WAIT_V
#undef PG8_WAIT_L
#undef PG8_BAR
#undef PG8_SCHED
}
}
using pg8::Unit;
typedef f32x4 Acc[2][2][4][2];

struct EpiF32 {
    static constexpr bool PERM = false;
    float* C; int ldc;
    __device__ __forceinline__ void operator()(const Acc& acc, const Unit& u, int wr, int wc, int fr, int fq) const {
        const int row0 = u.pm * 256 + wr * 64 + fr, col0 = u.pn * 256 + wc * 32 + 4 * fq;
#pragma unroll
        for (int ai = 0; ai < 2; ++ai)
#pragma unroll
            for (int m = 0; m < 4; ++m) { float* rowp = C + (size_t)(row0 + ai * 128 + m * 16) * ldc + col0;
#pragma unroll
                for (int bj = 0; bj < 2; ++bj)
#pragma unroll
                    for (int n = 0; n < 2; ++n) *(f32x4*)(rowp + bj * 128 + n * 16) = acc[ai][bj][m][n]; }
    }
};
struct EpiBf16Out {
    static constexpr bool PERM = true;
    bf16_t* O; int ldc;
    __device__ __forceinline__ void operator()(const Acc& acc, const Unit& u, int wr, int wc, int fr, int fq) const {
        const int row0 = u.pm * 256 + wr * 64 + fr, col0 = u.pn * 256 + wc * 32 + 8 * fq;
#pragma unroll
        for (int ai = 0; ai < 2; ++ai)
#pragma unroll
            for (int m = 0; m < 4; ++m) { bf16_t* rowp = O + (size_t)(row0 + ai * 128 + m * 16) * ldc + col0;
#pragma unroll
                for (int bj = 0; bj < 2; ++bj) { const f32x4 v0 = acc[ai][bj][m][0], v1 = acc[ai][bj][m][1];
                    u32x4 w; w.x = pk2(v0[0], v0[1]); w.y = pk2(v0[2], v0[3]); w.z = pk2(v1[0], v1[1]); w.w = pk2(v1[2], v1[3]);
                    *(u32x4*)(rowp + bj * 128) = w; } }
    }
};
struct EpiSwiGLU {
    static constexpr bool PERM = true;
    bf16_t* O;
    __device__ __forceinline__ void operator()(const Acc& acc, const Unit& u, int wr, int wc, int fr, int fq) const {
        const int row0 = u.pm * 256 + wr * 64 + fr, col0 = u.pn * 128 + wc * 32 + 8 * fq;
#pragma unroll
        for (int ai = 0; ai < 2; ++ai)
#pragma unroll
            for (int m = 0; m < 4; ++m) {
                f32x4 v0, v1;
#pragma unroll
                for (int e = 0; e < 4; ++e) { v0[e] = siluf_(acc[ai][0][m][0][e]) * acc[ai][1][m][0][e]; v1[e] = siluf_(acc[ai][0][m][1][e]) * acc[ai][1][m][1][e]; }
                u32x4 w; w.x = pk2(v0[0], v0[1]); w.y = pk2(v0[2], v0[3]); w.z = pk2(v1[0], v1[1]); w.w = pk2(v1[2], v1[3]);
                *(u32x4*)(O + (size_t)(row0 + ai * 128 + m * 16) * FF + col0) = w; }
    }
};
struct EpiWin {
    static constexpr bool PERM = true;
    unsigned char* ws;
    __device__ __forceinline__ void operator()(const Acc& acc, const Unit& u, int wr, int wc, int fr, int fq) const {
        const int pn = u.pn, row0 = u.pm * 256 + wr * 64 + fr;
        if (pn == 52) {
            float* M = (float*)(ws + OFF_MISC);
#pragma unroll
            for (int ai = 0; ai < 2; ++ai)
#pragma unroll
                for (int m = 0; m < 4; ++m)
#pragma unroll
                    for (int n = 0; n < 2; ++n) *(f32x4*)(M + (size_t)(row0 + ai * 128 + m * 16) * 128 + 32 * wc + 8 * fq + 4 * n) = acc[ai][0][m][n];
            return;
        }
        bf16_t* base; int ld, col, mode = 0;
        if (pn < 12) { base = (bf16_t*)(ws + OFF_QKV); ld = 3072; col = pn * 256; }
        else if (pn < 16) { base = (bf16_t*)(ws + OFF_Z); ld = 1024; col = (pn - 12) * 256; }
        else if (pn < 24) { base = (bf16_t*)(ws + OFF_SG); ld = 2048; col = (pn - 16) * 256; mode = 2; }
        else if (pn < 26) { base = (bf16_t*)(ws + OFF_CQ); ld = 512; col = (pn - 24) * 256; }
        else if (pn < 28) { base = (bf16_t*)(ws + OFF_CKV); ld = 512; col = (pn - 26) * 256; }
        else { base = (bf16_t*)(ws + OFF_GATE); ld = 6144; col = (pn - 28) * 256; mode = 1; }
        col += wc * 32 + 8 * fq;
#pragma unroll
        for (int ai = 0; ai < 2; ++ai)
#pragma unroll
            for (int m = 0; m < 4; ++m) { bf16_t* rowp = base + (size_t)(row0 + ai * 128 + m * 16) * ld + col;
#pragma unroll
                for (int bj = 0; bj < 2; ++bj) { f32x4 v0 = acc[ai][bj][m][0], v1 = acc[ai][bj][m][1];
                    if (mode == 1) {
#pragma unroll
                        for (int e = 0; e < 4; ++e) { v0[e] = sigmoidf_(v0[e]); v1[e] = sigmoidf_(v1[e]); } }
                    else if (mode == 2) { f32x2 a = gelu_pk((f32x2){v0[0], v0[1]}), b = gelu_pk((f32x2){v0[2], v0[3]}), c = gelu_pk((f32x2){v1[0], v1[1]}), d = gelu_pk((f32x2){v1[2], v1[3]});
                        v0 = (f32x4){a.x, a.y, b.x, b.y}; v1 = (f32x4){c.x, c.y, d.x, d.y}; }
                    u32x4 w; w.x = pk2(v0[0], v0[1]); w.y = pk2(v0[2], v0[3]); w.z = pk2(v1[0], v1[1]); w.w = pk2(v1[2], v1[3]);
                    *(u32x4*)(rowp + bj * 128) = w; } }
    }
};
struct EpiQ {
    static constexpr bool PERM = true;
    bf16_t* QB; const float* RS; const float* CS; float qscale;
    __device__ __forceinline__ void operator()(const Acc& acc, const Unit& u, int wr, int wc, int fr, int fq) const {
        const int pn = u.pn, row0 = u.pm * 256 + wr * 64 + fr;
#pragma unroll
        for (int ai = 0; ai < 2; ++ai)
#pragma unroll
            for (int m = 0; m < 4; ++m) { const int row = row0 + ai * 128 + m * 16; const float sc = qscale;
                if (pn < 4) {
#pragma unroll
                    for (int bj = 0; bj < 2; ++bj) { const f32x4 v0 = acc[ai][bj][m][0] * sc, v1 = acc[ai][bj][m][1] * sc;
                        u32x4 w; w.x = pk2(v0[0], v0[1]); w.y = pk2(v0[2], v0[3]); w.z = pk2(v1[0], v1[1]); w.w = pk2(v1[2], v1[3]);
                        *(u32x4*)(QB + (size_t)row * 1536 + (pn * 2 + bj) * 192 + wc * 32 + 8 * fq) = w; }
                } else {
                    const int head = (pn - 4) * 4 + wc, i0 = 8 * fq;
                    const f32x4 c0 = *(const f32x4*)(CS + (size_t)row * 64 + i0), c1 = *(const f32x4*)(CS + (size_t)row * 64 + i0 + 4);
                    const f32x4 s0 = *(const f32x4*)(CS + (size_t)row * 64 + 32 + i0), s1 = *(const f32x4*)(CS + (size_t)row * 64 + 32 + i0 + 4);
                    const f32x4 x10 = acc[ai][0][m][0] * sc, x11 = acc[ai][0][m][1] * sc, x20 = acc[ai][1][m][0] * sc, x21 = acc[ai][1][m][1] * sc;
                    const f32x4 a0 = x10 * c0 - x20 * s0, a1 = x11 * c1 - x21 * s1, b0 = x10 * s0 + x20 * c0, b1 = x11 * s1 + x21 * c1;
                    u32x4 w; w.x = pk2(a0[0], a0[1]); w.y = pk2(a0[2], a0[3]); w.z = pk2(a1[0], a1[1]); w.w = pk2(a1[2], a1[3]);
                    *(u32x4*)(QB + (size_t)row * 1536 + head * 192 + 128 + i0) = w;
                    w.x = pk2(b0[0], b0[1]); w.y = pk2(b0[2], b0[3]); w.z = pk2(b1[0], b1[1]); w.w = pk2(b1[2], b1[3]);
                    *(u32x4*)(QB + (size_t)row * 1536 + head * 192 + 160 + i0) = w;
                } }
    }
};
struct EpiKN {
    static constexpr bool PERM = true;
    bf16_t* O; const float* RS;
    __device__ __forceinline__ void operator()(const Acc& acc, const Unit& u, int wr, int wc, int fr, int fq) const {
        const int row0 = u.pm * 256 + wr * 64 + fr, col0 = u.pn * 256 + wc * 32 + 8 * fq;
#pragma unroll
        for (int ai = 0; ai < 2; ++ai)
#pragma unroll
            for (int m = 0; m < 4; ++m) { const int row = row0 + ai * 128 + m * 16; const float sc = 1.f;
#pragma unroll
                for (int bj = 0; bj < 2; ++bj) { const f32x4 v0 = acc[ai][bj][m][0] * sc, v1 = acc[ai][bj][m][1] * sc;
                    u32x4 w; w.x = pk2(v0[0], v0[1]); w.y = pk2(v0[2], v0[3]); w.z = pk2(v1[0], v1[1]); w.w = pk2(v1[2], v1[3]);
                    *(u32x4*)(O + (size_t)row * 1024 + col0 + bj * 128) = w; } }
    }
};
struct EpiVT {
    static constexpr bool PERM = true;
    bf16_t* O; const float* RS;
    __device__ __forceinline__ void operator()(const Acc& acc, const Unit& u, int wr, int wc, int fr, int fq) const {
        const int row0 = u.pm * 256 + wr * 64 + fr, col0 = u.pn * 256 + wc * 32 + 8 * fq;
        float sc[2][8];
#pragma unroll
        for (int bj = 0; bj < 2; ++bj)
#pragma unroll
            for (int e = 0; e < 8; ++e) sc[bj][e] = 1.f;
#pragma unroll
        for (int ai = 0; ai < 2; ++ai)
#pragma unroll
            for (int m = 0; m < 4; ++m) { const int row = row0 + ai * 128 + m * 16;
#pragma unroll
                for (int bj = 0; bj < 2; ++bj) { const f32x4 v0 = acc[ai][bj][m][0], v1 = acc[ai][bj][m][1];
                    u32x4 w; w.x = pk2(v0[0] * sc[bj][0], v0[1] * sc[bj][1]); w.y = pk2(v0[2] * sc[bj][2], v0[3] * sc[bj][3]);
                    w.z = pk2(v1[0] * sc[bj][4], v1[1] * sc[bj][5]); w.w = pk2(v1[2] * sc[bj][6], v1[3] * sc[bj][7]);
                    *(u32x4*)(O + (size_t)row * 8192 + col0 + bj * 128) = w; } }
    }
};
template <int BR> struct EpiBranch {
    static constexpr bool PERM = true;
    bf16_t* ACC; const bf16_t* GATE; bf16_t* OUT;
    __device__ __forceinline__ void operator()(const Acc& acc, const Unit& u, int wr, int wc, int fr, int fq) const {
        const int row0 = u.pm * 256 + wr * 64 + fr, col0 = u.pn * 256 + wc * 32 + 8 * fq;
#pragma unroll
        for (int ai = 0; ai < 2; ++ai)
#pragma unroll
            for (int m = 0; m < 4; ++m) { const int row = row0 + ai * 128 + m * 16;
#pragma unroll
                for (int bj = 0; bj < 2; ++bj) { const int col = col0 + bj * 128;
                    const u32x4 gw = *(const u32x4*)(GATE + (size_t)row * 6144 + BR * 2048 + col);
                    f32x4 v0 = acc[ai][bj][m][0], v1 = acc[ai][bj][m][1];
                    v0[0] *= bflo(gw.x); v0[1] *= bfhi(gw.x); v0[2] *= bflo(gw.y); v0[3] *= bfhi(gw.y);
                    v1[0] *= bflo(gw.z); v1[1] *= bfhi(gw.z); v1[2] *= bflo(gw.w); v1[3] *= bfhi(gw.w);
                    bf16_t* ap = ACC + (size_t)row * 2048 + col;
                    if (BR > 0) { const u32x4 pw = *(const u32x4*)ap;
                        v0[0] += bflo(pw.x); v0[1] += bfhi(pw.x); v0[2] += bflo(pw.y); v0[3] += bfhi(pw.y);
                        v1[0] += bflo(pw.z); v1[1] += bfhi(pw.z); v1[2] += bflo(pw.w); v1[3] += bfhi(pw.w); }
                    u32x4 w; w.x = pk2(v0[0], v0[1]); w.y = pk2(v0[2], v0[3]); w.z = pk2(v1[0], v1[1]); w.w = pk2(v1[2], v1[3]);
                    if (BR < 2) *(u32x4*)ap = w; else *(u32x4*)(OUT + (size_t)row * 2048 + col) = w; } }
    }
};

struct EpiBranchFused {
    static constexpr bool PERM = true;
    const bf16_t* GATE; bf16_t* OUT;
    __device__ __forceinline__ void operator()(Acc& acc, const Unit& u, int wr, int wc, int fr, int fq) const {
        const int row0 = u.pm * 256 + wr * 64 + fr, col0 = u.pn * 256 + wc * 32 + 8 * fq, seg = u.seg;
        const int segb = seg < 2 ? seg + 1 : seg;
#pragma unroll
        for (int aim = 0; aim < 4; ++aim) { const int ai = aim >> 1, mh = aim & 1;
            u32x4 ga[4][2], gb[4][2];
#pragma unroll
            for (int m = mh * 2; m < mh * 2 + 2; ++m)
#pragma unroll
                for (int bj = 0; bj < 2; ++bj) { const size_t off = (size_t)(row0 + ai * 128 + m * 16) * 6144 + col0 + bj * 128;
                    ga[m][bj] = *(const u32x4*)(GATE + off + seg * 2048); gb[m][bj] = *(const u32x4*)(GATE + off + segb * 2048); }
            __builtin_amdgcn_sched_barrier(0);
#pragma unroll
            for (int m = mh * 2; m < mh * 2 + 2; ++m) { const int row = row0 + ai * 128 + m * 16;
#pragma unroll
                for (int bj = 0; bj < 2; ++bj) { const int col = col0 + bj * 128;
                    const u32x4 a = ga[m][bj], d = gb[m][bj];
                    float sc[8] = {bflo(a.x), bfhi(a.x), bflo(a.y), bfhi(a.y), bflo(a.z), bfhi(a.z), bflo(a.w), bfhi(a.w)};
                    if (seg < 2) { const float dn[8] = {bflo(d.x), bfhi(d.x), bflo(d.y), bfhi(d.y), bflo(d.z), bfhi(d.z), bflo(d.w), bfhi(d.w)};
#pragma unroll
                        for (int e = 0; e < 8; ++e) sc[e] = sc[e] * __builtin_amdgcn_rcpf(dn[e]); }
                    f32x4 v0 = acc[ai][bj][m][0], v1 = acc[ai][bj][m][1];
#pragma unroll
                    for (int e = 0; e < 4; ++e) { v0[e] *= sc[e]; v1[e] *= sc[4 + e]; }
                    if (seg < 2) { acc[ai][bj][m][0] = v0; acc[ai][bj][m][1] = v1; }
                    else { u32x4 w; w.x = pk2(v0[0], v0[1]); w.y = pk2(v0[2], v0[3]); w.z = pk2(v1[0], v1[1]); w.w = pk2(v1[2], v1[3]);
                        *(u32x4*)(OUT + (size_t)row * 2048 + col) = w; } } }
            __builtin_amdgcn_sched_barrier(0);
        }
    }
};
__device__ __forceinline__ void run_branch_gemm(LAS unsigned char* lds, const bf16_t* A3, const bf16_t* Bt3, const EpiBranchFused& E) {
    pg8::Gemm g; g.A = A3; g.Bt = Bt3; g.M = T_; g.N = 2048; g.K = 1024; g.segA = (size_t)T_ * 1024 * 2; g.segB = (size_t)2048 * 1024 * 2;
    pg8::StaticOrder S; S.init(T_, 2048, (int)gridDim.x, (int)blockIdx.x); S.nseg = 3;
    pg8::gemm_phase<EpiBranchFused>(lds, g, S, E);
}
template <class Epi>
__device__ __forceinline__ void run_gemm(LAS unsigned char* lds, const bf16_t* A, const bf16_t* Bt, int M, int N, int K, const Epi& E) {
    pg8::Gemm g; g.A = A; g.Bt = Bt; g.M = M; g.N = N; g.K = K; g.segA = 0; g.segB = 0;
    pg8::StaticOrder S; S.init(M, N, (int)gridDim.x, (int)blockIdx.x);
    pg8::gemm_phase<Epi>(lds, g, S, E);
}

template <class Map>
__device__ __forceinline__ void cvt_item(const float* W, int K, int N, bf16_t* WT, const float* kscale, LAS float* scr, int item, int lane, Map map) {
    const int nblk = (N + 31) / 32, kb = item / nblk, nb = item % nblk, k0 = 128 * kb, n0 = 32 * nb;
    {
        const int nc4 = n0 + 4 * (lane & 7); const bool ok4 = nc4 < N;
        f32x4 v[16];
#pragma unroll
        for (int i = 0; i < 16; ++i) { const int kk = 8 * i + (lane >> 3); v[i] = ok4 ? *(const f32x4*)(W + (size_t)(k0 + kk) * N + nc4) : (f32x4){0.f, 0.f, 0.f, 0.f}; }
#pragma unroll
        for (int i = 0; i < 16; ++i) { const int kk = 8 * i + (lane >> 3); f32x4 x = v[i]; if (kscale) x = x * kscale[k0 + kk];
            LAS float* d = scr + kk * 33 + 4 * (lane & 7); d[0] = x[0]; d[1] = x[1]; d[2] = x[2]; d[3] = x[3]; }
    }
    LDS_WAIT();
    const int c = lane & 15;
    float tv[8][8];
#pragma unroll
    for (int j = 0; j < 8; ++j) { const LAS float* sp = scr + (8 * c) * 33 + (lane >> 4) + 4 * j;
#pragma unroll
        for (int e = 0; e < 8; ++e) tv[j][e] = sp[e * 33]; }
    __builtin_amdgcn_sched_barrier(0);
#pragma unroll
    for (int j = 0; j < 8; ++j) { const int n = (lane >> 4) + 4 * j;
        if (n0 + n < N) { const int drow = map(n0 + n);
            u32x4 o; o.x = pk2(tv[j][0], tv[j][1]); o.y = pk2(tv[j][2], tv[j][3]); o.z = pk2(tv[j][4], tv[j][5]); o.w = pk2(tv[j][6], tv[j][7]);
            *(u32x4*)(WT + (size_t)drow * K + k0 + 8 * c) = o; } }
    LDS_WAIT();
}
struct MapId { __device__ __forceinline__ int operator()(int n) const { return n; } };
struct MapGU { int off; __device__ __forceinline__ int operator()(int n) const { return (n >> 7) * 256 + off + (n & 127); } };
struct MapWin { __device__ __forceinline__ int operator()(int n) const {
    if (n < 4096) return n;
    if (n < 4112) return 13312 + 64 + (n - 4096);
    if (n < 6160) return 4096 + (n - 4112);
    if (n < 6672) return 6144 + (n - 6160);
    if (n < 7184) return 6656 + (n - 6672);
    if (n < 7248) return 13312 + (n - 7184);
    return 7168 + (n - 7248); } };
struct MapUQ { __device__ __forceinline__ int operator()(int n) const { const int hh = n / 192, d = n - hh * 192;
    if (d < 128) return (hh >> 1) * 256 + (hh & 1) * 128 + d;
    if (d < 160) return 1024 + (hh >> 2) * 256 + (hh & 3) * 32 + (d - 128);
    return 1024 + (hh >> 2) * 256 + 128 + (hh & 3) * 32 + (d - 160); } };
struct MapUKV { __device__ __forceinline__ int operator()(int n) const { const int hh = n >> 8, d = n & 255; return d < 128 ? hh * 128 + d : 1024 + hh * 128 + (d - 128); } };

__device__ __forceinline__ void convert_layer(const Params& p, int l, LAS unsigned char* lds) {
    int tid = threadIdx.x; asm volatile("" : "+v"(tid));
    const int lane = tid & 63, wave = tid >> 6;
    LAS float* scr = (LAS float*)(lds + wave * 16896);
    const int gw = blockIdx.x * 8 + wave, NGW = gridDim.x * 8;
    unsigned char* ws = p.ws;
    constexpr int I_GU = 16 * 176, I_DN = 44 * 64, I_WIN = 16 * 419, I_UQ = 4 * 48, I_UKV = 4 * 64, I_BR = 8 * 64, I_OUT = 16 * 64;
    constexpr int NITEMS = 4 * I_GU + 2 * I_DN + I_WIN + I_UQ + I_UKV + 3 * I_BR + I_OUT;
    for (int it = gw; it < NITEMS; it += NGW) {
        int r = it;
        if (r < 4 * I_GU) { const int which = r / I_GU, i = which >> 1, up = which & 1; r -= which * I_GU;
            const float* W = (up ? p.wu : p.wg) + (size_t)(l * 2 + i) * 2048 * FF;
            MapGU mp; mp.off = up * 128;
            cvt_item(W, 2048, FF, (bf16_t*)(ws + OFF_WGU) + (size_t)i * 11264 * 2048, nullptr, scr, r, lane, mp); continue; }
        r -= 4 * I_GU;
        if (r < 2 * I_DN) { const int i = r / I_DN; r -= i * I_DN;
            cvt_item(p.wd + (size_t)(l * 2 + i) * FF * 2048, FF, 2048, (bf16_t*)(ws + OFF_WDN) + (size_t)i * 2048 * FF, nullptr, scr, r, lane, MapId()); continue; }
        r -= 2 * I_DN;
        if (r < I_WIN) { cvt_item(p.win + (size_t)l * 2048 * NIN, 2048, NIN, (bf16_t*)(ws + OFF_WIN), nullptr, scr, r, lane, MapWin()); continue; }
        r -= I_WIN;
        if (r < I_UQ) { cvt_item(p.wuq + (size_t)l * 512 * 1536, 512, 1536, (bf16_t*)(ws + OFF_WUQ), p.cqg + l * 512, scr, r, lane, MapUQ()); continue; }
        r -= I_UQ;
        if (r < I_UKV) { cvt_item(p.wukv + (size_t)l * 512 * 2048, 512, 2048, (bf16_t*)(ws + OFF_WUKV), p.ckvg + l * 512, scr, r, lane, MapUKV()); continue; }
        r -= I_UKV;
        if (r < 3 * I_BR) { const int j = r / I_BR; r -= j * I_BR;
            cvt_item(p.wbr + (size_t)(l * 3 + j) * 1024 * 2048, 1024, 2048, (bf16_t*)(ws + OFF_WBR) + (size_t)j * 2048 * 1024, nullptr, scr, r, lane, MapId()); continue; }
        r -= 3 * I_BR;
        cvt_item(p.wout + (size_t)l * 2048 * 2048, 2048, 2048, (bf16_t*)(ws + OFF_WOUT), nullptr, scr, r, lane, MapId());
    }
    const size_t gt = (size_t)blockIdx.x * 512 + tid, NGT = (size_t)gridDim.x * 512;
    { bf16_t* SGW = (bf16_t*)(ws + OFF_SGW); const float* src = p.sgw + (size_t)l * 8 * 128 * 128;
      for (size_t e = gt; e < (size_t)8 * 128 * 128; e += NGT) { const int j = (int)(e & 127), i = (int)((e >> 7) & 127); SGW[e] = ((j >> 6) <= (i >> 6)) ? f2bf(src[e]) : (bf16_t)0; } }
    { bf16_t* WIN = (bf16_t*)(ws + OFF_WIN) + (size_t)(13312 + 80) * 2048;
      for (size_t e = gt; e < (size_t)176 * 2048; e += NGT) WIN[e] = 0; }
}

__device__ __forceinline__ void rowpass(const float* xin, const bf16_t* f, float alpha, const float* gpost, const float* gpre, float* xout, bf16_t* hout) {
    int tid = threadIdx.x; asm volatile("" : "+v"(tid));
    const int lane = tid & 63, wave = tid >> 6;
    const int gw = blockIdx.x * 8 + wave, NGW = gridDim.x * 8;
    for (int row0 = gw; row0 < T_; row0 += 2 * NGW) {
        const int row1 = row0 + NGW; const bool two = row1 < T_; const int rowb = two ? row1 : row0;
        f32x4 xa[8], xb[8]; u32x2 wa[8], wb[8]; f32x4 gp[8];
        { const f32x4* xr = (const f32x4*)(xin + (size_t)row0 * DM) + lane; const f32x4* xs = (const f32x4*)(xin + (size_t)rowb * DM) + lane;
#pragma unroll
          for (int j = 0; j < 8; ++j) { xa[j] = xr[64 * j]; xb[j] = xs[64 * j]; } }
        if (f) {
            const u32x2* fr = (const u32x2*)(f + (size_t)row0 * DM) + lane; const u32x2* fs = (const u32x2*)(f + (size_t)rowb * DM) + lane;
#pragma unroll
            for (int j = 0; j < 8; ++j) { wa[j] = fr[64 * j]; wb[j] = fs[64 * j]; gp[j] = *((const f32x4*)gpost + lane + 64 * j); }
        }
        __builtin_amdgcn_sched_barrier(0);
        if (f) {
            f32x4 fa[8], fb[8]; float sa = 0.f, sb = 0.f;
#pragma unroll
            for (int j = 0; j < 8; ++j) { fa[j] = (f32x4){bflo(wa[j].x), bfhi(wa[j].x), bflo(wa[j].y), bfhi(wa[j].y)}; fb[j] = (f32x4){bflo(wb[j].x), bfhi(wb[j].x), bflo(wb[j].y), bfhi(wb[j].y)}; }
#pragma unroll
            for (int j = 0; j < 8; ++j) { sa += fa[j][0] * fa[j][0] + fa[j][1] * fa[j][1] + fa[j][2] * fa[j][2] + fa[j][3] * fa[j][3];
                sb += fb[j][0] * fb[j][0] + fb[j][1] * fb[j][1] + fb[j][2] * fb[j][2] + fb[j][3] * fb[j][3]; }
            const float ra = rsqrtf(wave_sum(sa) * (1.f / DM) + EPS) * alpha, rb = rsqrtf(wave_sum(sb) * (1.f / DM) + EPS) * alpha;
#pragma unroll
            for (int j = 0; j < 8; ++j) { xa[j] += fa[j] * ra * gp[j]; xb[j] += fb[j] * rb * gp[j]; }
        }
        f32x4 gq[8];
        if (hout) {
#pragma unroll
            for (int j = 0; j < 8; ++j) gq[j] = *((const f32x4*)gpre + lane + 64 * j);
        }
        { f32x4* xo = (f32x4*)(xout + (size_t)row0 * DM) + lane;
#pragma unroll
          for (int j = 0; j < 8; ++j) xo[64 * j] = xa[j];
          if (two) { f32x4* xp = (f32x4*)(xout + (size_t)row1 * DM) + lane;
#pragma unroll
              for (int j = 0; j < 8; ++j) xp[64 * j] = xb[j]; } }
        __builtin_amdgcn_sched_barrier(0);
        if (hout) {
            float sa = 0.f, sb = 0.f;
#pragma unroll
            for (int j = 0; j < 8; ++j) { sa += xa[j][0] * xa[j][0] + xa[j][1] * xa[j][1] + xa[j][2] * xa[j][2] + xa[j][3] * xa[j][3];
                sb += xb[j][0] * xb[j][0] + xb[j][1] * xb[j][1] + xb[j][2] * xb[j][2] + xb[j][3] * xb[j][3]; }
            const float ra = rsqrtf(wave_sum(sa) * (1.f / DM) + EPS), rb = rsqrtf(wave_sum(sb) * (1.f / DM) + EPS);
            u32x2* ho = (u32x2*)(hout + (size_t)row0 * DM) + lane; u32x2* hp = (u32x2*)(hout + (size_t)rowb * DM) + lane;
#pragma unroll
            for (int j = 0; j < 8; ++j) { const f32x4 ya = xa[j] * ra * gq[j], yb = xb[j] * rb * gq[j];
                u32x2 w; w.x = pk2(ya[0], ya[1]); w.y = pk2(ya[2], ya[3]); ho[64 * j] = w;
                if (two) { u32x2 w2; w2.x = pk2(yb[0], yb[1]); w2.y = pk2(yb[2], yb[3]); hp[64 * j] = w2; } }
        }
    }
}

constexpr int XS = 260;
__device__ __forceinline__ void dn_prep_item(const Params& p, int l, LAS float* L, int item, unsigned long long& t0_, unsigned long long& tacc_) {
    unsigned char* ws = p.ws;
    int tid = threadIdx.x; asm volatile("" : "+v"(tid));
    const int lane = tid & 63, wave = tid >> 6;
    const int h = item & 7, n = (item >> 3) & 31, b = item >> 8;
    const int t0 = b * SEQ_ + n * 64;
    LAS float* sQ = L; LAS float* sK = L + 64 * 132; LAS float* sX = L + 2 * 64 * 132; LAS float* sA = sX + 64 * XS; LAS float* sG = sA + 64 * 68; LAS float* sB = sG + 64;
    const bf16_t* QKV = (const bf16_t*)(ws + OFF_QKV);
    const float* MISC = (const float*)(ws + OFF_MISC);
    const float* cw = p.convw + (size_t)l * 4 * 3072;
    TB(7);
    if (tid < 384) {
        const int cgp = tid % 48, tq = tid / 48, part = cgp >> 4, d0 = (cgp & 15) * 8, ch = part * 1024 + h * 128 + d0;
        f32x4 w0[4], w1[4];
#pragma unroll
        for (int j = 0; j < 4; ++j) { w0[j] = *(const f32x4*)(cw + j * 3072 + ch); w1[j] = *(const f32x4*)(cw + j * 3072 + ch + 4); }
        u32x4 xr[11];
#pragma unroll
        for (int r = 0; r < 11; ++r) { const int sq = n * 64 + tq * 8 - 3 + r; const int sc = sq < 0 ? 0 : sq;
            u32x4 v = *(const u32x4*)(QKV + (size_t)(b * SEQ_ + sc) * 3072 + ch);
            if (sq < 0) v = (u32x4){0u, 0u, 0u, 0u};
            xr[r] = v; }
#pragma unroll
        for (int tt = 0; tt < 8; ++tt) { const int t = tq * 8 + tt;
            f32x4 a0 = (f32x4){0.f, 0.f, 0.f, 0.f}, a1 = a0;
#pragma unroll
            for (int j = 0; j < 4; ++j) { const u32x4 xv = xr[tt + j];
                a0 += w0[j] * (f32x4){bflo(xv.x), bfhi(xv.x), bflo(xv.y), bfhi(xv.y)}; a1 += w1[j] * (f32x4){bflo(xv.z), bfhi(xv.z), bflo(xv.w), bfhi(xv.w)}; }
            LAS float* dst = part == 0 ? sQ + t * 132 + d0 : (part == 1 ? sK + t * 132 + d0 : sX + t * XS + 128 + d0);
#pragma unroll
            for (int e = 0; e < 4; ++e) { dst[e] = siluf_(a0[e]); dst[4 + e] = siluf_(a1[e]); } }
    }
    __syncthreads();
    TE(7);
    TB(8);
    { const int row = tid >> 2, sub = tid & 3; LAS float* rp = (row < 64 ? sQ + row * 132 : sK + (row - 64) * 132) + sub * 32;
      float ss = 0.f;
#pragma unroll
      for (int e = 0; e < 32; ++e) ss += rp[e] * rp[e];
      ss += __shfl_xor(ss, 1); ss += __shfl_xor(ss, 2);
      const float sc = rsqrtf(ss + 1e-6f) * (row < 64 ? 0.08838834764831845f : 1.f);
#pragma unroll
      for (int e = 0; e < 32; ++e) rp[e] *= sc; }
    if (tid < 64) { const float av = MISC[(size_t)(t0 + tid) * 128 + 64 + h], bv = MISC[(size_t)(t0 + tid) * 128 + 72 + h];
        const float xx = av + p.dtb[l * 8 + h]; const float sp = xx > 20.f ? xx : log1pf(__expf(xx));
        float gv = -__expf(p.alog[l * 8 + h]) * sp;
#pragma unroll
        for (int o = 1; o < 64; o <<= 1) { const float y = __shfl_up(gv, o); if (lane >= o) gv += y; }
        sG[tid] = gv; sB[tid] = sigmoidf_(bv); }
    __syncthreads();
    TE(8);
    TB(9);
    { const int jl = lane & 15, g = lane >> 4, ib = wave >> 1;
      bf16_t* QKo = (bf16_t*)(ws + OFF_DQK) + (size_t)item * 4096;
#pragma unroll
      for (int jj = 0; jj < 2; ++jj) { const int jb = (wave & 1) * 2 + jj;
          f32x4 aA = (f32x4){0.f, 0.f, 0.f, 0.f}, aQ = aA;
          if (jb <= ib) {
#pragma unroll
              for (int ks = 0; ks < 4; ++ks) {
                  const LAS float* kip = sK + (ib * 16 + jl) * 132 + ks * 32 + g * 8; const LAS float* qip = sQ + (ib * 16 + jl) * 132 + ks * 32 + g * 8;
                  const LAS float* kjp = sK + (jb * 16 + jl) * 132 + ks * 32 + g * 8;
                  const bf16x8 ki = pack8(*(const LAS f32x4*)kip, *(const LAS f32x4*)(kip + 4)), qi = pack8(*(const LAS f32x4*)qip, *(const LAS f32x4*)(qip + 4));
                  const bf16x8 kj = pack8(*(const LAS f32x4*)kjp, *(const LAS f32x4*)(kjp + 4));
                  aA = MFMA16(ki, kj, aA); aQ = MFMA16(qi, kj, aQ); } }
          const int j = jb * 16 + jl; const float gj = sG[j];
          const int pj = (j & 32) + ((j & 15) >> 2) * 8 + ((j >> 4) & 1) * 4 + (j & 3);
#pragma unroll
          for (int r = 0; r < 4; ++r) { const int i = ib * 16 + g * 4 + r; const float dec = (j <= i) ? __expf(sG[i] - gj) : 0.f;
              sA[i * 68 + j] = (j < i) ? sB[i] * aA[r] * dec : 0.f;
              QKo[i * 64 + pj] = f2bf((j <= i) ? aQ[r] * dec : 0.f); } } }
    for (int task = tid; task < 64 * 32; task += 512) { const int t = task >> 5, d4 = task & 31; const float bt = sB[t], kb = bt * __expf(sG[t]);
        const f32x4 kv = *(const LAS f32x4*)(sK + t * 132 + d4 * 4); *(LAS f32x4*)(sX + t * XS + d4 * 4) = kv * kb;
        LAS f32x4* vp = (LAS f32x4*)(sX + t * XS + 128 + d4 * 4); *vp = *vp * bt; }
    __syncthreads();
    TE(9);
    TB(10);
    if (tid < 256) {
        float x[64]; int va[64];
#pragma unroll
        for (int i = 0; i < 64; ++i) x[i] = sX[i * XS + tid];
#pragma unroll
        for (int i = 1; i < 64; ++i) va[i] = __float_as_int(sA[i * 68 + lane]);
#pragma unroll
        for (int i = 1; i < 64; ++i) {
            float acc0 = 0.f, acc1 = 0.f;
#pragma unroll
            for (int j = 0; j < i; ++j) { const float aij = __int_as_float(__builtin_amdgcn_readlane(va[i], j));
                if (j & 1) acc1 = fmaf(aij, x[j], acc1); else acc0 = fmaf(aij, x[j], acc0); }
            x[i] -= acc0 + acc1;
        }
#pragma unroll
        for (int i = 1; i < 64; ++i) sX[i * XS + tid] = x[i];
    } else {
        bf16_t* QGo = (bf16_t*)(ws + OFF_DQG) + (size_t)item * 8192; bf16_t* KGTo = (bf16_t*)(ws + OFF_DKGT) + (size_t)item * 8192;
        const float glast = sG[63];
        for (int task = tid - 256; task < 1024; task += 256) {
            { const int c = task >> 4, pc = task & 15, dA = (pc >> 2) * 32 + (pc & 3) * 4, dB = dA + 16;
              const float eg = __expf(sG[c]);
              const f32x4 q0 = *(const LAS f32x4*)(sQ + c * 132 + dA) * eg, q1 = *(const LAS f32x4*)(sQ + c * 132 + dB) * eg;
              u32x4 w; w.x = pk2(q0[0], q0[1]); w.y = pk2(q0[2], q0[3]); w.z = pk2(q1[0], q1[1]); w.w = pk2(q1[2], q1[3]);
              *(u32x4*)(QGo + c * 128 + pc * 8) = w; }
            { const int d = task & 127, pc = task >> 7, cA = (pc >> 2) * 32 + (pc & 3) * 4;
              float kk[8];
#pragma unroll
              for (int e = 0; e < 8; ++e) { const int cc = cA + (e & 3) + (e >> 2) * 16; kk[e] = sK[cc * 132 + d] * __expf(glast - sG[cc]); }
              u32x4 w; w.x = pk2(kk[0], kk[1]); w.y = pk2(kk[2], kk[3]); w.z = pk2(kk[4], kk[5]); w.w = pk2(kk[6], kk[7]);
              *(u32x4*)(KGTo + d * 64 + pc * 8) = w; }
        }
    }
    __syncthreads();
    TE(10);
    TB(11);
    { bf16_t* Wo = (bf16_t*)(ws + OFF_DW) + (size_t)item * 8192; bf16_t* UTo = (bf16_t*)(ws + OFF_DUT) + (size_t)item * 8192;
      for (int task = tid; task < 1024; task += 512) {
          { const int c = task >> 4, pc = task & 15, dA = (pc >> 2) * 32 + (pc & 3) * 4, dB = dA + 16;
            const f32x4 a = *(const LAS f32x4*)(sX + c * XS + dA), b2 = *(const LAS f32x4*)(sX + c * XS + dB);
            u32x4 w; w.x = pk2(a[0], a[1]); w.y = pk2(a[2], a[3]); w.z = pk2(b2[0], b2[1]); w.w = pk2(b2[2], b2[3]);
            *(u32x4*)(Wo + c * 128 + pc * 8) = w; }
          { const int d = task & 127, c0 = (task >> 7) * 8;
            float uu[8];
#pragma unroll
            for (int e = 0; e < 8; ++e) uu[e] = sX[(c0 + e) * XS + 128 + d];
            u32x4 w; w.x = pk2(uu[0], uu[1]); w.y = pk2(uu[2], uu[3]); w.z = pk2(uu[4], uu[5]); w.w = pk2(uu[6], uu[7]);
            *(u32x4*)(UTo + d * 64 + c0) = w; }
      }
      if (tid == 0) ((float*)(ws + OFF_DEG))[item] = __expf(sG[63]); }
    __syncthreads();
    TE(11);
}

__device__ __forceinline__ void row_items(const Params& p) {
    unsigned char* ws = p.ws;
    int tid = threadIdx.x; asm volatile("" : "+v"(tid));
    const int lane = tid & 63, wave = tid >> 6;
    const int gw = blockIdx.x * 8 + wave, NGW = gridDim.x * 8;
    const bf16_t* SG = (const bf16_t*)(ws + OFF_SG); const bf16_t* CQ = (const bf16_t*)(ws + OFF_CQ); const bf16_t* CKV = (const bf16_t*)(ws + OFF_CKV);
    const float* MISC = (const float*)(ws + OFF_MISC); const float* CS = (const float*)(ws + OFF_CS);
    float* STATS = (float*)(ws + OFF_STATS); float* RS = (float*)(ws + OFF_RS); bf16_t* KR = (bf16_t*)(ws + OFF_KR);
    for (int t = gw; t < T_; t += NGW) {
        { const u32x4 a = *(const u32x4*)(SG + (size_t)t * 2048 + 1024 + lane * 16), b = *(const u32x4*)(SG + (size_t)t * 2048 + 1024 + lane * 16 + 8);
          float v[16]; v[0] = bflo(a.x); v[1] = bfhi(a.x); v[2] = bflo(a.y); v[3] = bfhi(a.y); v[4] = bflo(a.z); v[5] = bfhi(a.z); v[6] = bflo(a.w); v[7] = bfhi(a.w);
          v[8] = bflo(b.x); v[9] = bfhi(b.x); v[10] = bflo(b.y); v[11] = bfhi(b.y); v[12] = bflo(b.z); v[13] = bfhi(b.z); v[14] = bflo(b.w); v[15] = bfhi(b.w);
          float s = 0.f;
#pragma unroll
          for (int e = 0; e < 16; ++e) s += v[e];
          const float mean = wave_sum(s) * (1.f / 1024.f); float s2 = 0.f;
#pragma unroll
          for (int e = 0; e < 16; ++e) { const float d = v[e] - mean; s2 += d * d; }
          const float rstd = rsqrtf(wave_sum(s2) * (1.f / 1024.f) + 1e-5f);
          if (lane == 0) { STATS[t * 2] = mean; STATS[t * 2 + 1] = rstd; } }
        float rsq_, rskv_;
        { const u32x4 a = *(const u32x4*)(CQ + (size_t)t * 512 + lane * 8), b = *(const u32x4*)(CKV + (size_t)t * 512 + lane * 8);
          float sa = bflo(a.x) * bflo(a.x) + bfhi(a.x) * bfhi(a.x) + bflo(a.y) * bflo(a.y) + bfhi(a.y) * bfhi(a.y) + bflo(a.z) * bflo(a.z) + bfhi(a.z) * bfhi(a.z) + bflo(a.w) * bflo(a.w) + bfhi(a.w) * bfhi(a.w);
          float sb = bflo(b.x) * bflo(b.x) + bfhi(b.x) * bfhi(b.x) + bflo(b.y) * bflo(b.y) + bfhi(b.y) * bfhi(b.y) + bflo(b.z) * bflo(b.z) + bfhi(b.z) * bfhi(b.z) + bflo(b.w) * bflo(b.w) + bfhi(b.w) * bfhi(b.w);
          sa = wave_sum(sa); sb = wave_sum(sb);
          rsq_ = rsqrtf(sa * (1.f / 512.f) + EPS); rskv_ = rsqrtf(sb * (1.f / 512.f) + EPS);
          if (lane == 0) { RS[t] = rsq_; RS[T_ + t] = rskv_; } }
        if (lane < 32) { const float x1 = MISC[(size_t)t * 128 + lane], x2 = MISC[(size_t)t * 128 + 32 + lane];
            const float c = CS[(size_t)t * 64 + lane], s = CS[(size_t)t * 64 + 32 + lane];
            const float ik = 1.f / rskv_;
            KR[(size_t)t * 64 + lane] = f2bf((x1 * c - x2 * s) * ik); KR[(size_t)t * 64 + 32 + lane] = f2bf((x1 * s + x2 * c) * ik); }
    }
}

__device__ __forceinline__ void dn_scan_item(const Params& p, int l, LAS unsigned char* lds, int bh) {
    unsigned char* ws = p.ws;
    int tid = threadIdx.x; asm volatile("" : "+v"(tid));
    const int lane = tid & 63, wave = tid >> 6, jl = lane & 15, g = lane >> 4;
    const int b = bh >> 3, h = bh & 7, dv0 = wave * 16;
    LAS bf16_t* sW = (LAS bf16_t*)lds; LAS bf16_t* sQG = sW + 64 * 136; LAS bf16_t* sKGT = sQG + 64 * 136; LAS bf16_t* sUT = sKGT + 128 * 72; LAS bf16_t* sQK = sUT + 128 * 72;
    LAS float* sO = (LAS float*)(sQK + 64 * 72);
    const bf16_t* Z = (const bf16_t*)(ws + OFF_Z); bf16_t* OA = (bf16_t*)(ws + OFF_OA);
    const float* EGp = (const float*)(ws + OFF_DEG);
    const int fc = wave * 8 + (lane >> 3), fd0 = (lane & 7) * 16;
    f32x4 ngv[4];
#pragma unroll
    for (int k = 0; k < 4; ++k) ngv[k] = *(const f32x4*)(p.dng + l * 128 + fd0 + 4 * k);
    const int gA = (tid >> 4) * 128 + (tid & 15) * 8, lA = (tid >> 4) * 136 + (tid & 15) * 8;
    const int gB = (tid >> 3) * 64 + (tid & 7) * 8, lB = (tid >> 3) * 72 + (tid & 7) * 8;
    u32x4 r[9];
#define SCAN_LOAD(nn) do { const size_t it_ = (size_t)((b * 32 + (nn)) * 8 + h); \
        const bf16_t* Wg = (const bf16_t*)(ws + OFF_DW) + it_ * 8192; const bf16_t* QGg = (const bf16_t*)(ws + OFF_DQG) + it_ * 8192; \
        const bf16_t* KGg = (const bf16_t*)(ws + OFF_DKGT) + it_ * 8192; const bf16_t* UTg = (const bf16_t*)(ws + OFF_DUT) + it_ * 8192; const bf16_t* QKg = (const bf16_t*)(ws + OFF_DQK) + it_ * 4096; \
        r[0] = *(const u32x4*)(Wg + gA); r[1] = *(const u32x4*)(Wg + gA + 32 * 128); r[2] = *(const u32x4*)(QGg + gA); r[3] = *(const u32x4*)(QGg + gA + 32 * 128); \
        r[4] = *(const u32x4*)(KGg + gB); r[5] = *(const u32x4*)(KGg + gB + 64 * 64); r[6] = *(const u32x4*)(UTg + gB); r[7] = *(const u32x4*)(UTg + gB + 64 * 64); r[8] = *(const u32x4*)(QKg + gB); } while (0)
#define SCAN_STORE() do { *(LAS u32x4*)(sW + lA) = r[0]; *(LAS u32x4*)(sW + lA + 32 * 136) = r[1]; *(LAS u32x4*)(sQG + lA) = r[2]; *(LAS u32x4*)(sQG + lA + 32 * 136) = r[3]; \
        *(LAS u32x4*)(sKGT + lB) = r[4]; *(LAS u32x4*)(sKGT + lB + 64 * 72) = r[5]; *(LAS u32x4*)(sUT + lB) = r[6]; *(LAS u32x4*)(sUT + lB + 64 * 72) = r[7]; *(LAS u32x4*)(sQK + lB) = r[8]; } while (0)
    f32x4 S[8];
#pragma unroll
    for (int i = 0; i < 8; ++i) S[i] = (f32x4){0.f, 0.f, 0.f, 0.f};
    __syncthreads();
    SCAN_LOAD(0); SCAN_STORE();
    __syncthreads();
    for (int n = 0; n < 32; ++n) {
        const int item = (b * 32 + n) * 8 + h;
        if (n + 1 < 32) SCAN_LOAD(n + 1);
        const float eg = EGp[item];
        const size_t tokf = (size_t)b * SEQ_ + n * 64 + fc;
        const u32x4 zw0 = *(const u32x4*)(Z + tokf * 1024 + h * 128 + fd0), zw1 = *(const u32x4*)(Z + tokf * 1024 + h * 128 + fd0 + 8);
        bf16x8 sf[4];
#pragma unroll
        for (int ks = 0; ks < 4; ++ks) sf[ks] = pack8(S[2 * ks], S[2 * ks + 1]);
#define SB __builtin_amdgcn_sched_barrier(0)
        f32x4 vn[4];
        bf16x8 vf[2];
        { bf16x8 wf[4][4]; u32x2 uw[4];
#pragma unroll
          for (int cb = 0; cb < 4; ++cb)
#pragma unroll
              for (int ks = 0; ks < 4; ++ks) wf[cb][ks] = *(const LAS bf16x8*)(sW + (cb * 16 + jl) * 136 + ks * 32 + g * 8);
#pragma unroll
          for (int cb = 0; cb < 4; ++cb) uw[cb] = *(const LAS u32x2*)(sUT + (dv0 + jl) * 72 + cb * 16 + g * 4);
          SB;
          bf16x8 qa[2][4];
#pragma unroll
          for (int cb = 0; cb < 2; ++cb)
#pragma unroll
              for (int ks = 0; ks < 4; ++ks) qa[cb][ks] = *(const LAS bf16x8*)(sQG + (cb * 16 + jl) * 136 + ks * 32 + g * 8);
          f32x4 ac[4], aq[4];
#pragma unroll
          for (int cb = 0; cb < 4; ++cb) { ac[cb] = (f32x4){0.f, 0.f, 0.f, 0.f}; aq[cb] = ac[cb]; }
#pragma unroll
          for (int ks = 0; ks < 4; ++ks)
#pragma unroll
              for (int cb = 0; cb < 4; ++cb) ac[cb] = MFMA16(wf[cb][ks], sf[ks], ac[cb]);
          SB;
          bf16x8 qb[2][4];
#pragma unroll
          for (int cb = 0; cb < 2; ++cb)
#pragma unroll
              for (int ks = 0; ks < 4; ++ks) qb[cb][ks] = *(const LAS bf16x8*)(sQG + ((cb + 2) * 16 + jl) * 136 + ks * 32 + g * 8);
#pragma unroll
          for (int ks = 0; ks < 4; ++ks)
#pragma unroll
              for (int cb = 0; cb < 2; ++cb) aq[cb] = MFMA16(qa[cb][ks], sf[ks], aq[cb]);
          SB;
          bf16x8 kq[4][2];
#pragma unroll
          for (int cb = 0; cb < 4; ++cb)
#pragma unroll
              for (int k2 = 0; k2 < 2; ++k2) kq[cb][k2] = *(const LAS bf16x8*)(sQK + (cb * 16 + jl) * 72 + k2 * 32 + g * 8);
#pragma unroll
          for (int ks = 0; ks < 4; ++ks)
#pragma unroll
              for (int cb = 0; cb < 2; ++cb) aq[cb + 2] = MFMA16(qb[cb][ks], sf[ks], aq[cb + 2]);
#pragma unroll
          for (int cb = 0; cb < 4; ++cb) vn[cb] = (f32x4){bflo(uw[cb].x), bfhi(uw[cb].x), bflo(uw[cb].y), bfhi(uw[cb].y)} - ac[cb];
          vf[0] = pack8(vn[0], vn[1]); vf[1] = pack8(vn[2], vn[3]);
#pragma unroll
          for (int db = 0; db < 8; ++db) S[db] = S[db] * eg;
          SB;
          bf16x8 ka[4][2];
#pragma unroll
          for (int db = 0; db < 4; ++db)
#pragma unroll
              for (int k2 = 0; k2 < 2; ++k2) ka[db][k2] = *(const LAS bf16x8*)(sKGT + (db * 16 + jl) * 72 + k2 * 32 + g * 8);
#pragma unroll
          for (int k2 = 0; k2 < 2; ++k2)
#pragma unroll
              for (int cb = 0; cb < 4; ++cb) aq[cb] = MFMA16(kq[cb][k2], vf[k2], aq[cb]);
          SB;
          bf16x8 kb2[4][2];
#pragma unroll
          for (int db = 0; db < 4; ++db)
#pragma unroll
              for (int k2 = 0; k2 < 2; ++k2) kb2[db][k2] = *(const LAS bf16x8*)(sKGT + ((db + 4) * 16 + jl) * 72 + k2 * 32 + g * 8);
#pragma unroll
          for (int k2 = 0; k2 < 2; ++k2)
#pragma unroll
              for (int db = 0; db < 4; ++db) S[db] = MFMA16(ka[db][k2], vf[k2], S[db]);
#pragma unroll
          for (int cb = 0; cb < 4; ++cb)
#pragma unroll
              for (int rr = 0; rr < 4; ++rr) sO[(cb * 16 + g * 4 + rr) * 132 + dv0 + jl] = aq[cb][rr];
          SB;
#pragma unroll
          for (int k2 = 0; k2 < 2; ++k2)
#pragma unroll
              for (int db = 0; db < 4; ++db) S[db + 4] = MFMA16(kb2[db][k2], vf[k2], S[db + 4]); }
#undef SB
        __syncthreads();
        if (n + 1 < 32) SCAN_STORE();
        { f32x4 ov[4]; float ss = 0.f;
#pragma unroll
          for (int k = 0; k < 4; ++k) { ov[k] = *(const LAS f32x4*)(sO + fc * 132 + fd0 + 4 * k); ss += ov[k][0] * ov[k][0] + ov[k][1] * ov[k][1] + ov[k][2] * ov[k][2] + ov[k][3] * ov[k][3]; }
          ss += __shfl_xor(ss, 1); ss += __shfl_xor(ss, 2); ss += __shfl_xor(ss, 4);
          const float rs = rsqrtf(ss * (1.f / 128.f) + EPS);
          const unsigned zu[8] = {zw0.x, zw0.y, zw0.z, zw0.w, zw1.x, zw1.y, zw1.z, zw1.w};
          unsigned ow[8];
#pragma unroll
          for (int k = 0; k < 4; ++k) { const f32x4 y = ov[k] * rs * ngv[k];
              ow[2 * k] = pk2(y[0] * siluf_(bflo(zu[2 * k])), y[1] * siluf_(bfhi(zu[2 * k])));
              ow[2 * k + 1] = pk2(y[2] * siluf_(bflo(zu[2 * k + 1])), y[3] * siluf_(bfhi(zu[2 * k + 1]))); }
          *(u32x4*)(OA + tokf * 1024 + h * 128 + fd0) = (u32x4){ow[0], ow[1], ow[2], ow[3]};
          *(u32x4*)(OA + tokf * 1024 + h * 128 + fd0 + 8) = (u32x4){ow[4], ow[5], ow[6], ow[7]}; }
        __syncthreads();
    }
#undef SCAN_LOAD
#undef SCAN_STORE
}

__device__ __forceinline__ void attn_block_item(const Params& p, LAS unsigned char* lds, int idx) {
    unsigned char* ws = p.ws;
    int tid = threadIdx.x; asm volatile("" : "+v"(tid));
    const int lane = tid & 63, wave = tid >> 6, jl = lane & 15, g = lane >> 4;
    const int qblk = 7 - (idx >> 5), bh = idx & 31, b = bh >> 3, h = bh & 7;
    const int s0 = qblk * 256 + wave * 32; const size_t tq = (size_t)b * SEQ_ + s0 + jl;
    const int mychunk = s0 >> 6, ntiles = 4 * qblk + 4;
    const bf16_t* QB = (const bf16_t*)(ws + OFF_QB);
    bf16x8 qf[2][6];
#pragma unroll
    for (int u = 0; u < 2; ++u)
#pragma unroll
        for (int ks = 0; ks < 6; ++ks) qf[u][ks] = *(const bf16x8*)(QB + (tq + u * 16) * 1536 + h * 192 + ks * 32 + g * 8);
    const bf16_t* kp[3]; int kst[3], kl[3];
#pragma unroll
    for (int k = 0; k < 3; ++k) { const int q = tid + 512 * k, row = q / 24, pc = q - row * 24;
        if (pc < 16) { kp[k] = (const bf16_t*)(ws + OFF_KN) + ((size_t)b * SEQ_ + row) * 1024 + h * 128 + pc * 8; kst[k] = 64 * 1024; }
        else { kp[k] = (const bf16_t*)(ws + OFF_KR) + ((size_t)b * SEQ_ + row) * 64 + (pc - 16) * 8; kst[k] = 64 * 64; }
        kl[k] = row * 200 + pc * 8; }
    const bf16_t* vp[2]; int vl[2];
#pragma unroll
    for (int k = 0; k < 2; ++k) { const int q = tid + 512 * k, row = q >> 3, pc = q & 7;
        vp[k] = (const bf16_t*)(ws + OFF_VT) + (size_t)(h * 128 + row) * 8192 + (size_t)b * SEQ_ + pc * 8;
        vl[k] = row * 72 + (pc >> 2) * 32 + (pc & 1) * 16 + ((pc >> 1) & 1) * 4; }
    u32x4 rk[3], rv[2];
    const float* RSp = (const float*)(ws + OFF_RS);
    const float rq0 = RSp[tq], rq1 = RSp[tq + 16];
    const float* rkvp = RSp + T_ + (size_t)b * SEQ_ + g * 4;
    f32x4 kvs[4];
#define AT_LOAD(tile) do { _Pragma("unroll") for (int k = 0; k < 3; ++k) rk[k] = *(const u32x4*)(kp[k] + (size_t)(tile) * kst[k]); \
        _Pragma("unroll") for (int k = 0; k < 2; ++k) rv[k] = *(const u32x4*)(vp[k] + (tile) * 64); } while (0)
#define AT_STORE(bi) do { LAS bf16_t* sKb = (LAS bf16_t*)(lds + (bi) * 44032); LAS bf16_t* sVb = sKb + 64 * 200; \
        _Pragma("unroll") for (int k = 0; k < 3; ++k) *(LAS u32x4*)(sKb + kl[k]) = rk[k]; \
        _Pragma("unroll") for (int k = 0; k < 2; ++k) { *(LAS u32x2*)(sVb + vl[k]) = (u32x2){rv[k].x, rv[k].y}; *(LAS u32x2*)(sVb + vl[k] + 8) = (u32x2){rv[k].z, rv[k].w}; } } while (0)
    f32x4 o[2][8];
#pragma unroll
    for (int u = 0; u < 2; ++u)
#pragma unroll
        for (int i = 0; i < 8; ++i) o[u][i] = (f32x4){0.f, 0.f, 0.f, 0.f};
    float mrun[2] = {-1e30f, -1e30f}, lsum[2] = {0.f, 0.f};
    __syncthreads();
    AT_LOAD(0); AT_STORE(0);
    if (ntiles > 1) AT_LOAD(1);
    __syncthreads();
    for (int t = 0; t < ntiles; ++t) {
#pragma unroll
        for (int sb = 0; sb < 4; ++sb) kvs[sb] = *(const f32x4*)(rkvp + t * 64 + sb * 16);
        if (t + 1 < ntiles) { AT_STORE((t + 1) & 1); if (t + 2 < ntiles) AT_LOAD(t + 2); }
        if (t <= mychunk) {
            const LAS bf16_t* sKb = (const LAS bf16_t*)(lds + (t & 1) * 44032); const LAS bf16_t* sVb = sKb + 64 * 200;
            f32x4 s[2][4];
            {
              bf16x8 kfr[2][3];
#pragma unroll
              for (int k3 = 0; k3 < 3; ++k3) kfr[0][k3] = *(const LAS bf16x8*)(sKb + jl * 200 + k3 * 32 + g * 8);
              __builtin_amdgcn_sched_barrier(0);
              f32x4 a0 = (f32x4){0.f, 0.f, 0.f, 0.f}, a1 = a0;
#pragma unroll
              for (int hs = 0; hs < 8; ++hs) { const int sb = hs >> 1, kh = hs & 1;
                  if (hs + 1 < 8) { const int sb2 = (hs + 1) >> 1, kh2 = (hs + 1) & 1;
#pragma unroll
                      for (int k3 = 0; k3 < 3; ++k3) kfr[(hs + 1) & 1][k3] = *(const LAS bf16x8*)(sKb + (sb2 * 16 + jl) * 200 + (kh2 * 3 + k3) * 32 + g * 8); }
#pragma unroll
                  for (int k3 = 0; k3 < 3; ++k3) { a0 = MFMA16(kfr[hs & 1][k3], qf[0][kh * 3 + k3], a0); a1 = MFMA16(kfr[hs & 1][k3], qf[1][kh * 3 + k3], a1); }
                  if (kh == 1) { s[0][sb] = a0 * kvs[sb] * rq0; s[1][sb] = a1 * kvs[sb] * rq1; a0 = (f32x4){0.f, 0.f, 0.f, 0.f}; a1 = a0; }
                  __builtin_amdgcn_sched_barrier(0); } }
            bf16x8 pf[2][2]; float alpha[2];
#pragma unroll
            for (int u = 0; u < 2; ++u) {
                float mx = -1e30f;
#pragma unroll
                for (int sb = 0; sb < 4; ++sb) mx = fmaxf(mx, fmaxf(fmaxf(s[u][sb][0], s[u][sb][1]), fmaxf(s[u][sb][2], s[u][sb][3])));
                mx = fmaxf(mx, __shfl_xor(mx, 16)); mx = fmaxf(mx, __shfl_xor(mx, 32));
                const float mnew = fmaxf(mrun[u], mx); alpha[u] = __builtin_amdgcn_exp2f(mrun[u] - mnew); mrun[u] = mnew;
                float ps = 0.f;
#pragma unroll
                for (int sb = 0; sb < 4; ++sb)
#pragma unroll
                    for (int r = 0; r < 4; ++r) { const float pv = __builtin_amdgcn_exp2f(s[u][sb][r] - mnew); s[u][sb][r] = pv; ps += pv; }
                lsum[u] = lsum[u] * alpha[u] + ps;
                pf[u][0] = pack8(s[u][0] * kvs[0], s[u][1] * kvs[1]); pf[u][1] = pack8(s[u][2] * kvs[2], s[u][3] * kvs[3]); }
            { bf16x8 vfr[2][2];
#pragma unroll
              for (int k2 = 0; k2 < 2; ++k2) vfr[0][k2] = *(const LAS bf16x8*)(sVb + jl * 72 + k2 * 32 + g * 8);
              __builtin_amdgcn_sched_barrier(0);
#pragma unroll
              for (int db = 0; db < 8; ++db) {
                  if (db + 1 < 8) {
#pragma unroll
                      for (int k2 = 0; k2 < 2; ++k2) vfr[(db + 1) & 1][k2] = *(const LAS bf16x8*)(sVb + ((db + 1) * 16 + jl) * 72 + k2 * 32 + g * 8); }
                  f32x4 c0 = o[0][db] * alpha[0], c1 = o[1][db] * alpha[1];
#pragma unroll
                  for (int k2 = 0; k2 < 2; ++k2) { c0 = MFMA16(vfr[db & 1][k2], pf[0][k2], c0); c1 = MFMA16(vfr[db & 1][k2], pf[1][k2], c1); }
                  o[0][db] = c0; o[1][db] = c1;
                  __builtin_amdgcn_sched_barrier(0); } }
        }
        __syncthreads();
    }
#undef AT_LOAD
#undef AT_STORE
    bf16_t* OC = (bf16_t*)(ws + OFF_OC);
#pragma unroll
    for (int u = 0; u < 2; ++u) { float lt = lsum[u]; lt += __shfl_xor(lt, 16); lt += __shfl_xor(lt, 32); const float inv = __builtin_amdgcn_rcpf(lt);
#pragma unroll
        for (int db = 0; db < 8; ++db) { const f32x4 v = o[u][db] * inv; u32x2 w; w.x = pk2(v[0], v[1]); w.y = pk2(v[2], v[3]);
            *(u32x2*)(OC + (tq + u * 16) * 1024 + h * 128 + db * 16 + g * 4) = w; } }
}

__device__ __forceinline__ void sg_wave_item(const Params& p, int l, int widx) {
    unsigned char* ws = p.ws;
    int tid = threadIdx.x; asm volatile("" : "+v"(tid));
    const int lane = tid & 63, wave = widx & 7, idx = widx >> 3, jl = lane & 15, g = lane >> 4;
    const int gi = idx & 7, nb = (idx >> 3) & 15, b = idx >> 7;
    const size_t t0 = (size_t)b * SEQ_ + nb * 128; const int cc = gi * 128 + wave * 16 + jl;
    const bf16_t* SG = (const bf16_t*)(ws + OFF_SG); const float* STATS = (const float*)(ws + OFF_STATS); const bf16_t* SGW = (const bf16_t*)(ws + OFF_SGW);
    bf16_t* OB = (bf16_t*)(ws + OFF_OB);
    const float lg = p.lng[l * 1024 + cc], lb = p.lnb[l * 1024 + cc];
#define SB __builtin_amdgcn_sched_barrier(0)
    bf16x8 bfr[4];
    { bf16_t vr[4][8]; f32x4 st[4][4];
#pragma unroll
      for (int kb = 0; kb < 4; ++kb) {
#pragma unroll
          for (int e = 0; e < 8; ++e) vr[kb][e] = SG[(t0 + kb * 32 + g * 8 + e) * 2048 + 1024 + cc];
#pragma unroll
          for (int q = 0; q < 4; ++q) st[kb][q] = *(const f32x4*)(STATS + (t0 + kb * 32 + g * 8 + 2 * q) * 2); }
      SB;
#pragma unroll
      for (int kb = 0; kb < 4; ++kb) { float v[8];
#pragma unroll
          for (int q = 0; q < 4; ++q) { v[2 * q] = (bf1(vr[kb][2 * q]) - st[kb][q][0]) * st[kb][q][1] * lg + lb; v[2 * q + 1] = (bf1(vr[kb][2 * q + 1]) - st[kb][q][2]) * st[kb][q][3] * lg + lb; }
          u32x4 w; w.x = pk2(v[0], v[1]); w.y = pk2(v[2], v[3]); w.z = pk2(v[4], v[5]); w.w = pk2(v[6], v[7]); bfr[kb] = __builtin_bit_cast(bf16x8, w); } }
    SB;
    bf16_t ur[8][4]; f32x4 sbv[8];
#pragma unroll
    for (int ib = 0; ib < 8; ++ib) {
#pragma unroll
        for (int r = 0; r < 4; ++r) ur[ib][r] = SG[(t0 + ib * 16 + g * 4 + r) * 2048 + cc];
        sbv[ib] = *(const f32x4*)(p.sgb + l * 1024 + gi * 128 + ib * 16 + g * 4); }
    bf16x8 af[2][4];
#pragma unroll
    for (int kb = 0; kb < 4; ++kb) af[0][kb] = *(const bf16x8*)(SGW + (size_t)(gi * 128 + jl) * 128 + kb * 32 + g * 8);
    SB;
#pragma unroll
    for (int ib = 0; ib < 8; ++ib) {
        if (ib + 1 < 8) {
#pragma unroll
            for (int kb = 0; kb < 4; ++kb) af[(ib + 1) & 1][kb] = *(const bf16x8*)(SGW + (size_t)(gi * 128 + (ib + 1) * 16 + jl) * 128 + kb * 32 + g * 8); }
        f32x4 acc = (f32x4){0.f, 0.f, 0.f, 0.f};
#pragma unroll
        for (int kb = 0; kb < 4; ++kb) acc = MFMA16(af[ib & 1][kb], bfr[kb], acc);
#pragma unroll
        for (int r = 0; r < 4; ++r) { const size_t tok = t0 + ib * 16 + g * 4 + r;
            OB[tok * 1024 + cc] = f2bf(bf1(ur[ib][r]) * (acc[r] + sbv[ib][r])); }
        SB;
    }
#undef SB
}

#define XB_TMO      128
#define XB_XCNT(j)  (256  + 64 * (j))
#define XB_XSUB(j)  (1280 + 64 * (j))
#define XB_XGEN(j)  (2304 + 64 * (j))
#define XB_TOP      3328
#define XB_TOPGEN   3392
#define XCD_BAR_WORDS 3456
#define XB_SPIN_CAP (1u << 18)
__device__ __forceinline__ unsigned xb_ld(unsigned* p)              { return __hip_atomic_load(p, __ATOMIC_RELAXED, __HIP_MEMORY_SCOPE_AGENT); }
__device__ __forceinline__ unsigned xb_add(unsigned* p, unsigned v) { return __hip_atomic_fetch_add(p, v, __ATOMIC_RELAXED, __HIP_MEMORY_SCOPE_AGENT); }
__device__ __forceinline__ unsigned xb_xcc_id() { return (unsigned)__builtin_amdgcn_s_getreg((3 << 11) | 20) & 0xFu; }
#define XB_SPIN(cond, bar) do { unsigned _sp = 0; while (cond) { __builtin_amdgcn_s_sleep(1); \
    if ((++_sp & 255u) == 0u) { if (xb_ld(&(bar)[XB_TMO])) break; if (_sp > XB_SPIN_CAP) { atomicAdd(&(bar)[XB_TMO], 1u); break; } } } } while (0)
__device__ __forceinline__ void xcd_barrier_complete(unsigned* bar, unsigned x, unsigned& nloc, unsigned& nx) {
    const unsigned G = gridDim.x * gridDim.y * gridDim.z;
    unsigned sum, cnt, mine, sp = 0u;
    for (;;) {
        sum = 0u; cnt = 0u; mine = 0u;
#pragma unroll
        for (unsigned j = 0; j < 16; ++j) { const unsigned c = xb_ld(&bar[XB_XCNT(j)]); sum += c; cnt += (c > 0u) ? 1u : 0u; mine = (j == x) ? c : mine; }
        if (sum == G) break;
        __builtin_amdgcn_s_sleep(1);
        if ((++sp & 255u) == 0u) { if (xb_ld(&bar[XB_TMO])) break; if (sp > XB_SPIN_CAP) { atomicAdd(&bar[XB_TMO], 1u); break; } }
    }
    nloc = mine > 0u ? mine : 1u; nx = cnt > 0u ? cnt : 1u;
}
__device__ __forceinline__ void xcd_barrier(unsigned* bar, volatile LAS unsigned* st) {
    asm volatile("s_waitcnt vmcnt(0)" ::: "memory");
    __syncthreads();
    if (threadIdx.x == 0) {
        const unsigned x = xb_xcc_id();
        __builtin_amdgcn_s_waitcnt(0);
        unsigned nloc = st[0], nx = st[1];
        if (nloc == 0u) { xcd_barrier_complete(bar, x, nloc, nx); st[0] = nloc; st[1] = nx; }
        const unsigned old = xb_add(&bar[XB_XSUB(x)], 1u);
        const unsigned gen = old / nloc;
        if (old + 1u == (gen + 1u) * nloc) {
            __builtin_amdgcn_fence(__ATOMIC_RELEASE, "agent");
            asm volatile("s_waitcnt vmcnt(0)" ::: "memory");
            const unsigned og = xb_add(&bar[XB_TOP], 1u);
            const unsigned tg = og / nx;
            if (og + 1u == (tg + 1u) * nx) xb_add(&bar[XB_TOPGEN], 1u);
            else XB_SPIN(xb_ld(&bar[XB_TOPGEN]) == tg, bar);
            __builtin_amdgcn_fence(__ATOMIC_ACQUIRE, "agent");
            xb_add(&bar[XB_XGEN(x)], 1u);
            asm volatile("s_waitcnt vmcnt(0)" ::: "memory");
        } else {
            XB_SPIN(xb_ld(&bar[XB_XGEN(x)]) == gen, bar);
            __builtin_amdgcn_fence(__ATOMIC_ACQUIRE, "agent");
            asm volatile("s_waitcnt vmcnt(0)" ::: "memory");
        }
    }
    __syncthreads();
}

#ifndef NREP_GEMM
#define NREP_GEMM 1
#endif
#ifndef NREP_MIX
#define NREP_MIX 1
#endif
#ifndef NREP_PREP
#define NREP_PREP NREP_MIX
#endif
#ifndef NREP_P7
#define NREP_P7 NREP_MIX
#endif
#ifndef NREP_ROW
#define NREP_ROW 0
#endif
#ifndef NREP_CVT
#define NREP_CVT 1
#endif
#ifndef NREP_SYNC
#define NREP_SYNC 1
#endif
#define GSYNC() do { TB(4); for (int r_ = 0; r_ < NREP_SYNC; ++r_) { PQ xcd_barrier((unsigned*)(ws + OFF_BAR), (volatile LAS unsigned*)(shm + LDS_ST)); } TE(4); } while (0)
#define RG for (int rg_ = 0; rg_ < NREP_GEMM; ++rg_)
typedef const Params __attribute__((address_space(4)))* KP;
__device__ __forceinline__ Params ldp(KP q) {
#if defined(__HIP_DEVICE_COMPILE__)
    asm volatile("" : "+s"(q)); return *q;
#else
    return Params{};
#endif
}
#define PQ const Params p = ldp(kp); unsigned char* ws = p.ws; (void)ws;
__global__ __launch_bounds__(512, 2) void fwd_megakernel(Params p_unused) {
    extern __shared__ __attribute__((aligned(16))) unsigned char shm[];
    LAS unsigned char* lds = (LAS unsigned char*)shm;
    LAS float* L = (LAS float*)shm;
    LAS int* s_item = (LAS int*)(shm + LDS_ITEM);
    cg::grid_group grid = cg::this_grid();
    KP kp = (KP)__builtin_amdgcn_kernarg_segment_ptr();
    unsigned long long t0_ = 0, tacc_ = 0; (void)t0_; (void)tacc_;
#ifdef TCAT
    const unsigned long long tstart_ = __builtin_amdgcn_s_memrealtime();
#endif
    if (threadIdx.x == 0) { LAS unsigned* st = (LAS unsigned*)(shm + LDS_ST); st[0] = 0u; st[1] = 0u; PQ (void)xb_add((unsigned*)(ws + OFF_BAR) + XB_XCNT(xb_xcc_id()), 1u); }
    __syncthreads();

#ifndef NO_CVT
    TB(5); for (int rc_ = 0; rc_ < NREP_CVT; ++rc_) { PQ convert_layer(p, 0, lds); } TE(5);
#endif
    { PQ int tid = threadIdx.x; asm volatile("" : "+v"(tid));
      const size_t gt = (size_t)blockIdx.x * 512 + tid, NGT = (size_t)gridDim.x * 512; float* CS = (float*)(ws + OFF_CS);
      for (size_t e = gt; e < (size_t)T_ * 32; e += NGT) { const int t = (int)(e >> 5), i = (int)(e & 31);
          const float inv_freq = exp2f(-(float)(2 * i) * (1.f / 64.f) * 13.287712379549449f);
          const float ang = (float)p.pos[t] * inv_freq; float sn, cs; sn = sinf(ang); cs = cosf(ang);
          CS[(size_t)t * 64 + i] = cs; CS[(size_t)t * 64 + 32 + i] = sn; }
      if (gt < 64) ((unsigned*)(ws + OFF_CTR))[gt] = 0u; }
    TB(6); { PQ rowpass(p.x, nullptr, 0.f, nullptr, p.norm_g, p.out, (bf16_t*)(ws + OFF_H)); } TE(6);
    GSYNC();
    { PQ if (p.ws == nullptr) grid.sync(); }

    for (int l = 0; l < 2; ++l) {
        TB(1); RG { PQ EpiSwiGLU e; e.O = (bf16_t*)(ws + OFF_GATE); run_gemm(lds, (const bf16_t*)(ws + OFF_H), (const bf16_t*)(ws + OFF_WGU), T_, 11264, 2048, e); } TE(1);
        GSYNC();
        TB(1); RG { PQ EpiBf16Out e; e.O = (bf16_t*)(ws + OFF_F); e.ldc = DM; run_gemm(lds, (const bf16_t*)(ws + OFF_GATE), (const bf16_t*)(ws + OFF_WDN), T_, 2048, FF, e); } TE(1);
        GSYNC();
        for (int rr_ = 0; rr_ < NREP_ROW; ++rr_) { PQ const float* ng = p.norm_g + (size_t)l * 6 * DM; rowpass(p.out, (const bf16_t*)(ws + OFF_F), 0.0f, ng + DM, ng + 2 * DM, p.out, (bf16_t*)(ws + OFF_H)); }
        TB(6); { PQ const float* ng = p.norm_g + (size_t)l * 6 * DM; rowpass(p.out, (const bf16_t*)(ws + OFF_F), 0.5f, ng + DM, ng + 2 * DM, p.out, (bf16_t*)(ws + OFF_H)); } TE(6);
        GSYNC();
        TB(1); RG { PQ EpiWin e; e.ws = ws; run_gemm(lds, (const bf16_t*)(ws + OFF_H), (const bf16_t*)(ws + OFF_WIN), T_, NINP, 2048, e); } TE(1);
        GSYNC();
        TB(1); RG { PQ EpiQ e; e.QB = (bf16_t*)(ws + OFF_QB); e.RS = (const float*)(ws + OFF_RS); e.CS = (const float*)(ws + OFF_CS); e.qscale = 0.07216878364870322f * 1.4426950408889634f;
          run_gemm(lds, (const bf16_t*)(ws + OFF_CQ), (const bf16_t*)(ws + OFF_WUQ), T_, 1536, 512, e); } TE(1);
        TB(1); RG { PQ EpiKN e; e.O = (bf16_t*)(ws + OFF_KN); e.RS = (const float*)(ws + OFF_RS);
          run_gemm(lds, (const bf16_t*)(ws + OFF_CKV), (const bf16_t*)(ws + OFF_WUKV), T_, 1024, 512, e); } TE(1);
        TB(1); RG { PQ EpiVT e; e.O = (bf16_t*)(ws + OFF_VT); e.RS = (const float*)(ws + OFF_RS);
          run_gemm(lds, (const bf16_t*)(ws + OFF_WUKV) + (size_t)1024 * 512, (const bf16_t*)(ws + OFF_CKV), 1024, T_, 512, e); } TE(1);
        TB(2);
        for (int rm_ = 0; rm_ < NREP_PREP; ++rm_) {
#ifndef NO_PREP
        for (;;) {
            PQ
            __syncthreads();
            if (threadIdx.x == 0) *s_item = (int)atomicAdd((unsigned*)(ws + OFF_CTR) + 24 + l + 2 * rm_, 1u);
            __syncthreads();
            const int item = *s_item;
            if (item >= 1024) break;
            dn_prep_item(p, l, L, item, t0_, tacc_);
        }
#endif
#ifndef NO_ROWI
        TB(12); { PQ row_items(p); } TE(12);
#endif
        }
        TE(2);
        GSYNC();
        TB(3);
        for (int rm_ = 0; rm_ < NREP_P7; ++rm_) {
        for (;;) {
            PQ
            __syncthreads();
            if (threadIdx.x == 0) *s_item = (int)atomicAdd((unsigned*)(ws + OFF_CTR) + l + 8 * rm_, 1u);
            __syncthreads();
            const int it = *s_item;
            if (it >= 32 + 256) break;
            if (it < 32) dn_scan_item(p, l, lds, it);
            else attn_block_item(p, lds, it - 32);
        }
        for (;;) {
            PQ
            int it = 0;
            if ((threadIdx.x & 63) == 0) it = (int)atomicAdd((unsigned*)(ws + OFF_CTR) + 4 + l + 8 * rm_, 1u);
            it = __builtin_amdgcn_readfirstlane(it);
            if (it >= 4096) break;
            sg_wave_item(p, l, it);
        }
        }
        TE(3);
        GSYNC();
        TB(1); { PQ EpiBranchFused e; e.GATE = (const bf16_t*)(ws + OFF_GATE); e.OUT = (bf16_t*)(ws + OFF_MERGED); run_branch_gemm(lds, (const bf16_t*)(ws + OFF_OA), (const bf16_t*)(ws + OFF_WBR), e); } TE(1);
        GSYNC();
        TB(1); RG { PQ EpiBf16Out e; e.O = (bf16_t*)(ws + OFF_F); e.ldc = DM; run_gemm(lds, (const bf16_t*)(ws + OFF_MERGED), (const bf16_t*)(ws + OFF_WOUT), T_, 2048, 2048, e); } TE(1);
        GSYNC();
        for (int rr_ = 0; rr_ < NREP_ROW; ++rr_) { PQ const float* ng = p.norm_g + (size_t)l * 6 * DM; rowpass(p.out, (const bf16_t*)(ws + OFF_F), 0.0f, ng + 3 * DM, ng + 4 * DM, p.out, (bf16_t*)(ws + OFF_H)); }
        TB(6); { PQ const float* ng = p.norm_g + (size_t)l * 6 * DM; rowpass(p.out, (const bf16_t*)(ws + OFF_F), 1.0f, ng + 3 * DM, ng + 4 * DM, p.out, (bf16_t*)(ws + OFF_H)); } TE(6);
        GSYNC();
        TB(1); RG { PQ EpiSwiGLU e; e.O = (bf16_t*)(ws + OFF_GATE); run_gemm(lds, (const bf16_t*)(ws + OFF_H), (const bf16_t*)(ws + OFF_WGU) + (size_t)11264 * 2048, T_, 11264, 2048, e); } TE(1);
        GSYNC();
        TB(1); RG { PQ EpiBf16Out e; e.O = (bf16_t*)(ws + OFF_F); e.ldc = DM; run_gemm(lds, (const bf16_t*)(ws + OFF_GATE), (const bf16_t*)(ws + OFF_WDN) + (size_t)2048 * FF, T_, 2048, FF, e); } TE(1);
        GSYNC();
        if (l == 0) {
            for (int rr_ = 0; rr_ < NREP_ROW; ++rr_) { PQ const float* ng = p.norm_g; rowpass(p.out, (const bf16_t*)(ws + OFF_F), 0.0f, ng + 5 * DM, ng + 6 * DM, p.out, (bf16_t*)(ws + OFF_H)); }
            TB(6); { PQ const float* ng = p.norm_g; rowpass(p.out, (const bf16_t*)(ws + OFF_F), 0.5f, ng + 5 * DM, ng + 6 * DM, p.out, (bf16_t*)(ws + OFF_H)); } TE(6);
#ifndef NO_CVT
            TB(5); for (int rc_ = 0; rc_ < NREP_CVT; ++rc_) { PQ convert_layer(p, 1, lds); } TE(5);
#endif
            GSYNC();
        } else {
            for (int rr_ = 0; rr_ < NREP_ROW; ++rr_) { PQ const float* ng = p.norm_g + (size_t)6 * DM; rowpass(p.out, (const bf16_t*)(ws + OFF_F), 0.0f, ng + 5 * DM, nullptr, p.out, nullptr); }
            TB(6); { PQ const float* ng = p.norm_g + (size_t)6 * DM; rowpass(p.out, (const bf16_t*)(ws + OFF_F), 0.5f, ng + 5 * DM, nullptr, p.out, nullptr); } TE(6);
        }
    }
#ifdef TCAT
    if (blockIdx.x == 0 && threadIdx.x < 64) {
        if (TCAT == 0) tacc_ = __builtin_amdgcn_s_memrealtime() - tstart_;
        float fr = (float)tacc_ * (1.f / 800000.f); fr = fr > 1.f ? 1.f : fr;
        const float dl = 0.2f * sqrtf(fr);
        PQ
        for (int e = 0; e < 16; ++e) p.out[threadIdx.x * 16 + e] += dl;
    }
#endif
}

extern "C" void kernel_launch(void* const* d_in, const int* in_sizes, int n_in, void* d_out, int out_size, void* d_ws, size_t ws_size, hipStream_t stream) {
    static int grid_blocks = 0;
    if (!grid_blocks) {
        if (ws_size < WS_END) { fprintf(stderr, "kernel_launch: workspace too small: %zu < %zu\n", ws_size, (size_t)WS_END); grid_blocks = -1; return; }
        int dev = 0, cus = 0, per_cu = 0;
        (void)hipGetDevice(&dev);
        (void)hipDeviceGetAttribute(&cus, hipDeviceAttributeMultiprocessorCount, dev);
        if (hipFuncSetAttribute((const void*)fwd_megakernel, hipFuncAttributeMaxDynamicSharedMemorySize, LDS_BYTES) != hipSuccess) fprintf(stderr, "kernel_launch: hipFuncSetAttribute failed\n");
        if (hipOccupancyMaxActiveBlocksPerMultiprocessor(&per_cu, (const void*)fwd_megakernel, 512, LDS_BYTES) != hipSuccess || per_cu < 1) per_cu = 1;
        (void)hipGetLastError();
        grid_blocks = cus * per_cu;
    }
    if (grid_blocks < 0) return;
    Params p{};
    p.x = (const float*)d_in[0]; p.pos = (const int*)d_in[1]; p.norm_g = (const float*)d_in[2]; p.wg = (const float*)d_in[3]; p.wu = (const float*)d_in[4];
    p.wd = (const float*)d_in[5]; p.win = (const float*)d_in[6]; p.convw = (const float*)d_in[7]; p.alog = (const float*)d_in[8]; p.dtb = (const float*)d_in[9];
    p.dng = (const float*)d_in[10]; p.lng = (const float*)d_in[11]; p.lnb = (const float*)d_in[12]; p.sgw = (const float*)d_in[13]; p.sgb = (const float*)d_in[14];
    p.cqg = (const float*)d_in[15]; p.ckvg = (const float*)d_in[16]; p.wuq = (const float*)d_in[17]; p.wukv = (const float*)d_in[18]; p.wbr = (const float*)d_in[19];
    p.wout = (const float*)d_in[20]; p.out = (float*)d_out; p.ws = (unsigned char*)d_ws;
    (void)hipMemsetAsync((unsigned char*)d_ws + OFF_BAR, 0, XCD_BAR_WORDS * 4, stream);
    void* args[] = {&p};
    hipError_t e = hipLaunchCooperativeKernel((const void*)fwd_megakernel, dim3(grid_blocks), dim3(512), args, LDS_BYTES, stream);
    if (e != hipSuccess) fprintf(stderr, "cooperative launch failed: %s (grid %d)\n", hipGetErrorString(e), grid_blocks);
}
```

```cpp
#include <hip/hip_runtime.h>
#include <hip/hip_cooperative_groups.h>
#include <cstdio>
namespace cg = cooperative_groups;

#define LAS __attribute__((address_space(3)))
typedef unsigned short bf16_t;
typedef short bf16x8 __attribute__((ext_vector_type(8)));
typedef short s16x4 __attribute__((ext_vector_type(4)));
typedef float f32x4 __attribute__((ext_vector_type(4)));
typedef float f32x2 __attribute__((ext_vector_type(2)));
typedef unsigned u32x4 __attribute__((ext_vector_type(4)));
typedef unsigned u32x2 __attribute__((ext_vector_type(2)));

constexpr int T_ = 8192, DM = 2048, FF = 5632, NIN = 13392, NINP = 13568, SEQ_ = 2048;
constexpr int LDS_BYTES = 152576;
constexpr int LDS_ITEM = 152320, LDS_ST = 152336;
constexpr float EPS = 1e-6f;

constexpr size_t al256(size_t x) { return (x + 255) & ~(size_t)255; }
constexpr size_t OFF_WGU = 0;
constexpr size_t OFF_WDN = OFF_WGU + (size_t)2 * 11264 * 2048 * 2;
constexpr size_t OFF_WIN = OFF_WDN + (size_t)2 * 2048 * 5632 * 2;
constexpr size_t OFF_WUQ = OFF_WIN + (size_t)NINP * 2048 * 2;
constexpr size_t OFF_WUKV = OFF_WUQ + (size_t)1536 * 512 * 2;
constexpr size_t OFF_WBR = OFF_WUKV + (size_t)2048 * 512 * 2;
constexpr size_t OFF_WOUT = OFF_WBR + (size_t)3 * 2048 * 1024 * 2;
constexpr size_t OFF_SGW = OFF_WOUT + (size_t)2048 * 2048 * 2;
constexpr size_t OFF_H = OFF_SGW + (size_t)8 * 128 * 128 * 2;
constexpr size_t OFF_F = OFF_H + (size_t)T_ * 2048 * 2;
constexpr size_t OFF_GATE = OFF_F + (size_t)T_ * 2048 * 4;
constexpr size_t OFF_QKV = OFF_GATE + (size_t)T_ * 6144 * 2;
constexpr size_t OFF_Z = OFF_QKV + (size_t)T_ * 3072 * 2;
constexpr size_t OFF_SG = OFF_Z + (size_t)T_ * 1024 * 2;
constexpr size_t OFF_CQ = OFF_SG + (size_t)T_ * 2048 * 2;
constexpr size_t OFF_CKV = OFF_CQ + (size_t)T_ * 512 * 2;
constexpr size_t OFF_MISC = OFF_CKV + (size_t)T_ * 512 * 2;
constexpr size_t OFF_DW = OFF_MISC + (size_t)T_ * 128 * 4;
constexpr size_t OFF_DQG = OFF_DW + (size_t)1024 * 8192 * 2;
constexpr size_t OFF_DKGT = OFF_DQG + (size_t)1024 * 8192 * 2;
constexpr size_t OFF_DUT = OFF_DKGT + (size_t)1024 * 8192 * 2;
constexpr size_t OFF_DQK = OFF_DUT + (size_t)1024 * 8192 * 2;
constexpr size_t OFF_DEG = OFF_DQK + (size_t)1024 * 4096 * 2;
constexpr size_t OFF_QB = OFF_DEG + 4096;
constexpr size_t OFF_KN = OFF_QB + (size_t)T_ * 1536 * 2;
constexpr size_t OFF_KR = OFF_KN + (size_t)T_ * 1024 * 2;
constexpr size_t OFF_VT = OFF_KR + (size_t)T_ * 64 * 2;
constexpr size_t OFF_OA = OFF_VT + (size_t)1024 * 8192 * 2;
constexpr size_t OFF_OB = OFF_OA + (size_t)T_ * 1024 * 2;
constexpr size_t OFF_OC = OFF_OB + (size_t)T_ * 1024 * 2;
constexpr size_t OFF_MERGED = OFF_OC + (size_t)T_ * 1024 * 2;
constexpr size_t OFF_STATS = OFF_MERGED + (size_t)T_ * 2048 * 2;
constexpr size_t OFF_RS = OFF_STATS + (size_t)T_ * 2 * 4;
constexpr size_t OFF_CS = OFF_RS + (size_t)T_ * 2 * 4;
constexpr size_t OFF_CTR = OFF_CS + (size_t)T_ * 64 * 4;
constexpr size_t OFF_BAR = OFF_CTR + 256;
constexpr size_t WS_END = OFF_BAR + 16384;

struct Params {
    const float* x; const int* pos; const float* norm_g; const float* wg; const float* wu; const float* wd; const float* win;
    const float* convw; const float* alog; const float* dtb; const float* dng; const float* lng; const float* lnb; const float* sgw; const float* sgb;
    const float* cqg; const float* ckvg; const float* wuq; const float* wukv; const float* wbr; const float* wout;
    float* out; unsigned char* ws;
};

__device__ __forceinline__ unsigned pk2(float lo, float hi) { unsigned r; asm("v_cvt_pk_bf16_f32 %0, %1, %2" : "=v"(r) : "v"(lo), "v"(hi)); return r; }
__device__ __forceinline__ float bflo(unsigned u) { return __uint_as_float(u << 16); }
__device__ __forceinline__ float bfhi(unsigned u) { return __uint_as_float(u & 0xffff0000u); }
__device__ __forceinline__ float bf1(bf16_t b) { return __uint_as_float(((unsigned)b) << 16); }
__device__ __forceinline__ bf16_t f2bf(float f) { return (bf16_t)(pk2(f, 0.f) & 0xffffu); }
__device__ __forceinline__ float wave_sum(float v) {
#pragma unroll
    for (int o = 1; o < 64; o <<= 1) v += __shfl_xor(v, o);
    return v;
}
__device__ __forceinline__ float sigmoidf_(float x) { return __builtin_amdgcn_rcpf(1.f + __builtin_amdgcn_exp2f(-1.4426950408889634f * x)); }
__device__ __forceinline__ float siluf_(float x) { return x * __builtin_amdgcn_rcpf(1.f + __builtin_amdgcn_exp2f(-1.4426950408889634f * x)); }
__device__ __forceinline__ f32x2 gelu_pk(f32x2 v) {
    const f32x2 av = __builtin_elementwise_abs(v), d = av * 0.2316418882f + 1.0f;
    f32x2 t; t.x = __builtin_amdgcn_rcpf(d.x); t.y = __builtin_amdgcn_rcpf(d.y);
    f32x2 q = t * 0.5307027145f + (-0.7265760135f); q = q * t + 0.7107068705f; q = q * t + (-0.142248368f); q = q * t + 0.127414796f; q = q * t;
    const f32x2 s = (v * v) * (-0.72134752044f);
    f32x2 e; e.x = __builtin_amdgcn_exp2f(s.x); e.y = __builtin_amdgcn_exp2f(s.y);
    const f32x2 m = v * (q * e), r = v - m;
    f32x2 o; o.x = v.x < 0.f ? m.x : r.x; o.y = v.y < 0.f ? m.y : r.y; return o;
}
__device__ __forceinline__ bf16x8 load2x4(const bf16_t* p) {
    const s16x4 lo = *(const s16x4*)p, hi = *(const s16x4*)(p + 16);
    return __builtin_shufflevector(lo, hi, 0, 1, 2, 3, 4, 5, 6, 7);
}
__device__ __forceinline__ bf16x8 pack8(f32x4 a, f32x4 b) {
    u32x4 w; w.x = pk2(a[0], a[1]); w.y = pk2(a[2], a[3]); w.z = pk2(b[0], b[1]); w.w = pk2(b[2], b[3]);
    return __builtin_bit_cast(bf16x8, w);
}
#define MFMA16(a, b, c) __builtin_amdgcn_mfma_f32_16x16x32_bf16((a), (b), (c), 0, 0, 0)
#define LDS_WAIT() asm volatile("s_waitcnt lgkmcnt(0)" ::: "memory")

#ifdef TCAT
#define TB(c) do { if (TCAT == (c)) t0_ = __builtin_amdgcn_s_memrealtime(); } while (0)
#define TE(c) do { if (TCAT == (c)) tacc_ += __builtin_amdgcn_s_memrealtime() - t0_; } while (0)
#else
#define TB(c) do {} while (0)
#define TE(c) do {} while (0)
#endif
namespace pg8 {
constexpr int BM = 256, BK = 64, HALF = 128, HTB = HALF * BK * 2, NXCD = 8, WGM = 8;
__device__ __forceinline__ int lds_byte(int r, int c) { const int st = (r >> 4) * 2 + (c >> 5), rr = r & 15, cc = c & 31, ob = rr * 64 + cc * 2; return st * 1024 + (ob ^ (((ob >> 9) & 1) << 5)); }
__device__ __forceinline__ void stage_rc(int b, int& R, int& C) { const int st = b / 1024, sb = b % 1024, swz = sb ^ (((sb >> 9) & 1) << 5); R = (st >> 1) * 16 + swz / 64; C = (st & 1) * 32 + (swz % 64) / 2; }
__device__ __forceinline__ int perm32(int rho) { const int n = rho >> 4, i = rho & 15; return 8 * (i >> 2) + 4 * n + (i & 3); }
struct Unit { int pm, pn, seg; };
struct Gemm { const bf16_t* A; const bf16_t* Bt; int M, N, K; size_t segA, segB; };
struct StaticOrder {
    int nM, nN, nwg, G, c, nseg;
    __device__ __forceinline__ void init(int M, int N, int G_, int c_) { nM = M / BM; nN = N / BM; nwg = nM * nN; G = G_; c = c_; nseg = 1; }
    __device__ __forceinline__ bool next(int i, Unit& u) const {
        const int ti = i / nseg; u.seg = i - ti * nseg;
        const long L = (long)ti * G + c; if (L >= nwg) return false;
        int wgid = (int)L; { const int q = nwg / NXCD, r = nwg % NXCD, xcd = wgid % NXCD, off = wgid / NXCD; wgid = (xcd < r ? xcd * (q + 1) : r * (q + 1) + (xcd - r) * q) + off; }
        const int nig = WGM * nN, gid = wgid / nig, fm = gid * WGM, gsz = (nM - fm) < WGM ? (nM - fm) : WGM;
        u.pm = fm + ((wgid % nig) % gsz); u.pn = (wgid % nig) / gsz; return true;
    }
};
template <class Epi>
__device__ __forceinline__ void gemm_phase(LAS unsigned char* lds, const Gemm g, const StaticOrder& S, const Epi& E) {
    int tid = threadIdx.x; asm volatile("" : "+v"(tid));
    const int wid = __builtin_amdgcn_readfirstlane(tid >> 6), lane = tid & 63, wr = wid >> 2, wc = wid & 3, fr = lane & 15, fq = lane >> 4;
    const int K = g.K, nt = K / BK;
    unsigned voffA[2], voffB[2];
#pragma unroll
    for (int i = 0; i < 2; ++i) { int R, C; stage_rc(tid * 16 + i * 8192, R, C); const int Rb = Epi::PERM ? ((R & ~31) + perm32(R & 31)) : R;
        voffA[i] = (unsigned)(R * K + C) * 2u; voffB[i] = (unsigned)(Rb * K + C) * 2u; }
    const size_t kstep = (size_t)(BK * 2);
    const size_t hstep = (size_t)HALF * K * 2;
    const size_t tstep = 2 * hstep;
    const unsigned ldsw = (unsigned)wid * 1024u;
    const int aoff = lds_byte(wr * 64 + fr, fq * 8), boff = lds_byte(wc * 32 + fr, fq * 8);
#define PG8_SA(b, h) (((b) * 2 + (h)) * HTB)
#define PG8_SB(b, h) ((4 + (b) * 2 + (h)) * HTB)
#define PG8_STAGE(bufoff, gbase, voff) do { _Pragma("unroll") for (int _i = 0; _i < 2; ++_i) \
        __builtin_amdgcn_global_load_lds((const unsigned*)((const char*)(gbase) + (voff)[_i]), (LAS unsigned*)(lds + (bufoff) + ldsw + _i * 8192), 16, 0, 0); } while (0)
#define PG8_LDA(dst, b, h) do { _Pragma("unroll") for (int m = 0; m < 4; ++m) _Pragma("unroll") for (int k = 0; k < 2; ++k) dst[m][k] = *(const LAS bf16x8*)(lds + PG8_SA(b, h) + aoff + m * 2048 + k * 1024); } while (0)
#define PG8_LDB(dst, b, h) do { _Pragma("unroll") for (int n = 0; n < 2; ++n) _Pragma("unroll") for (int k = 0; k < 2; ++k) dst[n][k] = *(const LAS bf16x8*)(lds + PG8_SB(b, h) + boff + n * 2048 + k * 1024); } while (0)
#define PG8_MMA(ai, bj, At, Bt) do { __builtin_amdgcn_s_setprio(1); _Pragma("unroll") for (int m = 0; m < 4; ++m) _Pragma("unroll") for (int n = 0; n < 2; ++n) _Pragma("unroll") for (int k = 0; k < 2; ++k) \
        acc[ai][bj][m][n] = __builtin_amdgcn_mfma_f32_16x16x32_bf16(Bt[n][k], At[m][k], acc[ai][bj][m][n], 0, 0, 0); __builtin_amdgcn_s_setprio(0); } while (0)
#define PG8_WAIT_V(n) asm volatile("s_waitcnt vmcnt(" #n ")" ::: "memory")
#define PG8_WAIT_L(n) asm volatile("s_waitcnt lgkmcnt(" #n ")" ::: "memory")
#define PG8_BAR __builtin_amdgcn_s_barrier()
#define PG8_SCHED __builtin_amdgcn_sched_barrier(0)
    Unit cur, nxt; int ui = 0;
    if (!S.next(0, cur)) return;
    f32x4 acc[2][2][4][2];
#pragma unroll
    for (int a = 0; a < 2; ++a)
#pragma unroll
        for (int b = 0; b < 2; ++b)
#pragma unroll
            for (int m = 0; m < 4; ++m)
#pragma unroll
                for (int n = 0; n < 2; ++n) acc[a][b][m][n] = (f32x4){0.f, 0.f, 0.f, 0.f};
    bf16x8 At[4][2], B0[2][2], B1[2][2];
    const char* cA = (const char*)g.A + cur.seg * g.segA + (size_t)cur.pm * tstep; const char* cB = (const char*)g.Bt + cur.seg * g.segB + (size_t)cur.pn * tstep;
    PG8_STAGE(PG8_SB(0, 0), cB, voffB); PG8_STAGE(PG8_SA(0, 0), cA, voffA); PG8_STAGE(PG8_SB(0, 1), cB + hstep, voffB); PG8_STAGE(PG8_SA(0, 1), cA + hstep, voffA);
    if (wr == 1) PG8_BAR;
    PG8_WAIT_V(4); PG8_BAR;
    PG8_STAGE(PG8_SB(1, 0), cB + kstep, voffB); PG8_STAGE(PG8_SA(1, 0), cA + kstep, voffA); PG8_STAGE(PG8_SB(1, 1), cB + hstep + kstep, voffB);
    PG8_WAIT_V(6); PG8_BAR;
    for (;;) {
        const bool has_next = S.next(ui + 1, nxt);
        const char* nA = has_next ? (const char*)g.A + nxt.seg * g.segA + (size_t)nxt.pm * tstep : cA; const char* nB = has_next ? (const char*)g.Bt + nxt.seg * g.segB + (size_t)nxt.pn * tstep : cB;
        for (int t = 0; t < nt; t += 2) {
            const bool last = (t == nt - 2);
            const char* a1 = cA + (size_t)(t + 1) * kstep;
            const char* a2 = last ? nA : cA + (size_t)(t + 2) * kstep; const char* b2 = last ? nB : cB + (size_t)(t + 2) * kstep;
            const char* a3 = a2 + kstep; const char* b3 = b2 + kstep;
            PG8_LDB(B0, 0, 0); PG8_SCHED; PG8_LDA(At, 0, 0); PG8_STAGE(PG8_SA(1, 1), a1 + hstep, voffA);
            PG8_WAIT_L(8); PG8_BAR; PG8_WAIT_L(0); PG8_MMA(0, 0, At, B0); PG8_BAR; PG8_SCHED;
            PG8_LDB(B1, 0, 1); PG8_STAGE(PG8_SB(0, 0), b2, voffB);
            PG8_BAR; PG8_WAIT_L(0); PG8_MMA(0, 1, At, B1); PG8_BAR;
            PG8_LDA(At, 0, 1); PG8_STAGE(PG8_SA(0, 0), a2, voffA);
            PG8_BAR; PG8_WAIT_L(0); PG8_MMA(1, 0, At, B0); PG8_BAR; PG8_SCHED;
            PG8_STAGE(PG8_SB(0, 1), b2 + hstep, voffB);
            PG8_WAIT_V(6); PG8_BAR; PG8_MMA(1, 1, At, B1); PG8_BAR;
            PG8_LDB(B0, 1, 0); PG8_SCHED; PG8_LDA(At, 1, 0); PG8_STAGE(PG8_SA(0, 1), a2 + hstep, voffA);
            PG8_WAIT_L(8); PG8_BAR; PG8_WAIT_L(0); PG8_MMA(0, 0, At, B0); PG8_BAR; PG8_SCHED;
            PG8_LDB(B1, 1, 1); PG8_STAGE(PG8_SB(1, 0), b3, voffB);
            PG8_BAR; PG8_WAIT_L(0); PG8_MMA(0, 1, At, B1); PG8_BAR;
            PG8_LDA(At, 1, 1); PG8_STAGE(PG8_SA(1, 0), a3, voffA);
            PG8_BAR; PG8_WAIT_L(0); PG8_MMA(1, 0, At, B0); PG8_BAR; PG8_SCHED;
            PG8_STAGE(PG8_SB(1, 1), b3 + hstep, voffB);
            PG8_WAIT_V(6); PG8_BAR; PG8_MMA(1, 1, At, B1); PG8_BAR;
        }
        E(acc, cur, wr, wc, fr, fq);
        if (!has_next) break;
        if (nxt.seg == 0) {
#pragma unroll
        for (int a = 0; a < 2; ++a)
#pragma unroll
            for (int b = 0; b < 2; ++b)
#pragma unroll
                for (int m = 0; m < 4; ++m)
#pragma unroll
                    for (int n = 0; n < 2; ++n) acc[a][b][m][n] = (f32x4){0.f, 0.f, 0.f, 0.f};
        }
        cur = nxt; cA = nA; cB = nB; ++ui;
    }
    PG8_WAIT_V(0);
    if (wr == 0) PG8_BAR;
    PG8_BAR;
#undef PG8_SA
#undef PG8_SB
#undef PG8_STAGE
#undef PG8_LDA
#undef PG8_LDB
#undef PG8_MMA
#undef PG8_WAIT_V
#undef PG8_WAIT_L
#undef PG8_BAR
#undef PG8_SCHED
}
}
using pg8::Unit;
typedef f32x4 Acc[2][2][4][2];

struct EpiF32 {
    static constexpr bool PERM = false;
    float* C; int ldc;
    __device__ __forceinline__ void operator()(const Acc& acc, const Unit& u, int wr, int wc, int fr, int fq) const {
        const int row0 = u.pm * 256 + wr * 64 + fr, col0 = u.pn * 256 + wc * 32 + 4 * fq;
#pragma unroll
        for (int ai = 0; ai < 2; ++ai)
#pragma unroll
            for (int m = 0; m < 4; ++m) { float* rowp = C + (size_t)(row0 + ai * 128 + m * 16) * ldc + col0;
#pragma unroll
                for (int bj = 0; bj < 2; ++bj)
#pragma unroll
                    for (int n = 0; n < 2; ++n) *(f32x4*)(rowp + bj * 128 + n * 16) = acc[ai][bj][m][n]; }
    }
};
struct EpiBf16Out {
    static constexpr bool PERM = true;
    bf16_t* O; int ldc;
    __device__ __forceinline__ void operator()(const Acc& acc, const Unit& u, int wr, int wc, int fr, int fq) const {
        const int row0 = u.pm * 256 + wr * 64 + fr, col0 = u.pn * 256 + wc * 32 + 8 * fq;
#pragma unroll
        for (int ai = 0; ai < 2; ++ai)
#pragma unroll
            for (int m = 0; m < 4; ++m) { bf16_t* rowp = O + (size_t)(row0 + ai * 128 + m * 16) * ldc + col0;
#pragma unroll
                for (int bj = 0; bj < 2; ++bj) { const f32x4 v0 = acc[ai][bj][m][0], v1 = acc[ai][bj][m][1];
                    u32x4 w; w.x = pk2(v0[0], v0[1]); w.y = pk2(v0[2], v0[3]); w.z = pk2(v1[0], v1[1]); w.w = pk2(v1[2], v1[3]);
                    *(u32x4*)(rowp + bj * 128) = w; } }
    }
};
struct EpiSwiGLU {
    static constexpr bool PERM = true;
    bf16_t* O;
    __device__ __forceinline__ void operator()(const Acc& acc, const Unit& u, int wr, int wc, int fr, int fq) const {
        const int row0 = u.pm * 256 + wr * 64 + fr, col0 = u.pn * 128 + wc * 32 + 8 * fq;
#pragma unroll
        for (int ai = 0; ai < 2; ++ai)
#pragma unroll
            for (int m = 0; m < 4; ++m) {
                f32x4 v0, v1;
#pragma unroll
                for (int e = 0; e < 4; ++e) { v0[e] = siluf_(acc[ai][0][m][0][e]) * acc[ai][1][m][0][e]; v1[e] = siluf_(acc[ai][0][m][1][e]) * acc[ai][1][m][1][e]; }
                u32x4 w; w.x = pk2(v0[0], v0[1]); w.y = pk2(v0[2], v0[3]); w.z = pk2(v1[0], v1[1]); w.w = pk2(v1[2], v1[3]);
                *(u32x4*)(O + (size_t)(row0 + ai * 128 + m * 16) * FF + col0) = w; }
    }
};
struct EpiWin {
    static constexpr bool PERM = true;
    unsigned char* ws;
    __device__ __forceinline__ void operator()(const Acc& acc, const Unit& u, int wr, int wc, int fr, int fq) const {
        const int pn = u.pn, row0 = u.pm * 256 + wr * 64 + fr;
        if (pn == 52) {
            float* M = (float*)(ws + OFF_MISC);
#pragma unroll
            for (int ai = 0; ai < 2; ++ai)
#pragma unroll
                for (int m = 0; m < 4; ++m)
#pragma unroll
                    for (int n = 0; n < 2; ++n) *(f32x4*)(M + (size_t)(row0 + ai * 128 + m * 16) * 128 + 32 * wc + 8 * fq + 4 * n) = acc[ai][0][m][n];
            return;
        }
        bf16_t* base; int ld, col, mode = 0;
        if (pn < 12) { base = (bf16_t*)(ws + OFF_QKV); ld = 3072; col = pn * 256; }
        else if (pn < 16) { base = (bf16_t*)(ws + OFF_Z); ld = 1024; col = (pn - 12) * 256; }
        else if (pn < 24) { base = (bf16_t*)(ws + OFF_SG); ld = 2048; col = (pn - 16) * 256; mode = 2; }
        else if (pn < 26) { base = (bf16_t*)(ws + OFF_CQ); ld = 512; col = (pn - 24) * 256; }
        else if (pn < 28) { base = (bf16_t*)(ws + OFF_CKV); ld = 512; col = (pn - 26) * 256; }
        else { base = (bf16_t*)(ws + OFF_GATE); ld = 6144; col = (pn - 28) * 256; mode = 1; }
        col += wc * 32 + 8 * fq;
#pragma unroll
        for (int ai = 0; ai < 2; ++ai)
#pragma unroll
            for (int m = 0; m < 4; ++m) { bf16_t* rowp = base + (size_t)(row0 + ai * 128 + m * 16) * ld + col;
#pragma unroll
                for (int bj = 0; bj < 2; ++bj) { f32x4 v0 = acc[ai][bj][m][0], v1 = acc[ai][bj][m][1];
                    if (mode == 1) {
#pragma unroll
                        for (int e = 0; e < 4; ++e) { v0[e] = sigmoidf_(v0[e]); v1[e] = sigmoidf_(v1[e]); } }
                    else if (mode == 2) { f32x2 a = gelu_pk((f32x2){v0[0], v0[1]}), b = gelu_pk((f32x2){v0[2], v0[3]}), c = gelu_pk((f32x2){v1[0], v1[1]}), d = gelu_pk((f32x2){v1[2], v1[3]});
                        v0 = (f32x4){a.x, a.y, b.x, b.y}; v1 = (f32x4){c.x, c.y, d.x, d.y}; }
                    u32x4 w; w.x = pk2(v0[0], v0[1]); w.y = pk2(v0[2], v0[3]); w.z = pk2(v1[0], v1[1]); w.w = pk2(v1[2], v1[3]);
                    *(u32x4*)(rowp + bj * 128) = w; } }
    }
};
struct EpiQ {
    static constexpr bool PERM = true;
    bf16_t* QB; const float* RS; const float* CS; float qscale;
    __device__ __forceinline__ void operator()(const Acc& acc, const Unit& u, int wr, int wc, int fr, int fq) const {
        const int pn = u.pn, row0 = u.pm * 256 + wr * 64 + fr;
#pragma unroll
        for (int ai = 0; ai < 2; ++ai)
#pragma unroll
            for (int m = 0; m < 4; ++m) { const int row = row0 + ai * 128 + m * 16; const float sc = qscale;
                if (pn < 4) {
#pragma unroll
                    for (int bj = 0; bj < 2; ++bj) { const f32x4 v0 = acc[ai][bj][m][0] * sc, v1 = acc[ai][bj][m][1] * sc;
                        u32x4 w; w.x = pk2(v0[0], v0[1]); w.y = pk2(v0[2], v0[3]); w.z = pk2(v1[0], v1[1]); w.w = pk2(v1[2], v1[3]);
                        *(u32x4*)(QB + (size_t)row * 1536 + (pn * 2 + bj) * 192 + wc * 32 + 8 * fq) = w; }
                } else {
                    const int head = (pn - 4) * 4 + wc, i0 = 8 * fq;
                    const f32x4 c0 = *(const f32x4*)(CS + (size_t)row * 64 + i0), c1 = *(const f32x4*)(CS + (size_t)row * 64 + i0 + 4);
                    const f32x4 s0 = *(const f32x4*)(CS + (size_t)row * 64 + 32 + i0), s1 = *(const f32x4*)(CS + (size_t)row * 64 + 32 + i0 + 4);
                    const f32x4 x10 = acc[ai][0][m][0] * sc, x11 = acc[ai][0][m][1] * sc, x20 = acc[ai][1][m][0] * sc, x21 = acc[ai][1][m][1] * sc;
                    const f32x4 a0 = x10 * c0 - x20 * s0, a1 = x11 * c1 - x21 * s1, b0 = x10 * s0 + x20 * c0, b1 = x11 * s1 + x21 * c1;
                    u32x4 w; w.x = pk2(a0[0], a0[1]); w.y = pk2(a0[2], a0[3]); w.z = pk2(a1[0], a1[1]); w.w = pk2(a1[2], a1[3]);
                    *(u32x4*)(QB + (size_t)row * 1536 + head * 192 + 128 + i0) = w;
                    w.x = pk2(b0[0], b0[1]); w.y = pk2(b0[2], b0[3]); w.z = pk2(b1[0], b1[1]); w.w = pk2(b1[2], b1[3]);
                    *(u32x4*)(QB + (size_t)row * 1536 + head * 192 + 160 + i0) = w;
                } }
    }
};
struct EpiKN {
    static constexpr bool PERM = true;
    bf16_t* O; const float* RS;
    __device__ __forceinline__ void operator()(const Acc& acc, const Unit& u, int wr, int wc, int fr, int fq) const {
        const int row0 = u.pm * 256 + wr * 64 + fr, col0 = u.pn * 256 + wc * 32 + 8 * fq;
#pragma unroll
        for (int ai = 0; ai < 2; ++ai)
#pragma unroll
            for (int m = 0; m < 4; ++m) { const int row = row0 + ai * 128 + m * 16; const float sc = 1.f;
#pragma unroll
                for (int bj = 0; bj < 2; ++bj) { const f32x4 v0 = acc[ai][bj][m][0] * sc, v1 = acc[ai][bj][m][1] * sc;
                    u32x4 w; w.x = pk2(v0[0], v0[1]); w.y = pk2(v0[2], v0[3]); w.z = pk2(v1[0], v1[1]); w.w = pk2(v1[2], v1[3]);
                    *(u32x4*)(O + (size_t)row * 1024 + col0 + bj * 128) = w; } }
    }
};
struct EpiVT {
    static constexpr bool PERM = true;
    bf16_t* O; const float* RS;
    __device__ __forceinline__ void operator()(const Acc& acc, const Unit& u, int wr, int wc, int fr, int fq) const {
        const int row0 = u.pm * 256 + wr * 64 + fr, col0 = u.pn * 256 + wc * 32 + 8 * fq;
        float sc[2][8];
#pragma unroll
        for (int bj = 0; bj < 2; ++bj)
#pragma unroll
            for (int e = 0; e < 8; ++e) sc[bj][e] = 1.f;
#pragma unroll
        for (int ai = 0; ai < 2; ++ai)
#pragma unroll
            for (int m = 0; m < 4; ++m) { const int row = row0 + ai * 128 + m * 16;
#pragma unroll
                for (int bj = 0; bj < 2; ++bj) { const f32x4 v0 = acc[ai][bj][m][0], v1 = acc[ai][bj][m][1];
                    u32x4 w; w.x = pk2(v0[0] * sc[bj][0], v0[1] * sc[bj][1]); w.y = pk2(v0[2] * sc[bj][2], v0[3] * sc[bj][3]);
                    w.z = pk2(v1[0] * sc[bj][4], v1[1] * sc[bj][5]); w.w = pk2(v1[2] * sc[bj][6], v1[3] * sc[bj][7]);
                    *(u32x4*)(O + (size_t)row * 8192 + col0 + bj * 128) = w; } }
    }
};
template <int BR> struct EpiBranch {
    static constexpr bool PERM = true;
    bf16_t* ACC; const bf16_t* GATE; bf16_t* OUT;
    __device__ __forceinline__ void operator()(const Acc& acc, const Unit& u, int wr, int wc, int fr, int fq) const {
        const int row0 = u.pm * 256 + wr * 64 + fr, col0 = u.pn * 256 + wc * 32 + 8 * fq;
#pragma unroll
        for (int ai = 0; ai < 2; ++ai)
#pragma unroll
            for (int m = 0; m < 4; ++m) { const int row = row0 + ai * 128 + m * 16;
#pragma unroll
                for (int bj = 0; bj < 2; ++bj) { const int col = col0 + bj * 128;
                    const u32x4 gw = *(const u32x4*)(GATE + (size_t)row * 6144 + BR * 2048 + col);
                    f32x4 v0 = acc[ai][bj][m][0], v1 = acc[ai][bj][m][1];
                    v0[0] *= bflo(gw.x); v0[1] *= bfhi(gw.x); v0[2] *= bflo(gw.y); v0[3] *= bfhi(gw.y);
                    v1[0] *= bflo(gw.z); v1[1] *= bfhi(gw.z); v1[2] *= bflo(gw.w); v1[3] *= bfhi(gw.w);
                    bf16_t* ap = ACC + (size_t)row * 2048 + col;
                    if (BR > 0) { const u32x4 pw = *(const u32x4*)ap;
                        v0[0] += bflo(pw.x); v0[1] += bfhi(pw.x); v0[2] += bflo(pw.y); v0[3] += bfhi(pw.y);
                        v1[0] += bflo(pw.z); v1[1] += bfhi(pw.z); v1[2] += bflo(pw.w); v1[3] += bfhi(pw.w); }
                    u32x4 w; w.x = pk2(v0[0], v0[1]); w.y = pk2(v0[2], v0[3]); w.z = pk2(v1[0], v1[1]); w.w = pk2(v1[2], v1[3]);
                    if (BR < 2) *(u32x4*)ap = w; else *(u32x4*)(OUT + (size_t)row * 2048 + col) = w; } }
    }
};

struct EpiBranchFused {
    static constexpr bool PERM = true;
    const bf16_t* GATE; bf16_t* OUT;
    __device__ __forceinline__ void operator()(Acc& acc, const Unit& u, int wr, int wc, int fr, int fq) const {
        const int row0 = u.pm * 256 + wr * 64 + fr, col0 = u.pn * 256 + wc * 32 + 8 * fq, seg = u.seg;
        const int segb = seg < 2 ? seg + 1 : seg;
#pragma unroll
        for (int aim = 0; aim < 4; ++aim) { const int ai = aim >> 1, mh = aim & 1;
            u32x4 ga[4][2], gb[4][2];
#pragma unroll
            for (int m = mh * 2; m < mh * 2 + 2; ++m)
#pragma unroll
                for (int bj = 0; bj < 2; ++bj) { const size_t off = (size_t)(row0 + ai * 128 + m * 16) * 6144 + col0 + bj * 128;
                    ga[m][bj] = *(const u32x4*)(GATE + off + seg * 2048); gb[m][bj] = *(const u32x4*)(GATE + off + segb * 2048); }
            __builtin_amdgcn_sched_barrier(0);
#pragma unroll
            for (int m = mh * 2; m < mh * 2 + 2; ++m) { const int row = row0 + ai * 128 + m * 16;
#pragma unroll
                for (int bj = 0; bj < 2; ++bj) { const int col = col0 + bj * 128;
                    const u32x4 a = ga[m][bj], d = gb[m][bj];
                    float sc[8] = {bflo(a.x), bfhi(a.x), bflo(a.y), bfhi(a.y), bflo(a.z), bfhi(a.z), bflo(a.w), bfhi(a.w)};
                    if (seg < 2) { const float dn[8] = {bflo(d.x), bfhi(d.x), bflo(d.y), bfhi(d.y), bflo(d.z), bfhi(d.z), bflo(d.w), bfhi(d.w)};
#pragma unroll
                        for (int e = 0; e < 8; ++e) sc[e] = sc[e] * __builtin_amdgcn_rcpf(dn[e]); }
                    f32x4 v0 = acc[ai][bj][m][0], v1 = acc[ai][bj][m][1];
#pragma unroll
                    for (int e = 0; e < 4; ++e) { v0[e] *= sc[e]; v1[e] *= sc[4 + e]; }
                    if (seg < 2) { acc[ai][bj][m][0] = v0; acc[ai][bj][m][1] = v1; }
                    else { u32x4 w; w.x = pk2(v0[0], v0[1]); w.y = pk2(v0[2], v0[3]); w.z = pk2(v1[0], v1[1]); w.w = pk2(v1[2], v1[3]);
                        *(u32x4*)(OUT + (size_t)row * 2048 + col) = w; } } }
            __builtin_amdgcn_sched_barrier(0);
        }
    }
};
__device__ __forceinline__ void run_branch_gemm(LAS unsigned char* lds, const bf16_t* A3, const bf16_t* Bt3, const EpiBranchFused& E) {
    pg8::Gemm g; g.A = A3; g.Bt = Bt3; g.M = T_; g.N = 2048; g.K = 1024; g.segA = (size_t)T_ * 1024 * 2; g.segB = (size_t)2048 * 1024 * 2;
    pg8::StaticOrder S; S.init(T_, 2048, (int)gridDim.x, (int)blockIdx.x); S.nseg = 3;
    pg8::gemm_phase<EpiBranchFused>(lds, g, S, E);
}
template <class Epi>
__device__ __forceinline__ void run_gemm(LAS unsigned char* lds, const bf16_t* A, const bf16_t* Bt, int M, int N, int K, const Epi& E) {
    pg8::Gemm g; g.A = A; g.Bt = Bt; g.M = M; g.N = N; g.K = K; g.segA = 0; g.segB = 0;
    pg8::StaticOrder S; S.init(M, N, (int)gridDim.x, (int)blockIdx.x);
    pg8::gemm_phase<Epi>(lds, g, S, E);
}

template <class Map>
__device__ __forceinline__ void cvt_item(const float* W, int K, int N, bf16_t* WT, const float* kscale, LAS float* scr, int item, int lane, Map map) {
    const int nblk = (N + 31) / 32, kb = item / nblk, nb = item % nblk, k0 = 128 * kb, n0 = 32 * nb;
    {
        const int nc4 = n0 + 4 * (lane & 7); const bool ok4 = nc4 < N;
        f32x4 v[16];
#pragma unroll
        for (int i = 0; i < 16; ++i) { const int kk = 8 * i + (lane >> 3); v[i] = ok4 ? *(const f32x4*)(W + (size_t)(k0 + kk) * N + nc4) : (f32x4){0.f, 0.f, 0.f, 0.f}; }
#pragma unroll
        for (int i = 0; i < 16; ++i) { const int kk = 8 * i + (lane >> 3); f32x4 x = v[i]; if (kscale) x = x * kscale[k0 + kk];
            LAS float* d = scr + kk * 33 + 4 * (lane & 7); d[0] = x[0]; d[1] = x[1]; d[2] = x[2]; d[3] = x[3]; }
    }
    LDS_WAIT();
    const int c = lane & 15;
#pragma unroll
    for (int j = 0; j < 8; ++j) { const int n = (lane >> 4) + 4 * j; const LAS float* s = scr + (8 * c) * 33 + n;
        if (n0 + n < N) { const int drow = map(n0 + n);
            u32x4 o; o.x = pk2(s[0 * 33], s[1 * 33]); o.y = pk2(s[2 * 33], s[3 * 33]); o.z = pk2(s[4 * 33], s[5 * 33]); o.w = pk2(s[6 * 33], s[7 * 33]);
            *(u32x4*)(WT + (size_t)drow * K + k0 + 8 * c) = o; } }
    LDS_WAIT();
}
struct MapId { __device__ __forceinline__ int operator()(int n) const { return n; } };
struct MapGU { int off; __device__ __forceinline__ int operator()(int n) const { return (n >> 7) * 256 + off + (n & 127); } };
struct MapWin { __device__ __forceinline__ int operator()(int n) const {
    if (n < 4096) return n;
    if (n < 4112) return 13312 + 64 + (n - 4096);
    if (n < 6160) return 4096 + (n - 4112);
    if (n < 6672) return 6144 + (n - 6160);
    if (n < 7184) return 6656 + (n - 6672);
    if (n < 7248) return 13312 + (n - 7184);
    return 7168 + (n - 7248); } };
struct MapUQ { __device__ __forceinline__ int operator()(int n) const { const int hh = n / 192, d = n - hh * 192;
    if (d < 128) return (hh >> 1) * 256 + (hh & 1) * 128 + d;
    if (d < 160) return 1024 + (hh >> 2) * 256 + (hh & 3) * 32 + (d - 128);
    return 1024 + (hh >> 2) * 256 + 128 + (hh & 3) * 32 + (d - 160); } };
struct MapUKV { __device__ __forceinline__ int operator()(int n) const { const int hh = n >> 8, d = n & 255; return d < 128 ? hh * 128 + d : 1024 + hh * 128 + (d - 128); } };

__device__ __forceinline__ void convert_layer(const Params& p, int l, LAS unsigned char* lds) {
    int tid = threadIdx.x; asm volatile("" : "+v"(tid));
    const int lane = tid & 63, wave = tid >> 6;
    LAS float* scr = (LAS float*)(lds + wave * 16896);
    const int gw = blockIdx.x * 8 + wave, NGW = gridDim.x * 8;
    unsigned char* ws = p.ws;
    constexpr int I_GU = 16 * 176, I_DN = 44 * 64, I_WIN = 16 * 419, I_UQ = 4 * 48, I_UKV = 4 * 64, I_BR = 8 * 64, I_OUT = 16 * 64;
    constexpr int NITEMS = 4 * I_GU + 2 * I_DN + I_WIN + I_UQ + I_UKV + 3 * I_BR + I_OUT;
    for (int it = gw; it < NITEMS; it += NGW) {
        int r = it;
        if (r < 4 * I_GU) { const int which = r / I_GU, i = which >> 1, up = which & 1; r -= which * I_GU;
            const float* W = (up ? p.wu : p.wg) + (size_t)(l * 2 + i) * 2048 * FF;
            MapGU mp; mp.off = up * 128;
            cvt_item(W, 2048, FF, (bf16_t*)(ws + OFF_WGU) + (size_t)i * 11264 * 2048, nullptr, scr, r, lane, mp); continue; }
        r -= 4 * I_GU;
        if (r < 2 * I_DN) { const int i = r / I_DN; r -= i * I_DN;
            cvt_item(p.wd + (size_t)(l * 2 + i) * FF * 2048, FF, 2048, (bf16_t*)(ws + OFF_WDN) + (size_t)i * 2048 * FF, nullptr, scr, r, lane, MapId()); continue; }
        r -= 2 * I_DN;
        if (r < I_WIN) { cvt_item(p.win + (size_t)l * 2048 * NIN, 2048, NIN, (bf16_t*)(ws + OFF_WIN), nullptr, scr, r, lane, MapWin()); continue; }
        r -= I_WIN;
        if (r < I_UQ) { cvt_item(p.wuq + (size_t)l * 512 * 1536, 512, 1536, (bf16_t*)(ws + OFF_WUQ), p.cqg + l * 512, scr, r, lane, MapUQ()); continue; }
        r -= I_UQ;
        if (r < I_UKV) { cvt_item(p.wukv + (size_t)l * 512 * 2048, 512, 2048, (bf16_t*)(ws + OFF_WUKV), p.ckvg + l * 512, scr, r, lane, MapUKV()); continue; }
        r -= I_UKV;
        if (r < 3 * I_BR) { const int j = r / I_BR; r -= j * I_BR;
            cvt_item(p.wbr + (size_t)(l * 3 + j) * 1024 * 2048, 1024, 2048, (bf16_t*)(ws + OFF_WBR) + (size_t)j * 2048 * 1024, nullptr, scr, r, lane, MapId()); continue; }
        r -= 3 * I_BR;
        cvt_item(p.wout + (size_t)l * 2048 * 2048, 2048, 2048, (bf16_t*)(ws + OFF_WOUT), nullptr, scr, r, lane, MapId());
    }
    const size_t gt = (size_t)blockIdx.x * 512 + tid, NGT = (size_t)gridDim.x * 512;
    { bf16_t* SGW = (bf16_t*)(ws + OFF_SGW); const float* src = p.sgw + (size_t)l * 8 * 128 * 128;
      for (size_t e = gt; e < (size_t)8 * 128 * 128; e += NGT) { const int j = (int)(e & 127), i = (int)((e >> 7) & 127); SGW[e] = ((j >> 6) <= (i >> 6)) ? f2bf(src[e]) : (bf16_t)0; } }
    { bf16_t* WIN = (bf16_t*)(ws + OFF_WIN) + (size_t)(13312 + 80) * 2048;
      for (size_t e = gt; e < (size_t)176 * 2048; e += NGT) WIN[e] = 0; }
}

__device__ __forceinline__ void rowpass(const float* xin, const bf16_t* f, float alpha, const float* gpost, const float* gpre, float* xout, bf16_t* hout) {
    int tid = threadIdx.x; asm volatile("" : "+v"(tid));
    const int lane = tid & 63, wave = tid >> 6;
    const int gw = blockIdx.x * 8 + wave, NGW = gridDim.x * 8;
    for (int row0 = gw; row0 < T_; row0 += 2 * NGW) {
        const int row1 = row0 + NGW; const bool two = row1 < T_; const int rowb = two ? row1 : row0;
        f32x4 xa[8], xb[8]; u32x2 wa[8], wb[8]; f32x4 gp[8];
        { const f32x4* xr = (const f32x4*)(xin + (size_t)row0 * DM) + lane; const f32x4* xs = (const f32x4*)(xin + (size_t)rowb * DM) + lane;
#pragma unroll
          for (int j = 0; j < 8; ++j) { xa[j] = xr[64 * j]; xb[j] = xs[64 * j]; } }
        if (f) {
            const u32x2* fr = (const u32x2*)(f + (size_t)row0 * DM) + lane; const u32x2* fs = (const u32x2*)(f + (size_t)rowb * DM) + lane;
#pragma unroll
            for (int j = 0; j < 8; ++j) { wa[j] = fr[64 * j]; wb[j] = fs[64 * j]; gp[j] = *((const f32x4*)gpost + lane + 64 * j); }
        }
        __builtin_amdgcn_sched_barrier(0);
        if (f) {
            f32x4 fa[8], fb[8]; float sa = 0.f, sb = 0.f;
#pragma unroll
            for (int j = 0; j < 8; ++j) { fa[j] = (f32x4){bflo(wa[j].x), bfhi(wa[j].x), bflo(wa[j].y), bfhi(wa[j].y)}; fb[j] = (f32x4){bflo(wb[j].x), bfhi(wb[j].x), bflo(wb[j].y), bfhi(wb[j].y)}; }
#pragma unroll
            for (int j = 0; j < 8; ++j) { sa += fa[j][0] * fa[j][0] + fa[j][1] * fa[j][1] + fa[j][2] * fa[j][2] + fa[j][3] * fa[j][3];
                sb += fb[j][0] * fb[j][0] + fb[j][1] * fb[j][1] + fb[j][2] * fb[j][2] + fb[j][3] * fb[j][3]; }
            const float ra = rsqrtf(wave_sum(sa) * (1.f / DM) + EPS) * alpha, rb = rsqrtf(wave_sum(sb) * (1.f / DM) + EPS) * alpha;
#pragma unroll
            for (int j = 0; j < 8; ++j) { xa[j] += fa[j] * ra * gp[j]; xb[j] += fb[j] * rb * gp[j]; }
        }
        f32x4 gq[8];
        if (hout) {
#pragma unroll
            for (int j = 0; j < 8; ++j) gq[j] = *((const f32x4*)gpre + lane + 64 * j);
        }
        { f32x4* xo = (f32x4*)(xout + (size_t)row0 * DM) + lane;
#pragma unroll
          for (int j = 0; j < 8; ++j) xo[64 * j] = xa[j];
          if (two) { f32x4* xp = (f32x4*)(xout + (size_t)row1 * DM) + lane;
#pragma unroll
              for (int j = 0; j < 8; ++j) xp[64 * j] = xb[j]; } }
        __builtin_amdgcn_sched_barrier(0);
        if (hout) {
            float sa = 0.f, sb = 0.f;
#pragma unroll
            for (int j = 0; j < 8; ++j) { sa += xa[j][0] * xa[j][0] + xa[j][1] * xa[j][1] + xa[j][2] * xa[j][2] + xa[j][3] * xa[j][3];
                sb += xb[j][0] * xb[j][0] + xb[j][1] * xb[j][1] + xb[j][2] * xb[j][2] + xb[j][3] * xb[j][3]; }
            const float ra = rsqrtf(wave_sum(sa) * (1.f / DM) + EPS), rb = rsqrtf(wave_sum(sb) * (1.f / DM) + EPS);
            u32x2* ho = (u32x2*)(hout + (size_t)row0 * DM) + lane; u32x2* hp = (u32x2*)(hout + (size_t)rowb * DM) + lane;
#pragma unroll
            for (int j = 0; j < 8; ++j) { const f32x4 ya = xa[j] * ra * gq[j], yb = xb[j] * rb * gq[j];
                u32x2 w; w.x = pk2(ya[0], ya[1]); w.y = pk2(ya[2], ya[3]); ho[64 * j] = w;
                if (two) { u32x2 w2; w2.x = pk2(yb[0], yb[1]); w2.y = pk2(yb[2], yb[3]); hp[64 * j] = w2; } }
        }
    }
}

constexpr int XS = 260;
__device__ __forceinline__ void dn_prep_item(const Params& p, int l, LAS float* L, int item, unsigned long long& t0_, unsigned long long& tacc_) {
    unsigned char* ws = p.ws;
    int tid = threadIdx.x; asm volatile("" : "+v"(tid));
    const int lane = tid & 63, wave = tid >> 6;
    const int h = item & 7, n = (item >> 3) & 31, b = item >> 8;
    const int t0 = b * SEQ_ + n * 64;
    LAS float* sQ = L; LAS float* sK = L + 64 * 132; LAS float* sX = L + 2 * 64 * 132; LAS float* sA = sX + 64 * XS; LAS float* sG = sA + 64 * 68; LAS float* sB = sG + 64;
    const bf16_t* QKV = (const bf16_t*)(ws + OFF_QKV);
    const float* MISC = (const float*)(ws + OFF_MISC);
    const float* cw = p.convw + (size_t)l * 4 * 3072;
    TB(7);
    if (tid < 384) {
        const int cgp = tid % 48, tq = tid / 48, part = cgp >> 4, d0 = (cgp & 15) * 8, ch = part * 1024 + h * 128 + d0;
        f32x4 w0[4], w1[4];
#pragma unroll
        for (int j = 0; j < 4; ++j) { w0[j] = *(const f32x4*)(cw + j * 3072 + ch); w1[j] = *(const f32x4*)(cw + j * 3072 + ch + 4); }
        u32x4 xr[11];
#pragma unroll
        for (int r = 0; r < 11; ++r) { const int sq = n * 64 + tq * 8 - 3 + r; const int sc = sq < 0 ? 0 : sq;
            u32x4 v = *(const u32x4*)(QKV + (size_t)(b * SEQ_ + sc) * 3072 + ch);
            xr[r] = v; }
        __builtin_amdgcn_sched_barrier(0);
#pragma unroll
        for (int r = 0; r < 3; ++r) if (n * 64 + tq * 8 - 3 + r < 0) xr[r] = (u32x4){0u, 0u, 0u, 0u};
#pragma unroll
        for (int tt = 0; tt < 8; ++tt) { const int t = tq * 8 + tt;
            f32x4 a0 = (f32x4){0.f, 0.f, 0.f, 0.f}, a1 = a0;
#pragma unroll
            for (int j = 0; j < 4; ++j) { const u32x4 xv = xr[tt + j];
                a0 += w0[j] * (f32x4){bflo(xv.x), bfhi(xv.x), bflo(xv.y), bfhi(xv.y)}; a1 += w1[j] * (f32x4){bflo(xv.z), bfhi(xv.z), bflo(xv.w), bfhi(xv.w)}; }
            LAS float* dst = part == 0 ? sQ + t * 132 + d0 : (part == 1 ? sK + t * 132 + d0 : sX + t * XS + 128 + d0);
#pragma unroll
            for (int e = 0; e < 4; ++e) { dst[e] = siluf_(a0[e]); dst[4 + e] = siluf_(a1[e]); } }
    }
    __syncthreads();
    TE(7);
    TB(8);
    { const int row = tid >> 2, sub = tid & 3; LAS float* rp = (row < 64 ? sQ + row * 132 : sK + (row - 64) * 132) + sub * 32;
      float ss = 0.f;
#pragma unroll
      for (int e = 0; e < 32; ++e) ss += rp[e] * rp[e];
      ss += __shfl_xor(ss, 1); ss += __shfl_xor(ss, 2);
      const float sc = rsqrtf(ss + 1e-6f) * (row < 64 ? 0.08838834764831845f : 1.f);
#pragma unroll
      for (int e = 0; e < 32; ++e) rp[e] *= sc; }
    if (tid < 64) { const float av = MISC[(size_t)(t0 + tid) * 128 + 64 + h], bv = MISC[(size_t)(t0 + tid) * 128 + 72 + h];
        const float xx = av + p.dtb[l * 8 + h]; const float sp = xx > 20.f ? xx : log1pf(__expf(xx));
        float gv = -__expf(p.alog[l * 8 + h]) * sp;
#pragma unroll
        for (int o = 1; o < 64; o <<= 1) { const float y = __shfl_up(gv, o); if (lane >= o) gv += y; }
        sG[tid] = gv; sB[tid] = sigmoidf_(bv); }
    __syncthreads();
    TE(8);
    TB(9);
    { const int jl = lane & 15, g = lane >> 4, ib = wave >> 1;
      bf16_t* QKo = (bf16_t*)(ws + OFF_DQK) + (size_t)item * 4096;
#pragma unroll
      for (int jj = 0; jj < 2; ++jj) { const int jb = (wave & 1) * 2 + jj;
          f32x4 aA = (f32x4){0.f, 0.f, 0.f, 0.f}, aQ = aA;
          if (jb <= ib) {
#pragma unroll
              for (int ks = 0; ks < 4; ++ks) {
                  const LAS float* kip = sK + (ib * 16 + jl) * 132 + ks * 32 + g * 8; const LAS float* qip = sQ + (ib * 16 + jl) * 132 + ks * 32 + g * 8;
                  const LAS float* kjp = sK + (jb * 16 + jl) * 132 + ks * 32 + g * 8;
                  const bf16x8 ki = pack8(*(const LAS f32x4*)kip, *(const LAS f32x4*)(kip + 4)), qi = pack8(*(const LAS f32x4*)qip, *(const LAS f32x4*)(qip + 4));
                  const bf16x8 kj = pack8(*(const LAS f32x4*)kjp, *(const LAS f32x4*)(kjp + 4));
                  aA = MFMA16(ki, kj, aA); aQ = MFMA16(qi, kj, aQ); } }
          const int j = jb * 16 + jl; const float gj = sG[j];
          const int pj = (j & 32) + ((j & 15) >> 2) * 8 + ((j >> 4) & 1) * 4 + (j & 3);
#pragma unroll
          for (int r = 0; r < 4; ++r) { const int i = ib * 16 + g * 4 + r; const float dec = (j <= i) ? __expf(sG[i] - gj) : 0.f;
              sA[i * 68 + j] = (j < i) ? sB[i] * aA[r] * dec : 0.f;
              QKo[i * 64 + pj] = f2bf((j <= i) ? aQ[r] * dec : 0.f); } } }
    for (int task = tid; task < 64 * 32; task += 512) { const int t = task >> 5, d4 = task & 31; const float bt = sB[t], kb = bt * __expf(sG[t]);
        const f32x4 kv = *(const LAS f32x4*)(sK + t * 132 + d4 * 4); *(LAS f32x4*)(sX + t * XS + d4 * 4) = kv * kb;
        LAS f32x4* vp = (LAS f32x4*)(sX + t * XS + 128 + d4 * 4); *vp = *vp * bt; }
    __syncthreads();
    TE(9);
    TB(10);
    if (tid < 256) {
        float x[64]; int va[64];
#pragma unroll
        for (int i = 0; i < 64; ++i) x[i] = sX[i * XS + tid];
#pragma unroll
        for (int i = 1; i < 64; ++i) va[i] = __float_as_int(sA[i * 68 + lane]);
#pragma unroll
        for (int i = 1; i < 64; ++i) {
            float acc0 = 0.f, acc1 = 0.f;
#pragma unroll
            for (int j = 0; j < i; ++j) { const float aij = __int_as_float(__builtin_amdgcn_readlane(va[i], j));
                if (j & 1) acc1 = fmaf(aij, x[j], acc1); else acc0 = fmaf(aij, x[j], acc0); }
            x[i] -= acc0 + acc1;
        }
#pragma unroll
        for (int i = 1; i < 64; ++i) sX[i * XS + tid] = x[i];
    } else {
        bf16_t* QGo = (bf16_t*)(ws + OFF_DQG) + (size_t)item * 8192; bf16_t* KGTo = (bf16_t*)(ws + OFF_DKGT) + (size_t)item * 8192;
        const float glast = sG[63];
        for (int task = tid - 256; task < 1024; task += 256) {
            { const int c = task >> 4, pc = task & 15, dA = (pc >> 2) * 32 + (pc & 3) * 4, dB = dA + 16;
              const float eg = __expf(sG[c]);
              const f32x4 q0 = *(const LAS f32x4*)(sQ + c * 132 + dA) * eg, q1 = *(const LAS f32x4*)(sQ + c * 132 + dB) * eg;
              u32x4 w; w.x = pk2(q0[0], q0[1]); w.y = pk2(q0[2], q0[3]); w.z = pk2(q1[0], q1[1]); w.w = pk2(q1[2], q1[3]);
              *(u32x4*)(QGo + c * 128 + pc * 8) = w; }
            { const int d = task & 127, pc = task >> 7, cA = (pc >> 2) * 32 + (pc & 3) * 4;
              float kk[8];
#pragma unroll
              for (int e = 0; e < 8; ++e) { const int cc = cA + (e & 3) + (e >> 2) * 16; kk[e] = sK[cc * 132 + d] * __expf(glast - sG[cc]); }
              u32x4 w; w.x = pk2(kk[0], kk[1]); w.y = pk2(kk[2], kk[3]); w.z = pk2(kk[4], kk[5]); w.w = pk2(kk[6], kk[7]);
              *(u32x4*)(KGTo + d * 64 + pc * 8) = w; }
        }
    }
    __syncthreads();
    TE(10);
    TB(11);
    { bf16_t* Wo = (bf16_t*)(ws + OFF_DW) + (size_t)item * 8192; bf16_t* UTo = (bf16_t*)(ws + OFF_DUT) + (size_t)item * 8192;
      for (int task = tid; task < 1024; task += 512) {
          { const int c = task >> 4, pc = task & 15, dA = (pc >> 2) * 32 + (pc & 3) * 4, dB = dA + 16;
            const f32x4 a = *(const LAS f32x4*)(sX + c * XS + dA), b2 = *(const LAS f32x4*)(sX + c * XS + dB);
            u32x4 w; w.x = pk2(a[0], a[1]); w.y = pk2(a[2], a[3]); w.z = pk2(b2[0], b2[1]); w.w = pk2(b2[2], b2[3]);
            *(u32x4*)(Wo + c * 128 + pc * 8) = w; }
          { const int d = task & 127, c0 = (task >> 7) * 8;
            float uu[8];
#pragma unroll
            for (int e = 0; e < 8; ++e) uu[e] = sX[(c0 + e) * XS + 128 + d];
            u32x4 w; w.x = pk2(uu[0], uu[1]); w.y = pk2(uu[2], uu[3]); w.z = pk2(uu[4], uu[5]); w.w = pk2(uu[6], uu[7]);
            *(u32x4*)(UTo + d * 64 + c0) = w; }
      }
      if (tid == 0) ((float*)(ws + OFF_DEG))[item] = __expf(sG[63]); }
    __syncthreads();
    TE(11);
}

__device__ __forceinline__ void row_items(const Params& p) {
    unsigned char* ws = p.ws;
    int tid = threadIdx.x; asm volatile("" : "+v"(tid));
    const int lane = tid & 63, wave = tid >> 6;
    const int gw = blockIdx.x * 8 + wave, NGW = gridDim.x * 8;
    const bf16_t* SG = (const bf16_t*)(ws + OFF_SG); const bf16_t* CQ = (const bf16_t*)(ws + OFF_CQ); const bf16_t* CKV = (const bf16_t*)(ws + OFF_CKV);
    const float* MISC = (const float*)(ws + OFF_MISC); const float* CS = (const float*)(ws + OFF_CS);
    float* STATS = (float*)(ws + OFF_STATS); float* RS = (float*)(ws + OFF_RS); bf16_t* KR = (bf16_t*)(ws + OFF_KR);
    for (int t = gw; t < T_; t += NGW) {
        { const u32x4 a = *(const u32x4*)(SG + (size_t)t * 2048 + 1024 + lane * 16), b = *(const u32x4*)(SG + (size_t)t * 2048 + 1024 + lane * 16 + 8);
          float v[16]; v[0] = bflo(a.x); v[1] = bfhi(a.x); v[2] = bflo(a.y); v[3] = bfhi(a.y); v[4] = bflo(a.z); v[5] = bfhi(a.z); v[6] = bflo(a.w); v[7] = bfhi(a.w);
          v[8] = bflo(b.x); v[9] = bfhi(b.x); v[10] = bflo(b.y); v[11] = bfhi(b.y); v[12] = bflo(b.z); v[13] = bfhi(b.z); v[14] = bflo(b.w); v[15] = bfhi(b.w);
          float s = 0.f;
#pragma unroll
          for (int e = 0; e < 16; ++e) s += v[e];
          const float mean = wave_sum(s) * (1.f / 1024.f); float s2 = 0.f;
#pragma unroll
          for (int e = 0; e < 16; ++e) { const float d = v[e] - mean; s2 += d * d; }
          const float rstd = rsqrtf(wave_sum(s2) * (1.f / 1024.f) + 1e-5f);
          if (lane == 0) { STATS[t * 2] = mean; STATS[t * 2 + 1] = rstd; } }
        float rsq_, rskv_;
        { const u32x4 a = *(const u32x4*)(CQ + (size_t)t * 512 + lane * 8), b = *(const u32x4*)(CKV + (size_t)t * 512 + lane * 8);
          float sa = bflo(a.x) * bflo(a.x) + bfhi(a.x) * bfhi(a.x) + bflo(a.y) * bflo(a.y) + bfhi(a.y) * bfhi(a.y) + bflo(a.z) * bflo(a.z) + bfhi(a.z) * bfhi(a.z) + bflo(a.w) * bflo(a.w) + bfhi(a.w) * bfhi(a.w);
          float sb = bflo(b.x) * bflo(b.x) + bfhi(b.x) * bfhi(b.x) + bflo(b.y) * bflo(b.y) + bfhi(b.y) * bfhi(b.y) + bflo(b.z) * bflo(b.z) + bfhi(b.z) * bfhi(b.z) + bflo(b.w) * bflo(b.w) + bfhi(b.w) * bfhi(b.w);
          sa = wave_sum(sa); sb = wave_sum(sb);
          rsq_ = rsqrtf(sa * (1.f / 512.f) + EPS); rskv_ = rsqrtf(sb * (1.f / 512.f) + EPS);
          if (lane == 0) { RS[t] = rsq_; RS[T_ + t] = rskv_; } }
        if (lane < 32) { const float x1 = MISC[(size_t)t * 128 + lane], x2 = MISC[(size_t)t * 128 + 32 + lane];
            const float c = CS[(size_t)t * 64 + lane], s = CS[(size_t)t * 64 + 32 + lane];
            const float ik = 1.f / rskv_;
            KR[(size_t)t * 64 + lane] = f2bf((x1 * c - x2 * s) * ik); KR[(size_t)t * 64 + 32 + lane] = f2bf((x1 * s + x2 * c) * ik); }
    }
}

__device__ __forceinline__ void dn_scan_item(const Params& p, int l, LAS unsigned char* lds, int bh) {
    unsigned char* ws = p.ws;
    int tid = threadIdx.x; asm volatile("" : "+v"(tid));
    const int lane = tid & 63, wave = tid >> 6, jl = lane & 15, g = lane >> 4;
    const int b = bh >> 3, h = bh & 7, dv0 = wave * 16;
    LAS bf16_t* sW = (LAS bf16_t*)lds; LAS bf16_t* sQG = sW + 64 * 136; LAS bf16_t* sKGT = sQG + 64 * 136; LAS bf16_t* sUT = sKGT + 128 * 72; LAS bf16_t* sQK = sUT + 128 * 72;
    LAS float* sO = (LAS float*)(sQK + 64 * 72);
    const bf16_t* Z = (const bf16_t*)(ws + OFF_Z); bf16_t* OA = (bf16_t*)(ws + OFF_OA);
    const float* EGp = (const float*)(ws + OFF_DEG);
    const int fc = wave * 8 + (lane >> 3), fd0 = (lane & 7) * 16;
    f32x4 ngv[4];
#pragma unroll
    for (int k = 0; k < 4; ++k) ngv[k] = *(const f32x4*)(p.dng + l * 128 + fd0 + 4 * k);
    const int gA = (tid >> 4) * 128 + (tid & 15) * 8, lA = (tid >> 4) * 136 + (tid & 15) * 8;
    const int gB = (tid >> 3) * 64 + (tid & 7) * 8, lB = (tid >> 3) * 72 + (tid & 7) * 8;
    u32x4 r[9];
#define SCAN_LOAD(nn) do { const size_t it_ = (size_t)((b * 32 + (nn)) * 8 + h); \
        const bf16_t* Wg = (const bf16_t*)(ws + OFF_DW) + it_ * 8192; const bf16_t* QGg = (const bf16_t*)(ws + OFF_DQG) + it_ * 8192; \
        const bf16_t* KGg = (const bf16_t*)(ws + OFF_DKGT) + it_ * 8192; const bf16_t* UTg = (const bf16_t*)(ws + OFF_DUT) + it_ * 8192; const bf16_t* QKg = (const bf16_t*)(ws + OFF_DQK) + it_ * 4096; \
        r[0] = *(const u32x4*)(Wg + gA); r[1] = *(const u32x4*)(Wg + gA + 32 * 128); r[2] = *(const u32x4*)(QGg + gA); r[3] = *(const u32x4*)(QGg + gA + 32 * 128); \
        r[4] = *(const u32x4*)(KGg + gB); r[5] = *(const u32x4*)(KGg + gB + 64 * 64); r[6] = *(const u32x4*)(UTg + gB); r[7] = *(const u32x4*)(UTg + gB + 64 * 64); r[8] = *(const u32x4*)(QKg + gB); } while (0)
#define SCAN_STORE() do { *(LAS u32x4*)(sW + lA) = r[0]; *(LAS u32x4*)(sW + lA + 32 * 136) = r[1]; *(LAS u32x4*)(sQG + lA) = r[2]; *(LAS u32x4*)(sQG + lA + 32 * 136) = r[3]; \
        *(LAS u32x4*)(sKGT + lB) = r[4]; *(LAS u32x4*)(sKGT + lB + 64 * 72) = r[5]; *(LAS u32x4*)(sUT + lB) = r[6]; *(LAS u32x4*)(sUT + lB + 64 * 72) = r[7]; *(LAS u32x4*)(sQK + lB) = r[8]; } while (0)
    f32x4 S[8];
#pragma unroll
    for (int i = 0; i < 8; ++i) S[i] = (f32x4){0.f, 0.f, 0.f, 0.f};
    __syncthreads();
    SCAN_LOAD(0); SCAN_STORE();
    __syncthreads();
    for (int n = 0; n < 32; ++n) {
        const int item = (b * 32 + n) * 8 + h;
        if (n + 1 < 32) SCAN_LOAD(n + 1);
        const float eg = EGp[item];
        const size_t tokf = (size_t)b * SEQ_ + n * 64 + fc;
        const u32x4 zw0 = *(const u32x4*)(Z + tokf * 1024 + h * 128 + fd0), zw1 = *(const u32x4*)(Z + tokf * 1024 + h * 128 + fd0 + 8);
        bf16x8 sf[4];
#pragma unroll
        for (int ks = 0; ks < 4; ++ks) sf[ks] = pack8(S[2 * ks], S[2 * ks + 1]);
#define SB __builtin_amdgcn_sched_barrier(0)
        f32x4 vn[4];
        bf16x8 vf[2];
        { bf16x8 wf[4][4]; u32x2 uw[4];
#pragma unroll
          for (int cb = 0; cb < 4; ++cb)
#pragma unroll
              for (int ks = 0; ks < 4; ++ks) wf[cb][ks] = *(const LAS bf16x8*)(sW + (cb * 16 + jl) * 136 + ks * 32 + g * 8);
#pragma unroll
          for (int cb = 0; cb < 4; ++cb) uw[cb] = *(const LAS u32x2*)(sUT + (dv0 + jl) * 72 + cb * 16 + g * 4);
          SB;
          bf16x8 qa[2][4];
#pragma unroll
          for (int cb = 0; cb < 2; ++cb)
#pragma unroll
              for (int ks = 0; ks < 4; ++ks) qa[cb][ks] = *(const LAS bf16x8*)(sQG + (cb * 16 + jl) * 136 + ks * 32 + g * 8);
          f32x4 ac[4], aq[4];
#pragma unroll
          for (int cb = 0; cb < 4; ++cb) { ac[cb] = (f32x4){0.f, 0.f, 0.f, 0.f}; aq[cb] = ac[cb]; }
#pragma unroll
          for (int ks = 0; ks < 4; ++ks)
#pragma unroll
              for (int cb = 0; cb < 4; ++cb) ac[cb] = MFMA16(wf[cb][ks], sf[ks], ac[cb]);
          SB;
          bf16x8 qb[2][4];
#pragma unroll
          for (int cb = 0; cb < 2; ++cb)
#pragma unroll
              for (int ks = 0; ks < 4; ++ks) qb[cb][ks] = *(const LAS bf16x8*)(sQG + ((cb + 2) * 16 + jl) * 136 + ks * 32 + g * 8);
#pragma unroll
          for (int ks = 0; ks < 4; ++ks)
#pragma unroll
              for (int cb = 0; cb < 2; ++cb) aq[cb] = MFMA16(qa[cb][ks], sf[ks], aq[cb]);
          SB;
          bf16x8 kq[4][2];
#pragma unroll
          for (int cb = 0; cb < 4; ++cb)
#pragma unroll
              for (int k2 = 0; k2 < 2; ++k2) kq[cb][k2] = *(const LAS bf16x8*)(sQK + (cb * 16 + jl) * 72 + k2 * 32 + g * 8);
#pragma unroll
          for (int ks = 0; ks < 4; ++ks)
#pragma unroll
              for (int cb = 0; cb < 2; ++cb) aq[cb + 2] = MFMA16(qb[cb][ks], sf[ks], aq[cb + 2]);
#pragma unroll
          for (int cb = 0; cb < 4; ++cb) vn[cb] = (f32x4){bflo(uw[cb].x), bfhi(uw[cb].x), bflo(uw[cb].y), bfhi(uw[cb].y)} - ac[cb];
          vf[0] = pack8(vn[0], vn[1]); vf[1] = pack8(vn[2], vn[3]);
#pragma unroll
          for (int db = 0; db < 8; ++db) S[db] = S[db] * eg;
          SB;
          bf16x8 ka[4][2];
#pragma unroll
          for (int db = 0; db < 4; ++db)
#pragma unroll
              for (int k2 = 0; k2 < 2; ++k2) ka[db][k2] = *(const LAS bf16x8*)(sKGT + (db * 16 + jl) * 72 + k2 * 32 + g * 8);
#pragma unroll
          for (int k2 = 0; k2 < 2; ++k2)
#pragma unroll
              for (int cb = 0; cb < 4; ++cb) aq[cb] = MFMA16(kq[cb][k2], vf[k2], aq[cb]);
          SB;
          bf16x8 kb2[4][2];
#pragma unroll
          for (int db = 0; db < 4; ++db)
#pragma unroll
              for (int k2 = 0; k2 < 2; ++k2) kb2[db][k2] = *(const LAS bf16x8*)(sKGT + ((db + 4) * 16 + jl) * 72 + k2 * 32 + g * 8);
#pragma unroll
          for (int k2 = 0; k2 < 2; ++k2)
#pragma unroll
              for (int db = 0; db < 4; ++db) S[db] = MFMA16(ka[db][k2], vf[k2], S[db]);
#pragma unroll
          for (int cb = 0; cb < 4; ++cb)
#pragma unroll
              for (int rr = 0; rr < 4; ++rr) sO[(cb * 16 + g * 4 + rr) * 132 + dv0 + jl] = aq[cb][rr];
          SB;
#pragma unroll
          for (int k2 = 0; k2 < 2; ++k2)
#pragma unroll
              for (int db = 0; db < 4; ++db) S[db + 4] = MFMA16(kb2[db][k2], vf[k2], S[db + 4]); }
#undef SB
        __syncthreads();
        if (n + 1 < 32) SCAN_STORE();
        { f32x4 ov[4]; float ss = 0.f;
#pragma unroll
          for (int k = 0; k < 4; ++k) { ov[k] = *(const LAS f32x4*)(sO + fc * 132 + fd0 + 4 * k); ss += ov[k][0] * ov[k][0] + ov[k][1] * ov[k][1] + ov[k][2] * ov[k][2] + ov[k][3] * ov[k][3]; }
          ss += __shfl_xor(ss, 1); ss += __shfl_xor(ss, 2); ss += __shfl_xor(ss, 4);
          const float rs = rsqrtf(ss * (1.f / 128.f) + EPS);
          const unsigned zu[8] = {zw0.x, zw0.y, zw0.z, zw0.w, zw1.x, zw1.y, zw1.z, zw1.w};
          unsigned ow[8];
#pragma unroll
          for (int k = 0; k < 4; ++k) { const f32x4 y = ov[k] * rs * ngv[k];
              ow[2 * k] = pk2(y[0] * siluf_(bflo(zu[2 * k])), y[1] * siluf_(bfhi(zu[2 * k])));
              ow[2 * k + 1] = pk2(y[2] * siluf_(bflo(zu[2 * k + 1])), y[3] * siluf_(bfhi(zu[2 * k + 1]))); }
          *(u32x4*)(OA + tokf * 1024 + h * 128 + fd0) = (u32x4){ow[0], ow[1], ow[2], ow[3]};
          *(u32x4*)(OA + tokf * 1024 + h * 128 + fd0 + 8) = (u32x4){ow[4], ow[5], ow[6], ow[7]}; }
        __syncthreads();
    }
#undef SCAN_LOAD
#undef SCAN_STORE
}

__device__ __forceinline__ void attn_block_item(const Params& p, LAS unsigned char* lds, int idx) {
    unsigned char* ws = p.ws;
    int tid = threadIdx.x; asm volatile("" : "+v"(tid));
    const int lane = tid & 63, wave = tid >> 6, jl = lane & 15, g = lane >> 4;
    const int qblk = 7 - (idx >> 5), bh = idx & 31, b = bh >> 3, h = bh & 7;
    const int s0 = qblk * 256 + wave * 32; const size_t tq = (size_t)b * SEQ_ + s0 + jl;
    const int mychunk = s0 >> 6, ntiles = 4 * qblk + 4;
    const bf16_t* QB = (const bf16_t*)(ws + OFF_QB);
    bf16x8 qf[2][6];
#pragma unroll
    for (int u = 0; u < 2; ++u)
#pragma unroll
        for (int ks = 0; ks < 6; ++ks) qf[u][ks] = *(const bf16x8*)(QB + (tq + u * 16) * 1536 + h * 192 + ks * 32 + g * 8);
    const bf16_t* kp[3]; int kst[3], kl[3];
#pragma unroll
    for (int k = 0; k < 3; ++k) { const int q = tid + 512 * k, row = q / 24, pc = q - row * 24;
        if (pc < 16) { kp[k] = (const bf16_t*)(ws + OFF_KN) + ((size_t)b * SEQ_ + row) * 1024 + h * 128 + pc * 8; kst[k] = 64 * 1024; }
        else { kp[k] = (const bf16_t*)(ws + OFF_KR) + ((size_t)b * SEQ_ + row) * 64 + (pc - 16) * 8; kst[k] = 64 * 64; }
        kl[k] = row * 200 + pc * 8; }
    const bf16_t* vp[2]; int vl[2];
#pragma unroll
    for (int k = 0; k < 2; ++k) { const int q = tid + 512 * k, row = q >> 3, pc = q & 7;
        vp[k] = (const bf16_t*)(ws + OFF_VT) + (size_t)(h * 128 + row) * 8192 + (size_t)b * SEQ_ + pc * 8;
        vl[k] = row * 72 + (pc >> 2) * 32 + (pc & 1) * 16 + ((pc >> 1) & 1) * 4; }
    u32x4 rk[3], rv[2];
    const float* RSp = (const float*)(ws + OFF_RS);
    const float rq0 = RSp[tq], rq1 = RSp[tq + 16];
    const float* rkvp = RSp + T_ + (size_t)b * SEQ_ + g * 4;
    f32x4 kvs[4];
#define AT_LOAD(tile) do { _Pragma("unroll") for (int k = 0; k < 3; ++k) rk[k] = *(const u32x4*)(kp[k] + (size_t)(tile) * kst[k]); \
        _Pragma("unroll") for (int k = 0; k < 2; ++k) rv[k] = *(const u32x4*)(vp[k] + (tile) * 64); } while (0)
#define AT_STORE(bi) do { LAS bf16_t* sKb = (LAS bf16_t*)(lds + (bi) * 44032); LAS bf16_t* sVb = sKb + 64 * 200; \
        _Pragma("unroll") for (int k = 0; k < 3; ++k) *(LAS u32x4*)(sKb + kl[k]) = rk[k]; \
        _Pragma("unroll") for (int k = 0; k < 2; ++k) { *(LAS u32x2*)(sVb + vl[k]) = (u32x2){rv[k].x, rv[k].y}; *(LAS u32x2*)(sVb + vl[k] + 8) = (u32x2){rv[k].z, rv[k].w}; } } while (0)
    f32x4 o[2][8];
#pragma unroll
    for (int u = 0; u < 2; ++u)
#pragma unroll
        for (int i = 0; i < 8; ++i) o[u][i] = (f32x4){0.f, 0.f, 0.f, 0.f};
    float mrun[2] = {-1e30f, -1e30f}, lsum[2] = {0.f, 0.f};
    __syncthreads();
    AT_LOAD(0); AT_STORE(0);
    if (ntiles > 1) AT_LOAD(1);
    __syncthreads();
    for (int t = 0; t < ntiles; ++t) {
#pragma unroll
        for (int sb = 0; sb < 4; ++sb) kvs[sb] = *(const f32x4*)(rkvp + t * 64 + sb * 16);
        if (t + 1 < ntiles) { AT_STORE((t + 1) & 1); if (t + 2 < ntiles) AT_LOAD(t + 2); }
        if (t <= mychunk) {
            const LAS bf16_t* sKb = (const LAS bf16_t*)(lds + (t & 1) * 44032); const LAS bf16_t* sVb = sKb + 64 * 200;
            f32x4 s[2][4];
            {
              bf16x8 kfr[2][3];
#pragma unroll
              for (int k3 = 0; k3 < 3; ++k3) kfr[0][k3] = *(const LAS bf16x8*)(sKb + jl * 200 + k3 * 32 + g * 8);
              __builtin_amdgcn_sched_barrier(0);
              f32x4 a0 = (f32x4){0.f, 0.f, 0.f, 0.f}, a1 = a0;
#pragma unroll
              for (int hs = 0; hs < 8; ++hs) { const int sb = hs >> 1, kh = hs & 1;
                  if (hs + 1 < 8) { const int sb2 = (hs + 1) >> 1, kh2 = (hs + 1) & 1;
#pragma unroll
                      for (int k3 = 0; k3 < 3; ++k3) kfr[(hs + 1) & 1][k3] = *(const LAS bf16x8*)(sKb + (sb2 * 16 + jl) * 200 + (kh2 * 3 + k3) * 32 + g * 8); }
#pragma unroll
                  for (int k3 = 0; k3 < 3; ++k3) { a0 = MFMA16(kfr[hs & 1][k3], qf[0][kh * 3 + k3], a0); a1 = MFMA16(kfr[hs & 1][k3], qf[1][kh * 3 + k3], a1); }
                  if (kh == 1) { s[0][sb] = a0 * kvs[sb] * rq0; s[1][sb] = a1 * kvs[sb] * rq1; a0 = (f32x4){0.f, 0.f, 0.f, 0.f}; a1 = a0; }
                  __builtin_amdgcn_sched_barrier(0); } }
            bf16x8 pf[2][2]; float alpha[2];
#pragma unroll
            for (int u = 0; u < 2; ++u) {
                float mx = -1e30f;
#pragma unroll
                for (int sb = 0; sb < 4; ++sb) mx = fmaxf(mx, fmaxf(fmaxf(s[u][sb][0], s[u][sb][1]), fmaxf(s[u][sb][2], s[u][sb][3])));
                mx = fmaxf(mx, __shfl_xor(mx, 16)); mx = fmaxf(mx, __shfl_xor(mx, 32));
                const float mnew = fmaxf(mrun[u], mx); alpha[u] = __builtin_amdgcn_exp2f(mrun[u] - mnew); mrun[u] = mnew;
                float ps = 0.f;
#pragma unroll
                for (int sb = 0; sb < 4; ++sb)
#pragma unroll
                    for (int r = 0; r < 4; ++r) { const float pv = __builtin_amdgcn_exp2f(s[u][sb][r] - mnew); s[u][sb][r] = pv; ps += pv; }
                lsum[u] = lsum[u] * alpha[u] + ps;
                pf[u][0] = pack8(s[u][0] * kvs[0], s[u][1] * kvs[1]); pf[u][1] = pack8(s[u][2] * kvs[2], s[u][3] * kvs[3]); }
            { bf16x8 vfr[2][2];
#pragma unroll
              for (int k2 = 0; k2 < 2; ++k2) vfr[0][k2] = *(const LAS bf16x8*)(sVb + jl * 72 + k2 * 32 + g * 8);
              __builtin_amdgcn_sched_barrier(0);
#pragma unroll
              for (int db = 0; db < 8; ++db) {
                  if (db + 1 < 8) {
#pragma unroll
                      for (int k2 = 0; k2 < 2; ++k2) vfr[(db + 1) & 1][k2] = *(const LAS bf16x8*)(sVb + ((db + 1) * 16 + jl) * 72 + k2 * 32 + g * 8); }
                  f32x4 c0 = o[0][db] * alpha[0], c1 = o[1][db] * alpha[1];
#pragma unroll
                  for (int k2 = 0; k2 < 2; ++k2) { c0 = MFMA16(vfr[db & 1][k2], pf[0][k2], c0); c1 = MFMA16(vfr[db & 1][k2], pf[1][k2], c1); }
                  o[0][db] = c0; o[1][db] = c1;
                  __builtin_amdgcn_sched_barrier(0); } }
        }
        __syncthreads();
    }
#undef AT_LOAD
#undef AT_STORE
    bf16_t* OC = (bf16_t*)(ws + OFF_OC);
#pragma unroll
    for (int u = 0; u < 2; ++u) { float lt = lsum[u]; lt += __shfl_xor(lt, 16); lt += __shfl_xor(lt, 32); const float inv = __builtin_amdgcn_rcpf(lt);
#pragma unroll
        for (int db = 0; db < 8; ++db) { const f32x4 v = o[u][db] * inv; u32x2 w; w.x = pk2(v[0], v[1]); w.y = pk2(v[2], v[3]);
            *(u32x2*)(OC + (tq + u * 16) * 1024 + h * 128 + db * 16 + g * 4) = w; } }
}

__device__ __forceinline__ void sg_wave_item(const Params& p, int l, int widx) {
    unsigned char* ws = p.ws;
    int tid = threadIdx.x; asm volatile("" : "+v"(tid));
    const int lane = tid & 63, wave = widx & 7, idx = widx >> 3, jl = lane & 15, g = lane >> 4;
    const int gi = idx & 7, nb = (idx >> 3) & 15, b = idx >> 7;
    const size_t t0 = (size_t)b * SEQ_ + nb * 128; const int cc = gi * 128 + wave * 16 + jl;
    const bf16_t* SG = (const bf16_t*)(ws + OFF_SG); const float* STATS = (const float*)(ws + OFF_STATS); const bf16_t* SGW = (const bf16_t*)(ws + OFF_SGW);
    bf16_t* OB = (bf16_t*)(ws + OFF_OB);
    const float lg = p.lng[l * 1024 + cc], lb = p.lnb[l * 1024 + cc];
#define SB __builtin_amdgcn_sched_barrier(0)
    bf16x8 bfr[4];
    { bf16_t vr[4][8]; f32x4 st[4][4];
#pragma unroll
      for (int kb = 0; kb < 4; ++kb) {
#pragma unroll
          for (int e = 0; e < 8; ++e) vr[kb][e] = SG[(t0 + kb * 32 + g * 8 + e) * 2048 + 1024 + cc];
#pragma unroll
          for (int q = 0; q < 4; ++q) st[kb][q] = *(const f32x4*)(STATS + (t0 + kb * 32 + g * 8 + 2 * q) * 2); }
      SB;
#pragma unroll
      for (int kb = 0; kb < 4; ++kb) { float v[8];
#pragma unroll
          for (int q = 0; q < 4; ++q) { v[2 * q] = (bf1(vr[kb][2 * q]) - st[kb][q][0]) * st[kb][q][1] * lg + lb; v[2 * q + 1] = (bf1(vr[kb][2 * q + 1]) - st[kb][q][2]) * st[kb][q][3] * lg + lb; }
          u32x4 w; w.x = pk2(v[0], v[1]); w.y = pk2(v[2], v[3]); w.z = pk2(v[4], v[5]); w.w = pk2(v[6], v[7]); bfr[kb] = __builtin_bit_cast(bf16x8, w); } }
    SB;
    bf16_t ur[8][4]; f32x4 sbv[8];
#pragma unroll
    for (int ib = 0; ib < 8; ++ib) {
#pragma unroll
        for (int r = 0; r < 4; ++r) ur[ib][r] = SG[(t0 + ib * 16 + g * 4 + r) * 2048 + cc];
        sbv[ib] = *(const f32x4*)(p.sgb + l * 1024 + gi * 128 + ib * 16 + g * 4); }
    bf16x8 af[2][4];
#pragma unroll
    for (int kb = 0; kb < 4; ++kb) af[0][kb] = *(const bf16x8*)(SGW + (size_t)(gi * 128 + jl) * 128 + kb * 32 + g * 8);
    SB;
#pragma unroll
    for (int ib = 0; ib < 8; ++ib) {
        if (ib + 1 < 8) {
#pragma unroll
            for (int kb = 0; kb < 4; ++kb) af[(ib + 1) & 1][kb] = *(const bf16x8*)(SGW + (size_t)(gi * 128 + (ib + 1) * 16 + jl) * 128 + kb * 32 + g * 8); }
        f32x4 acc = (f32x4){0.f, 0.f, 0.f, 0.f};
#pragma unroll
        for (int kb = 0; kb < 4; ++kb) acc = MFMA16(af[ib & 1][kb], bfr[kb], acc);
#pragma unroll
        for (int r = 0; r < 4; ++r) { const size_t tok = t0 + ib * 16 + g * 4 + r;
            OB[tok * 1024 + cc] = f2bf(bf1(ur[ib][r]) * (acc[r] + sbv[ib][r])); }
        SB;
    }
#undef SB
}

#define XB_TMO      128
#define XB_XCNT(j)  (256  + 64 * (j))
#define XB_XSUB(j)  (1280 + 64 * (j))
#define XB_XGEN(j)  (2304 + 64 * (j))
#define XB_TOP      3328
#define XB_TOPGEN   3392
#define XCD_BAR_WORDS 3456
#define XB_SPIN_CAP (1u << 18)
__device__ __forceinline__ unsigned xb_ld(unsigned* p)              { return __hip_atomic_load(p, __ATOMIC_RELAXED, __HIP_MEMORY_SCOPE_AGENT); }
__device__ __forceinline__ unsigned xb_add(unsigned* p, unsigned v) { return __hip_atomic_fetch_add(p, v, __ATOMIC_RELAXED, __HIP_MEMORY_SCOPE_AGENT); }
__device__ __forceinline__ unsigned xb_xcc_id() { return (unsigned)__builtin_amdgcn_s_getreg((3 << 11) | 20) & 0xFu; }
#define XB_SPIN(cond, bar) do { unsigned _sp = 0; while (cond) { __builtin_amdgcn_s_sleep(1); \
    if ((++_sp & 255u) == 0u) { if (xb_ld(&(bar)[XB_TMO])) break; if (_sp > XB_SPIN_CAP) { atomicAdd(&(bar)[XB_TMO], 1u); break; } } } } while (0)
__device__ __forceinline__ void xcd_barrier_complete(unsigned* bar, unsigned x, unsigned& nloc, unsigned& nx) {
    const unsigned G = gridDim.x * gridDim.y * gridDim.z;
    unsigned sum, cnt, mine, sp = 0u;
    for (;;) {
        sum = 0u; cnt = 0u; mine = 0u;
#pragma unroll
        for (unsigned j = 0; j < 16; ++j) { const unsigned c = xb_ld(&bar[XB_XCNT(j)]); sum += c; cnt += (c > 0u) ? 1u : 0u; mine = (j == x) ? c : mine; }
        if (sum == G) break;
        __builtin_amdgcn_s_sleep(1);
        if ((++sp & 255u) == 0u) { if (xb_ld(&bar[XB_TMO])) break; if (sp > XB_SPIN_CAP) { atomicAdd(&bar[XB_TMO], 1u); break; } }
    }
    nloc = mine > 0u ? mine : 1u; nx = cnt > 0u ? cnt : 1u;
}
__device__ __forceinline__ void xcd_barrier(unsigned* bar, volatile LAS unsigned* st) {
    asm volatile("s_waitcnt vmcnt(0)" ::: "memory");
    __syncthreads();
    if (threadIdx.x == 0) {
        const unsigned x = xb_xcc_id();
        __builtin_amdgcn_s_waitcnt(0);
        unsigned nloc = st[0], nx = st[1];
        if (nloc == 0u) { xcd_barrier_complete(bar, x, nloc, nx); st[0] = nloc; st[1] = nx; }
        const unsigned old = xb_add(&bar[XB_XSUB(x)], 1u);
        const unsigned gen = old / nloc;
        if (old + 1u == (gen + 1u) * nloc) {
            __builtin_amdgcn_fence(__ATOMIC_RELEASE, "agent");
            asm volatile("s_waitcnt vmcnt(0)" ::: "memory");
            const unsigned og = xb_add(&bar[XB_TOP], 1u);
            const unsigned tg = og / nx;
            if (og + 1u == (tg + 1u) * nx) xb_add(&bar[XB_TOPGEN], 1u);
            else XB_SPIN(xb_ld(&bar[XB_TOPGEN]) == tg, bar);
            __builtin_amdgcn_fence(__ATOMIC_ACQUIRE, "agent");
            xb_add(&bar[XB_XGEN(x)], 1u);
            asm volatile("s_waitcnt vmcnt(0)" ::: "memory");
        } else {
            XB_SPIN(xb_ld(&bar[XB_XGEN(x)]) == gen, bar);
            __builtin_amdgcn_fence(__ATOMIC_ACQUIRE, "agent");
            asm volatile("s_waitcnt vmcnt(0)" ::: "memory");
        }
    }
    __syncthreads();
}

#ifndef NREP_GEMM
#define NREP_GEMM 1
#endif
#ifndef NREP_MIX
#define NREP_MIX 1
#endif
#ifndef NREP_PREP
#define NREP_PREP NREP_MIX
#endif
#ifndef NREP_P7
#define NREP_P7 NREP_MIX
#endif
#ifndef NREP_ROW
#define NREP_ROW 0
#endif
#ifndef NREP_CVT
#define NREP_CVT 1
#endif
#ifndef NREP_SYNC
#define NREP_SYNC 1
#endif
#define GSYNC() do { TB(4); for (int r_ = 0; r_ < NREP_SYNC; ++r_) { PQ xcd_barrier((unsigned*)(ws + OFF_BAR), (volatile LAS unsigned*)(shm + LDS_ST)); } TE(4); } while (0)
#define RG for (int rg_ = 0; rg_ < NREP_GEMM; ++rg_)
typedef const Params __attribute__((address_space(4)))* KP;
__device__ __forceinline__ Params ldp(KP q) {
#if defined(__HIP_DEVICE_COMPILE__)
    asm volatile("" : "+s"(q)); return *q;
#else
    return Params{};
#endif
}
#define PQ const Params p = ldp(kp); unsigned char* ws = p.ws; (void)ws;
__global__ __launch_bounds__(512, 2) void fwd_megakernel(Params p_unused) {
    extern __shared__ __attribute__((aligned(16))) unsigned char shm[];
    LAS unsigned char* lds = (LAS unsigned char*)shm;
    LAS float* L = (LAS float*)shm;
    LAS int* s_item = (LAS int*)(shm + LDS_ITEM);
    cg::grid_group grid = cg::this_grid();
    KP kp = (KP)__builtin_amdgcn_kernarg_segment_ptr();
    unsigned long long t0_ = 0, tacc_ = 0; (void)t0_; (void)tacc_;
#ifdef TCAT
    const unsigned long long tstart_ = __builtin_amdgcn_s_memrealtime();
#endif
    if (threadIdx.x == 0) { LAS unsigned* st = (LAS unsigned*)(shm + LDS_ST); st[0] = 0u; st[1] = 0u; PQ (void)xb_add((unsigned*)(ws + OFF_BAR) + XB_XCNT(xb_xcc_id()), 1u); }
    __syncthreads();

#ifndef NO_CVT
    TB(5); for (int rc_ = 0; rc_ < NREP_CVT; ++rc_) { PQ convert_layer(p, 0, lds); } TE(5);
#endif
    { PQ int tid = threadIdx.x; asm volatile("" : "+v"(tid));
      const size_t gt = (size_t)blockIdx.x * 512 + tid, NGT = (size_t)gridDim.x * 512; float* CS = (float*)(ws + OFF_CS);
      for (size_t e = gt; e < (size_t)T_ * 32; e += NGT) { const int t = (int)(e >> 5), i = (int)(e & 31);
          const float inv_freq = exp2f(-(float)(2 * i) * (1.f / 64.f) * 13.287712379549449f);
          const float ang = (float)p.pos[t] * inv_freq; float sn, cs; sn = sinf(ang); cs = cosf(ang);
          CS[(size_t)t * 64 + i] = cs; CS[(size_t)t * 64 + 32 + i] = sn; }
      if (gt < 64) ((unsigned*)(ws + OFF_CTR))[gt] = 0u; }
    TB(6); { PQ rowpass(p.x, nullptr, 0.f, nullptr, p.norm_g, p.out, (bf16_t*)(ws + OFF_H)); } TE(6);
    GSYNC();
    { PQ if (p.ws == nullptr) grid.sync(); }

    for (int l = 0; l < 2; ++l) {
        TB(1); RG { PQ EpiSwiGLU e; e.O = (bf16_t*)(ws + OFF_GATE); run_gemm(lds, (const bf16_t*)(ws + OFF_H), (const bf16_t*)(ws + OFF_WGU), T_, 11264, 2048, e); } TE(1);
        GSYNC();
        TB(1); RG { PQ EpiBf16Out e; e.O = (bf16_t*)(ws + OFF_F); e.ldc = DM; run_gemm(lds, (const bf16_t*)(ws + OFF_GATE), (const bf16_t*)(ws + OFF_WDN), T_, 2048, FF, e); } TE(1);
        GSYNC();
        for (int rr_ = 0; rr_ < NREP_ROW; ++rr_) { PQ const float* ng = p.norm_g + (size_t)l * 6 * DM; rowpass(p.out, (const bf16_t*)(ws + OFF_F), 0.0f, ng + DM, ng + 2 * DM, p.out, (bf16_t*)(ws + OFF_H)); }
        TB(6); { PQ const float* ng = p.norm_g + (size_t)l * 6 * DM; rowpass(p.out, (const bf16_t*)(ws + OFF_F), 0.5f, ng + DM, ng + 2 * DM, p.out, (bf16_t*)(ws + OFF_H)); } TE(6);
        GSYNC();
        TB(1); RG { PQ EpiWin e; e.ws = ws; run_gemm(lds, (const bf16_t*)(ws + OFF_H), (const bf16_t*)(ws + OFF_WIN), T_, NINP, 2048, e); } TE(1);
        GSYNC();
        TB(1); RG { PQ EpiQ e; e.QB = (bf16_t*)(ws + OFF_QB); e.RS = (const float*)(ws + OFF_RS); e.CS = (const float*)(ws + OFF_CS); e.qscale = 0.07216878364870322f * 1.4426950408889634f;
          run_gemm(lds, (const bf16_t*)(ws + OFF_CQ), (const bf16_t*)(ws + OFF_WUQ), T_, 1536, 512, e); } TE(1);
        TB(1); RG { PQ EpiKN e; e.O = (bf16_t*)(ws + OFF_KN); e.RS = (const float*)(ws + OFF_RS);
          run_gemm(lds, (const bf16_t*)(ws + OFF_CKV), (const bf16_t*)(ws + OFF_WUKV), T_, 1024, 512, e); } TE(1);
        TB(1); RG { PQ EpiVT e; e.O = (bf16_t*)(ws + OFF_VT); e.RS = (const float*)(ws + OFF_RS);
          run_gemm(lds, (const bf16_t*)(ws + OFF_WUKV) + (size_t)1024 * 512, (const bf16_t*)(ws + OFF_CKV), 1024, T_, 512, e); } TE(1);
        TB(2);
        for (int rm_ = 0; rm_ < NREP_PREP; ++rm_) {
#ifndef NO_PREP
        for (;;) {
            PQ
            __syncthreads();
            if (threadIdx.x == 0) *s_item = (int)atomicAdd((unsigned*)(ws + OFF_CTR) + 24 + l + 2 * rm_, 1u);
            __syncthreads();
            const int item = *s_item;
            if (item >= 1024) break;
            dn_prep_item(p, l, L, item, t0_, tacc_);
        }
#endif
#ifndef NO_ROWI
        TB(12); { PQ row_items(p); } TE(12);
#endif
        }
        TE(2);
        GSYNC();
        TB(3);
        for (int rm_ = 0; rm_ < NREP_P7; ++rm_) {
        for (;;) {
            PQ
            __syncthreads();
            if (threadIdx.x == 0) *s_item = (int)atomicAdd((unsigned*)(ws + OFF_CTR) + l + 8 * rm_, 1u);
            __syncthreads();
            const int it = *s_item;
            if (it >= 32 + 256) break;
            if (it < 32) dn_scan_item(p, l, lds, it);
            else attn_block_item(p, lds, it - 32);
        }
        for (;;) {
            PQ
            int it = 0;
            if ((threadIdx.x & 63) == 0) it = (int)atomicAdd((unsigned*)(ws + OFF_CTR) + 4 + l + 8 * rm_, 1u);
            it = __builtin_amdgcn_readfirstlane(it);
            if (it >= 4096) break;
            sg_wave_item(p, l, it);
        }
        }
        TE(3);
        GSYNC();
        TB(1); { PQ EpiBranchFused e; e.GATE = (const bf16_t*)(ws + OFF_GATE); e.OUT = (bf16_t*)(ws + OFF_MERGED); run_branch_gemm(lds, (const bf16_t*)(ws + OFF_OA), (const bf16_t*)(ws + OFF_WBR), e); } TE(1);
        GSYNC();
        TB(1); RG { PQ EpiBf16Out e; e.O = (bf16_t*)(ws + OFF_F); e.ldc = DM; run_gemm(lds, (const bf16_t*)(ws + OFF_MERGED), (const bf16_t*)(ws + OFF_WOUT), T_, 2048, 2048, e); } TE(1);
        GSYNC();
        for (int rr_ = 0; rr_ < NREP_ROW; ++rr_) { PQ const float* ng = p.norm_g + (size_t)l * 6 * DM; rowpass(p.out, (const bf16_t*)(ws + OFF_F), 0.0f, ng + 3 * DM, ng + 4 * DM, p.out, (bf16_t*)(ws + OFF_H)); }
        TB(6); { PQ const float* ng = p.norm_g + (size_t)l * 6 * DM; rowpass(p.out, (const bf16_t*)(ws + OFF_F), 1.0f, ng + 3 * DM, ng + 4 * DM, p.out, (bf16_t*)(ws + OFF_H)); } TE(6);
        GSYNC();
        TB(1); RG { PQ EpiSwiGLU e; e.O = (bf16_t*)(ws + OFF_GATE); run_gemm(lds, (const bf16_t*)(ws + OFF_H), (const bf16_t*)(ws + OFF_WGU) + (size_t)11264 * 2048, T_, 11264, 2048, e); } TE(1);
        GSYNC();
        TB(1); RG { PQ EpiBf16Out e; e.O = (bf16_t*)(ws + OFF_F); e.ldc = DM; run_gemm(lds, (const bf16_t*)(ws + OFF_GATE), (const bf16_t*)(ws + OFF_WDN) + (size_t)2048 * FF, T_, 2048, FF, e); } TE(1);
        GSYNC();
        if (l == 0) {
            for (int rr_ = 0; rr_ < NREP_ROW; ++rr_) { PQ const float* ng = p.norm_g; rowpass(p.out, (const bf16_t*)(ws + OFF_F), 0.0f, ng + 5 * DM, ng + 6 * DM, p.out, (bf16_t*)(ws + OFF_H)); }
            TB(6); { PQ const float* ng = p.norm_g; rowpass(p.out, (const bf16_t*)(ws + OFF_F), 0.5f, ng + 5 * DM, ng + 6 * DM, p.out, (bf16_t*)(ws + OFF_H)); } TE(6);
#ifndef NO_CVT
            TB(5); for (int rc_ = 0; rc_ < NREP_CVT; ++rc_) { PQ convert_layer(p, 1, lds); } TE(5);
#endif
            GSYNC();
        } else {
            for (int rr_ = 0; rr_ < NREP_ROW; ++rr_) { PQ const float* ng = p.norm_g + (size_t)6 * DM; rowpass(p.out, (const bf16_t*)(ws + OFF_F), 0.0f, ng + 5 * DM, nullptr, p.out, nullptr); }
            TB(6); { PQ const float* ng = p.norm_g + (size_t)6 * DM; rowpass(p.out, (const bf16_t*)(ws + OFF_F), 0.5f, ng + 5 * DM, nullptr, p.out, nullptr); } TE(6);
        }
    }
#ifdef TCAT
    if (blockIdx.x == 0 && threadIdx.x < 64) {
        if (TCAT == 0) tacc_ = __builtin_amdgcn_s_memrealtime() - tstart_;
        float fr = (float)tacc_ * (1.f / 800000.f); fr = fr > 1.f ? 1.f : fr;
        const float dl = 0.2f * sqrtf(fr);
        PQ
        for (int e = 0; e < 16; ++e) p.out[threadIdx.x * 16 + e] += dl;
    }
#endif
}

extern "C" void kernel_launch(void* const* d_in, const int* in_sizes, int n_in, void* d_out, int out_size, void* d_ws, size_t ws_size, hipStream_t stream) {
    static int grid_blocks = 0;
    if (!grid_blocks) {
        if (ws_size < WS_END) { fprintf(stderr, "kernel_launch: workspace too small: %zu < %zu\n", ws_size, (size_t)WS_END); grid_blocks = -1; return; }
        int dev = 0, cus = 0, per_cu = 0;
        (void)hipGetDevice(&dev);
        (void)hipDeviceGetAttribute(&cus, hipDeviceAttributeMultiprocessorCount, dev);
        if (hipFuncSetAttribute((const void*)fwd_megakernel, hipFuncAttributeMaxDynamicSharedMemorySize, LDS_BYTES) != hipSuccess) fprintf(stderr, "kernel_launch: hipFuncSetAttribute failed\n");
        if (hipOccupancyMaxActiveBlocksPerMultiprocessor(&per_cu, (const void*)fwd_megakernel, 512, LDS_BYTES) != hipSuccess || per_cu < 1) per_cu = 1;
        (void)hipGetLastError();
        grid_blocks = cus * per_cu;
    }
    if (grid_blocks < 0) return;
    Params p{};
    p.x = (const float*)d_in[0]; p.pos = (const int*)d_in[1]; p.norm_g = (const float*)d_in[2]; p.wg = (const float*)d_in[3]; p.wu = (const float*)d_in[4];
    p.wd = (const float*)d_in[5]; p.win = (const float*)d_in[6]; p.convw = (const float*)d_in[7]; p.alog = (const float*)d_in[8]; p.dtb = (const float*)d_in[9];
    p.dng = (const float*)d_in[10]; p.lng = (const float*)d_in[11]; p.lnb = (const float*)d_in[12]; p.sgw = (const float*)d_in[13]; p.sgb = (const float*)d_in[14];
    p.cqg = (const float*)d_in[15]; p.ckvg = (const float*)d_in[16]; p.wuq = (const float*)d_in[17]; p.wukv = (const float*)d_in[18]; p.wbr = (const float*)d_in[19];
    p.wout = (const float*)d_in[20]; p.out = (float*)d_out; p.ws = (unsigned char*)d_ws;
    (void)hipMemsetAsync((unsigned char*)d_ws + OFF_BAR, 0, XCD_BAR_WORDS * 4, stream);
    void* args[] = {&p};
    hipError_t e = hipLaunchCooperativeKernel((const void*)fwd_megakernel, dim3(grid_blocks), dim3(512), args, LDS_BYTES, stream);
    if (e != hipSuccess) fprintf(stderr, "cooperative launch failed: %s (grid %d)\n", hipGetErrorString(e), grid_blocks);
}
```

```cpp
#include <hip/hip_runtime.h>
#include <hip/hip_cooperative_groups.h>
#include <cstdio>
namespace cg = cooperative_groups;

#define LAS __attribute__((address_space(3)))
typedef unsigned short bf16_t;
typedef short bf16x8 __attribute__((ext_vector_type(8)));
typedef short s16x4 __attribute__((ext_vector_type(4)));
typedef float f32x4 __attribute__((ext_vector_type(4)));
typedef float f32x2 __attribute__((ext_vector_type(2)));
typedef unsigned u32x4 __attribute__((ext_vector_type(4)));
typedef unsigned u32x2 __attribute__((ext_vector_type(2)));

constexpr int T_ = 8192, DM = 2048, FF = 5632, NIN = 13392, NINP = 13568, SEQ_ = 2048;
constexpr int LDS_BYTES = 152576;
constexpr int LDS_ITEM = 152320, LDS_ST = 152336;
constexpr float EPS = 1e-6f;

constexpr size_t al256(size_t x) { return (x + 255) & ~(size_t)255; }
constexpr size_t OFF_WGU = 0;
constexpr size_t OFF_WDN = OFF_WGU + (size_t)2 * 11264 * 2048 * 2;
constexpr size_t OFF_WIN = OFF_WDN + (size_t)2 * 2048 * 5632 * 2;
constexpr size_t OFF_WUQ = OFF_WIN + (size_t)NINP * 2048 * 2;
constexpr size_t OFF_WUKV = OFF_WUQ + (size_t)1536 * 512 * 2;
constexpr size_t OFF_WBR = OFF_WUKV + (size_t)2048 * 512 * 2;
constexpr size_t OFF_WOUT = OFF_WBR + (size_t)3 * 2048 * 1024 * 2;
constexpr size_t OFF_SGW = OFF_WOUT + (size_t)2048 * 2048 * 2;
constexpr size_t OFF_H = OFF_SGW + (size_t)8 * 128 * 128 * 2;
constexpr size_t OFF_F = OFF_H + (size_t)T_ * 2048 * 2;
constexpr size_t OFF_GATE = OFF_F + (size_t)T_ * 2048 * 4;
constexpr size_t OFF_QKV = OFF_GATE + (size_t)T_ * 6144 * 2;
constexpr size_t OFF_Z = OFF_QKV + (size_t)T_ * 3072 * 2;
constexpr size_t OFF_SG = OFF_Z + (size_t)T_ * 1024 * 2;
constexpr size_t OFF_CQ = OFF_SG + (size_t)T_ * 2048 * 2;
constexpr size_t OFF_CKV = OFF_CQ + (size_t)T_ * 512 * 2;
constexpr size_t OFF_MISC = OFF_CKV + (size_t)T_ * 512 * 2;
constexpr size_t OFF_DW = OFF_MISC + (size_t)T_ * 128 * 4;
constexpr size_t OFF_DQG = OFF_DW + (size_t)1024 * 8192 * 2;
constexpr size_t OFF_DKGT = OFF_DQG + (size_t)1024 * 8192 * 2;
constexpr size_t OFF_DUT = OFF_DKGT + (size_t)1024 * 8192 * 2;
constexpr size_t OFF_DQK = OFF_DUT + (size_t)1024 * 8192 * 2;
constexpr size_t OFF_DEG = OFF_DQK + (size_t)1024 * 4096 * 2;
constexpr size_t OFF_QB = OFF_DEG + 4096;
constexpr size_t OFF_KN = OFF_QB + (size_t)T_ * 1536 * 2;
constexpr size_t OFF_KR = OFF_KN + (size_t)T_ * 1024 * 2;
constexpr size_t OFF_VT = OFF_KR + (size_t)T_ * 64 * 2;
constexpr size_t OFF_OA = OFF_VT + (size_t)1024 * 8192 * 2;
constexpr size_t OFF_OB = OFF_OA + (size_t)T_ * 1024 * 2;
constexpr size_t OFF_OC = OFF_OB + (size_t)T_ * 1024 * 2;
constexpr size_t OFF_MERGED = OFF_OC + (size_t)T_ * 1024 * 2;
constexpr size_t OFF_STATS = OFF_MERGED + (size_t)T_ * 2048 * 2;
constexpr size_t OFF_RS = OFF_STATS + (size_t)T_ * 2 * 4;
constexpr size_t OFF_CS = OFF_RS + (size_t)T_ * 2 * 4;
constexpr size_t OFF_CTR = OFF_CS + (size_t)T_ * 64 * 4;
constexpr size_t OFF_BAR = OFF_CTR + 256;
constexpr size_t WS_END = OFF_BAR + 16384;

struct Params {
    const float* x; const int* pos; const float* norm_g; const float* wg; const float* wu; const float* wd; const float* win;
    const float* convw; const float* alog; const float* dtb; const float* dng; const float* lng; const float* lnb; const float* sgw; const float* sgb;
    const float* cqg; const float* ckvg; const float* wuq; const float* wukv; const float* wbr; const float* wout;
    float* out; unsigned char* ws;
};

__device__ __forceinline__ unsigned pk2(float lo, float hi) { unsigned r; asm("v_cvt_pk_bf16_f32 %0, %1, %2" : "=v"(r) : "v"(lo), "v"(hi)); return r; }
__device__ __forceinline__ float bflo(unsigned u) { return __uint_as_float(u << 16); }
__device__ __forceinline__ float bfhi(unsigned u) { return __uint_as_float(u & 0xffff0000u); }
__device__ __forceinline__ float bf1(bf16_t b) { return __uint_as_float(((unsigned)b) << 16); }
__device__ __forceinline__ bf16_t f2bf(float f) { return (bf16_t)(pk2(f, 0.f) & 0xffffu); }
__device__ __forceinline__ float wave_sum(float v) {
#pragma unroll
    for (int o = 1; o < 64; o <<= 1) v += __shfl_xor(v, o);
    return v;
}
__device__ __forceinline__ float sigmoidf_(float x) { return __builtin_amdgcn_rcpf(1.f + __builtin_amdgcn_exp2f(-1.4426950408889634f * x)); }
__device__ __forceinline__ float siluf_(float x) { return x * __builtin_amdgcn_rcpf(1.f + __builtin_amdgcn_exp2f(-1.4426950408889634f * x)); }
__device__ __forceinline__ f32x2 gelu_pk(f32x2 v) {
    const f32x2 av = __builtin_elementwise_abs(v), d = av * 0.2316418882f + 1.0f;
    f32x2 t; t.x = __builtin_amdgcn_rcpf(d.x); t.y = __builtin_amdgcn_rcpf(d.y);
    f32x2 q = t * 0.5307027145f + (-0.7265760135f); q = q * t + 0.7107068705f; q = q * t + (-0.142248368f); q = q * t + 0.127414796f; q = q * t;
    const f32x2 s = (v * v) * (-0.72134752044f);
    f32x2 e; e.x = __builtin_amdgcn_exp2f(s.x); e.y = __builtin_amdgcn_exp2f(s.y);
    const f32x2 m = v * (q * e), r = v - m;
    f32x2 o; o.x = v.x < 0.f ? m.x : r.x; o.y = v.y < 0.f ? m.y : r.y; return o;
}
__device__ __forceinline__ bf16x8 load2x4(const bf16_t* p) {
    const s16x4 lo = *(const s16x4*)p, hi = *(const s16x4*)(p + 16);
    return __builtin_shufflevector(lo, hi, 0, 1, 2, 3, 4, 5, 6, 7);
}
__device__ __forceinline__ bf16x8 pack8(f32x4 a, f32x4 b) {
    u32x4 w; w.x = pk2(a[0], a[1]); w.y = pk2(a[2], a[3]); w.z = pk2(b[0], b[1]); w.w = pk2(b[2], b[3]);
    return __builtin_bit_cast(bf16x8, w);
}
#define MFMA16(a, b, c) __builtin_amdgcn_mfma_f32_16x16x32_bf16((a), (b), (c), 0, 0, 0)
#define LDS_WAIT() asm volatile("s_waitcnt lgkmcnt(0)" ::: "memory")

#ifdef TCAT
#define TB(c) do { if (TCAT == (c)) t0_ = __builtin_amdgcn_s_memrealtime(); } while (0)
#define TE(c) do { if (TCAT == (c)) tacc_ += __builtin_amdgcn_s_memrealtime() - t0_; } while (0)
#else
#define TB(c) do {} while (0)
#define TE(c) do {} while (0)
#endif
namespace pg8 {
constexpr int BM = 256, BK = 64, HALF = 128, HTB = HALF * BK * 2, NXCD = 8, WGM = 8;
__device__ __forceinline__ int lds_byte(int r, int c) { const int st = (r >> 4) * 2 + (c >> 5), rr = r & 15, cc = c & 31, ob = rr * 64 + cc * 2; return st * 1024 + (ob ^ (((ob >> 9) & 1) << 5)); }
__device__ __forceinline__ void stage_rc(int b, int& R, int& C) { const int st = b / 1024, sb = b % 1024, swz = sb ^ (((sb >> 9) & 1) << 5); R = (st >> 1) * 16 + swz / 64; C = (st & 1) * 32 + (swz % 64) / 2; }
__device__ __forceinline__ int perm32(int rho) { const int n = rho >> 4, i = rho & 15; return 8 * (i >> 2) + 4 * n + (i & 3); }
struct Unit { int pm, pn, seg; };
struct Gemm { const bf16_t* A; const bf16_t* Bt; int M, N, K; size_t segA, segB; };
struct StaticOrder {
    int nM, nN, nwg, G, c, nseg;
    __device__ __forceinline__ void init(int M, int N, int G_, int c_) { nM = M / BM; nN = N / BM; nwg = nM * nN; G = G_; c = c_; nseg = 1; }
    __device__ __forceinline__ bool next(int i, Unit& u) const {
        const int ti = i / nseg; u.seg = i - ti * nseg;
        const long L = (long)ti * G + c; if (L >= nwg) return false;
        int wgid = (int)L; { const int q = nwg / NXCD, r = nwg % NXCD, xcd = wgid % NXCD, off = wgid / NXCD; wgid = (xcd < r ? xcd * (q + 1) : r * (q + 1) + (xcd - r) * q) + off; }
        const int nig = WGM * nN, gid = wgid / nig, fm = gid * WGM, gsz = (nM - fm) < WGM ? (nM - fm) : WGM;
        u.pm = fm + ((wgid % nig) % gsz); u.pn = (wgid % nig) / gsz; return true;
    }
};
template <class Epi>
__device__ __forceinline__ void gemm_phase(LAS unsigned char* lds, const Gemm g, const StaticOrder& S, const Epi& E) {
    int tid = threadIdx.x; asm volatile("" : "+v"(tid));
    const int wid = __builtin_amdgcn_readfirstlane(tid >> 6), lane = tid & 63, wr = wid >> 2, wc = wid & 3, fr = lane & 15, fq = lane >> 4;
    const int K = g.K, nt = K / BK;
    unsigned voffA[2], voffB[2];
#pragma unroll
    for (int i = 0; i < 2; ++i) { int R, C; stage_rc(tid * 16 + i * 8192, R, C); const int Rb = Epi::PERM ? ((R & ~31) + perm32(R & 31)) : R;
        voffA[i] = (unsigned)(R * K + C) * 2u; voffB[i] = (unsigned)(Rb * K + C) * 2u; }
    const size_t kstep = (size_t)(BK * 2);
    const size_t hstep = (size_t)HALF * K * 2;
    const size_t tstep = 2 * hstep;
    const unsigned ldsw = (unsigned)wid * 1024u;
    const int aoff = lds_byte(wr * 64 + fr, fq * 8), boff = lds_byte(wc * 32 + fr, fq * 8);
#define PG8_SA(b, h) (((b) * 2 + (h)) * HTB)
#define PG8_SB(b, h) ((4 + (b) * 2 + (h)) * HTB)
#define PG8_STAGE(bufoff, gbase, voff) do { _Pragma("unroll") for (int _i = 0; _i < 2; ++_i) \
        __builtin_amdgcn_global_load_lds((const unsigned*)((const char*)(gbase) + (voff)[_i]), (LAS unsigned*)(lds + (bufoff) + ldsw + _i * 8192), 16, 0, 0); } while (0)
#define PG8_LDA(dst, b, h) do { _Pragma("unroll") for (int m = 0; m < 4; ++m) _Pragma("unroll") for (int k = 0; k < 2; ++k) dst[m][k] = *(const LAS bf16x8*)(lds + PG8_SA(b, h) + aoff + m * 2048 + k * 1024); } while (0)
#define PG8_LDB(dst, b, h) do { _Pragma("unroll") for (int n = 0; n < 2; ++n) _Pragma("unroll") for (int k = 0; k < 2; ++k) dst[n][k] = *(const LAS bf16x8*)(lds + PG8_SB(b, h) + boff + n * 2048 + k * 1024); } while (0)
#define PG8_MMA(ai, bj, At, Bt) do { __builtin_amdgcn_s_setprio(1); _Pragma("unroll") for (int m = 0; m < 4; ++m) _Pragma("unroll") for (int n = 0; n < 2; ++n) _Pragma("unroll") for (int k = 0; k < 2; ++k) \
        acc[ai][bj][m][n] = __builtin_amdgcn_mfma_f32_16x16x32_bf16(Bt[n][k], At[m][k], acc[ai][bj][m][n], 0, 0, 0); __builtin_amdgcn_s_setprio(0); } while (0)
#define PG8_WAIT_V(n) asm volatile("s_waitcnt vmcnt(" #n ")" ::: "memory")
#define PG8_WAIT_L(n) asm volatile("s_waitcnt lgkmcnt(" #n ")" ::: "memory")
#define PG8_BAR __builtin_amdgcn_s_barrier()
#define PG8_SCHED __builtin_amdgcn_sched_barrier(0)
    Unit cur, nxt; int ui = 0;
    if (!S.next(0, cur)) return;
    f32x4 acc[2][2][4][2];
#pragma unroll
    for (int a = 0; a < 2; ++a)
#pragma unroll
        for (int b = 0; b < 2; ++b)
#pragma unroll
            for (int m = 0; m < 4; ++m)
#pragma unroll
                for (int n = 0; n < 2; ++n) acc[a][b][m][n] = (f32x4){0.f, 0.f, 0.f, 0.f};
    bf16x8 At[4][2], B0[2][2], B1[2][2];
    const char* cA = (const char*)g.A + cur.seg * g.segA + (size_t)cur.pm * tstep; const char* cB = (const char*)g.Bt + cur.seg * g.segB + (size_t)cur.pn * tstep;
    PG8_STAGE(PG8_SB(0, 0), cB, voffB); PG8_STAGE(PG8_SA(0, 0), cA, voffA); PG8_STAGE(PG8_SB(0, 1), cB + hstep, voffB); PG8_STAGE(PG8_SA(0, 1), cA + hstep, voffA);
    if (wr == 1) PG8_BAR;
    PG8_WAIT_V(4); PG8_BAR;
    PG8_STAGE(PG8_SB(1, 0), cB + kstep, voffB); PG8_STAGE(PG8_SA(1, 0), cA + kstep, voffA); PG8_STAGE(PG8_SB(1, 1), cB + hstep + kstep, voffB);
    PG8_WAIT_V(6); PG8_BAR;
    for (;;) {
        const bool has_next = S.next(ui + 1, nxt);
        const char* nA = has_next ? (const char*)g.A + nxt.seg * g.segA + (size_t)nxt.pm * tstep : cA; const char* nB = has_next ? (const char*)g.Bt + nxt.seg * g.segB + (size_t)nxt.pn * tstep : cB;
        for (int t = 0; t < nt; t += 2) {
            const bool last = (t == nt - 2);
            const char* a1 = cA + (size_t)(t + 1) * kstep;
            const char* a2 = last ? nA : cA + (size_t)(t + 2) * kstep; const char* b2 = last ? nB : cB + (size_t)(t + 2) * kstep;
            const char* a3 = a2 + kstep; const char* b3 = b2 + kstep;
            PG8_LDB(B0, 0, 0); PG8_SCHED; PG8_LDA(At, 0, 0); PG8_STAGE(PG8_SA(1, 1), a1 + hstep, voffA);
            PG8_WAIT_L(8); PG8_BAR; PG8_WAIT_L(0); PG8_MMA(0, 0, At, B0); PG8_BAR; PG8_SCHED;
            PG8_LDB(B1, 0, 1); PG8_STAGE(PG8_SB(0, 0), b2, voffB);
            PG8_BAR; PG8_WAIT_L(0); PG8_MMA(0, 1, At, B1); PG8_BAR;
            PG8_LDA(At, 0, 1); PG8_STAGE(PG8_SA(0, 0), a2, voffA);
            PG8_BAR; PG8_WAIT_L(0); PG8_MMA(1, 0, At, B0); PG8_BAR; PG8_SCHED;
            PG8_STAGE(PG8_SB(0, 1), b2 + hstep, voffB);
            PG8_WAIT_V(6); PG8_BAR; PG8_MMA(1, 1, At, B1); PG8_BAR;
            PG8_LDB(B0, 1, 0); PG8_SCHED; PG8_LDA(At, 1, 0); PG8_STAGE(PG8_SA(0, 1), a2 + hstep, voffA);
            PG8_WAIT_L(8); PG8_BAR; PG8_WAIT_L(0); PG8_MMA(0, 0, At, B0); PG8_BAR; PG8_SCHED;
            PG8_LDB(B1, 1, 1); PG8_STAGE(PG8_SB(1, 0), b3, voffB);
            PG8_BAR; PG8_WAIT_L(0); PG8_MMA(0, 1, At, B1); PG8_BAR;
            PG8_LDA(At, 1, 1); PG8_STAGE(PG8_SA(1, 0), a3, voffA);
            PG8_BAR; PG8_WAIT_L(0); PG8_MMA(1, 0, At, B0); PG8_BAR; PG8_SCHED;
            PG8_STAGE(PG8_SB(1, 1), b3 + hstep, voffB);
            PG8_WAIT_V(6); PG8_BAR; PG8_MMA(1, 1, At, B1); PG8_BAR;
        }
        E(acc, cur, wr, wc, fr, fq);
        if (!has_next) break;
        if (nxt.seg == 0) {
#pragma unroll
        for (int a = 0; a < 2; ++a)
#pragma unroll
            for (int b = 0; b < 2; ++b)
#pragma unroll
                for (int m = 0; m < 4; ++m)
#pragma unroll
                    for (int n = 0; n < 2; ++n) acc[a][b][m][n] = (f32x4){0.f, 0.f, 0.f, 0.f};
        }
        cur = nxt; cA = nA; cB = nB; ++ui;
    }
    PG8_WAIT_V(0);
    if (wr == 0) PG8_BAR;
    PG8_BAR;
#undef PG8_SA
#undef PG8_SB
#undef PG8_STAGE
#undef PG8_LDA
#undef PG8_LDB
#undef PG8_MMA
#undef PG8_WAIT_V
#undef PG8_WAIT_L
#undef PG8_BAR
#undef PG8_SCHED
}
}
using pg8::Unit;
typedef f32x4 Acc[2][2][4][2];

struct EpiF32 {
    static constexpr bool PERM = false;
    float* C; int ldc;
    __device__ __forceinline__ void operator()(const Acc& acc, const Unit& u, int wr, int wc, int fr, int fq) const {
        const int row0 = u.pm * 256 + wr * 64 + fr, col0 = u.pn * 256 + wc * 32 + 4 * fq;
#pragma unroll
        for (int ai = 0; ai < 2; ++ai)
#pragma unroll
            for (int m = 0; m < 4; ++m) { float* rowp = C + (size_t)(row0 + ai * 128 + m * 16) * ldc + col0;
#pragma unroll
                for (int bj = 0; bj < 2; ++bj)
#pragma unroll
                    for (int n = 0; n < 2; ++n) *(f32x4*)(rowp + bj * 128 + n * 16) = acc[ai][bj][m][n]; }
    }
};
struct EpiBf16Out {
    static constexpr bool PERM = true;
    bf16_t* O; int ldc;
    __device__ __forceinline__ void operator()(const Acc& acc, const Unit& u, int wr, int wc, int fr, int fq) const {
        const int row0 = u.pm * 256 + wr * 64 + fr, col0 = u.pn * 256 + wc * 32 + 8 * fq;
#pragma unroll
        for (int ai = 0; ai < 2; ++ai)
#pragma unroll
            for (int m = 0; m < 4; ++m) { bf16_t* rowp = O + (size_t)(row0 + ai * 128 + m * 16) * ldc + col0;
#pragma unroll
                for (int bj = 0; bj < 2; ++bj) { const f32x4 v0 = acc[ai][bj][m][0], v1 = acc[ai][bj][m][1];
                    u32x4 w; w.x = pk2(v0[0], v0[1]); w.y = pk2(v0[2], v0[3]); w.z = pk2(v1[0], v1[1]); w.w = pk2(v1[2], v1[3]);
                    *(u32x4*)(rowp + bj * 128) = w; } }
    }
};
struct EpiSwiGLU {
    static constexpr bool PERM = true;
    bf16_t* O;
    __device__ __forceinline__ void operator()(const Acc& acc, const Unit& u, int wr, int wc, int fr, int fq) const {
        const int row0 = u.pm * 256 + wr * 64 + fr, col0 = u.pn * 128 + wc * 32 + 8 * fq;
#pragma unroll
        for (int ai = 0; ai < 2; ++ai)
#pragma unroll
            for (int m = 0; m < 4; ++m) {
                f32x4 v0, v1;
#pragma unroll
                for (int e = 0; e < 4; ++e) { v0[e] = siluf_(acc[ai][0][m][0][e]) * acc[ai][1][m][0][e]; v1[e] = siluf_(acc[ai][0][m][1][e]) * acc[ai][1][m][1][e]; }
                u32x4 w; w.x = pk2(v0[0], v0[1]); w.y = pk2(v0[2], v0[3]); w.z = pk2(v1[0], v1[1]); w.w = pk2(v1[2], v1[3]);
                *(u32x4*)(O + (size_t)(row0 + ai * 128 + m * 16) * FF + col0) = w; }
    }
};
struct EpiWin {
    static constexpr bool PERM = true;
    unsigned char* ws;
    __device__ __forceinline__ void operator()(const Acc& acc, const Unit& u, int wr, int wc, int fr, int fq) const {
        const int pn = u.pn, row0 = u.pm * 256 + wr * 64 + fr;
        if (pn == 52) {
            float* M = (float*)(ws + OFF_MISC);
#pragma unroll
            for (int ai = 0; ai < 2; ++ai)
#pragma unroll
                for (int m = 0; m < 4; ++m)
#pragma unroll
                    for (int n = 0; n < 2; ++n) *(f32x4*)(M + (size_t)(row0 + ai * 128 + m * 16) * 128 + 32 * wc + 8 * fq + 4 * n) = acc[ai][0][m][n];
            return;
        }
        bf16_t* base; int ld, col, mode = 0;
        if (pn < 12) { base = (bf16_t*)(ws + OFF_QKV); ld = 3072; col = pn * 256; }
        else if (pn < 16) { base = (bf16_t*)(ws + OFF_Z); ld = 1024; col = (pn - 12) * 256; }
        else if (pn < 24) { base = (bf16_t*)(ws + OFF_SG); ld = 2048; col = (pn - 16) * 256; mode = 2; }
        else if (pn < 26) { base = (bf16_t*)(ws + OFF_CQ); ld = 512; col = (pn - 24) * 256; }
        else if (pn < 28) { base = (bf16_t*)(ws + OFF_CKV); ld = 512; col = (pn - 26) * 256; }
        else { base = (bf16_t*)(ws + OFF_GATE); ld = 6144; col = (pn - 28) * 256; mode = 1; }
        col += wc * 32 + 8 * fq;
#pragma unroll
        for (int ai = 0; ai < 2; ++ai)
#pragma unroll
            for (int m = 0; m < 4; ++m) { bf16_t* rowp = base + (size_t)(row0 + ai * 128 + m * 16) * ld + col;
#pragma unroll
                for (int bj = 0; bj < 2; ++bj) { f32x4 v0 = acc[ai][bj][m][0], v1 = acc[ai][bj][m][1];
                    if (mode == 1) {
#pragma unroll
                        for (int e = 0; e < 4; ++e) { v0[e] = sigmoidf_(v0[e]); v1[e] = sigmoidf_(v1[e]); } }
                    else if (mode == 2) { f32x2 a = gelu_pk((f32x2){v0[0], v0[1]}), b = gelu_pk((f32x2){v0[2], v0[3]}), c = gelu_pk((f32x2){v1[0], v1[1]}), d = gelu_pk((f32x2){v1[2], v1[3]});
                        v0 = (f32x4){a.x, a.y, b.x, b.y}; v1 = (f32x4){c.x, c.y, d.x, d.y}; }
                    u32x4 w; w.x = pk2(v0[0], v0[1]); w.y = pk2(v0[2], v0[3]); w.z = pk2(v1[0], v1[1]); w.w = pk2(v1[2], v1[3]);
                    *(u32x4*)(rowp + bj * 128) = w; } }
    }
};
struct EpiQ {
    static constexpr bool PERM = true;
    bf16_t* QB; const float* RS; const float* CS; float qscale;
    __device__ __forceinline__ void operator()(const Acc& acc, const Unit& u, int wr, int wc, int fr, int fq) const {
        const int pn = u.pn, row0 = u.pm * 256 + wr * 64 + fr;
#pragma unroll
        for (int ai = 0; ai < 2; ++ai)
#pragma unroll
            for (int m = 0; m < 4; ++m) { const int row = row0 + ai * 128 + m * 16; const float sc = qscale;
                if (pn < 4) {
#pragma unroll
                    for (int bj = 0; bj < 2; ++bj) { const f32x4 v0 = acc[ai][bj][m][0] * sc, v1 = acc[ai][bj][m][1] * sc;
                        u32x4 w; w.x = pk2(v0[0], v0[1]); w.y = pk2(v0[2], v0[3]); w.z = pk2(v1[0], v1[1]); w.w = pk2(v1[2], v1[3]);
                        *(u32x4*)(QB + (size_t)row * 1536 + (pn * 2 + bj) * 192 + wc * 32 + 8 * fq) = w; }
                } else {
                    const int head = (pn - 4) * 4 + wc, i0 = 8 * fq;
                    const f32x4 c0 = *(const f32x4*)(CS + (size_t)row * 64 + i0), c1 = *(const f32x4*)(CS + (size_t)row * 64 + i0 + 4);
                    const f32x4 s0 = *(const f32x4*)(CS + (size_t)row * 64 + 32 + i0), s1 = *(const f32x4*)(CS + (size_t)row * 64 + 32 + i0 + 4);
                    const f32x4 x10 = acc[ai][0][m][0] * sc, x11 = acc[ai][0][m][1] * sc, x20 = acc[ai][1][m][0] * sc, x21 = acc[ai][1][m][1] * sc;
                    const f32x4 a0 = x10 * c0 - x20 * s0, a1 = x11 * c1 - x21 * s1, b0 = x10 * s0 + x20 * c0, b1 = x11 * s1 + x21 * c1;
                    u32x4 w; w.x = pk2(a0[0], a0[1]); w.y = pk2(a0[2], a0[3]); w.z = pk2(a1[0], a1[1]); w.w = pk2(a1[2], a1[3]);
                    *(u32x4*)(QB + (size_t)row * 1536 + head * 192 + 128 + i0) = w;
                    w.x = pk2(b0[0], b0[1]); w.y = pk2(b0[2], b0[3]); w.z = pk2(b1[0], b1[1]); w.w = pk2(b1[2], b1[3]);
                    *(u32x4*)(QB + (size_t)row * 1536 + head * 192 + 160 + i0) = w;
                } }
    }
};
struct EpiKN {
    static constexpr bool PERM = true;
    bf16_t* O; const float* RS;
    __device__ __forceinline__ void operator()(const Acc& acc, const Unit& u, int wr, int wc, int fr, int fq) const {
        const int row0 = u.pm * 256 + wr * 64 + fr, col0 = u.pn * 256 + wc * 32 + 8 * fq;
#pragma unroll
        for (int ai = 0; ai < 2; ++ai)
#pragma unroll
            for (int m = 0; m < 4; ++m) { const int row = row0 + ai * 128 + m * 16; const float sc = 1.f;
#pragma unroll
                for (int bj = 0; bj < 2; ++bj) { const f32x4 v0 = acc[ai][bj][m][0] * sc, v1 = acc[ai][bj][m][1] * sc;
                    u32x4 w; w.x = pk2(v0[0], v0[1]); w.y = pk2(v0[2], v0[3]); w.z = pk2(v1[0], v1[1]); w.w = pk2(v1[2], v1[3]);
                    *(u32x4*)(O + (size_t)row * 1024 + col0 + bj * 128) = w; } }
    }
};
struct EpiVT {
    static constexpr bool PERM = true;
    bf16_t* O; const float* RS;
    __device__ __forceinline__ void operator()(const Acc& acc, const Unit& u, int wr, int wc, int fr, int fq) const {
        const int row0 = u.pm * 256 + wr * 64 + fr, col0 = u.pn * 256 + wc * 32 + 8 * fq;
        float sc[2][8];
#pragma unroll
        for (int bj = 0; bj < 2; ++bj)
#pragma unroll
            for (int e = 0; e < 8; ++e) sc[bj][e] = 1.f;
#pragma unroll
        for (int ai = 0; ai < 2; ++ai)
#pragma unroll
            for (int m = 0; m < 4; ++m) { const int row = row0 + ai * 128 + m * 16;
#pragma unroll
                for (int bj = 0; bj < 2; ++bj) { const f32x4 v0 = acc[ai][bj][m][0], v1 = acc[ai][bj][m][1];
                    u32x4 w; w.x = pk2(v0[0] * sc[bj][0], v0[1] * sc[bj][1]); w.y = pk2(v0[2] * sc[bj][2], v0[3] * sc[bj][3]);
                    w.z = pk2(v1[0] * sc[bj][4], v1[1] * sc[bj][5]); w.w = pk2(v1[2] * sc[bj][6], v1[3] * sc[bj][7]);
                    *(u32x4*)(O + (size_t)row * 8192 + col0 + bj * 128) = w; } }
    }
};
template <int BR> struct EpiBranch {
    static constexpr bool PERM = true;
    bf16_t* ACC; const bf16_t* GATE; bf16_t* OUT;
    __device__ __forceinline__ void operator()(const Acc& acc, const Unit& u, int wr, int wc, int fr, int fq) const {
        const int row0 = u.pm * 256 + wr * 64 + fr, col0 = u.pn * 256 + wc * 32 + 8 * fq;
#pragma unroll
        for (int ai = 0; ai < 2; ++ai)
#pragma unroll
            for (int m = 0; m < 4; ++m) { const int row = row0 + ai * 128 + m * 16;
#pragma unroll
                for (int bj = 0; bj < 2; ++bj) { const int col = col0 + bj * 128;
                    const u32x4 gw = *(const u32x4*)(GATE + (size_t)row * 6144 + BR * 2048 + col);
                    f32x4 v0 = acc[ai][bj][m][0], v1 = acc[ai][bj][m][1];
                    v0[0] *= bflo(gw.x); v0[1] *= bfhi(gw.x); v0[2] *= bflo(gw.y); v0[3] *= bfhi(gw.y);
                    v1[0] *= bflo(gw.z); v1[1] *= bfhi(gw.z); v1[2] *= bflo(gw.w); v1[3] *= bfhi(gw.w);
                    bf16_t* ap = ACC + (size_t)row * 2048 + col;
                    if (BR > 0) { const u32x4 pw = *(const u32x4*)ap;
                        v0[0] += bflo(pw.x); v0[1] += bfhi(pw.x); v0[2] += bflo(pw.y); v0[3] += bfhi(pw.y);
                        v1[0] += bflo(pw.z); v1[1] += bfhi(pw.z); v1[2] += bflo(pw.w); v1[3] += bfhi(pw.w); }
                    u32x4 w; w.x = pk2(v0[0], v0[1]); w.y = pk2(v0[2], v0[3]); w.z = pk2(v1[0], v1[1]); w.w = pk2(v1[2], v1[3]);
                    if (BR < 2) *(u32x4*)ap = w; else *(u32x4*)(OUT + (size_t)row * 2048 + col) = w; } }
    }
};

struct EpiBranchFused {
    static constexpr bool PERM = true;
    const bf16_t* GATE; bf16_t* OUT;
    __device__ __forceinline__ void operator()(Acc& acc, const Unit& u, int wr, int wc, int fr, int fq) const {
        const int row0 = u.pm * 256 + wr * 64 + fr, col0 = u.pn * 256 + wc * 32 + 8 * fq, seg = u.seg;
        const int segb = seg < 2 ? seg + 1 : seg;
#pragma unroll
        for (int aim = 0; aim < 4; ++aim) { const int ai = aim >> 1, mh = aim & 1;
            u32x4 ga[4][2], gb[4][2];
#pragma unroll
            for (int m = mh * 2; m < mh * 2 + 2; ++m)
#pragma unroll
                for (int bj = 0; bj < 2; ++bj) { const size_t off = (size_t)(row0 + ai * 128 + m * 16) * 6144 + col0 + bj * 128;
                    ga[m][bj] = *(const u32x4*)(GATE + off + seg * 2048); gb[m][bj] = *(const u32x4*)(GATE + off + segb * 2048); }
            __builtin_amdgcn_sched_barrier(0);
#pragma unroll
            for (int m = mh * 2; m < mh * 2 + 2; ++m) { const int row = row0 + ai * 128 + m * 16;
#pragma unroll
                for (int bj = 0; bj < 2; ++bj) { const int col = col0 + bj * 128;
                    const u32x4 a = ga[m][bj], d = gb[m][bj];
                    float sc[8] = {bflo(a.x), bfhi(a.x), bflo(a.y), bfhi(a.y), bflo(a.z), bfhi(a.z), bflo(a.w), bfhi(a.w)};
                    if (seg < 2) { const float dn[8] = {bflo(d.x), bfhi(d.x), bflo(d.y), bfhi(d.y), bflo(d.z), bfhi(d.z), bflo(d.w), bfhi(d.w)};
#pragma unroll
                        for (int e = 0; e < 8; ++e) sc[e] = sc[e] * __builtin_amdgcn_rcpf(dn[e]); }
                    f32x4 v0 = acc[ai][bj][m][0], v1 = acc[ai][bj][m][1];
#pragma unroll
                    for (int e = 0; e < 4; ++e) { v0[e] *= sc[e]; v1[e] *= sc[4 + e]; }
                    if (seg < 2) { acc[ai][bj][m][0] = v0; acc[ai][bj][m][1] = v1; }
                    else { u32x4 w; w.x = pk2(v0[0], v0[1]); w.y = pk2(v0[2], v0[3]); w.z = pk2(v1[0], v1[1]); w.w = pk2(v1[2], v1[3]);
                        *(u32x4*)(OUT + (size_t)row * 2048 + col) = w; } } }
            __builtin_amdgcn_sched_barrier(0);
        }
    }
};
__device__ __forceinline__ void run_branch_gemm(LAS unsigned char* lds, const bf16_t* A3, const bf16_t* Bt3, const EpiBranchFused& E) {
    pg8::Gemm g; g.A = A3; g.Bt = Bt3; g.M = T_; g.N = 2048; g.K = 1024; g.segA = (size_t)T_ * 1024 * 2; g.segB = (size_t)2048 * 1024 * 2;
    pg8::StaticOrder S; S.init(T_, 2048, (int)gridDim.x, (int)blockIdx.x); S.nseg = 3;
    pg8::gemm_phase<EpiBranchFused>(lds, g, S, E);
}
template <class Epi>
__device__ __forceinline__ void run_gemm(LAS unsigned char* lds, const bf16_t* A, const bf16_t* Bt, int M, int N, int K, const Epi& E) {
    pg8::Gemm g; g.A = A; g.Bt = Bt; g.M = M; g.N = N; g.K = K; g.segA = 0; g.segB = 0;
    pg8::StaticOrder S; S.init(M, N, (int)gridDim.x, (int)blockIdx.x);
    pg8::gemm_phase<Epi>(lds, g, S, E);
}

template <class Map>
__device__ __forceinline__ void cvt_item(const float* W, int K, int N, bf16_t* WT, const float* kscale, LAS float* scr, int item, int lane, Map map) {
    const int nblk = (N + 31) / 32, kb = item / nblk, nb = item % nblk, k0 = 128 * kb, n0 = 32 * nb;
    {
        const int nc4 = n0 + 4 * (lane & 7); const bool ok4 = nc4 < N;
        f32x4 v[16];
#pragma unroll
        for (int i = 0; i < 16; ++i) { const int kk = 8 * i + (lane >> 3); v[i] = ok4 ? *(const f32x4*)(W + (size_t)(k0 + kk) * N + nc4) : (f32x4){0.f, 0.f, 0.f, 0.f}; }
#pragma unroll
        for (int i = 0; i < 16; ++i) { const int kk = 8 * i + (lane >> 3); f32x4 x = v[i]; if (kscale) x = x * kscale[k0 + kk];
            LAS float* d = scr + kk * 33 + 4 * (lane & 7); d[0] = x[0]; d[1] = x[1]; d[2] = x[2]; d[3] = x[3]; }
    }
    LDS_WAIT();
    const int c = lane & 15;
#pragma unroll
    for (int j = 0; j < 8; ++j) { const int n = (lane >> 4) + 4 * j; const LAS float* s = scr + (8 * c) * 33 + n;
        if (n0 + n < N) { const int drow = map(n0 + n);
            u32x4 o; o.x = pk2(s[0 * 33], s[1 * 33]); o.y = pk2(s[2 * 33], s[3 * 33]); o.z = pk2(s[4 * 33], s[5 * 33]); o.w = pk2(s[6 * 33], s[7 * 33]);
            *(u32x4*)(WT + (size_t)drow * K + k0 + 8 * c) = o; } }
    LDS_WAIT();
}
struct MapId { __device__ __forceinline__ int operator()(int n) const { return n; } };
struct MapGU { int off; __device__ __forceinline__ int operator()(int n) const { return (n >> 7) * 256 + off + (n & 127); } };
struct MapWin { __device__ __forceinline__ int operator()(int n) const {
    if (n < 4096) return n;
    if (n < 4112) return 13312 + 64 + (n - 4096);
    if (n < 6160) return 4096 + (n - 4112);
    if (n < 6672) return 6144 + (n - 6160);
    if (n < 7184) return 6656 + (n - 6672);
    if (n < 7248) return 13312 + (n - 7184);
    return 7168 + (n - 7248); } };
struct MapUQ { __device__ __forceinline__ int operator()(int n) const { const int hh = n / 192, d = n - hh * 192;
    if (d < 128) return (hh >> 1) * 256 + (hh & 1) * 128 + d;
    if (d < 160) return 1024 + (hh >> 2) * 256 + (hh & 3) * 32 + (d - 128);
    return 1024 + (hh >> 2) * 256 + 128 + (hh & 3) * 32 + (d - 160); } };
struct MapUKV { __device__ __forceinline__ int operator()(int n) const { const int hh = n >> 8, d = n & 255; return d < 128 ? hh * 128 + d : 1024 + hh * 128 + (d - 128); } };

__device__ __forceinline__ void convert_layer(const Params& p, int l, LAS unsigned char* lds) {
    int tid = threadIdx.x; asm volatile("" : "+v"(tid));
    const int lane = tid & 63, wave = tid >> 6;
    LAS float* scr = (LAS float*)(lds + wave * 16896);
    const int gw = blockIdx.x * 8 + wave, NGW = gridDim.x * 8;
    unsigned char* ws = p.ws;
    constexpr int I_GU = 16 * 176, I_DN = 44 * 64, I_WIN = 16 * 419, I_UQ = 4 * 48, I_UKV = 4 * 64, I_BR = 8 * 64, I_OUT = 16 * 64;
    constexpr int NITEMS = 4 * I_GU + 2 * I_DN + I_WIN + I_UQ + I_UKV + 3 * I_BR + I_OUT;
    for (int it = gw; it < NITEMS; it += NGW) {
        int r = it;
        if (r < 4 * I_GU) { const int which = r / I_GU, i = which >> 1, up = which & 1; r -= which * I_GU;
            const float* W = (up ? p.wu : p.wg) + (size_t)(l * 2 + i) * 2048 * FF;
            MapGU mp; mp.off = up * 128;
            cvt_item(W, 2048, FF, (bf16_t*)(ws + OFF_WGU) + (size_t)i * 11264 * 2048, nullptr, scr, r, lane, mp); continue; }
        r -= 4 * I_GU;
        if (r < 2 * I_DN) { const int i = r / I_DN; r -= i * I_DN;
            cvt_item(p.wd + (size_t)(l * 2 + i) * FF * 2048, FF, 2048, (bf16_t*)(ws + OFF_WDN) + (size_t)i * 2048 * FF, nullptr, scr, r, lane, MapId()); continue; }
        r -= 2 * I_DN;
        if (r < I_WIN) { cvt_item(p.win + (size_t)l * 2048 * NIN, 2048, NIN, (bf16_t*)(ws + OFF_WIN), nullptr, scr, r, lane, MapWin()); continue; }
        r -= I_WIN;
        if (r < I_UQ) { cvt_item(p.wuq + (size_t)l * 512 * 1536, 512, 1536, (bf16_t*)(ws + OFF_WUQ), p.cqg + l * 512, scr, r, lane, MapUQ()); continue; }
        r -= I_UQ;
        if (r < I_UKV) { cvt_item(p.wukv + (size_t)l * 512 * 2048, 512, 2048, (bf16_t*)(ws + OFF_WUKV), p.ckvg + l * 512, scr, r, lane, MapUKV()); continue; }
        r -= I_UKV;
        if (r < 3 * I_BR) { const int j = r / I_BR; r -= j * I_BR;
            cvt_item(p.wbr + (size_t)(l * 3 + j) * 1024 * 2048, 1024, 2048, (bf16_t*)(ws + OFF_WBR) + (size_t)j * 2048 * 1024, nullptr, scr, r, lane, MapId()); continue; }
        r -= 3 * I_BR;
        cvt_item(p.wout + (size_t)l * 2048 * 2048, 2048, 2048, (bf16_t*)(ws + OFF_WOUT), nullptr, scr, r, lane, MapId());
    }
    const size_t gt = (size_t)blockIdx.x * 512 + tid, NGT = (size_t)gridDim.x * 512;
    { bf16_t* SGW = (bf16_t*)(ws + OFF_SGW); const float* src = p.sgw + (size_t)l * 8 * 128 * 128;
      for (size_t e = gt; e < (size_t)8 * 128 * 128; e += NGT) { const int j = (int)(e & 127), i = (int)((e >> 7) & 127); SGW[e] = ((j >> 6) <= (i >> 6)) ? f2bf(src[e]) : (bf16_t)0; } }
    { bf16_t* WIN = (bf16_t*)(ws + OFF_WIN) + (size_t)(13312 + 80) * 2048;
      for (size_t e = gt; e < (size_t)176 * 2048; e += NGT) WIN[e] = 0; }
}

__device__ __forceinline__ void rowpass(const float* xin, const bf16_t* f, float alpha, const float* gpost, const float* gpre, float* xout, bf16_t* hout) {
    int tid = threadIdx.x; asm volatile("" : "+v"(tid));
    const int lane = tid & 63, wave = tid >> 6;
    const int gw = blockIdx.x * 8 + wave, NGW = gridDim.x * 8;
    for (int row0 = gw; row0 < T_; row0 += 2 * NGW) {
        const int row1 = row0 + NGW; const bool two = row1 < T_; const int rowb = two ? row1 : row0;
        f32x4 xa[8], xb[8]; u32x2 wa[8], wb[8]; f32x4 gp[8];
        { const f32x4* xr = (const f32x4*)(xin + (size_t)row0 * DM) + lane; const f32x4* xs = (const f32x4*)(xin + (size_t)rowb * DM) + lane;
#pragma unroll
          for (int j = 0; j < 8; ++j) { xa[j] = xr[64 * j]; xb[j] = xs[64 * j]; } }
        if (f) {
            const u32x2* fr = (const u32x2*)(f + (size_t)row0 * DM) + lane; const u32x2* fs = (const u32x2*)(f + (size_t)rowb * DM) + lane;
#pragma unroll
            for (int j = 0; j < 8; ++j) { wa[j] = fr[64 * j]; wb[j] = fs[64 * j]; gp[j] = *((const f32x4*)gpost + lane + 64 * j); }
        }
        __builtin_amdgcn_sched_barrier(0);
        if (f) {
            f32x4 fa[8], fb[8]; float sa = 0.f, sb = 0.f;
#pragma unroll
            for (int j = 0; j < 8; ++j) { fa[j] = (f32x4){bflo(wa[j].x), bfhi(wa[j].x), bflo(wa[j].y), bfhi(wa[j].y)}; fb[j] = (f32x4){bflo(wb[j].x), bfhi(wb[j].x), bflo(wb[j].y), bfhi(wb[j].y)}; }
#pragma unroll
            for (int j = 0; j < 8; ++j) { sa += fa[j][0] * fa[j][0] + fa[j][1] * fa[j][1] + fa[j][2] * fa[j][2] + fa[j][3] * fa[j][3];
                sb += fb[j][0] * fb[j][0] + fb[j][1] * fb[j][1] + fb[j][2] * fb[j][2] + fb[j][3] * fb[j][3]; }
            const float ra = rsqrtf(wave_sum(sa) * (1.f / DM) + EPS) * alpha, rb = rsqrtf(wave_sum(sb) * (1.f / DM) + EPS) * alpha;
#pragma unroll
            for (int j = 0; j < 8; ++j) { xa[j] += fa[j] * ra * gp[j]; xb[j] += fb[j] * rb * gp[j]; }
        }
        f32x4 gq[8];
        if (hout) {
#pragma unroll
            for (int j = 0; j < 8; ++j) gq[j] = *((const f32x4*)gpre + lane + 64 * j);
        }
        { f32x4* xo = (f32x4*)(xout + (size_t)row0 * DM) + lane;
#pragma unroll
          for (int j = 0; j < 8; ++j) xo[64 * j] = xa[j];
          if (two) { f32x4* xp = (f32x4*)(xout + (size_t)row1 * DM) + lane;
#pragma unroll
              for (int j = 0; j < 8; ++j) xp[64 * j] = xb[j]; } }
        __builtin_amdgcn_sched_barrier(0);
        if (hout) {
            float sa = 0.f, sb = 0.f;
#pragma unroll
            for (int j = 0; j < 8; ++j) { sa += xa[j][0] * xa[j][0] + xa[j][1] * xa[j][1] + xa[j][2] * xa[j][2] + xa[j][3] * xa[j][3];
                sb += xb[j][0] * xb[j][0] + xb[j][1] * xb[j][1] + xb[j][2] * xb[j][2] + xb[j][3] * xb[j][3]; }
            const float ra = rsqrtf(wave_sum(sa) * (1.f / DM) + EPS), rb = rsqrtf(wave_sum(sb) * (1.f / DM) + EPS);
            u32x2* ho = (u32x2*)(hout + (size_t)row0 * DM) + lane; u32x2* hp = (u32x2*)(hout + (size_t)rowb * DM) + lane;
#pragma unroll
            for (int j = 0; j < 8; ++j) { const f32x4 ya = xa[j] * ra * gq[j], yb = xb[j] * rb * gq[j];
                u32x2 w; w.x = pk2(ya[0], ya[1]); w.y = pk2(ya[2], ya[3]); ho[64 * j] = w;
                if (two) { u32x2 w2; w2.x = pk2(yb[0], yb[1]); w2.y = pk2(yb[2], yb[3]); hp[64 * j] = w2; } }
        }
    }
}

constexpr int XS = 260;
__device__ __forceinline__ void dn_prep_item(const Params& p, int l, LAS float* L, int item, unsigned long long& t0_, unsigned long long& tacc_) {
    unsigned char* ws = p.ws;
    int tid = threadIdx.x; asm volatile("" : "+v"(tid));
    const int lane = tid & 63, wave = tid >> 6;
    const int h = item & 7, n = (item >> 3) & 31, b = item >> 8;
    const int t0 = b * SEQ_ + n * 64;
    LAS float* sQ = L; LAS float* sK = L + 64 * 132; LAS float* sX = L + 2 * 64 * 132; LAS float* sA = sX + 64 * XS; LAS float* sG = sA + 64 * 68; LAS float* sB = sG + 64;
    const bf16_t* QKV = (const bf16_t*)(ws + OFF_QKV);
    const float* MISC = (const float*)(ws + OFF_MISC);
    const float* cw = p.convw + (size_t)l * 4 * 3072;
    TB(7);
    if (tid < 384) {
        const int cgp = tid % 48, tq = tid / 48, part = cgp >> 4, d0 = (cgp & 15) * 8, ch = part * 1024 + h * 128 + d0;
        f32x4 w0[4], w1[4];
#pragma unroll
        for (int j = 0; j < 4; ++j) { w0[j] = *(const f32x4*)(cw + j * 3072 + ch); w1[j] = *(const f32x4*)(cw + j * 3072 + ch + 4); }
        u32x4 xr[11];
#pragma unroll
        for (int r = 0; r < 11; ++r) { const int sq = n * 64 + tq * 8 - 3 + r; const int sc = sq < 0 ? 0 : sq;
            u32x4 v = *(const u32x4*)(QKV + (size_t)(b * SEQ_ + sc) * 3072 + ch);
            xr[r] = v; }
        __builtin_amdgcn_sched_barrier(0);
#pragma unroll
        for (int r = 0; r < 3; ++r) if (n * 64 + tq * 8 - 3 + r < 0) xr[r] = (u32x4){0u, 0u, 0u, 0u};
#pragma unroll
        for (int tt = 0; tt < 8; ++tt) { const int t = tq * 8 + tt;
            f32x4 a0 = (f32x4){0.f, 0.f, 0.f, 0.f}, a1 = a0;
#pragma unroll
            for (int j = 0; j < 4; ++j) { const u32x4 xv = xr[tt + j];
                a0 += w0[j] * (f32x4){bflo(xv.x), bfhi(xv.x), bflo(xv.y), bfhi(xv.y)}; a1 += w1[j] * (f32x4){bflo(xv.z), bfhi(xv.z), bflo(xv.w), bfhi(xv.w)}; }
            LAS float* dst = part == 0 ? sQ + t * 132 + d0 : (part == 1 ? sK + t * 132 + d0 : sX + t * XS + 128 + d0);
#pragma unroll
            for (int e = 0; e < 4; ++e) { dst[e] = siluf_(a0[e]); dst[4 + e] = siluf_(a1[e]); } }
    }
    __syncthreads();
    TE(7);
    TB(8);
    { const int row = tid >> 2, sub = tid & 3; LAS float* rp = (row < 64 ? sQ + row * 132 : sK + (row - 64) * 132) + sub * 32;
      float ss = 0.f;
#pragma unroll
      for (int e = 0; e < 32; ++e) ss += rp[e] * rp[e];
      ss += __shfl_xor(ss, 1); ss += __shfl_xor(ss, 2);
      const float sc = rsqrtf(ss + 1e-6f) * (row < 64 ? 0.08838834764831845f : 1.f);
#pragma unroll
      for (int e = 0; e < 32; ++e) rp[e] *= sc; }
    if (tid < 64) { const float av = MISC[(size_t)(t0 + tid) * 128 + 64 + h], bv = MISC[(size_t)(t0 + tid) * 128 + 72 + h];
        const float xx = av + p.dtb[l * 8 + h]; const float sp = xx > 20.f ? xx : log1pf(__expf(xx));
        float gv = -__expf(p.alog[l * 8 + h]) * sp;
#pragma unroll
        for (int o = 1; o < 64; o <<= 1) { const float y = __shfl_up(gv, o); if (lane >= o) gv += y; }
        sG[tid] = gv; sB[tid] = sigmoidf_(bv); }
    __syncthreads();
    TE(8);
    TB(9);
    { const int jl = lane & 15, g = lane >> 4, ib = wave >> 1;
      bf16_t* QKo = (bf16_t*)(ws + OFF_DQK) + (size_t)item * 4096;
#pragma unroll
      for (int jj = 0; jj < 2; ++jj) { const int jb = (wave & 1) * 2 + jj;
          f32x4 aA = (f32x4){0.f, 0.f, 0.f, 0.f}, aQ = aA;
          if (jb <= ib) {
              f32x4 rk[4][2], rq[4][2], rj[4][2];
#pragma unroll
              for (int ks = 0; ks < 4; ++ks) {
                  const LAS float* kip = sK + (ib * 16 + jl) * 132 + ks * 32 + g * 8; const LAS float* qip = sQ + (ib * 16 + jl) * 132 + ks * 32 + g * 8;
                  const LAS float* kjp = sK + (jb * 16 + jl) * 132 + ks * 32 + g * 8;
                  rk[ks][0] = *(const LAS f32x4*)kip; rk[ks][1] = *(const LAS f32x4*)(kip + 4); rq[ks][0] = *(const LAS f32x4*)qip; rq[ks][1] = *(const LAS f32x4*)(qip + 4);
                  rj[ks][0] = *(const LAS f32x4*)kjp; rj[ks][1] = *(const LAS f32x4*)(kjp + 4); }
              __builtin_amdgcn_sched_barrier(0);
#pragma unroll
              for (int ks = 0; ks < 4; ++ks) { const bf16x8 ki = pack8(rk[ks][0], rk[ks][1]), qi = pack8(rq[ks][0], rq[ks][1]), kj = pack8(rj[ks][0], rj[ks][1]);
                  aA = MFMA16(ki, kj, aA); aQ = MFMA16(qi, kj, aQ); } }
          const int j = jb * 16 + jl; const float gj = sG[j];
          const int pj = (j & 32) + ((j & 15) >> 2) * 8 + ((j >> 4) & 1) * 4 + (j & 3);
#pragma unroll
          for (int r = 0; r < 4; ++r) { const int i = ib * 16 + g * 4 + r; const float dec = (j <= i) ? __expf(sG[i] - gj) : 0.f;
              sA[i * 68 + j] = (j < i) ? sB[i] * aA[r] * dec : 0.f;
              QKo[i * 64 + pj] = f2bf((j <= i) ? aQ[r] * dec : 0.f); } } }
    for (int task = tid; task < 64 * 32; task += 512) { const int t = task >> 5, d4 = task & 31; const float bt = sB[t], kb = bt * __expf(sG[t]);
        const f32x4 kv = *(const LAS f32x4*)(sK + t * 132 + d4 * 4); *(LAS f32x4*)(sX + t * XS + d4 * 4) = kv * kb;
        LAS f32x4* vp = (LAS f32x4*)(sX + t * XS + 128 + d4 * 4); *vp = *vp * bt; }
    __syncthreads();
    TE(9);
    TB(10);
    if (tid < 256) {
        float x[64]; int va[64];
#pragma unroll
        for (int i = 0; i < 64; ++i) x[i] = sX[i * XS + tid];
#pragma unroll
        for (int i = 1; i < 64; ++i) va[i] = __float_as_int(sA[i * 68 + lane]);
#pragma unroll
        for (int i = 1; i < 64; ++i) {
            float acc0 = 0.f, acc1 = 0.f;
#pragma unroll
            for (int j = 0; j < i; ++j) { const float aij = __int_as_float(__builtin_amdgcn_readlane(va[i], j));
                if (j & 1) acc1 = fmaf(aij, x[j], acc1); else acc0 = fmaf(aij, x[j], acc0); }
            x[i] -= acc0 + acc1;
        }
#pragma unroll
        for (int i = 1; i < 64; ++i) sX[i * XS + tid] = x[i];
    } else {
        bf16_t* QGo = (bf16_t*)(ws + OFF_DQG) + (size_t)item * 8192; bf16_t* KGTo = (bf16_t*)(ws + OFF_DKGT) + (size_t)item * 8192;
        const float glast = sG[63];
        for (int task = tid - 256; task < 1024; task += 256) {
            { const int c = task >> 4, pc = task & 15, dA = (pc >> 2) * 32 + (pc & 3) * 4, dB = dA + 16;
              const float eg = __expf(sG[c]);
              const f32x4 q0 = *(const LAS f32x4*)(sQ + c * 132 + dA) * eg, q1 = *(const LAS f32x4*)(sQ + c * 132 + dB) * eg;
              u32x4 w; w.x = pk2(q0[0], q0[1]); w.y = pk2(q0[2], q0[3]); w.z = pk2(q1[0], q1[1]); w.w = pk2(q1[2], q1[3]);
              *(u32x4*)(QGo + c * 128 + pc * 8) = w; }
            { const int d = task & 127, pc = task >> 7, cA = (pc >> 2) * 32 + (pc & 3) * 4;
              float kk[8];
#pragma unroll
              for (int e = 0; e < 8; ++e) { const int cc = cA + (e & 3) + (e >> 2) * 16; kk[e] = sK[cc * 132 + d] * __expf(glast - sG[cc]); }
              u32x4 w; w.x = pk2(kk[0], kk[1]); w.y = pk2(kk[2], kk[3]); w.z = pk2(kk[4], kk[5]); w.w = pk2(kk[6], kk[7]);
              *(u32x4*)(KGTo + d * 64 + pc * 8) = w; }
        }
    }
    __syncthreads();
    TE(10);
    TB(11);
    { bf16_t* Wo = (bf16_t*)(ws + OFF_DW) + (size_t)item * 8192; bf16_t* UTo = (bf16_t*)(ws + OFF_DUT) + (size_t)item * 8192;
      for (int task = tid; task < 1024; task += 512) {
          { const int c = task >> 4, pc = task & 15, dA = (pc >> 2) * 32 + (pc & 3) * 4, dB = dA + 16;
            const f32x4 a = *(const LAS f32x4*)(sX + c * XS + dA), b2 = *(const LAS f32x4*)(sX + c * XS + dB);
            u32x4 w; w.x = pk2(a[0], a[1]); w.y = pk2(a[2], a[3]); w.z = pk2(b2[0], b2[1]); w.w = pk2(b2[2], b2[3]);
            *(u32x4*)(Wo + c * 128 + pc * 8) = w; }
          { const int d = task & 127, c0 = (task >> 7) * 8;
            float uu[8];
#pragma unroll
            for (int e = 0; e < 8; ++e) uu[e] = sX[(c0 + e) * XS + 128 + d];
            u32x4 w; w.x = pk2(uu[0], uu[1]); w.y = pk2(uu[2], uu[3]); w.z = pk2(uu[4], uu[5]); w.w = pk2(uu[6], uu[7]);
            *(u32x4*)(UTo + d * 64 + c0) = w; }
      }
      if (tid == 0) ((float*)(ws + OFF_DEG))[item] = __expf(sG[63]); }
    __syncthreads();
    TE(11);
}

__device__ __forceinline__ void row_items(const Params& p) {
    unsigned char* ws = p.ws;
    int tid = threadIdx.x; asm volatile("" : "+v"(tid));
    const int lane = tid & 63, wave = tid >> 6;
    const int gw = blockIdx.x * 8 + wave, NGW = gridDim.x * 8;
    const bf16_t* SG = (const bf16_t*)(ws + OFF_SG); const bf16_t* CQ = (const bf16_t*)(ws + OFF_CQ); const bf16_t* CKV = (const bf16_t*)(ws + OFF_CKV);
    const float* MISC = (const float*)(ws + OFF_MISC); const float* CS = (const float*)(ws + OFF_CS);
    float* STATS = (float*)(ws + OFF_STATS); float* RS = (float*)(ws + OFF_RS); bf16_t* KR = (bf16_t*)(ws + OFF_KR);
    for (int t = gw; t < T_; t += NGW) {
        { const u32x4 a = *(const u32x4*)(SG + (size_t)t * 2048 + 1024 + lane * 16), b = *(const u32x4*)(SG + (size_t)t * 2048 + 1024 + lane * 16 + 8);
          float v[16]; v[0] = bflo(a.x); v[1] = bfhi(a.x); v[2] = bflo(a.y); v[3] = bfhi(a.y); v[4] = bflo(a.z); v[5] = bfhi(a.z); v[6] = bflo(a.w); v[7] = bfhi(a.w);
          v[8] = bflo(b.x); v[9] = bfhi(b.x); v[10] = bflo(b.y); v[11] = bfhi(b.y); v[12] = bflo(b.z); v[13] = bfhi(b.z); v[14] = bflo(b.w); v[15] = bfhi(b.w);
          float s = 0.f;
#pragma unroll
          for (int e = 0; e < 16; ++e) s += v[e];
          const float mean = wave_sum(s) * (1.f / 1024.f); float s2 = 0.f;
#pragma unroll
          for (int e = 0; e < 16; ++e) { const float d = v[e] - mean; s2 += d * d; }
          const float rstd = rsqrtf(wave_sum(s2) * (1.f / 1024.f) + 1e-5f);
          if (lane == 0) { STATS[t * 2] = mean; STATS[t * 2 + 1] = rstd; } }
        float rsq_, rskv_;
        { const u32x4 a = *(const u32x4*)(CQ + (size_t)t * 512 + lane * 8), b = *(const u32x4*)(CKV + (size_t)t * 512 + lane * 8);
          float sa = bflo(a.x) * bflo(a.x) + bfhi(a.x) * bfhi(a.x) + bflo(a.y) * bflo(a.y) + bfhi(a.y) * bfhi(a.y) + bflo(a.z) * bflo(a.z) + bfhi(a.z) * bfhi(a.z) + bflo(a.w) * bflo(a.w) + bfhi(a.w) * bfhi(a.w);
          float sb = bflo(b.x) * bflo(b.x) + bfhi(b.x) * bfhi(b.x) + bflo(b.y) * bflo(b.y) + bfhi(b.y) * bfhi(b.y) + bflo(b.z) * bflo(b.z) + bfhi(b.z) * bfhi(b.z) + bflo(b.w) * bflo(b.w) + bfhi(b.w) * bfhi(b.w);
          sa = wave_sum(sa); sb = wave_sum(sb);
          rsq_ = rsqrtf(sa * (1.f / 512.f) + EPS); rskv_ = rsqrtf(sb * (1.f / 512.f) + EPS);
          if (lane == 0) { RS[t] = rsq_; RS[T_ + t] = rskv_; } }
        if (lane < 32) { const float x1 = MISC[(size_t)t * 128 + lane], x2 = MISC[(size_t)t * 128 + 32 + lane];
            const float c = CS[(size_t)t * 64 + lane], s = CS[(size_t)t * 64 + 32 + lane];
            const float ik = 1.f / rskv_;
            KR[(size_t)t * 64 + lane] = f2bf((x1 * c - x2 * s) * ik); KR[(size_t)t * 64 + 32 + lane] = f2bf((x1 * s + x2 * c) * ik); }
    }
}

__device__ __forceinline__ void dn_scan_item(const Params& p, int l, LAS unsigned char* lds, int bh) {
    unsigned char* ws = p.ws;
    int tid = threadIdx.x; asm volatile("" : "+v"(tid));
    const int lane = tid & 63, wave = tid >> 6, jl = lane & 15, g = lane >> 4;
    const int b = bh >> 3, h = bh & 7, dv0 = wave * 16;
    LAS bf16_t* sW = (LAS bf16_t*)lds; LAS bf16_t* sQG = sW + 64 * 136; LAS bf16_t* sKGT = sQG + 64 * 136; LAS bf16_t* sUT = sKGT + 128 * 72; LAS bf16_t* sQK = sUT + 128 * 72;
    LAS float* sO = (LAS float*)(sQK + 64 * 72);
    const bf16_t* Z = (const bf16_t*)(ws + OFF_Z); bf16_t* OA = (bf16_t*)(ws + OFF_OA);
    const float* EGp = (const float*)(ws + OFF_DEG);
    const int fc = wave * 8 + (lane >> 3), fd0 = (lane & 7) * 16;
    f32x4 ngv[4];
#pragma unroll
    for (int k = 0; k < 4; ++k) ngv[k] = *(const f32x4*)(p.dng + l * 128 + fd0 + 4 * k);
    const int gA = (tid >> 4) * 128 + (tid & 15) * 8, lA = (tid >> 4) * 136 + (tid & 15) * 8;
    const int gB = (tid >> 3) * 64 + (tid & 7) * 8, lB = (tid >> 3) * 72 + (tid & 7) * 8;
    u32x4 r[9];
#define SCAN_LOAD(nn) do { const size_t it_ = (size_t)((b * 32 + (nn)) * 8 + h); \
        const bf16_t* Wg = (const bf16_t*)(ws + OFF_DW) + it_ * 8192; const bf16_t* QGg = (const bf16_t*)(ws + OFF_DQG) + it_ * 8192; \
        const bf16_t* KGg = (const bf16_t*)(ws + OFF_DKGT) + it_ * 8192; const bf16_t* UTg = (const bf16_t*)(ws + OFF_DUT) + it_ * 8192; const bf16_t* QKg = (const bf16_t*)(ws + OFF_DQK) + it_ * 4096; \
        r[0] = *(const u32x4*)(Wg + gA); r[1] = *(const u32x4*)(Wg + gA + 32 * 128); r[2] = *(const u32x4*)(QGg + gA); r[3] = *(const u32x4*)(QGg + gA + 32 * 128); \
        r[4] = *(const u32x4*)(KGg + gB); r[5] = *(const u32x4*)(KGg + gB + 64 * 64); r[6] = *(const u32x4*)(UTg + gB); r[7] = *(const u32x4*)(UTg + gB + 64 * 64); r[8] = *(const u32x4*)(QKg + gB); } while (0)
#define SCAN_STORE() do { *(LAS u32x4*)(sW + lA) = r[0]; *(LAS u32x4*)(sW + lA + 32 * 136) = r[1]; *(LAS u32x4*)(sQG + lA) = r[2]; *(LAS u32x4*)(sQG + lA + 32 * 136) = r[3]; \
        *(LAS u32x4*)(sKGT + lB) = r[4]; *(LAS u32x4*)(sKGT + lB + 64 * 72) = r[5]; *(LAS u32x4*)(sUT + lB) = r[6]; *(LAS u32x4*)(sUT + lB + 64 * 72) = r[7]; *(LAS u32x4*)(sQK + lB) = r[8]; } while (0)
    f32x4 S[8];
#pragma unroll
    for (int i = 0; i < 8; ++i) S[i] = (f32x4){0.f, 0.f, 0.f, 0.f};
    __syncthreads();
    SCAN_LOAD(0); SCAN_STORE();
    __syncthreads();
    for (int n = 0; n < 32; ++n) {
        const int item = (b * 32 + n) * 8 + h;
        if (n + 1 < 32) SCAN_LOAD(n + 1);
        const float eg = EGp[item];
        const size_t tokf = (size_t)b * SEQ_ + n * 64 + fc;
        const u32x4 zw0 = *(const u32x4*)(Z + tokf * 1024 + h * 128 + fd0), zw1 = *(const u32x4*)(Z + tokf * 1024 + h * 128 + fd0 + 8);
        bf16x8 sf[4];
#pragma unroll
        for (int ks = 0; ks < 4; ++ks) sf[ks] = pack8(S[2 * ks], S[2 * ks + 1]);
#define SB __builtin_amdgcn_sched_barrier(0)
        f32x4 vn[4];
        bf16x8 vf[2];
        { bf16x8 wf[4][4]; u32x2 uw[4];
#pragma unroll
          for (int cb = 0; cb < 4; ++cb)
#pragma unroll
              for (int ks = 0; ks < 4; ++ks) wf[cb][ks] = *(const LAS bf16x8*)(sW + (cb * 16 + jl) * 136 + ks * 32 + g * 8);
#pragma unroll
          for (int cb = 0; cb < 4; ++cb) uw[cb] = *(const LAS u32x2*)(sUT + (dv0 + jl) * 72 + cb * 16 + g * 4);
          SB;
          bf16x8 qa[2][4];
#pragma unroll
          for (int cb = 0; cb < 2; ++cb)
#pragma unroll
              for (int ks = 0; ks < 4; ++ks) qa[cb][ks] = *(const LAS bf16x8*)(sQG + (cb * 16 + jl) * 136 + ks * 32 + g * 8);
          f32x4 ac[4], aq[4];
#pragma unroll
          for (int cb = 0; cb < 4; ++cb) { ac[cb] = (f32x4){0.f, 0.f, 0.f, 0.f}; aq[cb] = ac[cb]; }
#pragma unroll
          for (int ks = 0; ks < 4; ++ks)
#pragma unroll
              for (int cb = 0; cb < 4; ++cb) ac[cb] = MFMA16(wf[cb][ks], sf[ks], ac[cb]);
          SB;
          bf16x8 qb[2][4];
#pragma unroll
          for (int cb = 0; cb < 2; ++cb)
#pragma unroll
              for (int ks = 0; ks < 4; ++ks) qb[cb][ks] = *(const LAS bf16x8*)(sQG + ((cb + 2) * 16 + jl) * 136 + ks * 32 + g * 8);
#pragma unroll
          for (int ks = 0; ks < 4; ++ks)
#pragma unroll
              for (int cb = 0; cb < 2; ++cb) aq[cb] = MFMA16(qa[cb][ks], sf[ks], aq[cb]);
          SB;
          bf16x8 kq[4][2];
#pragma unroll
          for (int cb = 0; cb < 4; ++cb)
#pragma unroll
              for (int k2 = 0; k2 < 2; ++k2) kq[cb][k2] = *(const LAS bf16x8*)(sQK + (cb * 16 + jl) * 72 + k2 * 32 + g * 8);
#pragma unroll
          for (int ks = 0; ks < 4; ++ks)
#pragma unroll
              for (int cb = 0; cb < 2; ++cb) aq[cb + 2] = MFMA16(qb[cb][ks], sf[ks], aq[cb + 2]);
#pragma unroll
          for (int cb = 0; cb < 4; ++cb) vn[cb] = (f32x4){bflo(uw[cb].x), bfhi(uw[cb].x), bflo(uw[cb].y), bfhi(uw[cb].y)} - ac[cb];
          vf[0] = pack8(vn[0], vn[1]); vf[1] = pack8(vn[2], vn[3]);
#pragma unroll
          for (int db = 0; db < 8; ++db) S[db] = S[db] * eg;
          SB;
          bf16x8 ka[4][2];
#pragma unroll
          for (int db = 0; db < 4; ++db)
#pragma unroll
              for (int k2 = 0; k2 < 2; ++k2) ka[db][k2] = *(const LAS bf16x8*)(sKGT + (db * 16 + jl) * 72 + k2 * 32 + g * 8);
#pragma unroll
          for (int k2 = 0; k2 < 2; ++k2)
#pragma unroll
              for (int cb = 0; cb < 4; ++cb) aq[cb] = MFMA16(kq[cb][k2], vf[k2], aq[cb]);
          SB;
          bf16x8 kb2[4][2];
#pragma unroll
          for (int db = 0; db < 4; ++db)
#pragma unroll
              for (int k2 = 0; k2 < 2; ++k2) kb2[db][k2] = *(const LAS bf16x8*)(sKGT + ((db + 4) * 16 + jl) * 72 + k2 * 32 + g * 8);
#pragma unroll
          for (int k2 = 0; k2 < 2; ++k2)
#pragma unroll
              for (int db = 0; db < 4; ++db) S[db] = MFMA16(ka[db][k2], vf[k2], S[db]);
#pragma unroll
          for (int cb = 0; cb < 4; ++cb)
#pragma unroll
              for (int rr = 0; rr < 4; ++rr) sO[(cb * 16 + g * 4 + rr) * 132 + dv0 + jl] = aq[cb][rr];
          SB;
#pragma unroll
          for (int k2 = 0; k2 < 2; ++k2)
#pragma unroll
              for (int db = 0; db < 4; ++db) S[db + 4] = MFMA16(kb2[db][k2], vf[k2], S[db + 4]); }
#undef SB
        __syncthreads();
        if (n + 1 < 32) SCAN_STORE();
        { f32x4 ov[4]; float ss = 0.f;
#pragma unroll
          for (int k = 0; k < 4; ++k) { ov[k] = *(const LAS f32x4*)(sO + fc * 132 + fd0 + 4 * k); ss += ov[k][0] * ov[k][0] + ov[k][1] * ov[k][1] + ov[k][2] * ov[k][2] + ov[k][3] * ov[k][3]; }
          ss += __shfl_xor(ss, 1); ss += __shfl_xor(ss, 2); ss += __shfl_xor(ss, 4);
          const float rs = rsqrtf(ss * (1.f / 128.f) + EPS);
          const unsigned zu[8] = {zw0.x, zw0.y, zw0.z, zw0.w, zw1.x, zw1.y, zw1.z, zw1.w};
          unsigned ow[8];
#pragma unroll
          for (int k = 0; k < 4; ++k) { const f32x4 y = ov[k] * rs * ngv[k];
              ow[2 * k] = pk2(y[0] * siluf_(bflo(zu[2 * k])), y[1] * siluf_(bfhi(zu[2 * k])));
              ow[2 * k + 1] = pk2(y[2] * siluf_(bflo(zu[2 * k + 1])), y[3] * siluf_(bfhi(zu[2 * k + 1]))); }
          *(u32x4*)(OA + tokf * 1024 + h * 128 + fd0) = (u32x4){ow[0], ow[1], ow[2], ow[3]};
          *(u32x4*)(OA + tokf * 1024 + h * 128 + fd0 + 8) = (u32x4){ow[4], ow[5], ow[6], ow[7]}; }
        __syncthreads();
    }
#undef SCAN_LOAD
#undef SCAN_STORE
}

__device__ __forceinline__ void attn_block_item(const Params& p, LAS unsigned char* lds, int idx) {
    unsigned char* ws = p.ws;
    int tid = threadIdx.x; asm volatile("" : "+v"(tid));
    const int lane = tid & 63, wave = tid >> 6, jl = lane & 15, g = lane >> 4;
    const int qblk = 7 - (idx >> 5), bh = idx & 31, b = bh >> 3, h = bh & 7;
    const int s0 = qblk * 256 + wave * 32; const size_t tq = (size_t)b * SEQ_ + s0 + jl;
    const int mychunk = s0 >> 6, ntiles = 4 * qblk + 4;
    const bf16_t* QB = (const bf16_t*)(ws + OFF_QB);
    bf16x8 qf[2][6];
#pragma unroll
    for (int u = 0; u < 2; ++u)
#pragma unroll
        for (int ks = 0; ks < 6; ++ks) qf[u][ks] = *(const bf16x8*)(QB + (tq + u * 16) * 1536 + h * 192 + ks * 32 + g * 8);
    const bf16_t* kp[3]; int kst[3], kl[3];
#pragma unroll
    for (int k = 0; k < 3; ++k) { const int q = tid + 512 * k, row = q / 24, pc = q - row * 24;
        if (pc < 16) { kp[k] = (const bf16_t*)(ws + OFF_KN) + ((size_t)b * SEQ_ + row) * 1024 + h * 128 + pc * 8; kst[k] = 64 * 1024; }
        else { kp[k] = (const bf16_t*)(ws + OFF_KR) + ((size_t)b * SEQ_ + row) * 64 + (pc - 16) * 8; kst[k] = 64 * 64; }
        kl[k] = row * 200 + pc * 8; }
    const bf16_t* vp[2]; int vl[2];
#pragma unroll
    for (int k = 0; k < 2; ++k) { const int q = tid + 512 * k, row = q >> 3, pc = q & 7;
        vp[k] = (const bf16_t*)(ws + OFF_VT) + (size_t)(h * 128 + row) * 8192 + (size_t)b * SEQ_ + pc * 8;
        vl[k] = row * 72 + (pc >> 2) * 32 + (pc & 1) * 16 + ((pc >> 1) & 1) * 4; }
    u32x4 rk[3], rv[2];
    const float* RSp = (const float*)(ws + OFF_RS);
    const float rq0 = RSp[tq], rq1 = RSp[tq + 16];
    const float* rkvp = RSp + T_ + (size_t)b * SEQ_ + g * 4;
    f32x4 kvs[4];
#define AT_LOAD(tile) do { _Pragma("unroll") for (int k = 0; k < 3; ++k) rk[k] = *(const u32x4*)(kp[k] + (size_t)(tile) * kst[k]); \
        _Pragma("unroll") for (int k = 0; k < 2; ++k) rv[k] = *(const u32x4*)(vp[k] + (tile) * 64); } while (0)
#define AT_STORE(bi) do { LAS bf16_t* sKb = (LAS bf16_t*)(lds + (bi) * 44032); LAS bf16_t* sVb = sKb + 64 * 200; \
        _Pragma("unroll") for (int k = 0; k < 3; ++k) *(LAS u32x4*)(sKb + kl[k]) = rk[k]; \
        _Pragma("unroll") for (int k = 0; k < 2; ++k) { *(LAS u32x2*)(sVb + vl[k]) = (u32x2){rv[k].x, rv[k].y}; *(LAS u32x2*)(sVb + vl[k] + 8) = (u32x2){rv[k].z, rv[k].w}; } } while (0)
    f32x4 o[2][8];
#pragma unroll
    for (int u = 0; u < 2; ++u)
#pragma unroll
        for (int i = 0; i < 8; ++i) o[u][i] = (f32x4){0.f, 0.f, 0.f, 0.f};
    float mrun[2] = {-1e30f, -1e30f}, lsum[2] = {0.f, 0.f};
    __syncthreads();
    AT_LOAD(0); AT_STORE(0);
    if (ntiles > 1) AT_LOAD(1);
    __syncthreads();
    for (int t = 0; t < ntiles; ++t) {
#pragma unroll
        for (int sb = 0; sb < 4; ++sb) kvs[sb] = *(const f32x4*)(rkvp + t * 64 + sb * 16);
        if (t + 1 < ntiles) { AT_STORE((t + 1) & 1); if (t + 2 < ntiles) AT_LOAD(t + 2); }
        if (t <= mychunk) {
            const LAS bf16_t* sKb = (const LAS bf16_t*)(lds + (t & 1) * 44032); const LAS bf16_t* sVb = sKb + 64 * 200;
            f32x4 s[2][4];
            {
              bf16x8 kfr[2][3];
#pragma unroll
              for (int k3 = 0; k3 < 3; ++k3) kfr[0][k3] = *(const LAS bf16x8*)(sKb + jl * 200 + k3 * 32 + g * 8);
              __builtin_amdgcn_sched_barrier(0);
              f32x4 a0 = (f32x4){0.f, 0.f, 0.f, 0.f}, a1 = a0;
#pragma unroll
              for (int hs = 0; hs < 8; ++hs) { const int sb = hs >> 1, kh = hs & 1;
                  if (hs + 1 < 8) { const int sb2 = (hs + 1) >> 1, kh2 = (hs + 1) & 1;
#pragma unroll
                      for (int k3 = 0; k3 < 3; ++k3) kfr[(hs + 1) & 1][k3] = *(const LAS bf16x8*)(sKb + (sb2 * 16 + jl) * 200 + (kh2 * 3 + k3) * 32 + g * 8); }
#pragma unroll
                  for (int k3 = 0; k3 < 3; ++k3) { a0 = MFMA16(kfr[hs & 1][k3], qf[0][kh * 3 + k3], a0); a1 = MFMA16(kfr[hs & 1][k3], qf[1][kh * 3 + k3], a1); }
                  if (kh == 1) { s[0][sb] = a0 * kvs[sb] * rq0; s[1][sb] = a1 * kvs[sb] * rq1; a0 = (f32x4){0.f, 0.f, 0.f, 0.f}; a1 = a0; }
                  __builtin_amdgcn_sched_barrier(0); } }
            bf16x8 pf[2][2]; float alpha[2];
#pragma unroll
            for (int u = 0; u < 2; ++u) {
                float mx = -1e30f;
#pragma unroll
                for (int sb = 0; sb < 4; ++sb) mx = fmaxf(mx, fmaxf(fmaxf(s[u][sb][0], s[u][sb][1]), fmaxf(s[u][sb][2], s[u][sb][3])));
                mx = fmaxf(mx, __shfl_xor(mx, 16)); mx = fmaxf(mx, __shfl_xor(mx, 32));
                const float mnew = fmaxf(mrun[u], mx); alpha[u] = __builtin_amdgcn_exp2f(mrun[u] - mnew); mrun[u] = mnew;
                float ps = 0.f;
#pragma unroll
                for (int sb = 0; sb < 4; ++sb)
#pragma unroll
                    for (int r = 0; r < 4; ++r) { const float pv = __builtin_amdgcn_exp2f(s[u][sb][r] - mnew); s[u][sb][r] = pv; ps += pv; }
                lsum[u] = lsum[u] * alpha[u] + ps;
                pf[u][0] = pack8(s[u][0] * kvs[0], s[u][1] * kvs[1]); pf[u][1] = pack8(s[u][2] * kvs[2], s[u][3] * kvs[3]); }
            { bf16x8 vfr[2][2];
#pragma unroll
              for (int k2 = 0; k2 < 2; ++k2) vfr[0][k2] = *(const LAS bf16x8*)(sVb + jl * 72 + k2 * 32 + g * 8);
              __builtin_amdgcn_sched_barrier(0);
#pragma unroll
              for (int db = 0; db < 8; ++db) {
                  if (db + 1 < 8) {
#pragma unroll
                      for (int k2 = 0; k2 < 2; ++k2) vfr[(db + 1) & 1][k2] = *(const LAS bf16x8*)(sVb + ((db + 1) * 16 + jl) * 72 + k2 * 32 + g * 8); }
                  f32x4 c0 = o[0][db] * alpha[0], c1 = o[1][db] * alpha[1];
#pragma unroll
                  for (int k2 = 0; k2 < 2; ++k2) { c0 = MFMA16(vfr[db & 1][k2], pf[0][k2], c0); c1 = MFMA16(vfr[db & 1][k2], pf[1][k2], c1); }
                  o[0][db] = c0; o[1][db] = c1;
                  __builtin_amdgcn_sched_barrier(0); } }
        }
        __syncthreads();
    }
#undef AT_LOAD
#undef AT_STORE
    bf16_t* OC = (bf16_t*)(ws + OFF_OC);
#pragma unroll
    for (int u = 0; u < 2; ++u) { float lt = lsum[u]; lt += __shfl_xor(lt, 16); lt += __shfl_xor(lt, 32); const float inv = __builtin_amdgcn_rcpf(lt);
#pragma unroll
        for (int db = 0; db < 8; ++db) { const f32x4 v = o[u][db] * inv; u32x2 w; w.x = pk2(v[0], v[1]); w.y = pk2(v[2], v[3]);
            *(u32x2*)(OC + (tq + u * 16) * 1024 + h * 128 + db * 16 + g * 4) = w; } }
}

__device__ __forceinline__ void sg_wave_item(const Params& p, int l, int widx) {
    unsigned char* ws = p.ws;
    int tid = threadIdx.x; asm volatile("" : "+v"(tid));
    const int lane = tid & 63, wave = widx & 7, idx = widx >> 3, jl = lane & 15, g = lane >> 4;
    const int gi = idx & 7, nb = (idx >> 3) & 15, b = idx >> 7;
    const size_t t0 = (size_t)b * SEQ_ + nb * 128; const int cc = gi * 128 + wave * 16 + jl;
    const bf16_t* SG = (const bf16_t*)(ws + OFF_SG); const float* STATS = (const float*)(ws + OFF_STATS); const bf16_t* SGW = (const bf16_t*)(ws + OFF_SGW);
    bf16_t* OB = (bf16_t*)(ws + OFF_OB);
    const float lg = p.lng[l * 1024 + cc], lb = p.lnb[l * 1024 + cc];
#define SB __builtin_amdgcn_sched_barrier(0)
    bf16x8 bfr[4];
    { bf16_t vr[4][8]; f32x4 st[4][4];
#pragma unroll
      for (int kb = 0; kb < 4; ++kb) {
#pragma unroll
          for (int e = 0; e < 8; ++e) vr[kb][e] = SG[(t0 + kb * 32 + g * 8 + e) * 2048 + 1024 + cc];
#pragma unroll
          for (int q = 0; q < 4; ++q) st[kb][q] = *(const f32x4*)(STATS + (t0 + kb * 32 + g * 8 + 2 * q) * 2); }
      SB;
#pragma unroll
      for (int kb = 0; kb < 4; ++kb) { float v[8];
#pragma unroll
          for (int q = 0; q < 4; ++q) { v[2 * q] = (bf1(vr[kb][2 * q]) - st[kb][q][0]) * st[kb][q][1] * lg + lb; v[2 * q + 1] = (bf1(vr[kb][2 * q + 1]) - st[kb][q][2]) * st[kb][q][3] * lg + lb; }
          u32x4 w; w.x = pk2(v[0], v[1]); w.y = pk2(v[2], v[3]); w.z = pk2(v[4], v[5]); w.w = pk2(v[6], v[7]); bfr[kb] = __builtin_bit_cast(bf16x8, w); } }
    SB;
    bf16_t ur[8][4]; f32x4 sbv[8];
#pragma unroll
    for (int ib = 0; ib < 8; ++ib) {
#pragma unroll
        for (int r = 0; r < 4; ++r) ur[ib][r] = SG[(t0 + ib * 16 + g * 4 + r) * 2048 + cc];
        sbv[ib] = *(const f32x4*)(p.sgb + l * 1024 + gi * 128 + ib * 16 + g * 4); }
    bf16x8 af[2][4];
#pragma unroll
    for (int kb = 0; kb < 4; ++kb) af[0][kb] = *(const bf16x8*)(SGW + (size_t)(gi * 128 + jl) * 128 + kb * 32 + g * 8);
    SB;
#pragma unroll
    for (int ib = 0; ib < 8; ++ib) {
        if (ib + 1 < 8) {
#pragma unroll
            for (int kb = 0; kb < 4; ++kb) af[(ib + 1) & 1][kb] = *(const bf16x8*)(SGW + (size_t)(gi * 128 + (ib + 1) * 16 + jl) * 128 + kb * 32 + g * 8); }
        f32x4 acc = (f32x4){0.f, 0.f, 0.f, 0.f};
#pragma unroll
        for (int kb = 0; kb < 4; ++kb) acc = MFMA16(af[ib & 1][kb], bfr[kb], acc);
#pragma unroll
        for (int r = 0; r < 4; ++r) { const size_t tok = t0 + ib * 16 + g * 4 + r;
            OB[tok * 1024 + cc] = f2bf(bf1(ur[ib][r]) * (acc[r] + sbv[ib][r])); }
        SB;
    }
#undef SB
}

#define XB_TMO      128
#define XB_XCNT(j)  (256  + 64 * (j))
#define XB_XSUB(j)  (1280 + 64 * (j))
#define XB_XGEN(j)  (2304 + 64 * (j))
#define XB_TOP      3328
#define XB_TOPGEN   3392
#define XCD_BAR_WORDS 3456
#define XB_SPIN_CAP (1u << 18)
__device__ __forceinline__ unsigned xb_ld(unsigned* p)              { return __hip_atomic_load(p, __ATOMIC_RELAXED, __HIP_MEMORY_SCOPE_AGENT); }
__device__ __forceinline__ unsigned xb_add(unsigned* p, unsigned v) { return __hip_atomic_fetch_add(p, v, __ATOMIC_RELAXED, __HIP_MEMORY_SCOPE_AGENT); }
__device__ __forceinline__ unsigned xb_xcc_id() { return (unsigned)__builtin_amdgcn_s_getreg((3 << 11) | 20) & 0xFu; }
#define XB_SPIN(cond, bar) do { unsigned _sp = 0; while (cond) { __builtin_amdgcn_s_sleep(1); \
    if ((++_sp & 255u) == 0u) { if (xb_ld(&(bar)[XB_TMO])) break; if (_sp > XB_SPIN_CAP) { atomicAdd(&(bar)[XB_TMO], 1u); break; } } } } while (0)
__device__ __forceinline__ void xcd_barrier_complete(unsigned* bar, unsigned x, unsigned& nloc, unsigned& nx) {
    const unsigned G = gridDim.x * gridDim.y * gridDim.z;
    unsigned sum, cnt, mine, sp = 0u;
    for (;;) {
        sum = 0u; cnt = 0u; mine = 0u;
#pragma unroll
        for (unsigned j = 0; j < 16; ++j) { const unsigned c = xb_ld(&bar[XB_XCNT(j)]); sum += c; cnt += (c > 0u) ? 1u : 0u; mine = (j == x) ? c : mine; }
        if (sum == G) break;
        __builtin_amdgcn_s_sleep(1);
        if ((++sp & 255u) == 0u) { if (xb_ld(&bar[XB_TMO])) break; if (sp > XB_SPIN_CAP) { atomicAdd(&bar[XB_TMO], 1u); break; } }
    }
    nloc = mine > 0u ? mine : 1u; nx = cnt > 0u ? cnt : 1u;
}
__device__ __forceinline__ void xcd_barrier(unsigned* bar, volatile LAS unsigned* st) {
    asm volatile("s_waitcnt vmcnt(0)" ::: "memory");
    __syncthreads();
    if (threadIdx.x == 0) {
        const unsigned x = xb_xcc_id();
        __builtin_amdgcn_s_waitcnt(0);
        unsigned nloc = st[0], nx = st[1];
        if (nloc == 0u) { xcd_barrier_complete(bar, x, nloc, nx); st[0] = nloc; st[1] = nx; }
        const unsigned old = xb_add(&bar[XB_XSUB(x)], 1u);
        const unsigned gen = old / nloc;
        if (old + 1u == (gen + 1u) * nloc) {
            __builtin_amdgcn_fence(__ATOMIC_RELEASE, "agent");
            asm volatile("s_waitcnt vmcnt(0)" ::: "memory");
            const unsigned og = xb_add(&bar[XB_TOP], 1u);
            const unsigned tg = og / nx;
            if (og + 1u == (tg + 1u) * nx) xb_add(&bar[XB_TOPGEN], 1u);
            else XB_SPIN(xb_ld(&bar[XB_TOPGEN]) == tg, bar);
            __builtin_amdgcn_fence(__ATOMIC_ACQUIRE, "agent");
            xb_add(&bar[XB_XGEN(x)], 1u);
            asm volatile("s_waitcnt vmcnt(0)" ::: "memory");
        } else {
            XB_SPIN(xb_ld(&bar[XB_XGEN(x)]) == gen, bar);
            __builtin_amdgcn_fence(__ATOMIC_ACQUIRE, "agent");
            asm volatile("s_waitcnt vmcnt(0)" ::: "memory");
        }
    }
    __syncthreads();
}

#ifndef NREP_GEMM
#define NREP_GEMM 1
#endif
#ifndef NREP_MIX
#define NREP_MIX 1
#endif
#ifndef NREP_PREP
#define NREP_PREP NREP_MIX
#endif
#ifndef NREP_P7
#define NREP_P7 NREP_MIX
#endif
#ifndef NREP_ROW
#define NREP_ROW 0
#endif
#ifndef NREP_CVT
#define NREP_CVT 1
#endif
#ifndef NREP_SYNC
#define NREP_SYNC 1
#endif
#define GSYNC() do { TB(4); for (int r_ = 0; r_ < NREP_SYNC; ++r_) { PQ xcd_barrier((unsigned*)(ws + OFF_BAR), (volatile LAS unsigned*)(shm + LDS_ST)); } TE(4); } while (0)
#define RG for (int rg_ = 0; rg_ < NREP_GEMM; ++rg_)
typedef const Params __attribute__((address_space(4)))* KP;
__device__ __forceinline__ Params ldp(KP q) {
#if defined(__HIP_DEVICE_COMPILE__)
    asm volatile("" : "+s"(q)); return *q;
#else
    return Params{};
#endif
}
#define PQ const Params p = ldp(kp); unsigned char* ws = p.ws; (void)ws;
__global__ __launch_bounds__(512, 2) void fwd_megakernel(Params p_unused) {
    extern __shared__ __attribute__((aligned(16))) unsigned char shm[];
    LAS unsigned char* lds = (LAS unsigned char*)shm;
    LAS float* L = (LAS float*)shm;
    LAS int* s_item = (LAS int*)(shm + LDS_ITEM);
    cg::grid_group grid = cg::this_grid();
    KP kp = (KP)__builtin_amdgcn_kernarg_segment_ptr();
    unsigned long long t0_ = 0, tacc_ = 0; (void)t0_; (void)tacc_;
#ifdef TCAT
    const unsigned long long tstart_ = __builtin_amdgcn_s_memrealtime();
#endif
    if (threadIdx.x == 0) { LAS unsigned* st = (LAS unsigned*)(shm + LDS_ST); st[0] = 0u; st[1] = 0u; PQ (void)xb_add((unsigned*)(ws + OFF_BAR) + XB_XCNT(xb_xcc_id()), 1u); }
    __syncthreads();

#ifndef NO_CVT
    TB(5); for (int rc_ = 0; rc_ < NREP_CVT; ++rc_) { PQ convert_layer(p, 0, lds); } TE(5);
#endif
    { PQ int tid = threadIdx.x; asm volatile("" : "+v"(tid));
      const size_t gt = (size_t)blockIdx.x * 512 + tid, NGT = (size_t)gridDim.x * 512; float* CS = (float*)(ws + OFF_CS);
      for (size_t e = gt; e < (size_t)T_ * 32; e += NGT) { const int t = (int)(e >> 5), i = (int)(e & 31);
          const float inv_freq = exp2f(-(float)(2 * i) * (1.f / 64.f) * 13.287712379549449f);
          const float ang = (float)p.pos[t] * inv_freq; float sn, cs; sn = sinf(ang); cs = cosf(ang);
          CS[(size_t)t * 64 + i] = cs; CS[(size_t)t * 64 + 32 + i] = sn; }
      if (gt < 64) ((unsigned*)(ws + OFF_CTR))[gt] = 0u; }
    TB(6); { PQ rowpass(p.x, nullptr, 0.f, nullptr, p.norm_g, p.out, (bf16_t*)(ws + OFF_H)); } TE(6);
    GSYNC();
    { PQ if (p.ws == nullptr) grid.sync(); }

    for (int l = 0; l < 2; ++l) {
        TB(1); RG { PQ EpiSwiGLU e; e.O = (bf16_t*)(ws + OFF_GATE); run_gemm(lds, (const bf16_t*)(ws + OFF_H), (const bf16_t*)(ws + OFF_WGU), T_, 11264, 2048, e); } TE(1);
        GSYNC();
        TB(1); RG { PQ EpiBf16Out e; e.O = (bf16_t*)(ws + OFF_F); e.ldc = DM; run_gemm(lds, (const bf16_t*)(ws + OFF_GATE), (const bf16_t*)(ws + OFF_WDN), T_, 2048, FF, e); } TE(1);
        GSYNC();
        for (int rr_ = 0; rr_ < NREP_ROW; ++rr_) { PQ const float* ng = p.norm_g + (size_t)l * 6 * DM; rowpass(p.out, (const bf16_t*)(ws + OFF_F), 0.0f, ng + DM, ng + 2 * DM, p.out, (bf16_t*)(ws + OFF_H)); }
        TB(6); { PQ const float* ng = p.norm_g + (size_t)l * 6 * DM; rowpass(p.out, (const bf16_t*)(ws + OFF_F), 0.5f, ng + DM, ng + 2 * DM, p.out, (bf16_t*)(ws + OFF_H)); } TE(6);
        GSYNC();
        TB(1); RG { PQ EpiWin e; e.ws = ws; run_gemm(lds, (const bf16_t*)(ws + OFF_H), (const bf16_t*)(ws + OFF_WIN), T_, NINP, 2048, e); } TE(1);
        GSYNC();
        TB(1); RG { PQ EpiQ e; e.QB = (bf16_t*)(ws + OFF_QB); e.RS = (const float*)(ws + OFF_RS); e.CS = (const float*)(ws + OFF_CS); e.qscale = 0.07216878364870322f * 1.4426950408889634f;
          run_gemm(lds, (const bf16_t*)(ws + OFF_CQ), (const bf16_t*)(ws + OFF_WUQ), T_, 1536, 512, e); } TE(1);
        TB(1); RG { PQ EpiKN e; e.O = (bf16_t*)(ws + OFF_KN); e.RS = (const float*)(ws + OFF_RS);
          run_gemm(lds, (const bf16_t*)(ws + OFF_CKV), (const bf16_t*)(ws + OFF_WUKV), T_, 1024, 512, e); } TE(1);
        TB(1); RG { PQ EpiVT e; e.O = (bf16_t*)(ws + OFF_VT); e.RS = (const float*)(ws + OFF_RS);
          run_gemm(lds, (const bf16_t*)(ws + OFF_WUKV) + (size_t)1024 * 512, (const bf16_t*)(ws + OFF_CKV), 1024, T_, 512, e); } TE(1);
        TB(2);
        for (int rm_ = 0; rm_ < NREP_PREP; ++rm_) {
#ifndef NO_PREP
        for (;;) {
            PQ
            __syncthreads();
            if (threadIdx.x == 0) *s_item = (int)atomicAdd((unsigned*)(ws + OFF_CTR) + 24 + l + 2 * rm_, 1u);
            __syncthreads();
            const int item = *s_item;
            if (item >= 1024) break;
            dn_prep_item(p, l, L, item, t0_, tacc_);
        }
#endif
#ifndef NO_ROWI
        TB(12); { PQ row_items(p); } TE(12);
#endif
        }
        TE(2);
        GSYNC();
        TB(3);
        for (int rm_ = 0; rm_ < NREP_P7; ++rm_) {
        for (;;) {
            PQ
            __syncthreads();
            if (threadIdx.x == 0) *s_item = (int)atomicAdd((unsigned*)(ws + OFF_CTR) + l + 8 * rm_, 1u);
            __syncthreads();
            const int it = *s_item;
            if (it >= 32 + 256) break;
            if (it < 32) dn_scan_item(p, l, lds, it);
            else attn_block_item(p, lds, it - 32);
        }
        for (;;) {
            PQ
            int it = 0;
            if ((threadIdx.x & 63) == 0) it = (int)atomicAdd((unsigned*)(ws + OFF_CTR) + 4 + l + 8 * rm_, 1u);
            it = __builtin_amdgcn_readfirstlane(it);
            if (it >= 4096) break;
            sg_wave_item(p, l, it);
        }
        }
        TE(3);
        GSYNC();
        TB(1); { PQ EpiBranchFused e; e.GATE = (const bf16_t*)(ws + OFF_GATE); e.OUT = (bf16_t*)(ws + OFF_MERGED); run_branch_gemm(lds, (const bf16_t*)(ws + OFF_OA), (const bf16_t*)(ws + OFF_WBR), e); } TE(1);
        GSYNC();
        TB(1); RG { PQ EpiBf16Out e; e.O = (bf16_t*)(ws + OFF_F); e.ldc = DM; run_gemm(lds, (const bf16_t*)(ws + OFF_MERGED), (const bf16_t*)(ws + OFF_WOUT), T_, 2048, 2048, e); } TE(1);
        GSYNC();
        for (int rr_ = 0; rr_ < NREP_ROW; ++rr_) { PQ const float* ng = p.norm_g + (size_t)l * 6 * DM; rowpass(p.out, (const bf16_t*)(ws + OFF_F), 0.0f, ng + 3 * DM, ng + 4 * DM, p.out, (bf16_t*)(ws + OFF_H)); }
        TB(6); { PQ const float* ng = p.norm_g + (size_t)l * 6 * DM; rowpass(p.out, (const bf16_t*)(ws + OFF_F), 1.0f, ng + 3 * DM, ng + 4 * DM, p.out, (bf16_t*)(ws + OFF_H)); } TE(6);
        GSYNC();
        TB(1); RG { PQ EpiSwiGLU e; e.O = (bf16_t*)(ws + OFF_GATE); run_gemm(lds, (const bf16_t*)(ws + OFF_H), (const bf16_t*)(ws + OFF_WGU) + (size_t)11264 * 2048, T_, 11264, 2048, e); } TE(1);
        GSYNC();
        TB(1); RG { PQ EpiBf16Out e; e.O = (bf16_t*)(ws + OFF_F); e.ldc = DM; run_gemm(lds, (const bf16_t*)(ws + OFF_GATE), (const bf16_t*)(ws + OFF_WDN) + (size_t)2048 * FF, T_, 2048, FF, e); } TE(1);
        GSYNC();
        if (l == 0) {
            for (int rr_ = 0; rr_ < NREP_ROW; ++rr_) { PQ const float* ng = p.norm_g; rowpass(p.out, (const bf16_t*)(ws + OFF_F), 0.0f, ng + 5 * DM, ng + 6 * DM, p.out, (bf16_t*)(ws + OFF_H)); }
            TB(6); { PQ const float* ng = p.norm_g; rowpass(p.out, (const bf16_t*)(ws + OFF_F), 0.5f, ng + 5 * DM, ng + 6 * DM, p.out, (bf16_t*)(ws + OFF_H)); } TE(6);
#ifndef NO_CVT
            TB(5); for (int rc_ = 0; rc_ < NREP_CVT; ++rc_) { PQ convert_layer(p, 1, lds); } TE(5);
#endif
            GSYNC();
        } else {
            for (int rr_ = 0; rr_ < NREP_ROW; ++rr_) { PQ const float* ng = p.norm_g + (size_t)6 * DM; rowpass(p.out, (const bf16_t*)(ws + OFF_F), 0.0f, ng + 5 * DM, nullptr, p.out, nullptr); }
            TB(6); { PQ const float* ng = p.norm_g + (size_t)6 * DM; rowpass(p.out, (const bf16_t*)(ws + OFF_F), 0.5f, ng + 5 * DM, nullptr, p.out, nullptr); } TE(6);
        }
    }
#ifdef TCAT
    if (blockIdx.x == 0 && threadIdx.x < 64) {
        if (TCAT == 0) tacc_ = __builtin_amdgcn_s_memrealtime() - tstart_;
        float fr = (float)tacc_ * (1.f / 800000.f); fr = fr > 1.f ? 1.f : fr;
        const float dl = 0.2f * sqrtf(fr);
        PQ
        for (int e = 0; e < 16; ++e) p.out[threadIdx.x * 16 + e] += dl;
    }
#endif
}

extern "C" void kernel_launch(void* const* d_in, const int* in_sizes, int n_in, void* d_out, int out_size, void* d_ws, size_t ws_size, hipStream_t stream) {
    static int grid_blocks = 0;
    if (!grid_blocks) {
        if (ws_size < WS_END) { fprintf(stderr, "kernel_launch: workspace too small: %zu < %zu\n", ws_size, (size_t)WS_END); grid_blocks = -1; return; }
        int dev = 0, cus = 0, per_cu = 0;
        (void)hipGetDevice(&dev);
        (void)hipDeviceGetAttribute(&cus, hipDeviceAttributeMultiprocessorCount, dev);
        if (hipFuncSetAttribute((const void*)fwd_megakernel, hipFuncAttributeMaxDynamicSharedMemorySize, LDS_BYTES) != hipSuccess) fprintf(stderr, "kernel_launch: hipFuncSetAttribute failed\n");
        if (hipOccupancyMaxActiveBlocksPerMultiprocessor(&per_cu, (const void*)fwd_megakernel, 512, LDS_BYTES) != hipSuccess || per_cu < 1) per_cu = 1;
        (void)hipGetLastError();
        grid_blocks = cus * per_cu;
    }
    if (grid_blocks < 0) return;
    Params p{};
    p.x = (const float*)d_in[0]; p.pos = (const int*)d_in[1]; p.norm_g = (const float*)d_in[2]; p.wg = (const float*)d_in[3]; p.wu = (const float*)d_in[4];
    p.wd = (const float*)d_in[5]; p.win = (const float*)d_in[6]; p.convw = (const float*)d_in[7]; p.alog = (const float*)d_in[8]; p.dtb = (const float*)d_in[9];
    p.dng = (const float*)d_in[10]; p.lng = (const float*)d_in[11]; p.lnb = (const float*)d_in[12]; p.sgw = (const float*)d_in[13]; p.sgb = (const float*)d_in[14];
    p.cqg = (const float*)d_in[15]; p.ckvg = (const float*)d_in[16]; p.wuq = (const float*)d_in[17]; p.wukv = (const float*)d_in[18]; p.wbr = (const float*)d_in[19];
    p.wout = (const float*)d_in[20]; p.out = (float*)d_out; p.ws = (unsigned char*)d_ws;
    (void)hipMemsetAsync((unsigned char*)d_ws + OFF_BAR, 0, XCD_BAR_WORDS * 4, stream);
    void* args[] = {&p};
    hipError_t e = hipLaunchCooperativeKernel((const void*)fwd_megakernel, dim3(grid_blocks), dim3(512), args, LDS_BYTES, stream);
    if (e != hipSuccess) fprintf(stderr, "cooperative launch failed: %s (grid %d)\n", hipGetErrorString(e), grid_blocks);
}
```

```cpp
#include <hip/hip_runtime.h>
#include <hip/hip_cooperative_groups.h>
#include <cstdio>
namespace cg = cooperative_groups;

#define LAS __attribute__((address_space(3)))
typedef unsigned short bf16_t;
typedef short bf16x8 __attribute__((ext_vector_type(8)));
typedef short s16x4 __attribute__((ext_vector_type(4)));
typedef float f32x4 __attribute__((ext_vector_type(4)));
typedef float f32x2 __attribute__((ext_vector_type(2)));
typedef unsigned u32x4 __attribute__((ext_vector_type(4)));
typedef unsigned u32x2 __attribute__((ext_vector_type(2)));

constexpr int T_ = 8192, DM = 2048, FF = 5632, NIN = 13392, NINP = 13568, SEQ_ = 2048;
constexpr int LDS_BYTES = 152576;
constexpr int LDS_ITEM = 152320, LDS_ST = 152336;
constexpr float EPS = 1e-6f;

constexpr size_t al256(size_t x) { return (x + 255) & ~(size_t)255; }
constexpr size_t OFF_WGU = 0;
constexpr size_t OFF_WDN = OFF_WGU + (size_t)2 * 11264 * 2048 * 2;
constexpr size_t OFF_WIN = OFF_WDN + (size_t)2 * 2048 * 5632 * 2;
constexpr size_t OFF_WUQ = OFF_WIN + (size_t)NINP * 2048 * 2;
constexpr size_t OFF_WUKV = OFF_WUQ + (size_t)1536 * 512 * 2;
constexpr size_t OFF_WBR = OFF_WUKV + (size_t)2048 * 512 * 2;
constexpr size_t OFF_WOUT = OFF_WBR + (size_t)3 * 2048 * 1024 * 2;
constexpr size_t OFF_SGW = OFF_WOUT + (size_t)2048 * 2048 * 2;
constexpr size_t OFF_H = OFF_SGW + (size_t)8 * 128 * 128 * 2;
constexpr size_t OFF_F = OFF_H + (size_t)T_ * 2048 * 2;
constexpr size_t OFF_GATE = OFF_F + (size_t)T_ * 2048 * 4;
constexpr size_t OFF_QKV = OFF_GATE + (size_t)T_ * 6144 * 2;
constexpr size_t OFF_Z = OFF_QKV + (size_t)T_ * 3072 * 2;
constexpr size_t OFF_SG = OFF_Z + (size_t)T_ * 1024 * 2;
constexpr size_t OFF_CQ = OFF_SG + (size_t)T_ * 2048 * 2;
constexpr size_t OFF_CKV = OFF_CQ + (size_t)T_ * 512 * 2;
constexpr size_t OFF_MISC = OFF_CKV + (size_t)T_ * 512 * 2;
constexpr size_t OFF_DW = OFF_MISC + (size_t)T_ * 128 * 4;
constexpr size_t OFF_DQG = OFF_DW + (size_t)1024 * 8192 * 2;
constexpr size_t OFF_DKGT = OFF_DQG + (size_t)1024 * 8192 * 2;
constexpr size_t OFF_DUT = OFF_DKGT + (size_t)1024 * 8192 * 2;
constexpr size_t OFF_DQK = OFF_DUT + (size_t)1024 * 8192 * 2;
constexpr size_t OFF_DEG = OFF_DQK + (size_t)1024 * 4096 * 2;
constexpr size_t OFF_QB = OFF_DEG + 4096;
constexpr size_t OFF_KN = OFF_QB + (size_t)T_ * 1536 * 2;
constexpr size_t OFF_KR = OFF_KN + (size_t)T_ * 1024 * 2;
constexpr size_t OFF_VT = OFF_KR + (size_t)T_ * 64 * 2;
constexpr size_t OFF_OA = OFF_VT + (size_t)1024 * 8192 * 2;
constexpr size_t OFF_OB = OFF_OA + (size_t)T_ * 1024 * 2;
constexpr size_t OFF_OC = OFF_OB + (size_t)T_ * 1024 * 2;
constexpr size_t OFF_MERGED = OFF_OC + (size_t)T_ * 1024 * 2;
constexpr size_t OFF_STATS = OFF_MERGED + (size_t)T_ * 2048 * 2;
constexpr size_t OFF_RS = OFF_STATS + (size_t)T_ * 2 * 4;
constexpr size_t OFF_CS = OFF_RS + (size_t)T_ * 2 * 4;
constexpr size_t OFF_CTR = OFF_CS + (size_t)T_ * 64 * 4;
constexpr size_t OFF_BAR = OFF_CTR + 256;
constexpr size_t WS_END = OFF_BAR + 16384;

struct Params {
    const float* x; const int* pos; const float* norm_g; const float* wg; const float* wu; const float* wd; const float* win;
    const float* convw; const float* alog; const float* dtb; const float* dng; const float* lng; const float* lnb; const float* sgw; const float* sgb;
    const float* cqg; const float* ckvg; const float* wuq; const float* wukv; const float* wbr; const float* wout;
    float* out; unsigned char* ws;
};

__device__ __forceinline__ unsigned pk2(float lo, float hi) { unsigned r; asm("v_cvt_pk_bf16_f32 %0, %1, %2" : "=v"(r) : "v"(lo), "v"(hi)); return r; }
__device__ __forceinline__ float bflo(unsigned u) { return __uint_as_float(u << 16); }
__device__ __forceinline__ float bfhi(unsigned u) { return __uint_as_float(u & 0xffff0000u); }
__device__ __forceinline__ float bf1(bf16_t b) { return __uint_as_float(((unsigned)b) << 16); }
__device__ __forceinline__ bf16_t f2bf(float f) { return (bf16_t)(pk2(f, 0.f) & 0xffffu); }
__device__ __forceinline__ float wave_sum(float v) {
#pragma unroll
    for (int o = 1; o < 64; o <<= 1) v += __shfl_xor(v, o);
    return v;
}
__device__ __forceinline__ float sigmoidf_(float x) { return __builtin_amdgcn_rcpf(1.f + __builtin_amdgcn_exp2f(-1.4426950408889634f * x)); }
__device__ __forceinline__ float siluf_(float x) { return x * __builtin_amdgcn_rcpf(1.f + __builtin_amdgcn_exp2f(-1.4426950408889634f * x)); }
__device__ __forceinline__ f32x2 gelu_pk(f32x2 v) {
    const f32x2 av = __builtin_elementwise_abs(v), d = av * 0.2316418882f + 1.0f;
    f32x2 t; t.x = __builtin_amdgcn_rcpf(d.x); t.y = __builtin_amdgcn_rcpf(d.y);
    f32x2 q = t * 0.5307027145f + (-0.7265760135f); q = q * t + 0.7107068705f; q = q * t + (-0.142248368f); q = q * t + 0.127414796f; q = q * t;
    const f32x2 s = (v * v) * (-0.72134752044f);
    f32x2 e; e.x = __builtin_amdgcn_exp2f(s.x); e.y = __builtin_amdgcn_exp2f(s.y);
    const f32x2 m = v * (q * e), r = v - m;
    f32x2 o; o.x = v.x < 0.f ? m.x : r.x; o.y = v.y < 0.f ? m.y : r.y; return o;
}
__device__ __forceinline__ bf16x8 load2x4(const bf16_t* p) {
    const s16x4 lo = *(const s16x4*)p, hi = *(const s16x4*)(p + 16);
    return __builtin_shufflevector(lo, hi, 0, 1, 2, 3, 4, 5, 6, 7);
}
__device__ __forceinline__ bf16x8 pack8(f32x4 a, f32x4 b) {
    u32x4 w; w.x = pk2(a[0], a[1]); w.y = pk2(a[2], a[3]); w.z = pk2(b[0], b[1]); w.w = pk2(b[2], b[3]);
    return __builtin_bit_cast(bf16x8, w);
}
#define MFMA16(a, b, c) __builtin_amdgcn_mfma_f32_16x16x32_bf16((a), (b), (c), 0, 0, 0)
#define LDS_WAIT() asm volatile("s_waitcnt lgkmcnt(0)" ::: "memory")

#ifdef TCAT
#define TB(c) do { if (TCAT == (c)) t0_ = __builtin_amdgcn_s_memrealtime(); } while (0)
#define TE(c) do { if (TCAT == (c)) tacc_ += __builtin_amdgcn_s_memrealtime() - t0_; } while (0)
#else
#define TB(c) do {} while (0)
#define TE(c) do {} while (0)
#endif
namespace pg8 {
constexpr int BM = 256, BK = 64, HALF = 128, HTB = HALF * BK * 2, NXCD = 8, WGM = 8;
__device__ __forceinline__ int lds_byte(int r, int c) { const int st = (r >> 4) * 2 + (c >> 5), rr = r & 15, cc = c & 31, ob = rr * 64 + cc * 2; return st * 1024 + (ob ^ (((ob >> 9) & 1) << 5)); }
__device__ __forceinline__ void stage_rc(int b, int& R, int& C) { const int st = b / 1024, sb = b % 1024, swz = sb ^ (((sb >> 9) & 1) << 5); R = (st >> 1) * 16 + swz / 64; C = (st & 1) * 32 + (swz % 64) / 2; }
__device__ __forceinline__ int perm32(int rho) { const int n = rho >> 4, i = rho & 15; return 8 * (i >> 2) + 4 * n + (i & 3); }
struct Unit { int pm, pn, seg; };
struct Gemm { const bf16_t* A; const bf16_t* Bt; int M, N, K; size_t segA, segB; };
struct StaticOrder {
    int nM, nN, nwg, G, c, nseg;
    __device__ __forceinline__ void init(int M, int N, int G_, int c_) { nM = M / BM; nN = N / BM; nwg = nM * nN; G = G_; c = c_; nseg = 1; }
    __device__ __forceinline__ bool next(int i, Unit& u) const {
        const int ti = i / nseg; u.seg = i - ti * nseg;
        const long L = (long)ti * G + c; if (L >= nwg) return false;
        int wgid = (int)L; { const int q = nwg / NXCD, r = nwg % NXCD, xcd = wgid % NXCD, off = wgid / NXCD; wgid = (xcd < r ? xcd * (q + 1) : r * (q + 1) + (xcd - r) * q) + off; }
        const int nig = WGM * nN, gid = wgid / nig, fm = gid * WGM, gsz = (nM - fm) < WGM ? (nM - fm) : WGM;
        u.pm = fm + ((wgid % nig) % gsz); u.pn = (wgid % nig) / gsz; return true;
    }
};
template <class Epi>
__device__ __forceinline__ void gemm_phase(LAS unsigned char* lds, const Gemm g, const StaticOrder& S, const Epi& E) {
    int tid = threadIdx.x; asm volatile("" : "+v"(tid));
    const int wid = __builtin_amdgcn_readfirstlane(tid >> 6), lane = tid & 63, wr = wid >> 2, wc = wid & 3, fr = lane & 15, fq = lane >> 4;
    const int K = g.K, nt = K / BK;
    unsigned voffA[2], voffB[2];
#pragma unroll
    for (int i = 0; i < 2; ++i) { int R, C; stage_rc(tid * 16 + i * 8192, R, C); const int Rb = Epi::PERM ? ((R & ~31) + perm32(R & 31)) : R;
        voffA[i] = (unsigned)(R * K + C) * 2u; voffB[i] = (unsigned)(Rb * K + C) * 2u; }
    const size_t kstep = (size_t)(BK * 2);
    const size_t hstep = (size_t)HALF * K * 2;
    const size_t tstep = 2 * hstep;
    const unsigned ldsw = (unsigned)wid * 1024u;
    const int aoff = lds_byte(wr * 64 + fr, fq * 8), boff = lds_byte(wc * 32 + fr, fq * 8);
#define PG8_SA(b, h) (((b) * 2 + (h)) * HTB)
#define PG8_SB(b, h) ((4 + (b) * 2 + (h)) * HTB)
#define PG8_STAGE(bufoff, gbase, voff) do { _Pragma("unroll") for (int _i = 0; _i < 2; ++_i) \
        __builtin_amdgcn_global_load_lds((const unsigned*)((const char*)(gbase) + (voff)[_i]), (LAS unsigned*)(lds + (bufoff) + ldsw + _i * 8192), 16, 0, 0); } while (0)
#define PG8_LDA(dst, b, h) do { _Pragma("unroll") for (int m = 0; m < 4; ++m) _Pragma("unroll") for (int k = 0; k < 2; ++k) dst[m][k] = *(const LAS bf16x8*)(lds + PG8_SA(b, h) + aoff + m * 2048 + k * 1024); } while (0)
#define PG8_LDB(dst, b, h) do { _Pragma("unroll") for (int n = 0; n < 2; ++n) _Pragma("unroll") for (int k = 0; k < 2; ++k) dst[n][k] = *(const LAS bf16x8*)(lds + PG8_SB(b, h) + boff + n * 2048 + k * 1024); } while (0)
#define PG8_MMA(ai, bj, At, Bt) do { __builtin_amdgcn_s_setprio(1); _Pragma("unroll") for (int m = 0; m < 4; ++m) _Pragma("unroll") for (int n = 0; n < 2; ++n) _Pragma("unroll") for (int k = 0; k < 2; ++k) \
        acc[ai][bj][m][n] = __builtin_amdgcn_mfma_f32_16x16x32_bf16(Bt[n][k], At[m][k], acc[ai][bj][m][n], 0, 0, 0); __builtin_amdgcn_s_setprio(0); } while (0)
#define PG8_WAIT_V(n) asm volatile("s_waitcnt vmcnt(" #n ")" ::: "memory")
#define PG8_WAIT_L(n) asm volatile("s_waitcnt lgkmcnt(" #n ")" ::: "memory")
#define PG8_BAR __builtin_amdgcn_s_barrier()
#define PG8_SCHED __builtin_amdgcn_sched_barrier(0)
    Unit cur, nxt; int ui = 0;
    if (!S.next(0, cur)) return;
    f32x4 acc[2][2][4][2];
#pragma unroll
    for (int a = 0; a < 2; ++a)
#pragma unroll
        for (int b = 0; b < 2; ++b)
#pragma unroll
            for (int m = 0; m < 4; ++m)
#pragma unroll
                for (int n = 0; n < 2; ++n) acc[a][b][m][n] = (f32x4){0.f, 0.f, 0.f, 0.f};
    bf16x8 At[4][2], B0[2][2], B1[2][2];
    const char* cA = (const char*)g.A + cur.seg * g.segA + (size_t)cur.pm * tstep; const char* cB = (const char*)g.Bt + cur.seg * g.segB + (size_t)cur.pn * tstep;
    PG8_STAGE(PG8_SB(0, 0), cB, voffB); PG8_STAGE(PG8_SA(0, 0), cA, voffA); PG8_STAGE(PG8_SB(0, 1), cB + hstep, voffB); PG8_STAGE(PG8_SA(0, 1), cA + hstep, voffA);
    if (wr == 1) PG8_BAR;
    PG8_WAIT_V(4); PG8_BAR;
    PG8_STAGE(PG8_SB(1, 0), cB + kstep, voffB); PG8_STAGE(PG8_SA(1, 0), cA + kstep, voffA); PG8_STAGE(PG8_SB(1, 1), cB + hstep + kstep, voffB);
    PG8_WAIT_V(6); PG8_BAR;
    for (;;) {
        const bool has_next = S.next(ui + 1, nxt);
        const char* nA = has_next ? (const char*)g.A + nxt.seg * g.segA + (size_t)nxt.pm * tstep : cA; const char* nB = has_next ? (const char*)g.Bt + nxt.seg * g.segB + (size_t)nxt.pn * tstep : cB;
        for (int t = 0; t < nt; t += 2) {
            const bool last = (t == nt - 2);
            const char* a1 = cA + (size_t)(t + 1) * kstep;
            const char* a2 = last ? nA : cA + (size_t)(t + 2) * kstep; const char* b2 = last ? nB : cB + (size_t)(t + 2) * kstep;
            const char* a3 = a2 + kstep; const char* b3 = b2 + kstep;
            PG8_LDB(B0, 0, 0); PG8_SCHED; PG8_LDA(At, 0, 0); PG8_STAGE(PG8_SA(1, 1), a1 + hstep, voffA);
            PG8_WAIT_L(8); PG8_BAR; PG8_WAIT_L(0); PG8_MMA(0, 0, At, B0); PG8_BAR; PG8_SCHED;
            PG8_LDB(B1, 0, 1); PG8_STAGE(PG8_SB(0, 0), b2, voffB);
            PG8_BAR; PG8_WAIT_L(0); PG8_MMA(0, 1, At, B1); PG8_BAR;
            PG8_LDA(At, 0, 1); PG8_STAGE(PG8_SA(0, 0), a2, voffA);
            PG8_BAR; PG8_WAIT_L(0); PG8_MMA(1, 0, At, B0); PG8_BAR; PG8_SCHED;
            PG8_STAGE(PG8_SB(0, 1), b2 + hstep, voffB);
            PG8_WAIT_V(6); PG8_BAR; PG8_MMA(1, 1, At, B1); PG8_BAR;
            PG8_LDB(B0, 1, 0); PG8_SCHED; PG8_LDA(At, 1, 0); PG8_STAGE(PG8_SA(0, 1), a2 + hstep, voffA);
            PG8_WAIT_L(8); PG8_BAR; PG8_WAIT_L(0); PG8_MMA(0, 0, At, B0); PG8_BAR; PG8_SCHED;
            PG8_LDB(B1, 1, 1); PG8_STAGE(PG8_SB(1, 0), b3, voffB);
            PG8_BAR; PG8_WAIT_L(0); PG8_MMA(0, 1, At, B1); PG8_BAR;
            PG8_LDA(At, 1, 1); PG8_STAGE(PG8_SA(1, 0), a3, voffA);
            PG8_BAR; PG8_WAIT_L(0); PG8_MMA(1, 0, At, B0); PG8_BAR; PG8_SCHED;
            PG8_STAGE(PG8_SB(1, 1), b3 + hstep, voffB);
            PG8_WAIT_V(6); PG8_BAR; PG8_MMA(1, 1, At, B1); PG8_BAR;
        }
        E(acc, cur, wr, wc, fr, fq);
        if (!has_next) break;
        if (nxt.seg == 0) {
#pragma unroll
        for (int a = 0; a < 2; ++a)
#pragma unroll
            for (int b = 0; b < 2; ++b)
#pragma unroll
                for (int m = 0; m < 4; ++m)
#pragma unroll
                    for (int n = 0; n < 2; ++n) acc[a][b][m][n] = (f32x4){0.f, 0.f, 0.f, 0.f};
        }
        cur = nxt; cA = nA; cB = nB; ++ui;
    }
    PG8_WAIT_V(0);
    if (wr == 0) PG8_BAR;
    PG8_BAR;
#undef PG8_SA
#undef PG8_SB
#undef PG8_STAGE
#undef PG8_LDA
#undef PG8_LDB
#undef PG8_MMA
#undef PG8_WAIT_V
#undef PG8_WAIT_L
#undef PG8_BAR
#undef PG8_SCHED
}
}
using pg8::Unit;
typedef f32x4 Acc[2][2][4][2];

struct EpiF32 {
    static constexpr bool PERM = false;
    float* C; int ldc;
    __device__ __forceinline__ void operator()(const Acc& acc, const Unit& u, int wr, int wc, int fr, int fq) const {
        const int row0 = u.pm * 256 + wr * 64 + fr, col0 = u.pn * 256 + wc * 32 + 4 * fq;
#pragma unroll
        for (int ai = 0; ai < 2; ++ai)
#pragma unroll
            for (int m = 0; m < 4; ++m) { float* rowp = C + (size_t)(row0 + ai * 128 + m * 16) * ldc + col0;
#pragma unroll
                for (int bj = 0; bj < 2; ++bj)
#pragma unroll
                    for (int n = 0; n < 2; ++n) *(f32x4*)(rowp + bj * 128 + n * 16) = acc[ai][bj][m][n]; }
    }
};
struct EpiBf16Out {
    static constexpr bool PERM = true;
    bf16_t* O; int ldc;
    __device__ __forceinline__ void operator()(const Acc& acc, const Unit& u, int wr, int wc, int fr, int fq) const {
        const int row0 = u.pm * 256 + wr * 64 + fr, col0 = u.pn * 256 + wc * 32 + 8 * fq;
#pragma unroll
        for (int ai = 0; ai < 2; ++ai)
#pragma unroll
            for (int m = 0; m < 4; ++m) { bf16_t* rowp = O + (size_t)(row0 + ai * 128 + m * 16) * ldc + col0;
#pragma unroll
                for (int bj = 0; bj < 2; ++bj) { const f32x4 v0 = acc[ai][bj][m][0], v1 = acc[ai][bj][m][1];
                    u32x4 w; w.x = pk2(v0[0], v0[1]); w.y = pk2(v0[2], v0[3]); w.z = pk2(v1[0], v1[1]); w.w = pk2(v1[2], v1[3]);
                    *(u32x4*)(rowp + bj * 128) = w; } }
    }
};
struct EpiSwiGLU {
    static constexpr bool PERM = true;
    bf16_t* O;
    __device__ __forceinline__ void operator()(const Acc& acc, const Unit& u, int wr, int wc, int fr, int fq) const {
        const int row0 = u.pm * 256 + wr * 64 + fr, col0 = u.pn * 128 + wc * 32 + 8 * fq;
#pragma unroll
        for (int ai = 0; ai < 2; ++ai)
#pragma unroll
            for (int m = 0; m < 4; ++m) {
                f32x4 v0, v1;
#pragma unroll
                for (int e = 0; e < 4; ++e) { v0[e] = siluf_(acc[ai][0][m][0][e]) * acc[ai][1][m][0][e]; v1[e] = siluf_(acc[ai][0][m][1][e]) * acc[ai][1][m][1][e]; }
                u32x4 w; w.x = pk2(v0[0], v0[1]); w.y = pk2(v0[2], v0[3]); w.z = pk2(v1[0], v1[1]); w.w = pk2(v1[2], v1[3]);
                *(u32x4*)(O + (size_t)(row0 + ai * 128 + m * 16) * FF + col0) = w; }
    }
};
struct EpiWin {
    static constexpr bool PERM = true;
    unsigned char* ws;
    __device__ __forceinline__ void operator()(const Acc& acc, const Unit& u, int wr, int wc, int fr, int fq) const {
        const int pn = u.pn, row0 = u.pm * 256 + wr * 64 + fr;
        if (pn == 52) {
            float* M = (float*)(ws + OFF_MISC);
#pragma unroll
            for (int ai = 0; ai < 2; ++ai)
#pragma unroll
                for (int m = 0; m < 4; ++m)
#pragma unroll
                    for (int n = 0; n < 2; ++n) *(f32x4*)(M + (size_t)(row0 + ai * 128 + m * 16) * 128 + 32 * wc + 8 * fq + 4 * n) = acc[ai][0][m][n];
            return;
        }
        bf16_t* base; int ld, col, mode = 0;
        if (pn < 12) { base = (bf16_t*)(ws + OFF_QKV); ld = 3072; col = pn * 256; }
        else if (pn < 16) { base = (bf16_t*)(ws + OFF_Z); ld = 1024; col = (pn - 12) * 256; }
        else if (pn < 24) { base = (bf16_t*)(ws + OFF_SG); ld = 2048; col = (pn - 16) * 256; mode = 2; }
        else if (pn < 26) { base = (bf16_t*)(ws + OFF_CQ); ld = 512; col = (pn - 24) * 256; }
        else if (pn < 28) { base = (bf16_t*)(ws + OFF_CKV); ld = 512; col = (pn - 26) * 256; }
        else { base = (bf16_t*)(ws + OFF_GATE); ld = 6144; col = (pn - 28) * 256; mode = 1; }
        col += wc * 32 + 8 * fq;
#pragma unroll
        for (int ai = 0; ai < 2; ++ai)
#pragma unroll
            for (int m = 0; m < 4; ++m) { bf16_t* rowp = base + (size_t)(row0 + ai * 128 + m * 16) * ld + col;
#pragma unroll
                for (int bj = 0; bj < 2; ++bj) { f32x4 v0 = acc[ai][bj][m][0], v1 = acc[ai][bj][m][1];
                    if (mode == 1) {
#pragma unroll
                        for (int e = 0; e < 4; ++e) { v0[e] = sigmoidf_(v0[e]); v1[e] = sigmoidf_(v1[e]); } }
                    else if (mode == 2) { f32x2 a = gelu_pk((f32x2){v0[0], v0[1]}), b = gelu_pk((f32x2){v0[2], v0[3]}), c = gelu_pk((f32x2){v1[0], v1[1]}), d = gelu_pk((f32x2){v1[2], v1[3]});
                        v0 = (f32x4){a.x, a.y, b.x, b.y}; v1 = (f32x4){c.x, c.y, d.x, d.y}; }
                    u32x4 w; w.x = pk2(v0[0], v0[1]); w.y = pk2(v0[2], v0[3]); w.z = pk2(v1[0], v1[1]); w.w = pk2(v1[2], v1[3]);
                    *(u32x4*)(rowp + bj * 128) = w; } }
    }
};
struct EpiQ {
    static constexpr bool PERM = true;
    bf16_t* QB; const float* RS; const float* CS; float qscale;
    __device__ __forceinline__ void operator()(const Acc& acc, const Unit& u, int wr, int wc, int fr, int fq) const {
        const int pn = u.pn, row0 = u.pm * 256 + wr * 64 + fr;
#pragma unroll
        for (int ai = 0; ai < 2; ++ai)
#pragma unroll
            for (int m = 0; m < 4; ++m) { const int row = row0 + ai * 128 + m * 16; const float sc = qscale;
                if (pn < 4) {
#pragma unroll
                    for (int bj = 0; bj < 2; ++bj) { const f32x4 v0 = acc[ai][bj][m][0] * sc, v1 = acc[ai][bj][m][1] * sc;
                        u32x4 w; w.x = pk2(v0[0], v0[1]); w.y = pk2(v0[2], v0[3]); w.z = pk2(v1[0], v1[1]); w.w = pk2(v1[2], v1[3]);
                        *(u32x4*)(QB + (size_t)row * 1536 + (pn * 2 + bj) * 192 + wc * 32 + 8 * fq) = w; }
                } else {
                    const int head = (pn - 4) * 4 + wc, i0 = 8 * fq;
                    const f32x4 c0 = *(const f32x4*)(CS + (size_t)row * 64 + i0), c1 = *(const f32x4*)(CS + (size_t)row * 64 + i0 + 4);
                    const f32x4 s0 = *(const f32x4*)(CS + (size_t)row * 64 + 32 + i0), s1 = *(const f32x4*)(CS + (size_t)row * 64 + 32 + i0 + 4);
                    const f32x4 x10 = acc[ai][0][m][0] * sc, x11 = acc[ai][0][m][1] * sc, x20 = acc[ai][1][m][0] * sc, x21 = acc[ai][1][m][1] * sc;
                    const f32x4 a0 = x10 * c0 - x20 * s0, a1 = x11 * c1 - x21 * s1, b0 = x10 * s0 + x20 * c0, b1 = x11 * s1 + x21 * c1;
                    u32x4 w; w.x = pk2(a0[0], a0[1]); w.y = pk2(a0[2], a0[3]); w.z = pk2(a1[0], a1[1]); w.w = pk2(a1[2], a1[3]);
                    *(u32x4*)(QB + (size_t)row * 1536 + head * 192 + 128 + i0) = w;
                    w.x = pk2(b0[0], b0[1]); w.y = pk2(b0[2], b0[3]); w.z = pk2(b1[0], b1[1]); w.w = pk2(b1[2], b1[3]);
                    *(u32x4*)(QB + (size_t)row * 1536 + head * 192 + 160 + i0) = w;
                } }
    }
};
struct EpiKN {
    static constexpr bool PERM = true;
    bf16_t* O; const float* RS;
    __device__ __forceinline__ void operator()(const Acc& acc, const Unit& u, int wr, int wc, int fr, int fq) const {
        const int row0 = u.pm * 256 + wr * 64 + fr, col0 = u.pn * 256 + wc * 32 + 8 * fq;
#pragma unroll
        for (int ai = 0; ai < 2; ++ai)
#pragma unroll
            for (int m = 0; m < 4; ++m) { const int row = row0 + ai * 128 + m * 16; const float sc = 1.f;
#pragma unroll
                for (int bj = 0; bj < 2; ++bj) { const f32x4 v0 = acc[ai][bj][m][0] * sc, v1 = acc[ai][bj][m][1] * sc;
                    u32x4 w; w.x = pk2(v0[0], v0[1]); w.y = pk2(v0[2], v0[3]); w.z = pk2(v1[0], v1[1]); w.w = pk2(v1[2], v1[3]);
                    *(u32x4*)(O + (size_t)row * 1024 + col0 + bj * 128) = w; } }
    }
};
struct EpiVT {
    static constexpr bool PERM = true;
    bf16_t* O; const float* RS;
    __device__ __forceinline__ void operator()(const Acc& acc, const Unit& u, int wr, int wc, int fr, int fq) const {
        const int row0 = u.pm * 256 + wr * 64 + fr, col0 = u.pn * 256 + wc * 32 + 8 * fq;
        float sc[2][8];
#pragma unroll
        for (int bj = 0; bj < 2; ++bj)
#pragma unroll
            for (int e = 0; e < 8; ++e) sc[bj][e] = 1.f;
#pragma unroll
        for (int ai = 0; ai < 2; ++ai)
#pragma unroll
            for (int m = 0; m < 4; ++m) { const int row = row0 + ai * 128 + m * 16;
#pragma unroll
                for (int bj = 0; bj < 2; ++bj) { const f32x4 v0 = acc[ai][bj][m][0], v1 = acc[ai][bj][m][1];
                    u32x4 w; w.x = pk2(v0[0] * sc[bj][0], v0[1] * sc[bj][1]); w.y = pk2(v0[2] * sc[bj][2], v0[3] * sc[bj][3]);
                    w.z = pk2(v1[0] * sc[bj][4], v1[1] * sc[bj][5]); w.w = pk2(v1[2] * sc[bj][6], v1[3] * sc[bj][7]);
                    *(u32x4*)(O + (size_t)row * 8192 + col0 + bj * 128) = w; } }
    }
};
template <int BR> struct EpiBranch {
    static constexpr bool PERM = true;
    bf16_t* ACC; const bf16_t* GATE; bf16_t* OUT;
    __device__ __forceinline__ void operator()(const Acc& acc, const Unit& u, int wr, int wc, int fr, int fq) const {
        const int row0 = u.pm * 256 + wr * 64 + fr, col0 = u.pn * 256 + wc * 32 + 8 * fq;
#pragma unroll
        for (int ai = 0; ai < 2; ++ai)
#pragma unroll
            for (int m = 0; m < 4; ++m) { const int row = row0 + ai * 128 + m * 16;
#pragma unroll
                for (int bj = 0; bj < 2; ++bj) { const int col = col0 + bj * 128;
                    const u32x4 gw = *(const u32x4*)(GATE + (size_t)row * 6144 + BR * 2048 + col);
                    f32x4 v0 = acc[ai][bj][m][0], v1 = acc[ai][bj][m][1];
                    v0[0] *= bflo(gw.x); v0[1] *= bfhi(gw.x); v0[2] *= bflo(gw.y); v0[3] *= bfhi(gw.y);
                    v1[0] *= bflo(gw.z); v1[1] *= bfhi(gw.z); v1[2] *= bflo(gw.w); v1[3] *= bfhi(gw.w);
                    bf16_t* ap = ACC + (size_t)row * 2048 + col;
                    if (BR > 0) { const u32x4 pw = *(const u32x4*)ap;
                        v0[0] += bflo(pw.x); v0[1] += bfhi(pw.x); v0[2] += bflo(pw.y); v0[3] += bfhi(pw.y);
                        v1[0] += bflo(pw.z); v1[1] += bfhi(pw.z); v1[2] += bflo(pw.w); v1[3] += bfhi(pw.w); }
                    u32x4 w; w.x = pk2(v0[0], v0[1]); w.y = pk2(v0[2], v0[3]); w.z = pk2(v1[0], v1[1]); w.w = pk2(v1[2], v1[3]);
                    if (BR < 2) *(u32x4*)ap = w; else *(u32x4*)(OUT + (size_t)row * 2048 + col) = w; } }
    }
};

struct EpiBranchFused {
    static constexpr bool PERM = true;
    const bf16_t* GATE; bf16_t* OUT;
    __device__ __forceinline__ void operator()(Acc& acc, const Unit& u, int wr, int wc, int fr, int fq) const {
        const int row0 = u.pm * 256 + wr * 64 + fr, col0 = u.pn * 256 + wc * 32 + 8 * fq, seg = u.seg;
        const int segb = seg < 2 ? seg + 1 : seg;
#pragma unroll
        for (int aim = 0; aim < 4; ++aim) { const int ai = aim >> 1, mh = aim & 1;
            u32x4 ga[4][2], gb[4][2];
#pragma unroll
            for (int m = mh * 2; m < mh * 2 + 2; ++m)
#pragma unroll
                for (int bj = 0; bj < 2; ++bj) { const size_t off = (size_t)(row0 + ai * 128 + m * 16) * 6144 + col0 + bj * 128;
                    ga[m][bj] = *(const u32x4*)(GATE + off + seg * 2048); gb[m][bj] = *(const u32x4*)(GATE + off + segb * 2048); }
            __builtin_amdgcn_sched_barrier(0);
#pragma unroll
            for (int m = mh * 2; m < mh * 2 + 2; ++m) { const int row = row0 + ai * 128 + m * 16;
#pragma unroll
                for (int bj = 0; bj < 2; ++bj) { const int col = col0 + bj * 128;
                    const u32x4 a = ga[m][bj], d = gb[m][bj];
                    float sc[8] = {bflo(a.x), bfhi(a.x), bflo(a.y), bfhi(a.y), bflo(a.z), bfhi(a.z), bflo(a.w), bfhi(a.w)};
                    if (seg < 2) { const float dn[8] = {bflo(d.x), bfhi(d.x), bflo(d.y), bfhi(d.y), bflo(d.z), bfhi(d.z), bflo(d.w), bfhi(d.w)};
#pragma unroll
                        for (int e = 0; e < 8; ++e) sc[e] = sc[e] * __builtin_amdgcn_rcpf(dn[e]); }
                    f32x4 v0 = acc[ai][bj][m][0], v1 = acc[ai][bj][m][1];
#pragma unroll
                    for (int e = 0; e < 4; ++e) { v0[e] *= sc[e]; v1[e] *= sc[4 + e]; }
                    if (seg < 2) { acc[ai][bj][m][0] = v0; acc[ai][bj][m][1] = v1; }
                    else { u32x4 w; w.x = pk2(v0[0], v0[1]); w.y = pk2(v0[2], v0[3]); w.z = pk2(v1[0], v1[1]); w.w = pk2(v1[2], v1[3]);
                        *(u32x4*)(OUT + (size_t)row * 2048 + col) = w; } } }
            __builtin_amdgcn_sched_barrier(0);
        }
    }
};
__device__ __forceinline__ void run_branch_gemm(LAS unsigned char* lds, const bf16_t* A3, const bf16_t* Bt3, const EpiBranchFused& E) {
    pg8::Gemm g; g.A = A3; g.Bt = Bt3; g.M = T_; g.N = 2048; g.K = 1024; g.segA = (size_t)T_ * 1024 * 2; g.segB = (size_t)2048 * 1024 * 2;
    pg8::StaticOrder S; S.init(T_, 2048, (int)gridDim.x, (int)blockIdx.x); S.nseg = 3;
    pg8::gemm_phase<EpiBranchFused>(lds, g, S, E);
}
template <class Epi>
__device__ __forceinline__ void run_gemm(LAS unsigned char* lds, const bf16_t* A, const bf16_t* Bt, int M, int N, int K, const Epi& E) {
    pg8::Gemm g; g.A = A; g.Bt = Bt; g.M = M; g.N = N; g.K = K; g.segA = 0; g.segB = 0;
    pg8::StaticOrder S; S.init(M, N, (int)gridDim.x, (int)blockIdx.x);
    pg8::gemm_phase<Epi>(lds, g, S, E);
}

template <class Map>
__device__ __forceinline__ void cvt_item(const float* W, int K, int N, bf16_t* WT, const float* kscale, LAS float* scr, int item, int lane, Map map) {
    const int nblk = (N + 31) / 32, kb = item / nblk, nb = item % nblk, k0 = 128 * kb, n0 = 32 * nb;
    {
        const int nc4 = n0 + 4 * (lane & 7); const bool ok4 = nc4 < N;
        f32x4 v[16];
#pragma unroll
        for (int i = 0; i < 16; ++i) { const int kk = 8 * i + (lane >> 3); v[i] = ok4 ? *(const f32x4*)(W + (size_t)(k0 + kk) * N + nc4) : (f32x4){0.f, 0.f, 0.f, 0.f}; }
#pragma unroll
        for (int i = 0; i < 16; ++i) { const int kk = 8 * i + (lane >> 3); f32x4 x = v[i]; if (kscale) x = x * kscale[k0 + kk];
            LAS float* d = scr + kk * 33 + 4 * (lane & 7); d[0] = x[0]; d[1] = x[1]; d[2] = x[2]; d[3] = x[3]; }
    }
    LDS_WAIT();
    const int c = lane & 15;
#pragma unroll
    for (int j = 0; j < 8; ++j) { const int n = (lane >> 4) + 4 * j; const LAS float* s = scr + (8 * c) * 33 + n;
        if (n0 + n < N) { const int drow = map(n0 + n);
            u32x4 o; o.x = pk2(s[0 * 33], s[1 * 33]); o.y = pk2(s[2 * 33], s[3 * 33]); o.z = pk2(s[4 * 33], s[5 * 33]); o.w = pk2(s[6 * 33], s[7 * 33]);
            *(u32x4*)(WT + (size_t)drow * K + k0 + 8 * c) = o; } }
    LDS_WAIT();
}
struct MapId { __device__ __forceinline__ int operator()(int n) const { return n; } };
struct MapGU { int off; __device__ __forceinline__ int operator()(int n) const { return (n >> 7) * 256 + off + (n & 127); } };
struct MapWin { __device__ __forceinline__ int operator()(int n) const {
    if (n < 4096) return n;
    if (n < 4112) return 13312 + 64 + (n - 4096);
    if (n < 6160) return 4096 + (n - 4112);
    if (n < 6672) return 6144 + (n - 6160);
    if (n < 7184) return 6656 + (n - 6672);
    if (n < 7248) return 13312 + (n - 7184);
    return 7168 + (n - 7248); } };
struct MapUQ { __device__ __forceinline__ int operator()(int n) const { const int hh = n / 192, d = n - hh * 192;
    if (d < 128) return (hh >> 1) * 256 + (hh & 1) * 128 + d;
    if (d < 160) return 1024 + (hh >> 2) * 256 + (hh & 3) * 32 + (d - 128);
    return 1024 + (hh >> 2) * 256 + 128 + (hh & 3) * 32 + (d - 160); } };
struct MapUKV { __device__ __forceinline__ int operator()(int n) const { const int hh = n >> 8, d = n & 255; return d < 128 ? hh * 128 + d : 1024 + hh * 128 + (d - 128); } };

__device__ __forceinline__ void convert_layer(const Params& p, int l, LAS unsigned char* lds) {
    int tid = threadIdx.x; asm volatile("" : "+v"(tid));
    const int lane = tid & 63, wave = tid >> 6;
    LAS float* scr = (LAS float*)(lds + wave * 16896);
    const int gw = blockIdx.x * 8 + wave, NGW = gridDim.x * 8;
    unsigned char* ws = p.ws;
    constexpr int I_GU = 16 * 176, I_DN = 44 * 64, I_WIN = 16 * 419, I_UQ = 4 * 48, I_UKV = 4 * 64, I_BR = 8 * 64, I_OUT = 16 * 64;
    constexpr int NITEMS = 4 * I_GU + 2 * I_DN + I_WIN + I_UQ + I_UKV + 3 * I_BR + I_OUT;
    for (int it = gw; it < NITEMS; it += NGW) {
        int r = it;
        if (r < 4 * I_GU) { const int which = r / I_GU, i = which >> 1, up = which & 1; r -= which * I_GU;
            const float* W = (up ? p.wu : p.wg) + (size_t)(l * 2 + i) * 2048 * FF;
            MapGU mp; mp.off = up * 128;
            cvt_item(W, 2048, FF, (bf16_t*)(ws + OFF_WGU) + (size_t)i * 11264 * 2048, nullptr, scr, r, lane, mp); continue; }
        r -= 4 * I_GU;
        if (r < 2 * I_DN) { const int i = r / I_DN; r -= i * I_DN;
            cvt_item(p.wd + (size_t)(l * 2 + i) * FF * 2048, FF, 2048, (bf16_t*)(ws + OFF_WDN) + (size_t)i * 2048 * FF, nullptr, scr, r, lane, MapId()); continue; }
        r -= 2 * I_DN;
        if (r < I_WIN) { cvt_item(p.win + (size_t)l * 2048 * NIN, 2048, NIN, (bf16_t*)(ws + OFF_WIN), nullptr, scr, r, lane, MapWin()); continue; }
        r -= I_WIN;
        if (r < I_UQ) { cvt_item(p.wuq + (size_t)l * 512 * 1536, 512, 1536, (bf16_t*)(ws + OFF_WUQ), p.cqg + l * 512, scr, r, lane, MapUQ()); continue; }
        r -= I_UQ;
        if (r < I_UKV) { cvt_item(p.wukv + (size_t)l * 512 * 2048, 512, 2048, (bf16_t*)(ws + OFF_WUKV), p.ckvg + l * 512, scr, r, lane, MapUKV()); continue; }
        r -= I_UKV;
        if (r < 3 * I_BR) { const int j = r / I_BR; r -= j * I_BR;
            cvt_item(p.wbr + (size_t)(l * 3 + j) * 1024 * 2048, 1024, 2048, (bf16_t*)(ws + OFF_WBR) + (size_t)j * 2048 * 1024, nullptr, scr, r, lane, MapId()); continue; }
        r -= 3 * I_BR;
        cvt_item(p.wout + (size_t)l * 2048 * 2048, 2048, 2048, (bf16_t*)(ws + OFF_WOUT), nullptr, scr, r, lane, MapId());
    }
    const size_t gt = (size_t)blockIdx.x * 512 + tid, NGT = (size_t)gridDim.x * 512;
    { bf16_t* SGW = (bf16_t*)(ws + OFF_SGW); const float* src = p.sgw + (size_t)l * 8 * 128 * 128;
      for (size_t e = gt; e < (size_t)8 * 128 * 128; e += NGT) { const int j = (int)(e & 127), i = (int)((e >> 7) & 127); SGW[e] = ((j >> 6) <= (i >> 6)) ? f2bf(src[e]) : (bf16_t)0; } }
    { bf16_t* WIN = (bf16_t*)(ws + OFF_WIN) + (size_t)(13312 + 80) * 2048;
      for (size_t e = gt; e < (size_t)176 * 2048; e += NGT) WIN[e] = 0; }
}

__device__ __forceinline__ void rowpass(const float* xin, const bf16_t* f, float alpha, const float* gpost, const float* gpre, float* xout, bf16_t* hout) {
    int tid = threadIdx.x; asm volatile("" : "+v"(tid));
    const int lane = tid & 63, wave = tid >> 6;
    const int gw = blockIdx.x * 8 + wave, NGW = gridDim.x * 8;
    for (int row0 = gw; row0 < T_; row0 += 2 * NGW) {
        const int row1 = row0 + NGW; const bool two = row1 < T_; const int rowb = two ? row1 : row0;
        f32x4 xa[8], xb[8]; u32x2 wa[8], wb[8]; f32x4 gp[8];
        { const f32x4* xr = (const f32x4*)(xin + (size_t)row0 * DM) + lane; const f32x4* xs = (const f32x4*)(xin + (size_t)rowb * DM) + lane;
#pragma unroll
          for (int j = 0; j < 8; ++j) { xa[j] = xr[64 * j]; xb[j] = xs[64 * j]; } }
        if (f) {
            const u32x2* fr = (const u32x2*)(f + (size_t)row0 * DM) + lane; const u32x2* fs = (const u32x2*)(f + (size_t)rowb * DM) + lane;
#pragma unroll
            for (int j = 0; j < 8; ++j) { wa[j] = fr[64 * j]; wb[j] = fs[64 * j]; gp[j] = *((const f32x4*)gpost + lane + 64 * j); }
        }
        __builtin_amdgcn_sched_barrier(0);
        if (f) {
            f32x4 fa[8], fb[8]; float sa = 0.f, sb = 0.f;
#pragma unroll
            for (int j = 0; j < 8; ++j) { fa[j] = (f32x4){bflo(wa[j].x), bfhi(wa[j].x), bflo(wa[j].y), bfhi(wa[j].y)}; fb[j] = (f32x4){bflo(wb[j].x), bfhi(wb[j].x), bflo(wb[j].y), bfhi(wb[j].y)}; }
#pragma unroll
            for (int j = 0; j < 8; ++j) { sa += fa[j][0] * fa[j][0] + fa[j][1] * fa[j][1] + fa[j][2] * fa[j][2] + fa[j][3] * fa[j][3];
                sb += fb[j][0] * fb[j][0] + fb[j][1] * fb[j][1] + fb[j][2] * fb[j][2] + fb[j][3] * fb[j][3]; }
            const float ra = rsqrtf(wave_sum(sa) * (1.f / DM) + EPS) * alpha, rb = rsqrtf(wave_sum(sb) * (1.f / DM) + EPS) * alpha;
#pragma unroll
            for (int j = 0; j < 8; ++j) { xa[j] += fa[j] * ra * gp[j]; xb[j] += fb[j] * rb * gp[j]; }
        }
        f32x4 gq[8];
        if (hout) {
#pragma unroll
            for (int j = 0; j < 8; ++j) gq[j] = *((const f32x4*)gpre + lane + 64 * j);
        }
        { f32x4* xo = (f32x4*)(xout + (size_t)row0 * DM) + lane;
#pragma unroll
          for (int j = 0; j < 8; ++j) xo[64 * j] = xa[j];
          if (two) { f32x4* xp = (f32x4*)(xout + (size_t)row1 * DM) + lane;
#pragma unroll
              for (int j = 0; j < 8; ++j) xp[64 * j] = xb[j]; } }
        __builtin_amdgcn_sched_barrier(0);
        if (hout) {
            float sa = 0.f, sb = 0.f;
#pragma unroll
            for (int j = 0; j < 8; ++j) { sa += xa[j][0] * xa[j][0] + xa[j][1] * xa[j][1] + xa[j][2] * xa[j][2] + xa[j][3] * xa[j][3];
                sb += xb[j][0] * xb[j][0] + xb[j][1] * xb[j][1] + xb[j][2] * xb[j][2] + xb[j][3] * xb[j][3]; }
            const float ra = rsqrtf(wave_sum(sa) * (1.f / DM) + EPS), rb = rsqrtf(wave_sum(sb) * (1.f / DM) + EPS);
            u32x2* ho = (u32x2*)(hout + (size_t)row0 * DM) + lane; u32x2* hp = (u32x2*)(hout + (size_t)rowb * DM) + lane;
#pragma unroll
            for (int j = 0; j < 8; ++j) { const f32x4 ya = xa[j] * ra * gq[j], yb = xb[j] * rb * gq[j];
                u32x2 w; w.x = pk2(ya[0], ya[1]); w.y = pk2(ya[2], ya[3]); ho[64 * j] = w;
                if (two) { u32x2 w2; w2.x = pk2(yb[0], yb[1]); w2.y = pk2(yb[2], yb[3]); hp[64 * j] = w2; } }
        }
    }
}

constexpr int XS = 260;
__device__ __forceinline__ void dn_prep_item(const Params& p, int l, LAS float* L, int item, unsigned long long& t0_, unsigned long long& tacc_) {
    unsigned char* ws = p.ws;
    int tid = threadIdx.x; asm volatile("" : "+v"(tid));
    const int lane = tid & 63, wave = tid >> 6;
    const int h = item & 7, n = (item >> 3) & 31, b = item >> 8;
    const int t0 = b * SEQ_ + n * 64;
    LAS float* sQ = L; LAS float* sK = L + 64 * 132; LAS float* sX = L + 2 * 64 * 132; LAS float* sA = sX + 64 * XS; LAS float* sG = sA + 64 * 68; LAS float* sB = sG + 64;
    const bf16_t* QKV = (const bf16_t*)(ws + OFF_QKV);
    const float* MISC = (const float*)(ws + OFF_MISC);
    const float* cw = p.convw + (size_t)l * 4 * 3072;
    TB(7);
    if (tid < 384) {
        const int cgp = tid % 48, tq = tid / 48, part = cgp >> 4, d0 = (cgp & 15) * 8, ch = part * 1024 + h * 128 + d0;
        f32x4 w0[4], w1[4];
#pragma unroll
        for (int j = 0; j < 4; ++j) { w0[j] = *(const f32x4*)(cw + j * 3072 + ch); w1[j] = *(const f32x4*)(cw + j * 3072 + ch + 4); }
        u32x4 xr[11];
#pragma unroll
        for (int r = 0; r < 11; ++r) { const int sq = n * 64 + tq * 8 - 3 + r; const int sc = sq < 0 ? 0 : sq;
            u32x4 v = *(const u32x4*)(QKV + (size_t)(b * SEQ_ + sc) * 3072 + ch);
            xr[r] = v; }
        __builtin_amdgcn_sched_barrier(0);
#pragma unroll
        for (int r = 0; r < 3; ++r) if (n * 64 + tq * 8 - 3 + r < 0) xr[r] = (u32x4){0u, 0u, 0u, 0u};
#pragma unroll
        for (int tt = 0; tt < 8; ++tt) { const int t = tq * 8 + tt;
            f32x4 a0 = (f32x4){0.f, 0.f, 0.f, 0.f}, a1 = a0;
#pragma unroll
            for (int j = 0; j < 4; ++j) { const u32x4 xv = xr[tt + j];
                a0 += w0[j] * (f32x4){bflo(xv.x), bfhi(xv.x), bflo(xv.y), bfhi(xv.y)}; a1 += w1[j] * (f32x4){bflo(xv.z), bfhi(xv.z), bflo(xv.w), bfhi(xv.w)}; }
            LAS float* dst = part == 0 ? sQ + t * 132 + d0 : (part == 1 ? sK + t * 132 + d0 : sX + t * XS + 128 + d0);
#pragma unroll
            for (int e = 0; e < 4; ++e) { dst[e] = siluf_(a0[e]); dst[4 + e] = siluf_(a1[e]); } }
    }
    __syncthreads();
    TE(7);
    TB(8);
    { const int row = tid >> 2, sub = tid & 3; LAS float* rp = (row < 64 ? sQ + row * 132 : sK + (row - 64) * 132) + sub * 32;
      float ss = 0.f;
      f32x4 rv[8];
#pragma unroll
      for (int e = 0; e < 8; ++e) rv[e] = *(const LAS f32x4*)(rp + 4 * e);
      __builtin_amdgcn_sched_barrier(0);
#pragma unroll
      for (int e = 0; e < 8; ++e) ss += rv[e][0] * rv[e][0] + rv[e][1] * rv[e][1] + rv[e][2] * rv[e][2] + rv[e][3] * rv[e][3];
      ss += __shfl_xor(ss, 1); ss += __shfl_xor(ss, 2);
      const float sc = rsqrtf(ss + 1e-6f) * (row < 64 ? 0.08838834764831845f : 1.f);
#pragma unroll
      for (int e = 0; e < 8; ++e) *(LAS f32x4*)(rp + 4 * e) = rv[e] * sc; }
    if (tid < 64) { const float av = MISC[(size_t)(t0 + tid) * 128 + 64 + h], bv = MISC[(size_t)(t0 + tid) * 128 + 72 + h];
        const float xx = av + p.dtb[l * 8 + h]; const float sp = xx > 20.f ? xx : log1pf(__expf(xx));
        float gv = -__expf(p.alog[l * 8 + h]) * sp;
#pragma unroll
        for (int o = 1; o < 64; o <<= 1) { const float y = __shfl_up(gv, o); if (lane >= o) gv += y; }
        sG[tid] = gv; sB[tid] = sigmoidf_(bv); }
    __syncthreads();
    TE(8);
    TB(9);
    { const int jl = lane & 15, g = lane >> 4, ib = wave >> 1;
      bf16_t* QKo = (bf16_t*)(ws + OFF_DQK) + (size_t)item * 4096;
#pragma unroll
      for (int jj = 0; jj < 2; ++jj) { const int jb = (wave & 1) * 2 + jj;
          f32x4 aA = (f32x4){0.f, 0.f, 0.f, 0.f}, aQ = aA;
          if (jb <= ib) {
              f32x4 rk[4][2], rq[4][2], rj[4][2];
#pragma unroll
              for (int ks = 0; ks < 4; ++ks) {
                  const LAS float* kip = sK + (ib * 16 + jl) * 132 + ks * 32 + g * 8; const LAS float* qip = sQ + (ib * 16 + jl) * 132 + ks * 32 + g * 8;
                  const LAS float* kjp = sK + (jb * 16 + jl) * 132 + ks * 32 + g * 8;
                  rk[ks][0] = *(const LAS f32x4*)kip; rk[ks][1] = *(const LAS f32x4*)(kip + 4); rq[ks][0] = *(const LAS f32x4*)qip; rq[ks][1] = *(const LAS f32x4*)(qip + 4);
                  rj[ks][0] = *(const LAS f32x4*)kjp; rj[ks][1] = *(const LAS f32x4*)(kjp + 4); }
              __builtin_amdgcn_sched_barrier(0);
#pragma unroll
              for (int ks = 0; ks < 4; ++ks) { const bf16x8 ki = pack8(rk[ks][0], rk[ks][1]), qi = pack8(rq[ks][0], rq[ks][1]), kj = pack8(rj[ks][0], rj[ks][1]);
                  aA = MFMA16(ki, kj, aA); aQ = MFMA16(qi, kj, aQ); } }
          const int j = jb * 16 + jl; const float gj = sG[j];
          const int pj = (j & 32) + ((j & 15) >> 2) * 8 + ((j >> 4) & 1) * 4 + (j & 3);
#pragma unroll
          for (int r = 0; r < 4; ++r) { const int i = ib * 16 + g * 4 + r; const float dec = (j <= i) ? __expf(sG[i] - gj) : 0.f;
              sA[i * 68 + j] = (j < i) ? sB[i] * aA[r] * dec : 0.f;
              QKo[i * 64 + pj] = f2bf((j <= i) ? aQ[r] * dec : 0.f); } } }
    for (int task = tid; task < 64 * 32; task += 512) { const int t = task >> 5, d4 = task & 31; const float bt = sB[t], kb = bt * __expf(sG[t]);
        const f32x4 kv = *(const LAS f32x4*)(sK + t * 132 + d4 * 4); *(LAS f32x4*)(sX + t * XS + d4 * 4) = kv * kb;
        LAS f32x4* vp = (LAS f32x4*)(sX + t * XS + 128 + d4 * 4); *vp = *vp * bt; }
    __syncthreads();
    TE(9);
    TB(10);
    if (tid < 256) {
        float x[64]; int va[64];
#pragma unroll
        for (int i = 0; i < 64; ++i) x[i] = sX[i * XS + tid];
#pragma unroll
        for (int i = 1; i < 64; ++i) va[i] = __float_as_int(sA[i * 68 + lane]);
#pragma unroll
        for (int i = 1; i < 64; ++i) {
            float acc0 = 0.f, acc1 = 0.f;
#pragma unroll
            for (int j = 0; j < i; ++j) { const float aij = __int_as_float(__builtin_amdgcn_readlane(va[i], j));
                if (j & 1) acc1 = fmaf(aij, x[j], acc1); else acc0 = fmaf(aij, x[j], acc0); }
            x[i] -= acc0 + acc1;
        }
#pragma unroll
        for (int i = 1; i < 64; ++i) sX[i * XS + tid] = x[i];
    } else {
        bf16_t* QGo = (bf16_t*)(ws + OFF_DQG) + (size_t)item * 8192; bf16_t* KGTo = (bf16_t*)(ws + OFF_DKGT) + (size_t)item * 8192;
        const float glast = sG[63];
        for (int task = tid - 256; task < 1024; task += 256) {
            { const int c = task >> 4, pc = task & 15, dA = (pc >> 2) * 32 + (pc & 3) * 4, dB = dA + 16;
              const float eg = __expf(sG[c]);
              const f32x4 q0 = *(const LAS f32x4*)(sQ + c * 132 + dA) * eg, q1 = *(const LAS f32x4*)(sQ + c * 132 + dB) * eg;
              u32x4 w; w.x = pk2(q0[0], q0[1]); w.y = pk2(q0[2], q0[3]); w.z = pk2(q1[0], q1[1]); w.w = pk2(q1[2], q1[3]);
              *(u32x4*)(QGo + c * 128 + pc * 8) = w; }
            { const int d = task & 127, pc = task >> 7, cA = (pc >> 2) * 32 + (pc & 3) * 4;
              float kk[8];
#pragma unroll
              for (int e = 0; e < 8; ++e) { const int cc = cA + (e & 3) + (e >> 2) * 16; kk[e] = sK[cc * 132 + d] * __expf(glast - sG[cc]); }
              u32x4 w; w.x = pk2(kk[0], kk[1]); w.y = pk2(kk[2], kk[3]); w.z = pk2(kk[4], kk[5]); w.w = pk2(kk[6], kk[7]);
              *(u32x4*)(KGTo + d * 64 + pc * 8) = w; }
        }
    }
    __syncthreads();
    TE(10);
    TB(11);
    { bf16_t* Wo = (bf16_t*)(ws + OFF_DW) + (size_t)item * 8192; bf16_t* UTo = (bf16_t*)(ws + OFF_DUT) + (size_t)item * 8192;
      for (int task = tid; task < 1024; task += 512) {
          { const int c = task >> 4, pc = task & 15, dA = (pc >> 2) * 32 + (pc & 3) * 4, dB = dA + 16;
            const f32x4 a = *(const LAS f32x4*)(sX + c * XS + dA), b2 = *(const LAS f32x4*)(sX + c * XS + dB);
            u32x4 w; w.x = pk2(a[0], a[1]); w.y = pk2(a[2], a[3]); w.z = pk2(b2[0], b2[1]); w.w = pk2(b2[2], b2[3]);
            *(u32x4*)(Wo + c * 128 + pc * 8) = w; }
          { const int d = task & 127, c0 = (task >> 7) * 8;
            float uu[8];
#pragma unroll
            for (int e = 0; e < 8; ++e) uu[e] = sX[(c0 + e) * XS + 128 + d];
            u32x4 w; w.x = pk2(uu[0], uu[1]); w.y = pk2(uu[2], uu[3]); w.z = pk2(uu[4], uu[5]); w.w = pk2(uu[6], uu[7]);
            *(u32x4*)(UTo + d * 64 + c0) = w; }
      }
      if (tid == 0) ((float*)(ws + OFF_DEG))[item] = __expf(sG[63]); }
    __syncthreads();
    TE(11);
}

__device__ __forceinline__ void row_items(const Params& p) {
    unsigned char* ws = p.ws;
    int tid = threadIdx.x; asm volatile("" : "+v"(tid));
    const int lane = tid & 63, wave = tid >> 6;
    const int gw = blockIdx.x * 8 + wave, NGW = gridDim.x * 8;
    const bf16_t* SG = (const bf16_t*)(ws + OFF_SG); const bf16_t* CQ = (const bf16_t*)(ws + OFF_CQ); const bf16_t* CKV = (const bf16_t*)(ws + OFF_CKV);
    const float* MISC = (const float*)(ws + OFF_MISC); const float* CS = (const float*)(ws + OFF_CS);
    float* STATS = (float*)(ws + OFF_STATS); float* RS = (float*)(ws + OFF_RS); bf16_t* KR = (bf16_t*)(ws + OFF_KR);
    for (int t = gw; t < T_; t += NGW) {
        { const u32x4 a = *(const u32x4*)(SG + (size_t)t * 2048 + 1024 + lane * 16), b = *(const u32x4*)(SG + (size_t)t * 2048 + 1024 + lane * 16 + 8);
          float v[16]; v[0] = bflo(a.x); v[1] = bfhi(a.x); v[2] = bflo(a.y); v[3] = bfhi(a.y); v[4] = bflo(a.z); v[5] = bfhi(a.z); v[6] = bflo(a.w); v[7] = bfhi(a.w);
          v[8] = bflo(b.x); v[9] = bfhi(b.x); v[10] = bflo(b.y); v[11] = bfhi(b.y); v[12] = bflo(b.z); v[13] = bfhi(b.z); v[14] = bflo(b.w); v[15] = bfhi(b.w);
          float s = 0.f;
#pragma unroll
          for (int e = 0; e < 16; ++e) s += v[e];
          const float mean = wave_sum(s) * (1.f / 1024.f); float s2 = 0.f;
#pragma unroll
          for (int e = 0; e < 16; ++e) { const float d = v[e] - mean; s2 += d * d; }
          const float rstd = rsqrtf(wave_sum(s2) * (1.f / 1024.f) + 1e-5f);
          if (lane == 0) { STATS[t * 2] = mean; STATS[t * 2 + 1] = rstd; } }
        float rsq_, rskv_;
        { const u32x4 a = *(const u32x4*)(CQ + (size_t)t * 512 + lane * 8), b = *(const u32x4*)(CKV + (size_t)t * 512 + lane * 8);
          float sa = bflo(a.x) * bflo(a.x) + bfhi(a.x) * bfhi(a.x) + bflo(a.y) * bflo(a.y) + bfhi(a.y) * bfhi(a.y) + bflo(a.z) * bflo(a.z) + bfhi(a.z) * bfhi(a.z) + bflo(a.w) * bflo(a.w) + bfhi(a.w) * bfhi(a.w);
          float sb = bflo(b.x) * bflo(b.x) + bfhi(b.x) * bfhi(b.x) + bflo(b.y) * bflo(b.y) + bfhi(b.y) * bfhi(b.y) + bflo(b.z) * bflo(b.z) + bfhi(b.z) * bfhi(b.z) + bflo(b.w) * bflo(b.w) + bfhi(b.w) * bfhi(b.w);
          sa = wave_sum(sa); sb = wave_sum(sb);
          rsq_ = rsqrtf(sa * (1.f / 512.f) + EPS); rskv_ = rsqrtf(sb * (1.f / 512.f) + EPS);
          if (lane == 0) { RS[t] = rsq_; RS[T_ + t] = rskv_; } }
        if (lane < 32) { const float x1 = MISC[(size_t)t * 128 + lane], x2 = MISC[(size_t)t * 128 + 32 + lane];
            const float c = CS[(size_t)t * 64 + lane], s = CS[(size_t)t * 64 + 32 + lane];
            const float ik = 1.f / rskv_;
            KR[(size_t)t * 64 + lane] = f2bf((x1 * c - x2 * s) * ik); KR[(size_t)t * 64 + 32 + lane] = f2bf((x1 * s + x2 * c) * ik); }
    }
}

__device__ __forceinline__ void dn_scan_item(const Params& p, int l, LAS unsigned char* lds, int bh) {
    unsigned char* ws = p.ws;
    int tid = threadIdx.x; asm volatile("" : "+v"(tid));
    const int lane = tid & 63, wave = tid >> 6, jl = lane & 15, g = lane >> 4;
    const int b = bh >> 3, h = bh & 7, dv0 = wave * 16;
    LAS bf16_t* sW = (LAS bf16_t*)lds; LAS bf16_t* sQG = sW + 64 * 136; LAS bf16_t* sKGT = sQG + 64 * 136; LAS bf16_t* sUT = sKGT + 128 * 72; LAS bf16_t* sQK = sUT + 128 * 72;
    LAS float* sO = (LAS float*)(sQK + 64 * 72);
    const bf16_t* Z = (const bf16_t*)(ws + OFF_Z); bf16_t* OA = (bf16_t*)(ws + OFF_OA);
    const float* EGp = (const float*)(ws + OFF_DEG);
    const int fc = wave * 8 + (lane >> 3), fd0 = (lane & 7) * 16;
    f32x4 ngv[4];
#pragma unroll
    for (int k = 0; k < 4; ++k) ngv[k] = *(const f32x4*)(p.dng + l * 128 + fd0 + 4 * k);
    const int gA = (tid >> 4) * 128 + (tid & 15) * 8, lA = (tid >> 4) * 136 + (tid & 15) * 8;
    const int gB = (tid >> 3) * 64 + (tid & 7) * 8, lB = (tid >> 3) * 72 + (tid & 7) * 8;
    u32x4 r[9];
#define SCAN_LOAD(nn) do { const size_t it_ = (size_t)((b * 32 + (nn)) * 8 + h); \
        const bf16_t* Wg = (const bf16_t*)(ws + OFF_DW) + it_ * 8192; const bf16_t* QGg = (const bf16_t*)(ws + OFF_DQG) + it_ * 8192; \
        const bf16_t* KGg = (const bf16_t*)(ws + OFF_DKGT) + it_ * 8192; const bf16_t* UTg = (const bf16_t*)(ws + OFF_DUT) + it_ * 8192; const bf16_t* QKg = (const bf16_t*)(ws + OFF_DQK) + it_ * 4096; \
        r[0] = *(const u32x4*)(Wg + gA); r[1] = *(const u32x4*)(Wg + gA + 32 * 128); r[2] = *(const u32x4*)(QGg + gA); r[3] = *(const u32x4*)(QGg + gA + 32 * 128); \
        r[4] = *(const u32x4*)(KGg + gB); r[5] = *(const u32x4*)(KGg + gB + 64 * 64); r[6] = *(const u32x4*)(UTg + gB); r[7] = *(const u32x4*)(UTg + gB + 64 * 64); r[8] = *(const u32x4*)(QKg + gB); } while (0)
#define SCAN_STORE() do { *(LAS u32x4*)(sW + lA) = r[0]; *(LAS u32x4*)(sW + lA + 32 * 136) = r[1]; *(LAS u32x4*)(sQG + lA) = r[2]; *(LAS u32x4*)(sQG + lA + 32 * 136) = r[3]; \
        *(LAS u32x4*)(sKGT + lB) = r[4]; *(LAS u32x4*)(sKGT + lB + 64 * 72) = r[5]; *(LAS u32x4*)(sUT + lB) = r[6]; *(LAS u32x4*)(sUT + lB + 64 * 72) = r[7]; *(LAS u32x4*)(sQK + lB) = r[8]; } while (0)
    f32x4 S[8];
#pragma unroll
    for (int i = 0; i < 8; ++i) S[i] = (f32x4){0.f, 0.f, 0.f, 0.f};
    __syncthreads();
    SCAN_LOAD(0); SCAN_STORE();
    __syncthreads();
    for (int n = 0; n < 32; ++n) {
        const int item = (b * 32 + n) * 8 + h;
        if (n + 1 < 32) SCAN_LOAD(n + 1);
        const float eg = EGp[item];
        const size_t tokf = (size_t)b * SEQ_ + n * 64 + fc;
        const u32x4 zw0 = *(const u32x4*)(Z + tokf * 1024 + h * 128 + fd0), zw1 = *(const u32x4*)(Z + tokf * 1024 + h * 128 + fd0 + 8);
        bf16x8 sf[4];
#pragma unroll
        for (int ks = 0; ks < 4; ++ks) sf[ks] = pack8(S[2 * ks], S[2 * ks + 1]);
#define SB __builtin_amdgcn_sched_barrier(0)
        f32x4 vn[4];
        bf16x8 vf[2];
        { bf16x8 wf[4][4]; u32x2 uw[4];
#pragma unroll
          for (int cb = 0; cb < 4; ++cb)
#pragma unroll
              for (int ks = 0; ks < 4; ++ks) wf[cb][ks] = *(const LAS bf16x8*)(sW + (cb * 16 + jl) * 136 + ks * 32 + g * 8);
#pragma unroll
          for (int cb = 0; cb < 4; ++cb) uw[cb] = *(const LAS u32x2*)(sUT + (dv0 + jl) * 72 + cb * 16 + g * 4);
          SB;
          bf16x8 qa[2][4];
#pragma unroll
          for (int cb = 0; cb < 2; ++cb)
#pragma unroll
              for (int ks = 0; ks < 4; ++ks) qa[cb][ks] = *(const LAS bf16x8*)(sQG + (cb * 16 + jl) * 136 + ks * 32 + g * 8);
          f32x4 ac[4], aq[4];
#pragma unroll
          for (int cb = 0; cb < 4; ++cb) { ac[cb] = (f32x4){0.f, 0.f, 0.f, 0.f}; aq[cb] = ac[cb]; }
#pragma unroll
          for (int ks = 0; ks < 4; ++ks)
#pragma unroll
              for (int cb = 0; cb < 4; ++cb) ac[cb] = MFMA16(wf[cb][ks], sf[ks], ac[cb]);
          SB;
          bf16x8 qb[2][4];
#pragma unroll
          for (int cb = 0; cb < 2; ++cb)
#pragma unroll
              for (int ks = 0; ks < 4; ++ks) qb[cb][ks] = *(const LAS bf16x8*)(sQG + ((cb + 2) * 16 + jl) * 136 + ks * 32 + g * 8);
#pragma unroll
          for (int ks = 0; ks < 4; ++ks)
#pragma unroll
              for (int cb = 0; cb < 2; ++cb) aq[cb] = MFMA16(qa[cb][ks], sf[ks], aq[cb]);
          SB;
          bf16x8 kq[4][2];
#pragma unroll
          for (int cb = 0; cb < 4; ++cb)
#pragma unroll
              for (int k2 = 0; k2 < 2; ++k2) kq[cb][k2] = *(const LAS bf16x8*)(sQK + (cb * 16 + jl) * 72 + k2 * 32 + g * 8);
#pragma unroll
          for (int ks = 0; ks < 4; ++ks)
#pragma unroll
              for (int cb = 0; cb < 2; ++cb) aq[cb + 2] = MFMA16(qb[cb][ks], sf[ks], aq[cb + 2]);
#pragma unroll
          for (int cb = 0; cb < 4; ++cb) vn[cb] = (f32x4){bflo(uw[cb].x), bfhi(uw[cb].x), bflo(uw[cb].y), bfhi(uw[cb].y)} - ac[cb];
          vf[0] = pack8(vn[0], vn[1]); vf[1] = pack8(vn[2], vn[3]);
#pragma unroll
          for (int db = 0; db < 8; ++db) S[db] = S[db] * eg;
          SB;
          bf16x8 ka[4][2];
#pragma unroll
          for (int db = 0; db < 4; ++db)
#pragma unroll
              for (int k2 = 0; k2 < 2; ++k2) ka[db][k2] = *(const LAS bf16x8*)(sKGT + (db * 16 + jl) * 72 + k2 * 32 + g * 8);
#pragma unroll
          for (int k2 = 0; k2 < 2; ++k2)
#pragma unroll
              for (int cb = 0; cb < 4; ++cb) aq[cb] = MFMA16(kq[cb][k2], vf[k2], aq[cb]);
          SB;
          bf16x8 kb2[4][2];
#pragma unroll
          for (int db = 0; db < 4; ++db)
#pragma unroll
              for (int k2 = 0; k2 < 2; ++k2) kb2[db][k2] = *(const LAS bf16x8*)(sKGT + ((db + 4) * 16 + jl) * 72 + k2 * 32 + g * 8);
#pragma unroll
          for (int k2 = 0; k2 < 2; ++k2)
#pragma unroll
              for (int db = 0; db < 4; ++db) S[db] = MFMA16(ka[db][k2], vf[k2], S[db]);
#pragma unroll
          for (int cb = 0; cb < 4; ++cb)
#pragma unroll
              for (int rr = 0; rr < 4; ++rr) sO[(cb * 16 + g * 4 + rr) * 132 + dv0 + jl] = aq[cb][rr];
          SB;
#pragma unroll
          for (int k2 = 0; k2 < 2; ++k2)
#pragma unroll
              for (int db = 0; db < 4; ++db) S[db + 4] = MFMA16(kb2[db][k2], vf[k2], S[db + 4]); }
#undef SB
        __syncthreads();
        if (n + 1 < 32) SCAN_STORE();
        { f32x4 ov[4]; float ss = 0.f;
#pragma unroll
          for (int k = 0; k < 4; ++k) { ov[k] = *(const LAS f32x4*)(sO + fc * 132 + fd0 + 4 * k); ss += ov[k][0] * ov[k][0] + ov[k][1] * ov[k][1] + ov[k][2] * ov[k][2] + ov[k][3] * ov[k][3]; }
          ss += __shfl_xor(ss, 1); ss += __shfl_xor(ss, 2); ss += __shfl_xor(ss, 4);
          const float rs = rsqrtf(ss * (1.f / 128.f) + EPS);
          const unsigned zu[8] = {zw0.x, zw0.y, zw0.z, zw0.w, zw1.x, zw1.y, zw1.z, zw1.w};
          unsigned ow[8];
#pragma unroll
          for (int k = 0; k < 4; ++k) { const f32x4 y = ov[k] * rs * ngv[k];
              ow[2 * k] = pk2(y[0] * siluf_(bflo(zu[2 * k])), y[1] * siluf_(bfhi(zu[2 * k])));
              ow[2 * k + 1] = pk2(y[2] * siluf_(bflo(zu[2 * k + 1])), y[3] * siluf_(bfhi(zu[2 * k + 1]))); }
          *(u32x4*)(OA + tokf * 1024 + h * 128 + fd0) = (u32x4){ow[0], ow[1], ow[2], ow[3]};
          *(u32x4*)(OA + tokf * 1024 + h * 128 + fd0 + 8) = (u32x4){ow[4], ow[5], ow[6], ow[7]}; }
        __syncthreads();
    }
#undef SCAN_LOAD
#undef SCAN_STORE
}

__device__ __forceinline__ void attn_block_item(const Params& p, LAS unsigned char* lds, int idx) {
    unsigned char* ws = p.ws;
    int tid = threadIdx.x; asm volatile("" : "+v"(tid));
    const int lane = tid & 63, wave = tid >> 6, jl = lane & 15, g = lane >> 4;
    const int qblk = 7 - (idx >> 5), bh = idx & 31, b = bh >> 3, h = bh & 7;
    const int s0 = qblk * 256 + wave * 32; const size_t tq = (size_t)b * SEQ_ + s0 + jl;
    const int mychunk = s0 >> 6, ntiles = 4 * qblk + 4;
    const bf16_t* QB = (const bf16_t*)(ws + OFF_QB);
    bf16x8 qf[2][6];
#pragma unroll
    for (int u = 0; u < 2; ++u)
#pragma unroll
        for (int ks = 0; ks < 6; ++ks) qf[u][ks] = *(const bf16x8*)(QB + (tq + u * 16) * 1536 + h * 192 + ks * 32 + g * 8);
    const bf16_t* kp[3]; int kst[3], kl[3];
#pragma unroll
    for (int k = 0; k < 3; ++k) { const int q = tid + 512 * k, row = q / 24, pc = q - row * 24;
        if (pc < 16) { kp[k] = (const bf16_t*)(ws + OFF_KN) + ((size_t)b * SEQ_ + row) * 1024 + h * 128 + pc * 8; kst[k] = 64 * 1024; }
        else { kp[k] = (const bf16_t*)(ws + OFF_KR) + ((size_t)b * SEQ_ + row) * 64 + (pc - 16) * 8; kst[k] = 64 * 64; }
        kl[k] = row * 200 + pc * 8; }
    const bf16_t* vp[2]; int vl[2];
#pragma unroll
    for (int k = 0; k < 2; ++k) { const int q = tid + 512 * k, row = q >> 3, pc = q & 7;
        vp[k] = (const bf16_t*)(ws + OFF_VT) + (size_t)(h * 128 + row) * 8192 + (size_t)b * SEQ_ + pc * 8;
        vl[k] = row * 72 + (pc >> 2) * 32 + (pc & 1) * 16 + ((pc >> 1) & 1) * 4; }
    u32x4 rk[3], rv[2];
    const float* RSp = (const float*)(ws + OFF_RS);
    const float rq0 = RSp[tq], rq1 = RSp[tq + 16];
    const float* rkvp = RSp + T_ + (size_t)b * SEQ_ + g * 4;
    f32x4 kvs[4];
#define AT_LOAD(tile) do { _Pragma("unroll") for (int k = 0; k < 3; ++k) rk[k] = *(const u32x4*)(kp[k] + (size_t)(tile) * kst[k]); \
        _Pragma("unroll") for (int k = 0; k < 2; ++k) rv[k] = *(const u32x4*)(vp[k] + (tile) * 64); } while (0)
#define AT_STORE(bi) do { LAS bf16_t* sKb = (LAS bf16_t*)(lds + (bi) * 44032); LAS bf16_t* sVb = sKb + 64 * 200; \
        _Pragma("unroll") for (int k = 0; k < 3; ++k) *(LAS u32x4*)(sKb + kl[k]) = rk[k]; \
        _Pragma("unroll") for (int k = 0; k < 2; ++k) { *(LAS u32x2*)(sVb + vl[k]) = (u32x2){rv[k].x, rv[k].y}; *(LAS u32x2*)(sVb + vl[k] + 8) = (u32x2){rv[k].z, rv[k].w}; } } while (0)
    f32x4 o[2][8];
#pragma unroll
    for (int u = 0; u < 2; ++u)
#pragma unroll
        for (int i = 0; i < 8; ++i) o[u][i] = (f32x4){0.f, 0.f, 0.f, 0.f};
    float mrun[2] = {-1e30f, -1e30f}, lsum[2] = {0.f, 0.f};
    __syncthreads();
    AT_LOAD(0); AT_STORE(0);
    if (ntiles > 1) AT_LOAD(1);
    __syncthreads();
    for (int t = 0; t < ntiles; ++t) {
#pragma unroll
        for (int sb = 0; sb < 4; ++sb) kvs[sb] = *(const f32x4*)(rkvp + t * 64 + sb * 16);
        if (t + 1 < ntiles) { AT_STORE((t + 1) & 1); if (t + 2 < ntiles) AT_LOAD(t + 2); }
        if (t <= mychunk) {
            const LAS bf16_t* sKb = (const LAS bf16_t*)(lds + (t & 1) * 44032); const LAS bf16_t* sVb = sKb + 64 * 200;
            f32x4 s[2][4];
            {
              bf16x8 kfr[2][3];
#pragma unroll
              for (int k3 = 0; k3 < 3; ++k3) kfr[0][k3] = *(const LAS bf16x8*)(sKb + jl * 200 + k3 * 32 + g * 8);
              __builtin_amdgcn_sched_barrier(0);
              f32x4 a0 = (f32x4){0.f, 0.f, 0.f, 0.f}, a1 = a0;
#pragma unroll
              for (int hs = 0; hs < 8; ++hs) { const int sb = hs >> 1, kh = hs & 1;
                  if (hs + 1 < 8) { const int sb2 = (hs + 1) >> 1, kh2 = (hs + 1) & 1;
#pragma unroll
                      for (int k3 = 0; k3 < 3; ++k3) kfr[(hs + 1) & 1][k3] = *(const LAS bf16x8*)(sKb + (sb2 * 16 + jl) * 200 + (kh2 * 3 + k3) * 32 + g * 8); }
#pragma unroll
                  for (int k3 = 0; k3 < 3; ++k3) { a0 = MFMA16(kfr[hs & 1][k3], qf[0][kh * 3 + k3], a0); a1 = MFMA16(kfr[hs & 1][k3], qf[1][kh * 3 + k3], a1); }
                  if (kh == 1) { s[0][sb] = a0 * kvs[sb] * rq0; s[1][sb] = a1 * kvs[sb] * rq1; a0 = (f32x4){0.f, 0.f, 0.f, 0.f}; a1 = a0; }
                  __builtin_amdgcn_sched_barrier(0); } }
            bf16x8 pf[2][2]; float alpha[2];
#pragma unroll
            for (int u = 0; u < 2; ++u) {
                float mx = -1e30f;
#pragma unroll
                for (int sb = 0; sb < 4; ++sb) mx = fmaxf(mx, fmaxf(fmaxf(s[u][sb][0], s[u][sb][1]), fmaxf(s[u][sb][2], s[u][sb][3])));
                mx = fmaxf(mx, __shfl_xor(mx, 16)); mx = fmaxf(mx, __shfl_xor(mx, 32));
                const float mnew = fmaxf(mrun[u], mx); alpha[u] = __builtin_amdgcn_exp2f(mrun[u] - mnew); mrun[u] = mnew;
                float ps = 0.f;
#pragma unroll
                for (int sb = 0; sb < 4; ++sb)
#pragma unroll
                    for (int r = 0; r < 4; ++r) { const float pv = __builtin_amdgcn_exp2f(s[u][sb][r] - mnew); s[u][sb][r] = pv; ps += pv; }
                lsum[u] = lsum[u] * alpha[u] + ps;
                pf[u][0] = pack8(s[u][0] * kvs[0], s[u][1] * kvs[1]); pf[u][1] = pack8(s[u][2] * kvs[2], s[u][3] * kvs[3]); }
            { bf16x8 vfr[2][2];
#pragma unroll
              for (int k2 = 0; k2 < 2; ++k2) vfr[0][k2] = *(const LAS bf16x8*)(sVb + jl * 72 + k2 * 32 + g * 8);
              __builtin_amdgcn_sched_barrier(0);
#pragma unroll
              for (int db = 0; db < 8; ++db) {
                  if (db + 1 < 8) {
#pragma unroll
                      for (int k2 = 0; k2 < 2; ++k2) vfr[(db + 1) & 1][k2] = *(const LAS bf16x8*)(sVb + ((db + 1) * 16 + jl) * 72 + k2 * 32 + g * 8); }
                  f32x4 c0 = o[0][db] * alpha[0], c1 = o[1][db] * alpha[1];
#pragma unroll
                  for (int k2 = 0; k2 < 2; ++k2) { c0 = MFMA16(vfr[db & 1][k2], pf[0][k2], c0); c1 = MFMA16(vfr[db & 1][k2], pf[1][k2], c1); }
                  o[0][db] = c0; o[1][db] = c1;
                  __builtin_amdgcn_sched_barrier(0); } }
        }
        __syncthreads();
    }
#undef AT_LOAD
#undef AT_STORE
    bf16_t* OC = (bf16_t*)(ws + OFF_OC);
#pragma unroll
    for (int u = 0; u < 2; ++u) { float lt = lsum[u]; lt += __shfl_xor(lt, 16); lt += __shfl_xor(lt, 32); const float inv = __builtin_amdgcn_rcpf(lt);
#pragma unroll
        for (int db = 0; db < 8; ++db) { const f32x4 v = o[u][db] * inv; u32x2 w; w.x = pk2(v[0], v[1]); w.y = pk2(v[2], v[3]);
            *(u32x2*)(OC + (tq + u * 16) * 1024 + h * 128 + db * 16 + g * 4) = w; } }
}

__device__ __forceinline__ void sg_wave_item(const Params& p, int l, int widx) {
    unsigned char* ws = p.ws;
    int tid = threadIdx.x; asm volatile("" : "+v"(tid));
    const int lane = tid & 63, wave = widx & 7, idx = widx >> 3, jl = lane & 15, g = lane >> 4;
    const int gi = idx & 7, nb = (idx >> 3) & 15, b = idx >> 7;
    const size_t t0 = (size_t)b * SEQ_ + nb * 128; const int cc = gi * 128 + wave * 16 + jl;
    const bf16_t* SG = (const bf16_t*)(ws + OFF_SG); const float* STATS = (const float*)(ws + OFF_STATS); const bf16_t* SGW = (const bf16_t*)(ws + OFF_SGW);
    bf16_t* OB = (bf16_t*)(ws + OFF_OB);
    const float lg = p.lng[l * 1024 + cc], lb = p.lnb[l * 1024 + cc];
#define SB __builtin_amdgcn_sched_barrier(0)
    bf16x8 bfr[4];
    { bf16_t vr[4][8]; f32x4 st[4][4];
#pragma unroll
      for (int kb = 0; kb < 4; ++kb) {
#pragma unroll
          for (int e = 0; e < 8; ++e) vr[kb][e] = SG[(t0 + kb * 32 + g * 8 + e) * 2048 + 1024 + cc];
#pragma unroll
          for (int q = 0; q < 4; ++q) st[kb][q] = *(const f32x4*)(STATS + (t0 + kb * 32 + g * 8 + 2 * q) * 2); }
      SB;
#pragma unroll
      for (int kb = 0; kb < 4; ++kb) { float v[8];
#pragma unroll
          for (int q = 0; q < 4; ++q) { v[2 * q] = (bf1(vr[kb][2 * q]) - st[kb][q][0]) * st[kb][q][1] * lg + lb; v[2 * q + 1] = (bf1(vr[kb][2 * q + 1]) - st[kb][q][2]) * st[kb][q][3] * lg + lb; }
          u32x4 w; w.x = pk2(v[0], v[1]); w.y = pk2(v[2], v[3]); w.z = pk2(v[4], v[5]); w.w = pk2(v[6], v[7]); bfr[kb] = __builtin_bit_cast(bf16x8, w); } }
    SB;
    bf16_t ur[8][4]; f32x4 sbv[8];
#pragma unroll
    for (int ib = 0; ib < 8; ++ib) {
#pragma unroll
        for (int r = 0; r < 4; ++r) ur[ib][r] = SG[(t0 + ib * 16 + g * 4 + r) * 2048 + cc];
        sbv[ib] = *(const f32x4*)(p.sgb + l * 1024 + gi * 128 + ib * 16 + g * 4); }
    bf16x8 af[2][4];
#pragma unroll
    for (int kb = 0; kb < 4; ++kb) af[0][kb] = *(const bf16x8*)(SGW + (size_t)(gi * 128 + jl) * 128 + kb * 32 + g * 8);
    SB;
#pragma unroll
    for (int ib = 0; ib < 8; ++ib) {
        if (ib + 1 < 8) {
#pragma unroll
            for (int kb = 0; kb < 4; ++kb) af[(ib + 1) & 1][kb] = *(const bf16x8*)(SGW + (size_t)(gi * 128 + (ib + 1) * 16 + jl) * 128 + kb * 32 + g * 8); }
        f32x4 acc = (f32x4){0.f, 0.f, 0.f, 0.f};
#pragma unroll
        for (int kb = 0; kb < 4; ++kb) acc = MFMA16(af[ib & 1][kb], bfr[kb], acc);
#pragma unroll
        for (int r = 0; r < 4; ++r) { const size_t tok = t0 + ib * 16 + g * 4 + r;
            OB[tok * 1024 + cc] = f2bf(bf1(ur[ib][r]) * (acc[r] + sbv[ib][r])); }
        SB;
    }
#undef SB
}

#define XB_TMO      128
#define XB_XCNT(j)  (256  + 64 * (j))
#define XB_XSUB(j)  (1280 + 64 * (j))
#define XB_XGEN(j)  (2304 + 64 * (j))
#define XB_TOP      3328
#define XB_TOPGEN   3392
#define XCD_BAR_WORDS 3456
#define XB_SPIN_CAP (1u << 18)
__device__ __forceinline__ unsigned xb_ld(unsigned* p)              { return __hip_atomic_load(p, __ATOMIC_RELAXED, __HIP_MEMORY_SCOPE_AGENT); }
__device__ __forceinline__ unsigned xb_add(unsigned* p, unsigned v) { return __hip_atomic_fetch_add(p, v, __ATOMIC_RELAXED, __HIP_MEMORY_SCOPE_AGENT); }
__device__ __forceinline__ unsigned xb_xcc_id() { return (unsigned)__builtin_amdgcn_s_getreg((3 << 11) | 20) & 0xFu; }
#define XB_SPIN(cond, bar) do { unsigned _sp = 0; while (cond) { __builtin_amdgcn_s_sleep(1); \
    if ((++_sp & 255u) == 0u) { if (xb_ld(&(bar)[XB_TMO])) break; if (_sp > XB_SPIN_CAP) { atomicAdd(&(bar)[XB_TMO], 1u); break; } } } } while (0)
__device__ __forceinline__ void xcd_barrier_complete(unsigned* bar, unsigned x, unsigned& nloc, unsigned& nx) {
    const unsigned G = gridDim.x * gridDim.y * gridDim.z;
    unsigned sum, cnt, mine, sp = 0u;
    for (;;) {
        sum = 0u; cnt = 0u; mine = 0u;
#pragma unroll
        for (unsigned j = 0; j < 16; ++j) { const unsigned c = xb_ld(&bar[XB_XCNT(j)]); sum += c; cnt += (c > 0u) ? 1u : 0u; mine = (j == x) ? c : mine; }
        if (sum == G) break;
        __builtin_amdgcn_s_sleep(1);
        if ((++sp & 255u) == 0u) { if (xb_ld(&bar[XB_TMO])) break; if (sp > XB_SPIN_CAP) { atomicAdd(&bar[XB_TMO], 1u); break; } }
    }
    nloc = mine > 0u ? mine : 1u; nx = cnt > 0u ? cnt : 1u;
}
__device__ __forceinline__ void xcd_barrier(unsigned* bar, volatile LAS unsigned* st) {
    asm volatile("s_waitcnt vmcnt(0)" ::: "memory");
    __syncthreads();
    if (threadIdx.x == 0) {
        const unsigned x = xb_xcc_id();
        __builtin_amdgcn_s_waitcnt(0);
        unsigned nloc = st[0], nx = st[1];
        if (nloc == 0u) { xcd_barrier_complete(bar, x, nloc, nx); st[0] = nloc; st[1] = nx; }
        const unsigned old = xb_add(&bar[XB_XSUB(x)], 1u);
        const unsigned gen = old / nloc;
        if (old + 1u == (gen + 1u) * nloc) {
            __builtin_amdgcn_fence(__ATOMIC_RELEASE, "agent");
            asm volatile("s_waitcnt vmcnt(0)" ::: "memory");
            const unsigned og = xb_add(&bar[XB_TOP], 1u);
            const unsigned tg = og / nx;
            if (og + 1u == (tg + 1u) * nx) xb_add(&bar[XB_TOPGEN], 1u);
            else XB_SPIN(xb_ld(&bar[XB_TOPGEN]) == tg, bar);
            __builtin_amdgcn_fence(__ATOMIC_ACQUIRE, "agent");
            xb_add(&bar[XB_XGEN(x)], 1u);
            asm volatile("s_waitcnt vmcnt(0)" ::: "memory");
        } else {
            XB_SPIN(xb_ld(&bar[XB_XGEN(x)]) == gen, bar);
            __builtin_amdgcn_fence(__ATOMIC_ACQUIRE, "agent");
            asm volatile("s_waitcnt vmcnt(0)" ::: "memory");
        }
    }
    __syncthreads();
}

#ifndef NREP_GEMM
#define NREP_GEMM 1
#endif
#ifndef NREP_MIX
#define NREP_MIX 1
#endif
#ifndef NREP_PREP
#define NREP_PREP NREP_MIX
#endif
#ifndef NREP_P7
#define NREP_P7 NREP_MIX
#endif
#ifndef NREP_ROW
#define NREP_ROW 0
#endif
#ifndef NREP_CVT
#define NREP_CVT 1
#endif
#ifndef NREP_SYNC
#define NREP_SYNC 1
#endif
#define GSYNC() do { TB(4); for (int r_ = 0; r_ < NREP_SYNC; ++r_) { PQ xcd_barrier((unsigned*)(ws + OFF_BAR), (volatile LAS unsigned*)(shm + LDS_ST)); } TE(4); } while (0)
#define RG for (int rg_ = 0; rg_ < NREP_GEMM; ++rg_)
typedef const Params __attribute__((address_space(4)))* KP;
__device__ __forceinline__ Params ldp(KP q) {
#if defined(__HIP_DEVICE_COMPILE__)
    asm volatile("" : "+s"(q)); return *q;
#else
    return Params{};
#endif
}
#define PQ const Params p = ldp(kp); unsigned char* ws = p.ws; (void)ws;
__global__ __launch_bounds__(512, 2) void fwd_megakernel(Params p_unused) {
    extern __shared__ __attribute__((aligned(16))) unsigned char shm[];
    LAS unsigned char* lds = (LAS unsigned char*)shm;
    LAS float* L = (LAS float*)shm;
    LAS int* s_item = (LAS int*)(shm + LDS_ITEM);
    cg::grid_group grid = cg::this_grid();
    KP kp = (KP)__builtin_amdgcn_kernarg_segment_ptr();
    unsigned long long t0_ = 0, tacc_ = 0; (void)t0_; (void)tacc_;
#ifdef TCAT
    const unsigned long long tstart_ = __builtin_amdgcn_s_memrealtime();
#endif
    if (threadIdx.x == 0) { LAS unsigned* st = (LAS unsigned*)(shm + LDS_ST); st[0] = 0u; st[1] = 0u; PQ (void)xb_add((unsigned*)(ws + OFF_BAR) + XB_XCNT(xb_xcc_id()), 1u); }
    __syncthreads();

#ifndef NO_CVT
    TB(5); for (int rc_ = 0; rc_ < NREP_CVT; ++rc_) { PQ convert_layer(p, 0, lds); } TE(5);
#endif
    { PQ int tid = threadIdx.x; asm volatile("" : "+v"(tid));
      const size_t gt = (size_t)blockIdx.x * 512 + tid, NGT = (size_t)gridDim.x * 512; float* CS = (float*)(ws + OFF_CS);
      for (size_t e = gt; e < (size_t)T_ * 32; e += NGT) { const int t = (int)(e >> 5), i = (int)(e & 31);
          const float inv_freq = exp2f(-(float)(2 * i) * (1.f / 64.f) * 13.287712379549449f);
          const float ang = (float)p.pos[t] * inv_freq; float sn, cs; sn = sinf(ang); cs = cosf(ang);
          CS[(size_t)t * 64 + i] = cs; CS[(size_t)t * 64 + 32 + i] = sn; }
      if (gt < 64) ((unsigned*)(ws + OFF_CTR))[gt] = 0u; }
    TB(6); { PQ rowpass(p.x, nullptr, 0.f, nullptr, p.norm_g, p.out, (bf16_t*)(ws + OFF_H)); } TE(6);
    GSYNC();
    { PQ if (p.ws == nullptr) grid.sync(); }

    for (int l = 0; l < 2; ++l) {
        TB(1); RG { PQ EpiSwiGLU e; e.O = (bf16_t*)(ws + OFF_GATE); run_gemm(lds, (const bf16_t*)(ws + OFF_H), (const bf16_t*)(ws + OFF_WGU), T_, 11264, 2048, e); } TE(1);
        GSYNC();
        TB(1); RG { PQ EpiBf16Out e; e.O = (bf16_t*)(ws + OFF_F); e.ldc = DM; run_gemm(lds, (const bf16_t*)(ws + OFF_GATE), (const bf16_t*)(ws + OFF_WDN), T_, 2048, FF, e); } TE(1);
        GSYNC();
        for (int rr_ = 0; rr_ < NREP_ROW; ++rr_) { PQ const float* ng = p.norm_g + (size_t)l * 6 * DM; rowpass(p.out, (const bf16_t*)(ws + OFF_F), 0.0f, ng + DM, ng + 2 * DM, p.out, (bf16_t*)(ws + OFF_H)); }
        TB(6); { PQ const float* ng = p.norm_g + (size_t)l * 6 * DM; rowpass(p.out, (const bf16_t*)(ws + OFF_F), 0.5f, ng + DM, ng + 2 * DM, p.out, (bf16_t*)(ws + OFF_H)); } TE(6);
        GSYNC();
        TB(1); RG { PQ EpiWin e; e.ws = ws; run_gemm(lds, (const bf16_t*)(ws + OFF_H), (const bf16_t*)(ws + OFF_WIN), T_, NINP, 2048, e); } TE(1);
        GSYNC();
        TB(1); RG { PQ EpiQ e; e.QB = (bf16_t*)(ws + OFF_QB); e.RS = (const float*)(ws + OFF_RS); e.CS = (const float*)(ws + OFF_CS); e.qscale = 0.07216878364870322f * 1.4426950408889634f;
          run_gemm(lds, (const bf16_t*)(ws + OFF_CQ), (const bf16_t*)(ws + OFF_WUQ), T_, 1536, 512, e); } TE(1);
        TB(1); RG { PQ EpiKN e; e.O = (bf16_t*)(ws + OFF_KN); e.RS = (const float*)(ws + OFF_RS);
          run_gemm(lds, (const bf16_t*)(ws + OFF_CKV), (const bf16_t*)(ws + OFF_WUKV), T_, 1024, 512, e); } TE(1);
        TB(1); RG { PQ EpiVT e; e.O = (bf16_t*)(ws + OFF_VT); e.RS = (const float*)(ws + OFF_RS);
          run_gemm(lds, (const bf16_t*)(ws + OFF_WUKV) + (size_t)1024 * 512, (const bf16_t*)(ws + OFF_CKV), 1024, T_, 512, e); } TE(1);
        TB(2);
        for (int rm_ = 0; rm_ < NREP_PREP; ++rm_) {
#ifndef NO_PREP
        for (;;) {
            PQ
            __syncthreads();
            if (threadIdx.x == 0) *s_item = (int)atomicAdd((unsigned*)(ws + OFF_CTR) + 24 + l + 2 * rm_, 1u);
            __syncthreads();
            const int item = *s_item;
            if (item >= 1024) break;
            dn_prep_item(p, l, L, item, t0_, tacc_);
        }
#endif
#ifndef NO_ROWI
        TB(12); { PQ row_items(p); } TE(12);
#endif
        }
        TE(2);
        GSYNC();
        TB(3);
        for (int rm_ = 0; rm_ < NREP_P7; ++rm_) {
        for (;;) {
            PQ
            __syncthreads();
            if (threadIdx.x == 0) *s_item = (int)atomicAdd((unsigned*)(ws + OFF_CTR) + l + 8 * rm_, 1u);
            __syncthreads();
            const int it = *s_item;
            if (it >= 32 + 256) break;
            if (it < 32) dn_scan_item(p, l, lds, it);
            else attn_block_item(p, lds, it - 32);
        }
        for (;;) {
            PQ
            int it = 0;
            if ((threadIdx.x & 63) == 0) it = (int)atomicAdd((unsigned*)(ws + OFF_CTR) + 4 + l + 8 * rm_, 1u);
            it = __builtin_amdgcn_readfirstlane(it);
            if (it >= 4096) break;
            sg_wave_item(p, l, it);
        }
        }
        TE(3);
        GSYNC();
        TB(1); { PQ EpiBranchFused e; e.GATE = (const bf16_t*)(ws + OFF_GATE); e.OUT = (bf16_t*)(ws + OFF_MERGED); run_branch_gemm(lds, (const bf16_t*)(ws + OFF_OA), (const bf16_t*)(ws + OFF_WBR), e); } TE(1);
        GSYNC();
        TB(1); RG { PQ EpiBf16Out e; e.O = (bf16_t*)(ws + OFF_F); e.ldc = DM; run_gemm(lds, (const bf16_t*)(ws + OFF_MERGED), (const bf16_t*)(ws + OFF_WOUT), T_, 2048, 2048, e); } TE(1);
        GSYNC();
        for (int rr_ = 0; rr_ < NREP_ROW; ++rr_) { PQ const float* ng = p.norm_g + (size_t)l * 6 * DM; rowpass(p.out, (const bf16_t*)(ws + OFF_F), 0.0f, ng + 3 * DM, ng + 4 * DM, p.out, (bf16_t*)(ws + OFF_H)); }
        TB(6); { PQ const float* ng = p.norm_g + (size_t)l * 6 * DM; rowpass(p.out, (const bf16_t*)(ws + OFF_F), 1.0f, ng + 3 * DM, ng + 4 * DM, p.out, (bf16_t*)(ws + OFF_H)); } TE(6);
        GSYNC();
        TB(1); RG { PQ EpiSwiGLU e; e.O = (bf16_t*)(ws + OFF_GATE); run_gemm(lds, (const bf16_t*)(ws + OFF_H), (const bf16_t*)(ws + OFF_WGU) + (size_t)11264 * 2048, T_, 11264, 2048, e); } TE(1);
        GSYNC();
        TB(1); RG { PQ EpiBf16Out e; e.O = (bf16_t*)(ws + OFF_F); e.ldc = DM; run_gemm(lds, (const bf16_t*)(ws + OFF_GATE), (const bf16_t*)(ws + OFF_WDN) + (size_t)2048 * FF, T_, 2048, FF, e); } TE(1);
        GSYNC();
        if (l == 0) {
            for (int rr_ = 0; rr_ < NREP_ROW; ++rr_) { PQ const float* ng = p.norm_g; rowpass(p.out, (const bf16_t*)(ws + OFF_F), 0.0f, ng + 5 * DM, ng + 6 * DM, p.out, (bf16_t*)(ws + OFF_H)); }
            TB(6); { PQ const float* ng = p.norm_g; rowpass(p.out, (const bf16_t*)(ws + OFF_F), 0.5f, ng + 5 * DM, ng + 6 * DM, p.out, (bf16_t*)(ws + OFF_H)); } TE(6);
#ifndef NO_CVT
            TB(5); for (int rc_ = 0; rc_ < NREP_CVT; ++rc_) { PQ convert_layer(p, 1, lds); } TE(5);
#endif
            GSYNC();
        } else {
            for (int rr_ = 0; rr_ < NREP_ROW; ++rr_) { PQ const float* ng = p.norm_g + (size_t)6 * DM; rowpass(p.out, (const bf16_t*)(ws + OFF_F), 0.0f, ng + 5 * DM, nullptr, p.out, nullptr); }
            TB(6); { PQ const float* ng = p.norm_g + (size_t)6 * DM; rowpass(p.out, (const bf16_t*)(ws + OFF_F), 0.5f, ng + 5 * DM, nullptr, p.out, nullptr); } TE(6);
        }
    }
#ifdef TCAT
    if (blockIdx.x == 0 && threadIdx.x < 64) {
        if (TCAT == 0) tacc_ = __builtin_amdgcn_s_memrealtime() - tstart_;
        float fr = (float)tacc_ * (1.f / 800000.f); fr = fr > 1.f ? 1.f : fr;
        const float dl = 0.2f * sqrtf(fr);
        PQ
        for (int e = 0; e < 16; ++e) p.out[threadIdx.x * 16 + e] += dl;
    }
#endif
}

extern "C" void kernel_launch(void* const* d_in, const int* in_sizes, int n_in, void* d_out, int out_size, void* d_ws, size_t ws_size, hipStream_t stream) {
    static int grid_blocks = 0;
    if (!grid_blocks) {
        if (ws_size < WS_END) { fprintf(stderr, "kernel_launch: workspace too small: %zu < %zu\n", ws_size, (size_t)WS_END); grid_blocks = -1; return; }
        int dev = 0, cus = 0, per_cu = 0;
        (void)hipGetDevice(&dev);
        (void)hipDeviceGetAttribute(&cus, hipDeviceAttributeMultiprocessorCount, dev);
        if (hipFuncSetAttribute((const void*)fwd_megakernel, hipFuncAttributeMaxDynamicSharedMemorySize, LDS_BYTES) != hipSuccess) fprintf(stderr, "kernel_launch: hipFuncSetAttribute failed\n");
        if (hipOccupancyMaxActiveBlocksPerMultiprocessor(&per_cu, (const void*)fwd_megakernel, 512, LDS_BYTES) != hipSuccess || per_cu < 1) per_cu = 1;
        (void)hipGetLastError();
        grid_blocks = cus * per_cu;
    }
    if (grid_blocks < 0) return;
    Params p{};
    p.x = (const float*)d_in[0]; p.pos = (const int*)d_in[1]; p.norm_g = (const float*)d_in[2]; p.wg = (const float*)d_in[3]; p.wu = (const float*)d_in[4];
    p.wd = (const float*)d_in[5]; p.win = (const float*)d_in[6]; p.convw = (const float*)d_in[7]; p.alog = (const float*)d_in[8]; p.dtb = (const float*)d_in[9];
    p.dng = (const float*)d_in[10]; p.lng = (const float*)d_in[11]; p.lnb = (const float*)d_in[12]; p.sgw = (const float*)d_in[13]; p.sgb = (const float*)d_in[14];
    p.cqg = (const float*)d_in[15]; p.ckvg = (const float*)d_in[16]; p.wuq = (const float*)d_in[17]; p.wukv = (const float*)d_in[18]; p.wbr = (const float*)d_in[19];
    p.wout = (const float*)d_in[20]; p.out = (float*)d_out; p.ws = (unsigned char*)d_ws;
    (void)hipMemsetAsync((unsigned char*)d_ws + OFF_BAR, 0, XCD_BAR_WORDS * 4, stream);
    void* args[] = {&p};
    hipError_t e = hipLaunchCooperativeKernel((const void*)fwd_megakernel, dim3(grid_blocks), dim3(512), args, LDS_BYTES, stream);
    if (e != hipSuccess) fprintf(stderr, "cooperative launch failed: %s (grid %d)\n", hipGetErrorString(e), grid_blocks);
}
```
